# Optimizing an MI355X kernel written in HIP

```python
import numpy as np
import jax
import jax.numpy as jnp
from jax import lax

D_MODEL = 1024
BATCH = 2
SEQ = 16384
DEPTH = 2

GRID_W = 64
CTX_LEN = 256
HEAD_DIM = 64
N_Q_HEADS = 8
N_KV_HEADS = 2
WINDOW = 128
ATTN_BLOCK = 128
ROPE_THETA = 10000.0
POOL_WIDTH = 256
POOL_WINDOWS = (2, 4, 8, 16)
RET_HEADS = 4
RET_DIM = 64
RET_CHUNK = 128
N_EXPERTS = 32
TOP_K = 4
D_FF = 1024
SWIGLU_LIMIT = 7.0
SWIGLU_ALPHA = 1.702
MOE_BLOCK = 128
NORM_EPS = 1e-6
GN_EPS = 1e-5

ATTN_Q_WIDTH = N_Q_HEADS * HEAD_DIM
ATTN_KV_WIDTH = N_KV_HEADS * HEAD_DIM
RET_WIDTH = RET_HEADS * RET_DIM
IN_SPLIT_SIZES = (ATTN_Q_WIDTH, ATTN_KV_WIDTH, ATTN_KV_WIDTH, POOL_WIDTH, RET_WIDTH, RET_WIDTH, RET_WIDTH, RET_WIDTH, RET_WIDTH, D_MODEL, D_MODEL, D_MODEL)
IN_WIDTH = sum(IN_SPLIT_SIZES)

kernel_name = 'hybrid_gated_parallel_mixer_moe_dit'

F32 = jnp.float32


def rmsnorm(x, g):
    x32 = x.astype(F32)
    y = x32 * lax.rsqrt(jnp.mean(x32 * x32, axis=-1, keepdims=True) + NORM_EPS)
    return (y * g.astype(F32)).astype(x.dtype)


def heads(t, n):
    return t.reshape(t.shape[0], t.shape[1], n, -1)


def rotate(x, pos, inv_freq):
    ang = pos[:, None] * inv_freq[None, :]
    cos = jnp.cos(ang)[None, :, None, :]
    sin = jnp.sin(ang)[None, :, None, :]
    half = x.shape[-1] // 2
    x1 = x[..., :half].astype(F32)
    x2 = x[..., half:].astype(F32)
    return jnp.concatenate([x1 * cos - x2 * sin, x1 * sin + x2 * cos], axis=-1).astype(x.dtype)


def axial_rope(x, row, col):
    axis_dim = x.shape[-1] // 2
    inv = ROPE_THETA ** (-jnp.arange(0, axis_dim, 2, dtype=F32) / axis_dim)
    return jnp.concatenate([rotate(x[..., :axis_dim], row, inv), rotate(x[..., axis_dim:], col, inv)], axis=-1)


def retention_rotation(x, pos):
    dr = x.shape[-1]
    inv = 1.0 / (ROPE_THETA ** jnp.linspace(0.0, 1.0, dr // 2, dtype=F32))
    return rotate(x, pos, inv)


def sink_softmax(s, sink):
    sink_col = jnp.broadcast_to(sink.astype(F32), s.shape[:-1] + (1,))
    return jax.nn.softmax(jnp.concatenate([s, sink_col], axis=-1), axis=-1)[..., :-1]


def window_attention(q, k, v, ck, cv, sinks):
    B, L, Hq, d = q.shape
    Hkv = k.shape[2]
    G = Hq // Hkv
    C = ATTN_BLOCK
    N = L // C
    qb = (q * d ** -0.5).reshape(B, N, C, Hkv, G, d)
    pad = jnp.zeros((B, C, Hkv, d), k.dtype)

    def band(t):
        tp = jnp.concatenate([pad, t, pad], axis=1).reshape(B, N + 2, C, Hkv, d)
        return jnp.concatenate([tp[:, :-2], tp[:, 1:-1], tp[:, 2:]], axis=2)

    kw, vw = band(k), band(v)
    rel = jnp.arange(3 * C)[None, :] - C - jnp.arange(C)[:, None]
    kpos = (jnp.arange(N)[:, None] - 1) * C + jnp.arange(3 * C)[None, :]
    valid = (jnp.abs(rel)[None] <= WINDOW) & ((kpos >= 0) & (kpos < L))[:, None, :]
    s_loc = jnp.einsum('bnqhgd,bnkhd->bnhgqk', qb, kw).astype(F32)
    s_loc = jnp.where(valid[None, :, None, None], s_loc, -jnp.inf)
    s_ctx = jnp.einsum('bnqhgd,bchd->bnhgqc', qb, ck).astype(F32)
    p = sink_softmax(jnp.concatenate([s_loc, s_ctx], axis=-1), sinks.reshape(1, 1, Hkv, G, 1, 1)).astype(v.dtype)
    o = (jnp.einsum('bnhgqk,bnkhd->bnqhgd', p[..., :3 * C], vw)
         + jnp.einsum('bnhgqc,bchd->bnqhgd', p[..., 3 * C:], cv))
    return o.reshape(B, L, Hq * d)


def context_attention(cq, ck, cv, sinks):
    B, Lc, Hq, d = cq.shape
    Hkv = ck.shape[2]
    G = Hq // Hkv
    qg = (cq * d ** -0.5).reshape(B, Lc, Hkv, G, d)
    s = jnp.einsum('bqhgd,bkhd->bhgqk', qg, ck).astype(F32)
    p = sink_softmax(s, sinks.reshape(1, Hkv, G, 1, 1)).astype(cv.dtype)
    return jnp.einsum('bhgqk,bkhd->bqhgd', p, cv).reshape(B, Lc, Hq * d)


def multiscale_pool(u, pool_w, pool_scale):
    B, L, P = u.shape
    gw = P // len(POOL_WINDOWS)
    uf = u.astype(F32)
    cs = jnp.concatenate([jnp.zeros((B, 1, P), F32), lax.cumsum(uf, axis=1)], axis=1)
    t = jnp.arange(L)
    outs = []
    for g, w in enumerate(POOL_WINDOWS):
        lo = jnp.clip(t - w // 2, 0, L)
        hi = jnp.clip(t - w // 2 + w, 0, L)
        sl = slice(g * gw, (g + 1) * gw)
        mean = (cs[:, hi, sl] - cs[:, lo, sl]) / (hi - lo).astype(F32)[None, :, None]
        diff = (mean - uf[:, :, sl]).astype(u.dtype)
        outs.append(jnp.einsum('blc,ce->ble', diff, pool_w[g]))
    return jnp.concatenate(outs, axis=-1) * pool_scale


def retention_scan(q, k, v, log_g, s0):
    B, L, H, dk = q.shape
    dv = v.shape[-1]
    C = RET_CHUNK
    N = L // C
    qc = q.astype(F32).reshape(B, N, C, H, dk)
    kc = k.astype(F32).reshape(B, N, C, H, dk)
    vc = v.astype(F32).reshape(B, N, C, H, dv)
    i = jnp.arange(C, dtype=F32)
    rel = i[:, None] - i[None, :]
    dmat = jnp.where(rel[None] >= 0, jnp.exp(jnp.maximum(rel, 0.0)[None] * log_g[:, None, None]), 0.0)
    intra = jnp.einsum('bnihd,bnjhd->bnhij', qc, kc) * dmat
    y_intra = jnp.einsum('bnhij,bnjhe->bnihe', intra, vc)
    k_decay = jnp.exp((C - 1 - i)[None, :] * log_g[:, None])
    kv = jnp.einsum('bnjhd,hj,bnjhe->nbhde', kc, k_decay, vc)
    chunk_decay = jnp.exp(C * log_g)[:, None, None]

    def step(s, kv_n):
        return s * chunk_decay + kv_n, s

    s_final, s_prev = lax.scan(step, s0, kv)
    q_decay = jnp.exp((i + 1)[None, :] * log_g[:, None])
    y_cross = jnp.einsum('bnihd,hi,nbhde->bnihe', qc, q_decay, s_prev)
    return (y_intra + y_cross).reshape(B, L, H, dv), s_final


def context_final_state(k, v, log_g):
    Lc = k.shape[1]
    w = jnp.exp((Lc - 1 - jnp.arange(Lc, dtype=F32))[:, None] * log_g[None, :])
    return jnp.einsum('bmhd,mh,bmhe->bhde', k.astype(F32), w, v.astype(F32))


def head_norm(y):
    mu = jnp.mean(y, axis=-1, keepdims=True)
    var = jnp.mean(jnp.square(y - mu), axis=-1, keepdims=True)
    return (y - mu) * lax.rsqrt(var + GN_EPS)


def retention_bidir(q, k, v, gf, gb, log_g, s_f0, s_b0):
    B, L = q.shape[0], q.shape[1]
    y_f, s_f = retention_scan(q, k, v, log_g[0], s_f0)
    y_b, s_b = retention_scan(jnp.flip(q, 1), jnp.flip(k, 1), jnp.flip(v, 1), log_g[1], s_b0)
    y = (head_norm(y_f) * jax.nn.silu(gf.astype(F32))
         + head_norm(jnp.flip(y_b, 1)) * jax.nn.silu(gb.astype(F32)))
    return y.reshape(B, L, -1).astype(q.dtype), s_f, s_b


def merge_branches(attn, pool, ret, ga, gp, gr, w_o_attn, w_o_pool, w_o_ret, w_out):
    m = (jax.nn.sigmoid(ga) * (attn @ w_o_attn)
         + jax.nn.sigmoid(gp) * (pool @ w_o_pool)
         + jax.nn.sigmoid(gr) * (ret @ w_o_ret))
    return m @ w_out


def token_mixer(h, hc, w_in, attn_sinks, pool_w, pool_scale, ret_decay, w_o_attn, w_o_pool, w_o_ret, w_out, with_ctx_out):
    B, L, _ = h.shape
    split_at = np.cumsum(IN_SPLIT_SIZES)[:-1].tolist()
    q, k, v, u, rq, rk, rv, rgf, rgb, ga, gp, gr = jnp.split(h @ w_in, split_at, axis=-1)
    cq, ck, cv, cu, crq, crk, crv, crgf, crgb, cga, cgp, cgr = jnp.split(hc @ w_in, split_at, axis=-1)
    rows = L // GRID_W
    row = jnp.broadcast_to(jnp.arange(rows, dtype=F32)[:, None], (rows, GRID_W)).reshape(-1)
    col = jnp.broadcast_to(jnp.arange(GRID_W, dtype=F32)[None, :], (rows, GRID_W)).reshape(-1)
    tpos = jnp.arange(L, dtype=F32)

    ck = heads(ck, N_KV_HEADS)
    cv = heads(cv, N_KV_HEADS)
    attn = window_attention(axial_rope(heads(q, N_Q_HEADS), row, col), axial_rope(heads(k, N_KV_HEADS), row, col),
                            heads(v, N_KV_HEADS), ck, cv, attn_sinks)
    pool = multiscale_pool(u, pool_w, pool_scale)
    log_g = jax.nn.log_sigmoid(ret_decay.astype(F32))
    k_scale = RET_DIM ** -0.5
    crk_h = heads(crk, RET_HEADS) * k_scale
    crv_h = heads(crv, RET_HEADS)
    if with_ctx_out:
        s0 = jnp.zeros((B, RET_HEADS, RET_DIM, RET_DIM), F32)
        ret_c, s_f, s_b = retention_bidir(heads(crq, RET_HEADS), crk_h, crv_h, heads(crgf, RET_HEADS),
                                          heads(crgb, RET_HEADS), log_g, s0, s0)
    else:
        s_f = context_final_state(crk_h, crv_h, log_g[0])
        s_b = context_final_state(jnp.flip(crk_h, 1), jnp.flip(crv_h, 1), log_g[1])
    rq_h = retention_rotation(heads(rq, RET_HEADS), tpos)
    rk_h = retention_rotation(heads(rk, RET_HEADS), tpos) * k_scale
    ret, _, _ = retention_bidir(rq_h, rk_h, heads(rv, RET_HEADS), heads(rgf, RET_HEADS), heads(rgb, RET_HEADS),
                                log_g, s_f, s_b)
    out = merge_branches(attn, pool, ret, ga, gp, gr, w_o_attn, w_o_pool, w_o_ret, w_out)
    if not with_ctx_out:
        return out, None
    attn_c = context_attention(heads(cq, N_Q_HEADS), ck, cv, attn_sinks)
    pool_c = multiscale_pool(cu, pool_w, pool_scale)
    out_c = merge_branches(attn_c, pool_c, ret_c, cga, cgp, cgr, w_o_attn, w_o_pool, w_o_ret, w_out)
    return out, out_c


def moe(h, w_router, b_router, w1, b1, w2, b2):
    T, D = h.shape
    logits = (h @ w_router + b_router).astype(F32)
    top_logits, top_idx = lax.top_k(logits, TOP_K)
    gates = jax.nn.softmax(top_logits, axis=-1)
    A = T * TOP_K
    flat_e = top_idx.reshape(-1)
    flat_tok = jnp.arange(A, dtype=jnp.int32) // TOP_K
    flat_w = gates.reshape(-1)
    order = jnp.argsort(flat_e)
    sorted_e = flat_e[order]
    counts = jnp.bincount(flat_e, length=N_EXPERTS)
    start = jnp.cumsum(counts) - counts
    padded = (counts + MOE_BLOCK - 1) // MOE_BLOCK * MOE_BLOCK
    pad_end = jnp.cumsum(padded)
    pad_start = pad_end - padded
    dest = pad_start[sorted_e] + jnp.arange(A) - start[sorted_e]
    n_blocks = -(-A // MOE_BLOCK) + N_EXPERTS
    P = n_blocks * MOE_BLOCK
    row_tok = jnp.zeros((P,), jnp.int32).at[dest].set(flat_tok[order])
    row_w = jnp.zeros((P,), F32).at[dest].set(flat_w[order])
    block_e = jnp.minimum(jnp.searchsorted(pad_end, jnp.arange(n_blocks) * MOE_BLOCK, side='right'), N_EXPERTS - 1)
    xb = h[row_tok].reshape(n_blocks, MOE_BLOCK, D)

    def expert_block(args):
        xblk, e = args
        hid = xblk @ w1[e] + b1[e]
        glu = jnp.minimum(hid[:, :D_FF], SWIGLU_LIMIT)
        lin = jnp.clip(hid[:, D_FF:], -SWIGLU_LIMIT, SWIGLU_LIMIT)
        act = glu * jax.nn.sigmoid(SWIGLU_ALPHA * glu) * (lin + 1)
        return act @ w2[e] + b2[e]

    yb = lax.map(expert_block, (xb, block_e)).reshape(P, D)
    y = jax.ops.segment_sum(yb.astype(F32) * row_w[:, None], row_tok, num_segments=T)
    return y.astype(h.dtype)


def setup_inputs(seed: int = 0) -> dict:
    key = jax.random.key(seed)
    ks = jax.random.split(key, 24)
    D = D_MODEL
    gw = POOL_WIDTH // len(POOL_WINDOWS)

    def nrm(k, shape, s):
        return jax.random.normal(k, shape, F32) * s

    base_decay = jnp.log(2.0 ** (5.0 + jnp.arange(RET_HEADS, dtype=F32)) - 1.0)
    return {
        'x': nrm(ks[0], (BATCH, SEQ, D), 1.0),
        'c': nrm(ks[1], (BATCH, D), 1.0),
        'ctx': nrm(ks[2], (BATCH, CTX_LEN, D), 1.0),
        'c_ctx': nrm(ks[3], (D,), 1.0),
        'w_mod': nrm(ks[4], (DEPTH, D, 6 * D), 0.5 * D ** -0.5),
        'b_mod': nrm(ks[5], (DEPTH, 6 * D), 0.02),
        'norm1': 1.0 + nrm(ks[6], (DEPTH, D), 0.02),
        'norm2': 1.0 + nrm(ks[7], (DEPTH, D), 0.02),
        'w_in': nrm(ks[8], (DEPTH, D, IN_WIDTH), D ** -0.5),
        'attn_sinks': nrm(ks[9], (DEPTH, N_Q_HEADS), 1.0),
        'pool_w': nrm(ks[10], (DEPTH, len(POOL_WINDOWS), gw, gw), gw ** -0.5),
        'pool_scale': 1.0 + nrm(ks[11], (DEPTH, POOL_WIDTH), 0.02),
        'ret_decay': base_decay + nrm(ks[12], (DEPTH, 2, RET_HEADS), 0.1),
        'w_o_attn': nrm(ks[13], (DEPTH, ATTN_Q_WIDTH, D), ATTN_Q_WIDTH ** -0.5),
        'w_o_pool': nrm(ks[14], (DEPTH, POOL_WIDTH, D), POOL_WIDTH ** -0.5),
        'w_o_ret': nrm(ks[15], (DEPTH, RET_WIDTH, D), RET_WIDTH ** -0.5),
        'w_out': nrm(ks[16], (DEPTH, D, D), D ** -0.5),
        'w_router': nrm(ks[17], (DEPTH, D, N_EXPERTS), D ** -0.5),
        'b_router': nrm(ks[18], (DEPTH, N_EXPERTS), 0.01),
        'w_expert_in': nrm(ks[19], (DEPTH, N_EXPERTS, D, 2 * D_FF), D ** -0.5),
        'b_expert_in': nrm(ks[20], (DEPTH, N_EXPERTS, 2 * D_FF), 0.01),
        'w_expert_out': nrm(ks[21], (DEPTH, N_EXPERTS, D_FF, D), D_FF ** -0.5),
        'b_expert_out': nrm(ks[22], (DEPTH, N_EXPERTS, D), 0.01),
        'final_norm': 1.0 + nrm(ks[23], (D,), 0.02),
    }


def reference(x, c, ctx, c_ctx, w_mod, b_mod, norm1, norm2, w_in, attn_sinks, pool_w, pool_scale, ret_decay,
              w_o_attn, w_o_pool, w_o_ret, w_out, w_router, b_router, w_expert_in, b_expert_in, w_expert_out,
              b_expert_out, final_norm):
    B, L, D = x.shape
    silu_c = jax.nn.silu(c)
    silu_cc = jax.nn.silu(c_ctx)
    xc = ctx
    for l in range(DEPTH):
        last = l == DEPTH - 1
        sh1, sc1, g1, sh2, sc2, g2 = jnp.split((silu_c @ w_mod[l] + b_mod[l])[:, None, :], 6, axis=-1)
        csh1, csc1, cg1, csh2, csc2, cg2 = jnp.split(silu_cc @ w_mod[l] + b_mod[l], 6, axis=-1)
        h = rmsnorm(x, norm1[l]) * (1 + sc1) + sh1
        hc = rmsnorm(xc, norm1[l]) * (1 + csc1) + csh1
        y, yc = token_mixer(h, hc, w_in[l], attn_sinks[l], pool_w[l], pool_scale[l], ret_decay[l],
                            w_o_attn[l], w_o_pool[l], w_o_ret[l], w_out[l], not last)
        x = x + g1 * y
        h2 = rmsnorm(x, norm2[l]) * (1 + sc2) + sh2
        x = x + g2 * moe(h2.reshape(B * L, D), w_router[l], b_router[l], w_expert_in[l], b_expert_in[l],
                         w_expert_out[l], b_expert_out[l]).reshape(B, L, D)
        if not last:
            xc = xc + cg1 * yc
            hc2 = rmsnorm(xc, norm2[l]) * (1 + csc2) + csh2
            xc = xc + cg2 * moe(hc2.reshape(-1, D), w_router[l], b_router[l], w_expert_in[l], b_expert_in[l],
                                w_expert_out[l], b_expert_out[l]).reshape(xc.shape)
    return rmsnorm(x, final_norm)
```

```cpp
#include <hip/hip_runtime.h>
#include <stdint.h>
#include <stdio.h>
#include <string.h>
#include <math.h>
#include <type_traits>

#define DEV __device__ __forceinline__
#define LAS __attribute__((address_space(3)))
typedef unsigned short bf16_t;
typedef short bf16x8 __attribute__((ext_vector_type(8)));
typedef float f32x4 __attribute__((ext_vector_type(4)));
typedef float f32x2 __attribute__((ext_vector_type(2)));
typedef unsigned u32x4 __attribute__((ext_vector_type(4)));
typedef unsigned u32x2 __attribute__((ext_vector_type(2)));

constexpr int D = 1024, NBATCH = 2, L = 16384, LC = 256, TL = NBATCH * L, TC = NBATCH * LC, TA = TL + TC;
constexpr int NIN = 5376, NEXP = 32, CAP = TA, PMAX = 141312;
constexpr int C_Q = 0, C_K = 512, C_V = 640, C_U = 768, C_RQ = 1024, C_RK = 1280, C_RV = 1536, C_RGF = 1792, C_RGB = 2048, C_GA = 2304;
constexpr int T_V = 0, T_RV = 256, T_RKF = 512, T_RKB = 768, TROWS = 1024;
constexpr int MX_ATTN = 0, MX_POOL = 512, MX_RET = 768;
constexpr int NTHREADS = 512, NWAVES = 8;

constexpr size_t MiB = 1u << 20;
constexpr size_t OFF_CTL = 0, CTL_BYTES = 1 * MiB;
constexpr size_t OFF_MOD = 1 * MiB;
constexpr size_t OFF_TABR = 2 * MiB;
constexpr size_t OFF_TABA = 6 * MiB;
constexpr size_t OFF_TABW = 6 * MiB + 512 * 1024;
constexpr size_t OFF_WTIN = 7 * MiB;
constexpr size_t OFF_WTT = 28 * MiB;
constexpr size_t OFF_WTM = 31 * MiB;
constexpr size_t OFF_WTO = 35 * MiB;
constexpr size_t OFF_WT1 = 40 * MiB;
constexpr size_t OFF_WT2 = 296 * MiB;
constexpr size_t OFF_HBF = 424 * MiB;
constexpr size_t OFF_XR = 489 * MiB;
constexpr size_t OFF_TK = 1840 * MiB;
constexpr size_t OFF_PROJ = 627 * MiB;
constexpr size_t OFF_PROJT = 969 * MiB;
constexpr size_t OFF_MIX = 1034 * MiB;
constexpr size_t OFF_M = 1099 * MiB;
constexpr size_t OFF_HQ = 1164 * MiB;
constexpr size_t OFF_WTOQ = 1212 * MiB;
constexpr size_t OFF_ROWSQ = 1216 * MiB;
constexpr size_t OFF_WTINQ = 1204 * MiB;
constexpr size_t OFF_KV = 1229 * MiB;
constexpr size_t OFF_TABRT = 1272 * MiB;
constexpr size_t OFF_ACT = 1280 * MiB;
constexpr size_t OFF_YB = 1556 * MiB;
constexpr size_t WS_END = 1856 * MiB;
constexpr size_t TK_LAYER = 8 * MiB;
constexpr int CW_CNT = 65536;
constexpr int CW_DYN = 66560;

constexpr int LDS_BYTES = 147456;
constexpr float LOG2E = 1.4426950408889634f;
#ifndef MOE_FP8
#define MOE_FP8 2
#endif
#ifndef INP_FP8
#define INP_FP8 2
#endif
#ifndef OUT_FP8
#define OUT_FP8 0
#endif
constexpr float QW = 32.f, QA = 4.f, QM = 8.f;

struct P {
    const float *x, *c, *ctx, *c_ctx, *w_mod, *b_mod, *norm1, *norm2, *w_in, *sinks, *pool_w, *pool_scale, *ret_decay, *w_o_attn, *w_o_pool, *w_o_ret,
        *w_out, *w_router, *b_router, *w1, *b1, *w2, *b2, *final_norm;
    float* out;
    unsigned char* ws;
    double inv_ret[32];
    double inv_ax[16];
    int ph_lo, ph_hi;
};

DEV float bf2f(bf16_t b) { return __uint_as_float(((unsigned)b) << 16); }
typedef __bf16 bf16x2_t __attribute__((ext_vector_type(2)));
DEV unsigned pk2(float lo, float hi) { f32x2 v = {lo, hi}; bf16x2_t b = __builtin_convertvector(v, bf16x2_t); return __builtin_bit_cast(unsigned, b); }
DEV bf16_t f2bf(float f) { return (bf16_t)(pk2(f, 0.f) & 0xffffu); }
DEV unsigned pk4q(float a, float b, float c, float d) { int w = 0; w = __builtin_amdgcn_cvt_pk_fp8_f32(a, b, w, false); w = __builtin_amdgcn_cvt_pk_fp8_f32(c, d, w, true); return (unsigned)w; }
DEV float sigmoidf_(float x) { return __builtin_amdgcn_rcpf(1.f + __expf(-x)); }
DEV float siluf_(float x) { return x * __builtin_amdgcn_rcpf(1.f + __expf(-x)); }
DEV float rdl(float v, int l) { return __uint_as_float((unsigned)__builtin_amdgcn_readlane((int)__float_as_uint(v), l)); }
DEV int lane_id() { int r; asm volatile("v_mbcnt_lo_u32_b32 %0, -1, 0\n\tv_mbcnt_hi_u32_b32 %0, -1, %0" : "=v"(r)); return r; }
#define TID (wvx * 64 + lane_id())
DEV float wave_sum(float v) {
#pragma unroll
    for (int o = 1; o < 64; o <<= 1) v += __shfl_xor(v, o);
    return v;
}
DEV int row_mod(int r) { return r < TL ? (r >= L ? 1 : 0) : 2; }
DEV const float* in_row(const P& p, int r) { return r < TL ? p.x + (size_t)r * D : p.ctx + (size_t)(r - TL) * D; }
DEV const float* modp(const P& p, int l, int s, int part) { return (const float*)(p.ws + OFF_MOD) + ((size_t)(l * 3 + s) * 6 + part) * D; }

template <class Dst>
DEV void transpose_item(const float* W, int N, int kb, int nb, float* scr  , int lane, Dst dst) {
    const int k0 = 64 * kb + 16 * (lane >> 4), n0 = 64 * nb + 4 * (lane & 15);
    f32x4 v[16];
#pragma unroll
    for (int i = 0; i < 16; ++i) v[i] = *(const f32x4*)(W + (size_t)(k0 + i) * N + n0);
#pragma unroll
    for (int j = 0; j < 4; ++j) {
        u32x4 o0, o1;
        o0.x = pk2(v[0][j], v[1][j]); o0.y = pk2(v[2][j], v[3][j]); o0.z = pk2(v[4][j], v[5][j]); o0.w = pk2(v[6][j], v[7][j]);
        o1.x = pk2(v[8][j], v[9][j]); o1.y = pk2(v[10][j], v[11][j]); o1.z = pk2(v[12][j], v[13][j]); o1.w = pk2(v[14][j], v[15][j]);
        bf16_t* d0 = dst(n0 + j, 0); if (d0) { *(u32x4*)(d0 + k0) = o0; *(u32x4*)(d0 + k0 + 8) = o1; }
        bf16_t* d1 = dst(n0 + j, 1); if (d1) { *(u32x4*)(d1 + k0) = o0; *(u32x4*)(d1 + k0 + 8) = o1; }
    }
}
DEV float log_g(const P& p, int l, int dir, int h) { const float x = p.ret_decay[(l * 2 + dir) * 4 + h]; return -log1pf(__expf(-x)); }
DEV int ret_phys(int d) { return ((d >> 4) & 1) * 32 + (d >> 5) * 16 + (d & 15); }

template <bool NT>
DEV void titem_load(const float* W, int N, int kb, int nb, int lane, f32x4 (&v)[16]) {
    const int k0 = 64 * kb, n0 = 64 * nb;
#pragma unroll
    for (int i = 0; i < 16; ++i) {
        const int kk = 16 * (lane >> 4) + i, c4 = (lane & 15) * 4;
        const f32x4* src = (const f32x4*)(W + (size_t)(k0 + kk) * N + n0 + c4);
        v[i] = NT ? __builtin_nontemporal_load(src) : *src;
    }
}
template <class Dst>
DEV void titem_finish_q(const f32x4 (&v)[16], int kb, int nb, float* scr  , int lane, float sc, Dst dst) {
    const int k0 = 64 * kb + 16 * (lane >> 4), n0 = 64 * nb + 4 * (lane & 15);
#pragma unroll
    for (int j = 0; j < 4; ++j) {
        u32x4 o;
        o.x = pk4q(v[0][j] * sc, v[1][j] * sc, v[2][j] * sc, v[3][j] * sc); o.y = pk4q(v[4][j] * sc, v[5][j] * sc, v[6][j] * sc, v[7][j] * sc);
        o.z = pk4q(v[8][j] * sc, v[9][j] * sc, v[10][j] * sc, v[11][j] * sc); o.w = pk4q(v[12][j] * sc, v[13][j] * sc, v[14][j] * sc, v[15][j] * sc);
        unsigned char* d0 = dst(n0 + j, 0); if (d0) *(u32x4*)(d0 + k0) = o;
        unsigned char* d1 = dst(n0 + j, 1); if (d1) *(u32x4*)(d1 + k0) = o;
    }
}
template <class Dst>
DEV void transpose_item_q(const float* W, int N, int kb, int nb, float* scr, int lane, float sc, Dst dst) {
    f32x4 v[16]; titem_load<false>(W, N, kb, nb, lane, v); titem_finish_q(v, kb, nb, scr, lane, sc, dst);
}

DEV void stage_prep(const P& p, int bid, int nb, unsigned char* lds, int wvx) {
    const int tid = TID, lane = tid & 63, wave = tid >> 6;
    float* scr = (float*)lds + wave * (64 * 65);
    unsigned char* ws = p.ws;
    constexpr int I_IN = 16 * 84, I_OA = 8 * 16, I_OR = 4 * 16, I_OUT = 16 * 16, I_W1 = 16 * 32, I_W2 = 16 * 16;
    constexpr int PER_LAYER = I_IN + I_OA + I_OR + I_OUT;
    const int gw = bid * NWAVES + wave, ngw = nb * NWAVES;
    for (int it = gw; it < 2 * PER_LAYER; it += ngw) {
        const int l = it / PER_LAYER; int r = it % PER_LAYER;
#if INP_FP8 == 2
        if (r < I_IN && (r % 84) >= C_GA / 64) {
            unsigned char* wq = ws + OFF_WTINQ + (size_t)l * (NIN - C_GA) * D;
            transpose_item_q(p.w_in + (size_t)l * D * NIN, NIN, r / 84, r % 84, scr, lane, QW, [&](int n, int which) -> unsigned char* { return which ? (unsigned char*)nullptr : wq + (size_t)(n - C_GA) * D; });
            continue; }
#endif
#if INP_FP8 == 1
        if (r < I_IN) {
            unsigned char* wt = ws + OFF_WTIN + (size_t)l * NIN * D; unsigned char* wtt = ws + OFF_WTT + (size_t)l * 768 * D;
            transpose_item_q(p.w_in + (size_t)l * D * NIN, NIN, r / 84, r % 84, scr, lane, QW, [&](int n, int which) -> unsigned char* {
                int pr = n;
                if (n >= C_RQ && n < C_RV) pr = (n & ~63) + ret_phys(n & 63);
                if (which == 0) return wt + (size_t)pr * D;
                int tr = -1;
                if (n >= C_V && n < C_U) tr = n - C_V;
                else if (n >= C_K && n < C_V) tr = 128 + (n - C_K);
                else if (n >= C_RV && n < C_RGF) tr = 256 + (n - C_RV);
                else if (n >= C_RK && n < C_RV) tr = 512 + (pr - C_RK);
                return tr < 0 ? (unsigned char*)nullptr : wtt + (size_t)tr * D; });
            continue; }
#endif
        if (r < I_IN) {
            bf16_t* wt = (bf16_t*)(ws + OFF_WTIN) + (size_t)l * NIN * D; bf16_t* wtt = (bf16_t*)(ws + OFF_WTT) + (size_t)l * 768 * D;
            transpose_item(p.w_in + (size_t)l * D * NIN, NIN, r / 84, r % 84, scr, lane, [&](int n, int which) -> bf16_t* {
                int pr = n;
                if (n >= C_RQ && n < C_RV) pr = (n & ~63) + ret_phys(n & 63);
                if (which == 0) return wt + (size_t)pr * D;
                int tr = -1;
                if (n >= C_V && n < C_U) tr = n - C_V;
                else if (n >= C_K && n < C_V) tr = 128 + (n - C_K);
                else if (n >= C_RV && n < C_RGF) tr = 256 + (n - C_RV);
                else if (n >= C_RK && n < C_RV) tr = 512 + (pr - C_RK);
                return tr < 0 ? (bf16_t*)nullptr : wtt + (size_t)tr * D; });
            continue; }
        r -= I_IN;
        if (r < I_OA) { bf16_t* wt = (bf16_t*)(ws + OFF_WTM) + (size_t)l * D * D;
            transpose_item(p.w_o_attn + (size_t)l * 512 * D, D, r / 16, r % 16, scr, lane, [&](int n, int which) -> bf16_t* { return which ? (bf16_t*)nullptr : wt + (size_t)n * D + MX_ATTN; }); continue; }
        r -= I_OA;
        if (r < I_OR) { bf16_t* wt = (bf16_t*)(ws + OFF_WTM) + (size_t)l * D * D;
            transpose_item(p.w_o_ret + (size_t)l * 256 * D, D, r / 16, r % 16, scr, lane, [&](int n, int which) -> bf16_t* { return which ? (bf16_t*)nullptr : wt + (size_t)n * D + MX_RET; }); continue; }
        r -= I_OR;
#if OUT_FP8
        if (r < I_OUT) { unsigned char* wq = ws + OFF_WTOQ + (size_t)l * D * D;
            transpose_item_q(p.w_out + (size_t)l * D * D, D, r / 16, r % 16, scr, lane, QW, [&](int n, int which) -> unsigned char* { return which ? (unsigned char*)nullptr : wq + (size_t)n * D; }); }
#endif
        if (r < I_OUT) { bf16_t* wt = (bf16_t*)(ws + OFF_WTO) + (size_t)l * D * D;
            transpose_item(p.w_out + (size_t)l * D * D, D, r / 16, r % 16, scr, lane, [&](int n, int which) -> bf16_t* { return which ? (bf16_t*)nullptr : wt + (size_t)n * D; }); continue; }
    }
    const int gt = bid * NTHREADS + tid, ngt = nb * NTHREADS;
    for (int it = gt; it < 2 * 256 * D; it += ngt) {
        const int l = it / (256 * D), c = (it / D) % 256, n = it % D, g = c >> 6, cl = c & 63;
        const float* pw = p.pool_w + (((size_t)l * 4 + g) * 64 + cl) * 64; const float* ps = p.pool_scale + l * 256 + g * 64; const float* wo = p.w_o_pool + ((size_t)l * 256 + g * 64) * D + n;
        float s = 0.f;
        for (int e = 0; e < 64; ++e) s += pw[e] * ps[e] * wo[(size_t)e * D];
        ((bf16_t*)(ws + OFF_WTM))[(size_t)l * D * D + (size_t)n * D + MX_POOL + c] = f2bf(s);
    }
    {
        float* sl = (float*)(lds + 8 * 64 * 65 * 4);
        __syncthreads();
        for (int i = tid; i < 3 * D; i += NTHREADS) { const int s = i / D, k = i % D; const float v = s < 2 ? p.c[s * D + k] : p.c_ctx[k]; sl[i] = siluf_(v); }
        __syncthreads();
        float* mod = (float*)(ws + OFF_MOD);
        float* red = (float*)lds;
        for (int blk = bid; blk < 2 * 96; blk += nb) {
            const int l = blk / 96, n = (blk % 96) * 64 + (tid & 63), ks = tid >> 6;
            const float* w = p.w_mod + (size_t)l * D * 6 * D + (size_t)(128 * ks) * 6 * D + n; const float* s0 = sl + 128 * ks; float a0 = 0.f, a1 = 0.f, a2 = 0.f;
#pragma unroll 16
            for (int k = 0; k < 128; ++k) { const float wv = w[(size_t)k * 6 * D]; a0 += s0[k] * wv; a1 += s0[D + k] * wv; a2 += s0[2 * D + k] * wv; }
            red[(ks * 3 + 0) * 64 + (tid & 63)] = a0; red[(ks * 3 + 1) * 64 + (tid & 63)] = a1; red[(ks * 3 + 2) * 64 + (tid & 63)] = a2;
            __syncthreads();
            if (tid < 192) { const int sI = tid >> 6, nn = tid & 63; float a = 0.f;
#pragma unroll
                for (int q = 0; q < 8; ++q) a += red[(q * 3 + sI) * 64 + nn];
                const int nc = (blk % 96) * 64 + nn; mod[(size_t)(l * 3 + sI) * 6 * D + nc] = a + p.b_mod[l * 6 * D + nc]; }
            __syncthreads();
        }
    }
    {
        f32x2* tr = (f32x2*)(ws + OFF_TABR);
        const double TWO_PI = 6.283185307179586476925286766559, INV_2PI = 0.15915494309189533576888376337251;
        for (int it = gt; it < L * 32 + 256 * 16 + 64 * 16; it += ngt) {
            double ang; f32x2* dst;
            if (it < L * 32) { ang = (double)(it >> 5) * p.inv_ret[it & 31]; dst = tr + it; }
            else { const int j = it - L * 32; const int pos = j < 256 * 16 ? (j >> 4) : ((j - 256 * 16) >> 4); ang = (double)pos * p.inv_ax[j & 15]; dst = (f32x2*)(ws + OFF_TABA) + j; }
            const double n = rint(ang * INV_2PI); const float r = (float)(ang - n * TWO_PI);
            const float cv = __cosf(r), sv = __sinf(r);
            *dst = (f32x2){cv, sv};
            if (it < L * 32) { float* tt = (float*)(ws + OFF_TABRT); tt[(size_t)(it & 31) * L + (it >> 5)] = cv; tt[(size_t)(32 + (it & 31)) * L + (it >> 5)] = sv; }
        }
        for (int it = gt; it < 2 * 2 * 4 * 128; it += ngt) {
            const int j = it & 127, h = (it >> 7) & 3, dir = (it >> 9) & 1, l = it >> 10; const float lg = log_g(p, l, dir, h);
            ((float*)(ws + OFF_TABW))[it] = __expf(lg * (float)(dir == 0 ? 127 - j : j));
        }
    }
}


DEV void stage_prep_experts(const P& p, int l, int bid, int nb, unsigned char* lds, int wvx) {
    const int tid = TID, lane = tid & 63, wave = tid >> 6;
    float* scr = (float*)lds + wave * (64 * 65);
    unsigned char* ws = p.ws;
    constexpr int I_W1 = 16 * 32, I_W2 = 16 * 16;
    const int gw = bid * NWAVES + wave, ngw = nb * NWAVES;
#if MOE_FP8 >= 2
    auto src = [&](int it, const float*& W, int& N, int& kb, int& nbk) { const int e = it / (I_W1 + I_W2), r = it % (I_W1 + I_W2);
        if (r < I_W1) { W = p.w1 + ((size_t)l * NEXP + e) * D * 2048; N = 2048; kb = r / 32; nbk = r % 32; }
        else { W = p.w2 + ((size_t)l * NEXP + e) * D * D; N = D; kb = (r - I_W1) / 16; nbk = (r - I_W1) % 16; } };
    f32x4 va[16], vb[16];
    int it = gw;
    if (it < NEXP * (I_W1 + I_W2)) { const float* W; int N, kb, nbk; src(it, W, N, kb, nbk); titem_load<true>(W, N, kb, nbk, lane, va); }
    for (; it < NEXP * (I_W1 + I_W2); it += ngw) {
        const int itn = it + ngw;
        if (itn < NEXP * (I_W1 + I_W2)) { const float* W; int N, kb, nbk; src(itn, W, N, kb, nbk); titem_load<true>(W, N, kb, nbk, lane, vb); }
        const int e = it / (I_W1 + I_W2), r = it % (I_W1 + I_W2);
        if (r < I_W1) {
            unsigned char* wq = ws + OFF_WT1 + ((size_t)l * NEXP + e) * 2048 * D;
            titem_finish_q(va, r / 32, r % 32, scr, lane, QW, [&](int n, int which) -> unsigned char* {
                const int j = n & 1023, jq = (j >> 2) & 3, pq = jq == 1 ? 2 : jq == 2 ? 1 : jq;
                const int pr = 32 * (j >> 4) + (n >= 1024 ? 16 : 0) + 4 * pq + (j & 3);
                return which ? (unsigned char*)nullptr : wq + (size_t)pr * D; });
        } else {
            unsigned char* wq = ws + OFF_WT2 + ((size_t)l * NEXP + e) * D * D;
            titem_finish_q(va, (r - I_W1) / 16, (r - I_W1) % 16, scr, lane, QW, [&](int n, int which) -> unsigned char* { return which ? (unsigned char*)nullptr : wq + (size_t)n * D; });
        }
#pragma unroll
        for (int i = 0; i < 16; ++i) va[i] = vb[i];
    }
#else
    for (int it = gw; it < NEXP * (I_W1 + I_W2); it += ngw) {
        int r = it;
        const int e = r / (I_W1 + I_W2); r %= (I_W1 + I_W2);
        if (r < I_W1) {
#if MOE_FP8 >= 1
            unsigned char* wq = ws + OFF_WT1 + ((size_t)l * NEXP + e) * 2048 * D;
            transpose_item_q(p.w1 + ((size_t)l * NEXP + e) * D * 2048, 2048, r / 32, r % 32, scr, lane, QW, [&](int n, int which) -> unsigned char* {
                const int j = n & 1023, jq = (j >> 2) & 3, pq = jq == 1 ? 2 : jq == 2 ? 1 : jq;
                const int pr = 32 * (j >> 4) + (n >= 1024 ? 16 : 0) + 4 * pq + (j & 3);
                return which ? (unsigned char*)nullptr : wq + (size_t)pr * D; });
#else
            bf16_t* wt = (bf16_t*)(ws + OFF_WT1) + ((size_t)l * NEXP + e) * 2048 * D;
            transpose_item(p.w1 + ((size_t)l * NEXP + e) * D * 2048, 2048, r / 32, r % 32, scr, lane, [&](int n, int which) -> bf16_t* {
                const int j = n & 1023, jq = (j >> 2) & 3, pq = jq == 1 ? 2 : jq == 2 ? 1 : jq;
                const int pr = 32 * (j >> 4) + (n >= 1024 ? 16 : 0) + 4 * pq + (j & 3);
                return which ? (bf16_t*)nullptr : wt + (size_t)pr * D; });
#endif
            continue; }
        r -= I_W1;
#if MOE_FP8 >= 2
        { unsigned char* wq = ws + OFF_WT2 + ((size_t)l * NEXP + e) * D * D;
            transpose_item_q(p.w2 + ((size_t)l * NEXP + e) * D * D, D, r / 16, r % 16, scr, lane, QW, [&](int n, int which) -> unsigned char* { return which ? (unsigned char*)nullptr : wq + (size_t)n * D; }); }
#else
        { bf16_t* wt = (bf16_t*)(ws + OFF_WT2) + ((size_t)l * NEXP + e) * D * D;
            transpose_item(p.w2 + ((size_t)l * NEXP + e) * D * D, D, r / 16, r % 16, scr, lane, [&](int n, int which) -> bf16_t* { return which ? (bf16_t*)nullptr : wt + (size_t)n * D; }); }
#endif
    }
#endif
}

DEV void norm_store(const f32x4 (&v)[4], const float* gamma, const float* sc, const float* sh, bf16_t* orow, unsigned char* qrow, int lane) {
    float s = 0.f;
#pragma unroll
    for (int j = 0; j < 4; ++j) s += (v[j].x * v[j].x + v[j].y * v[j].y) + (v[j].z * v[j].z + v[j].w * v[j].w);
    const float rstd = rsqrtf(wave_sum(s) * (1.f / D) + 1e-6f);
    f32x4 g[4], a[4], b[4];
#pragma unroll
    for (int j = 0; j < 4; ++j) { const int k = 4 * lane + 256 * j; g[j] = *(const f32x4*)(gamma + k); a[j] = *(const f32x4*)(sc + k); b[j] = *(const f32x4*)(sh + k); }
#pragma unroll
    for (int j = 0; j < 4; ++j) {
        const int k = 4 * lane + 256 * j;
        f32x4 y = v[j] * rstd * g[j] * (a[j] + 1.f) + b[j];
#if INP_FP8 == 1
        *(unsigned*)((unsigned char*)orow + k) = pk4q(y.x, y.y, y.z, y.w);
#else
        u32x2 o; o.x = pk2(y.x, y.y); o.y = pk2(y.z, y.w);
        *(u32x2*)(orow + k) = o;
#if INP_FP8 == 2
        *(unsigned*)(qrow + k) = pk4q(y.x, y.y, y.z, y.w);
#endif
#endif
    }
}
constexpr size_t OFF_GM2 = OFF_MOD + 512 * 1024;
DEV void stage_norm0(const P& p, int bid, int nb, int wvx) {
    const int tid_ = TID, lane = tid_ & 63, wave = tid_ >> 6;
    if (bid == nb - 1) { float* gm2 = (float*)(p.ws + OFF_GM2);
        for (int i = tid_; i < 2 * 3 * D; i += NTHREADS) { const int l = i / (3 * D), s = (i / D) % 3, k = i % D; gm2[i] = p.norm2[l * D + k] * (modp(p, l, s, 4)[k] + 1.f); } }
    bf16_t* hbf = (bf16_t*)(p.ws + OFF_HBF);
    int r = bid * NWAVES + wave; f32x4 v[4], vn[4];
    if (r < TA) {
#pragma unroll
        for (int j = 0; j < 4; ++j) v[j] = *(const f32x4*)(in_row(p, r) + 4 * lane + 256 * j);
    }
    for (; r < TA; r += nb * NWAVES) {
        const int rn = r + nb * NWAVES;
        if (rn < TA) {
#pragma unroll
            for (int j = 0; j < 4; ++j) vn[j] = *(const f32x4*)(in_row(p, rn) + 4 * lane + 256 * j);
        }
        const int s = row_mod(r);
        norm_store(v, p.norm1, modp(p, 0, s, 1), modp(p, 0, s, 0), hbf + (size_t)r * (INP_FP8 == 1 ? D / 2 : D), p.ws + OFF_HQ + (size_t)r * D, lane);
#pragma unroll
        for (int j = 0; j < 4; ++j) v[j] = vn[j];
    }
}

DEV void mma_tile32(const bf16_t* a0, const bf16_t* a1, const bf16_t* b0, const bf16_t* b1, int K, f32x4 (&acc)[2][2]) {
#pragma unroll 4
    for (int k = 0; k < K; k += 32) {
        const bf16x8 fa0 = *(const bf16x8*)(a0 + k), fa1 = *(const bf16x8*)(a1 + k), fb0 = *(const bf16x8*)(b0 + k), fb1 = *(const bf16x8*)(b1 + k);
        acc[0][0] = __builtin_amdgcn_mfma_f32_16x16x32_bf16(fa0, fb0, acc[0][0], 0, 0, 0);
        acc[0][1] = __builtin_amdgcn_mfma_f32_16x16x32_bf16(fa0, fb1, acc[0][1], 0, 0, 0);
        acc[1][0] = __builtin_amdgcn_mfma_f32_16x16x32_bf16(fa1, fb0, acc[1][0], 0, 0, 0);
        acc[1][1] = __builtin_amdgcn_mfma_f32_16x16x32_bf16(fa1, fb1, acc[1][1], 0, 0, 0);
    }
}
DEV void zero_acc(f32x4 (&acc)[2][2]) {
#pragma unroll
    for (int a = 0; a < 2; ++a)
#pragma unroll
        for (int b = 0; b < 2; ++b) acc[a][b] = (f32x4){0.f, 0.f, 0.f, 0.f};
}

DEV f32x2 ax_cs(const P& p, int row, int sub, int f) {
    if (row >= TL) return (f32x2){1.f, 0.f};
    const int l = row & (L - 1); const f32x2* ta = (const f32x2*)(p.ws + OFF_TABA);
    return sub == 0 ? ta[(l >> 6) * 16 + f] : ta[256 * 16 + (l & 63) * 16 + f];
}
DEV f32x2 ret_cs(const P& p, int row, int f) {
    if (row >= TL) return (f32x2){1.f, 0.f};
    return ((const f32x2*)(p.ws + OFF_TABR))[(row & (L - 1)) * 32 + f];
}

DEV void inproj_pair(const P& p, int row, int c1, float x1, float x2, float& o1, float& o2) {
    const int f16 = c1 & 15;
    if (c1 < C_V) {
        const f32x2 cs = ax_cs(p, row, (c1 >> 5) & 1, f16);
        o1 = x1 * cs.x - x2 * cs.y; o2 = x1 * cs.y + x2 * cs.x;
        if (c1 < C_K) { o1 *= 0.125f; o2 *= 0.125f; }
    } else if (c1 < C_RQ) { o1 = x1; o2 = x2; }
    else if (c1 < C_RV) {
        const f32x2 cs = ret_cs(p, row, ((c1 >> 5) & 1) * 16 + f16);
        o1 = x1 * cs.x - x2 * cs.y; o2 = x1 * cs.y + x2 * cs.x;
        if (c1 >= C_RK) { o1 *= 0.125f; o2 *= 0.125f; }
    } else if (c1 < C_RGF) { o1 = x1; o2 = x2; }
    else if (c1 < C_GA) { o1 = siluf_(x1); o2 = siluf_(x2); }
    else { o1 = sigmoidf_(x1); o2 = sigmoidf_(x2); }
}


DEV void stage_pool_diff(const P& p, int l, int bid, int nb, int wvx) {
    const int NR = l == 0 ? TA : TL;
    const bf16_t* proj = (const bf16_t*)(p.ws + OFF_PROJ); bf16_t* mix = (bf16_t*)(p.ws + OFF_MIX);
    for (int it = bid * NTHREADS + TID; it < 4 * NR * 8; it += nb * NTHREADS) {
        const int g = it / (NR * 8), rem = it % (NR * 8), row = rem >> 3, c = g * 64 + (rem & 7) * 8, w = __builtin_amdgcn_readfirstlane(2 << g);
        int s0, len; if (row < TL) { s0 = row & ~(L - 1); len = L; } else { s0 = TL + (((row - TL) >> 8) << 8); len = LC; }
        const int t = row - s0, lo0 = t - w / 2;
        float acc[8];
#pragma unroll
        for (int j = 0; j < 8; ++j) acc[j] = 0.f;
        bf16x8 own = *(const bf16x8*)(proj + (size_t)row * NIN + C_U + c);
#pragma unroll
        for (int i = 0; i < 16; ++i) {
            {
                const int pos = lo0 + i; const bool ok = i < w && pos >= 0 && pos < len;
                const bf16x8 v = *(const bf16x8*)(proj + (size_t)(s0 + (ok ? pos : t)) * NIN + C_U + c);
                const float mk = ok ? 1.f : 0.f;
#pragma unroll
                for (int j = 0; j < 8; ++j) acc[j] += mk * bf2f((bf16_t)v[j]);
            }
        }
        int lo = lo0 < 0 ? 0 : lo0, hi = lo0 + w > len ? len : lo0 + w;
        const float inv = 1.f / (float)(hi - lo);
        float d[8];
#pragma unroll
        for (int j = 0; j < 8; ++j) d[j] = acc[j] * inv - bf2f((bf16_t)own[j]);
        u32x4 o; o.x = pk2(d[0], d[1]); o.y = pk2(d[2], d[3]); o.z = pk2(d[4], d[5]); o.w = pk2(d[6], d[7]);
        *(u32x4*)(mix + (size_t)row * D + MX_POOL + c) = o;
    }
}


constexpr int MAXENT = 640;
DEV void stage_route(const P& p, int l, int bid, int nb, unsigned char* lds, int wvx) {
    const int tid = TID, lane = tid & 63, wave = tid >> 6;
    float* wl = (float*)lds;
    int* lcnt = (int*)(lds + 131072); int* lbase = lcnt + 32; int* ent = lbase + 32;
    const float* wr = p.w_router + (size_t)l * D * NEXP;
    for (int k = tid; k < D; k += NTHREADS) {
#pragma unroll
        for (int e4 = 0; e4 < 8; ++e4) { const f32x4 w = *(const f32x4*)(wr + (size_t)k * NEXP + 4 * e4);
            wl[(4 * e4 + 0) * D + k] = w.x; wl[(4 * e4 + 1) * D + k] = w.y; wl[(4 * e4 + 2) * D + k] = w.z; wl[(4 * e4 + 3) * D + k] = w.w; }
    }
    for (int i = tid; i < 32; i += NTHREADS) lcnt[i] = 0;
    for (int i = tid; i < MAXENT; i += NTHREADS) ent[i] = -1;
    __syncthreads();
    const float* xr = (const float*)(p.ws + OFF_XR); bf16_t* hbf = (bf16_t*)(p.ws + OFF_HBF);
    int* tk_e = (int*)(p.ws + OFF_TK + (size_t)l * TK_LAYER); float* tk_w = (float*)(tk_e + TA * 4); int* tk_pos = (int*)(tk_w + TA * 4); int* list_tok = tk_pos + TA * 4;
    unsigned* cntg = (unsigned*)(p.ws + OFF_CTL) + CW_CNT + l * 32;
    const int NR = l == 0 ? TA : TL, ngw = nb * NWAVES, gw = bid * NWAVES + wave;
    const int t_begin = (int)(((long long)gw * NR) / ngw), t_end = (int)(((long long)(gw + 1) * NR) / ngw);
    const float* gamma = p.norm2 + l * D;
    f32x4 gam[4];
#pragma unroll
    for (int j = 0; j < 4; ++j) gam[j] = *(const f32x4*)(gamma + 4 * lane + 256 * j);
    for (int t0 = t_begin; t0 < t_end; t0 += 4) {
        f32x4 v[4][4]; int tok[4]; float ss[4];
#pragma unroll
        for (int u = 0; u < 4; ++u) { tok[u] = t0 + u < t_end ? t0 + u : t_end - 1; ss[u] = 0.f;
#pragma unroll
            for (int j = 0; j < 4; ++j) { v[u][j] = *(const f32x4*)(xr + (size_t)tok[u] * D + 4 * lane + 256 * j); ss[u] += (v[u][j].x * v[u][j].x + v[u][j].y * v[u][j].y) + (v[u][j].z * v[u][j].z + v[u][j].w * v[u][j].w); } }
        const int s0 = row_mod(tok[0]);
        f32x4 scv[4], shv[4];
#pragma unroll
        for (int j = 0; j < 4; ++j) { scv[j] = *(const f32x4*)(modp(p, l, s0, 4) + 4 * lane + 256 * j); shv[j] = *(const f32x4*)(modp(p, l, s0, 3) + 4 * lane + 256 * j); }
#pragma unroll
        for (int o = 1; o < 64; o <<= 1) {
#pragma unroll
            for (int u = 0; u < 4; ++u) ss[u] += __shfl_xor(ss[u], o); }
#pragma unroll
        for (int u = 0; u < 4; ++u) {
            const float rstd = rsqrtf(ss[u] * (1.f / D) + 1e-6f); const int sm = row_mod(tok[u]);
            f32x4 av[4], bv[4];
            if (sm != s0) {
                const float* sc = modp(p, l, sm, 4); const float* sh = modp(p, l, sm, 3);
#pragma unroll
                for (int j = 0; j < 4; ++j) { av[j] = *(const f32x4*)(sc + 4 * lane + 256 * j); bv[j] = *(const f32x4*)(sh + 4 * lane + 256 * j); }
            } else {
#pragma unroll
                for (int j = 0; j < 4; ++j) { av[j] = scv[j]; bv[j] = shv[j]; }
            }
#pragma unroll
            for (int j = 0; j < 4; ++j) { const int k = 4 * lane + 256 * j;
                const f32x4 g = gam[j], a = av[j], b = bv[j];
                v[u][j] = v[u][j] * rstd * g * (a + 1.f) + b;
#if MOE_FP8 >= 1
                if (t0 + u < t_end) *(unsigned*)((unsigned char*)hbf + (size_t)tok[u] * D + k) = pk4q(v[u][j].x, v[u][j].y, v[u][j].z, v[u][j].w); }
#else
                u32x2 o; o.x = pk2(v[u][j].x, v[u][j].y); o.y = pk2(v[u][j].z, v[u][j].w);
                if (t0 + u < t_end) *(u32x2*)(hbf + (size_t)tok[u] * D + k) = o; }
#endif
        }
        float lgc[4] = {0.f, 0.f, 0.f, 0.f};
        const int e8 = lane & 7, ut = (lane >> 3) & 3;
#pragma nounroll
        for (int c = 0; c < 4; ++c) {
            float val[32];
#pragma unroll
            for (int x = 0; x < 8; ++x) {
                f32x4 w[4];
#pragma unroll
                for (int j = 0; j < 4; ++j) w[j] = *(const f32x4*)(wl + (8 * c + x) * D + 4 * lane + 256 * j);
#pragma unroll
                for (int u = 0; u < 4; ++u) { float a = 0.f;
#pragma unroll
                    for (int j = 0; j < 4; ++j) a += (v[u][j].x * w[j].x + v[u][j].y * w[j].y) + (v[u][j].z * w[j].z + v[u][j].w * w[j].w);
                    val[u * 8 + x] = a; }
            }
            float v16[16], v8[8], v4[4], v2[2];
#define RT_STAGE(dst, src, n, b) do { const bool hi_ = (lane >> (b)) & 1; _Pragma("unroll") for (int i_ = 0; i_ < (n); ++i_) { const float lo_v = (src)[2 * i_], hi_v = (src)[2 * i_ + 1]; \
                const float keep = hi_ ? hi_v : lo_v, send = hi_ ? lo_v : hi_v; (dst)[i_] = keep + __shfl_xor(send, 1 << (b)); } } while (0)
            RT_STAGE(v16, val, 16, 0); RT_STAGE(v8, v16, 8, 1); RT_STAGE(v4, v8, 4, 2); RT_STAGE(v2, v4, 2, 3);
            float v1; { const bool hi_ = (lane >> 4) & 1; const float keep = hi_ ? v2[1] : v2[0], send = hi_ ? v2[0] : v2[1]; v1 = keep + __shfl_xor(send, 16); }
#undef RT_STAGE
            { const float lv = v1 + __shfl_xor(v1, 32) + p.b_router[l * NEXP + 8 * c + e8];
#pragma unroll
              for (int cc = 0; cc < 4; ++cc) lgc[cc] = (cc == c) ? lv : lgc[cc]; }
        }
        int te[4]; float tv[4];
#pragma unroll
        for (int k = 0; k < 4; ++k) {
            float bv = lgc[0]; int be = e8;
#pragma unroll
            for (int c = 1; c < 4; ++c) { const bool t = lgc[c] > bv; bv = t ? lgc[c] : bv; be = t ? 8 * c + e8 : be; }
#pragma unroll
            for (int d = 1; d < 8; d <<= 1) { const float ov = __shfl_xor(bv, d); const int oe = __shfl_xor(be, d); const bool t = (ov > bv) || (ov == bv && oe < be); bv = t ? ov : bv; be = t ? oe : be; }
            te[k] = be; tv[k] = bv;
#pragma unroll
            for (int c = 0; c < 4; ++c) lgc[c] = (be == 8 * c + e8) ? -INFINITY : lgc[c];
        }
        float ex[4], es = 0.f;
#pragma unroll
        for (int k = 0; k < 4; ++k) { ex[k] = __expf(tv[k] - tv[0]); es += ex[k]; }
        if (lane < 32 && e8 < 4 && t0 + ut < t_end) {
            const int e = e8 == 0 ? te[0] : e8 == 1 ? te[1] : e8 == 2 ? te[2] : te[3];
            const float wgt = (e8 == 0 ? ex[0] : e8 == 1 ? ex[1] : e8 == 2 ? ex[2] : ex[3]) / es;
            const int rank = atomicAdd(&lcnt[e], 1);
            const int tk = t0 + ut, lid = wave * 72 + (tk - t_begin) * 4 + e8;
            ent[lid] = e | (rank << 8);
            tk_e[tk * 4 + e8] = e; tk_w[tk * 4 + e8] = wgt;
        }
    }
    __syncthreads();
    if (tid < 32) lbase[tid] = (int)atomicAdd(&cntg[tid], (unsigned)lcnt[tid]);
    __syncthreads();
    for (int lid = tid; lid < 8 * 72; lid += NTHREADS) {
        const int en = ent[lid]; if (en < 0) continue;
        const int e = en & 255, rank = en >> 8, wv = lid / 72, rem = lid % 72, k = rem & 3;
        const int tb = (int)(((long long)(bid * NWAVES + wv) * NR) / ngw);
        const int tokk = tb + (rem >> 2), pos = lbase[e] + rank;
        tk_pos[tokk * 4 + k] = pos; list_tok[e * CAP + pos] = tokk;
    }
}

DEV void moe_prefix(const P& p, int l, int* pstart, int* cnt, int wvx) {
    const int tid = TID;
    if (tid < 64) {
        unsigned* cntg = (unsigned*)(p.ws + OFF_CTL) + CW_CNT + l * 32;
        const int c = tid < 32 ? (int)__hip_atomic_load(cntg + (tid & 31), __ATOMIC_RELAXED, __HIP_MEMORY_SCOPE_AGENT) : 0;
        const int pad = (c + 255) & ~255; int incl = pad;
#pragma unroll
        for (int o = 1; o < 32; o <<= 1) { const int t = __shfl_up(incl, o); if ((tid & 63) >= o) incl += t; }
        if (tid < 32) { cnt[tid] = c; pstart[tid] = incl - pad; if (tid == 31) pstart[32] = incl; }
    }
    __syncthreads();
}
#ifndef ROUTE_MFMA
#define ROUTE_MFMA 1
#endif
constexpr int RW_STRIDE = 2064, RW_LO = 32 * RW_STRIDE, RT_TAB = 2 * RW_LO, RT_MAXENT = 1024;
DEV void stage_route_mfma(const P& p, int l, int bid, int nb, unsigned char* lds_, int wvx) {
    const int tid = TID, lane = tid & 63, wave = tid >> 6, fr = lane & 15, fq = lane >> 4;
    LAS unsigned char* lds = (LAS unsigned char*)lds_;
    int* lcnt = (int*)(lds_ + RT_TAB); int* lbase = lcnt + 32; int* ent = lbase + 32; int* enttok = ent + RT_MAXENT;
    const float* wr = p.w_router + (size_t)l * D * NEXP;
    for (int k = tid; k < D; k += NTHREADS) {
#pragma unroll
        for (int e4 = 0; e4 < 8; ++e4) { const f32x4 w = *(const f32x4*)(wr + (size_t)k * NEXP + 4 * e4);
#pragma unroll
            for (int j = 0; j < 4; ++j) { const float wv = w[j]; const bf16_t h = f2bf(wv); const bf16_t lo = f2bf(wv - bf2f(h));
                *(LAS bf16_t*)(lds + (4 * e4 + j) * RW_STRIDE + 2 * k) = h; *(LAS bf16_t*)(lds + RW_LO + (4 * e4 + j) * RW_STRIDE + 2 * k) = lo; } }
    }
    for (int i = tid; i < 32; i += NTHREADS) lcnt[i] = 0;
    for (int i = tid; i < RT_MAXENT; i += NTHREADS) ent[i] = -1;
    __syncthreads();
    const float* xr = (const float*)(p.ws + OFF_XR); unsigned char* h2q = p.ws + OFF_HBF;
    int* tk_e = (int*)(p.ws + OFF_TK + (size_t)l * TK_LAYER); float* tk_w = (float*)(tk_e + TA * 4); int* tk_pos = (int*)(tk_w + TA * 4); int* list_tok = tk_pos + TA * 4;
    unsigned* cntg = (unsigned*)(p.ws + OFF_CTL) + CW_CNT + l * 32;
    const int NR = l == 0 ? TA : TL, ntile = NR / 16, ngw = nb * NWAVES, gw = bid * NWAVES + wave;
    auto body = [&](auto ntc) {
        constexpr int NT = decltype(ntc)::value;
        int tk[NT]; const float* xrow[NT]; const float* gmp[NT]; const float* shp[NT]; float rstd[NT]; unsigned char* hq[NT]; f32x4 acc[NT][2];
#pragma unroll
        for (int u = 0; u < NT; ++u) {
            const int tile = gw + u * ngw, sm = row_mod(tile * 16);
            tk[u] = tile * 16 + fr; xrow[u] = xr + (size_t)tk[u] * D + 8 * fq; hq[u] = h2q + (size_t)tk[u] * D + 8 * fq;
            gmp[u] = (const float*)(p.ws + OFF_GM2) + (size_t)(l * 3 + sm) * D + 8 * fq; shp[u] = modp(p, l, sm, 3) + 8 * fq;
            float ss = 0.f;
            if (tile * 16 < TL) { const f32x4 q = *(const f32x4*)((const float*)(p.ws + OFF_ROWSQ) + (size_t)tk[u] * 16 + 4 * fq); ss = (q.x + q.y) + (q.z + q.w); }
            else {
#pragma unroll 8
                for (int s = 0; s < 32; ++s) { const f32x4 a = *(const f32x4*)(xrow[u] + 32 * s), b = *(const f32x4*)(xrow[u] + 32 * s + 4);
                    ss += (a.x * a.x + a.y * a.y) + (a.z * a.z + a.w * a.w) + (b.x * b.x + b.y * b.y) + (b.z * b.z + b.w * b.w); }
            }
            ss += __shfl_xor(ss, 16); ss += __shfl_xor(ss, 32);
            rstd[u] = rsqrtf(ss * (1.f / D) + 1e-6f);
            acc[u][0] = (f32x4){0.f, 0.f, 0.f, 0.f}; acc[u][1] = acc[u][0];
        }
#pragma unroll 4
        for (int s = 0; s < 32; ++s) {
            bf16x8 yh[NT], yl[NT];
#pragma unroll
            for (int u = 0; u < NT; ++u) {
                f32x4 y[2];
#pragma unroll
                for (int c = 0; c < 2; ++c) { const int k = 32 * s + 4 * c; y[c] = *(const f32x4*)(xrow[u] + k) * rstd[u] * *(const f32x4*)(gmp[u] + k) + *(const f32x4*)(shp[u] + k); }
                u32x2 q8; q8.x = pk4q(y[0].x, y[0].y, y[0].z, y[0].w); q8.y = pk4q(y[1].x, y[1].y, y[1].z, y[1].w);
                *(u32x2*)(hq[u] + 32 * s) = q8;
                u32x4 hw, lw;
                hw.x = pk2(y[0].x, y[0].y); hw.y = pk2(y[0].z, y[0].w); hw.z = pk2(y[1].x, y[1].y); hw.w = pk2(y[1].z, y[1].w);
                lw.x = pk2(y[0].x - bf2f((bf16_t)(hw.x & 0xffff)), y[0].y - bf2f((bf16_t)(hw.x >> 16))); lw.y = pk2(y[0].z - bf2f((bf16_t)(hw.y & 0xffff)), y[0].w - bf2f((bf16_t)(hw.y >> 16)));
                lw.z = pk2(y[1].x - bf2f((bf16_t)(hw.z & 0xffff)), y[1].y - bf2f((bf16_t)(hw.z >> 16))); lw.w = pk2(y[1].z - bf2f((bf16_t)(hw.w & 0xffff)), y[1].w - bf2f((bf16_t)(hw.w >> 16)));
                yh[u] = __builtin_bit_cast(bf16x8, hw); yl[u] = __builtin_bit_cast(bf16x8, lw);
            }
#pragma unroll
            for (int et = 0; et < 2; ++et) {
                const bf16x8 ah = *(const LAS bf16x8*)(lds + (16 * et + fr) * RW_STRIDE + (4 * s + fq) * 16), al = *(const LAS bf16x8*)(lds + RW_LO + (16 * et + fr) * RW_STRIDE + (4 * s + fq) * 16);
#pragma unroll
                for (int u = 0; u < NT; ++u) {
                    acc[u][et] = __builtin_amdgcn_mfma_f32_16x16x32_bf16(ah, yh[u], acc[u][et], 0, 0, 0);
                    acc[u][et] = __builtin_amdgcn_mfma_f32_16x16x32_bf16(ah, yl[u], acc[u][et], 0, 0, 0);
                    acc[u][et] = __builtin_amdgcn_mfma_f32_16x16x32_bf16(al, yh[u], acc[u][et], 0, 0, 0);
                }
            }
        }
#pragma unroll
        for (int u = 0; u < NT; ++u) {
            float lg[8];
#pragma unroll
            for (int et = 0; et < 2; ++et) { const f32x4 bb = *(const f32x4*)(p.b_router + l * NEXP + 16 * et + 4 * fq);
#pragma unroll
                for (int j = 0; j < 4; ++j) lg[4 * et + j] = acc[u][et][j] + bb[j]; }
            int te[4]; float tv[4];
#pragma unroll
            for (int k = 0; k < 4; ++k) {
                float bv = lg[0]; int be = 4 * fq;
#pragma unroll
                for (int i = 1; i < 8; ++i) { const int ei = 16 * (i >> 2) + 4 * fq + (i & 3); const bool t = lg[i] > bv; bv = t ? lg[i] : bv; be = t ? ei : be; }
#pragma unroll
                for (int d = 16; d < 64; d <<= 1) { const float ov = __shfl_xor(bv, d); const int oe = __shfl_xor(be, d); const bool t = (ov > bv) || (ov == bv && oe < be); bv = t ? ov : bv; be = t ? oe : be; }
                te[k] = be; tv[k] = bv;
#pragma unroll
                for (int i = 0; i < 8; ++i) { const int ei = 16 * (i >> 2) + 4 * fq + (i & 3); lg[i] = (be == ei) ? -INFINITY : lg[i]; }
            }
            float ex[4], es = 0.f;
#pragma unroll
            for (int k = 0; k < 4; ++k) { ex[k] = __expf(tv[k] - tv[0]); es += ex[k]; }
            {
                const int e = fq == 0 ? te[0] : fq == 1 ? te[1] : fq == 2 ? te[2] : te[3];
                const float wgt = (fq == 0 ? ex[0] : fq == 1 ? ex[1] : fq == 2 ? ex[2] : ex[3]) / es;
                const int rank = atomicAdd(&lcnt[e], 1);
                const int lid = wave * 128 + u * 64 + fr * 4 + fq;
                ent[lid] = e | (rank << 8); enttok[lid] = tk[u];
                tk_e[tk[u] * 4 + fq] = e; tk_w[tk[u] * 4 + fq] = wgt;
            }
        }
    };
    if (gw + ngw < ntile) body(std::integral_constant<int, 2>{}); else if (gw < ntile) body(std::integral_constant<int, 1>{});
    __syncthreads();
    if (tid < 32) lbase[tid] = (int)atomicAdd(&cntg[tid], (unsigned)lcnt[tid]);
    __syncthreads();
    for (int lid = tid; lid < RT_MAXENT; lid += NTHREADS) {
        const int en = ent[lid]; if (en < 0) continue;
        const int e = en & 255, rank = en >> 8, tokk = enttok[lid], k = lid & 3, pos = lbase[e] + rank;
        tk_pos[tokk * 4 + k] = pos; list_tok[e * CAP + pos] = tokk;
    }
}

DEV void stage_combine(const P& p, int l, int bid, int nb, unsigned char* lds, int wvx) {
    const int tid_ = TID, lane = tid_ & 63, wave = tid_ >> 6;
    int* pstart = (int*)lds; int* cnt = pstart + 40;
    moe_prefix(p, l, pstart, cnt, wvx);
    float* xr = (float*)(p.ws + OFF_XR); const bf16_t* yb = (const bf16_t*)(p.ws + OFF_YB); bf16_t* hbf = (bf16_t*)(p.ws + OFF_HBF);
    const int* tk_e = (const int*)(p.ws + OFF_TK + (size_t)l * TK_LAYER); const float* tk_w = (const float*)(tk_e + TA * 4); const int* tk_pos = (const int*)(tk_w + TA * 4);
    const int NR = l == 0 ? TA : TL;
    int row = bid * NWAVES + wave;
    int ce[4], cp[4]; float cw[4]; f32x4 xv[4];
    if (row < NR) {
#pragma unroll
        for (int k = 0; k < 4; ++k) { ce[k] = tk_e[row * 4 + k]; cw[k] = tk_w[row * 4 + k]; cp[k] = tk_pos[row * 4 + k]; }
#pragma unroll
        for (int j = 0; j < 4; ++j) xv[j] = *(const f32x4*)(xr + (size_t)row * D + 4 * lane + 256 * j);
    }
    for (; row < NR; row += nb * NWAVES) {
        const int s = row_mod(row); const float* g2 = modp(p, l, s, 5);
        size_t slot[4];
#pragma unroll
        for (int k = 0; k < 4; ++k) slot[k] = (size_t)(pstart[ce[k]] + cp[k]);
        u32x2 yv[4][4];
#pragma unroll
        for (int k = 0; k < 4; ++k)
#pragma unroll
            for (int j = 0; j < 4; ++j) yv[k][j] = *(const u32x2*)(yb + slot[k] * D + 4 * lane + 256 * j);
        float w4[4]; f32x4 xc[4];
#pragma unroll
        for (int k = 0; k < 4; ++k) w4[k] = cw[k];
#pragma unroll
        for (int j = 0; j < 4; ++j) xc[j] = xv[j];
        const int rown = row + nb * NWAVES;
        if (rown < NR) {
#pragma unroll
            for (int k = 0; k < 4; ++k) { ce[k] = tk_e[rown * 4 + k]; cw[k] = tk_w[rown * 4 + k]; cp[k] = tk_pos[rown * 4 + k]; }
#pragma unroll
            for (int j = 0; j < 4; ++j) xv[j] = *(const f32x4*)(xr + (size_t)rown * D + 4 * lane + 256 * j);
        }
        f32x4 a[4];
#pragma unroll
        for (int j = 0; j < 4; ++j) a[j] = (f32x4){0.f, 0.f, 0.f, 0.f};
#pragma unroll
        for (int k = 0; k < 4; ++k) {
            const float w = w4[k];
#pragma unroll
            for (int j = 0; j < 4; ++j) { const u32x2 y = yv[k][j];
                a[j].x += w * bf2f((bf16_t)(y.x & 0xffff)); a[j].y += w * bf2f((bf16_t)(y.x >> 16)); a[j].z += w * bf2f((bf16_t)(y.y & 0xffff)); a[j].w += w * bf2f((bf16_t)(y.y >> 16)); }
        }
        f32x4 v[4];
#pragma unroll
        for (int j = 0; j < 4; ++j) { const int k = 4 * lane + 256 * j; v[j] = xc[j] + *(const f32x4*)(g2 + k) * a[j]; }
        if (l == 0) {
#pragma unroll
            for (int j = 0; j < 4; ++j) *(f32x4*)(xr + (size_t)row * D + 4 * lane + 256 * j) = v[j];
            norm_store(v, p.norm1 + D, modp(p, 1, s, 1), modp(p, 1, s, 0), hbf + (size_t)row * (INP_FP8 == 1 ? D / 2 : D), p.ws + OFF_HQ + (size_t)row * D, lane);
        } else if (row < TL) {
            float ss = 0.f;
#pragma unroll
            for (int j = 0; j < 4; ++j) ss += (v[j].x * v[j].x + v[j].y * v[j].y) + (v[j].z * v[j].z + v[j].w * v[j].w);
            const float rstd = rsqrtf(wave_sum(ss) * (1.f / D) + 1e-6f);
#pragma unroll
            for (int j = 0; j < 4; ++j) { const int k = 4 * lane + 256 * j; *(f32x4*)(p.out + (size_t)row * D + k) = v[j] * rstd * *(const f32x4*)(p.final_norm + k); }
        }
    }
}

namespace pg {
#define LAS __attribute__((address_space(3)))
constexpr int BM = 256, BK = 64, HALF = 128, HTB = HALF * BK * 2, STAGE_BYTES = 8 * HTB, NXCD = 8, WGM = 4;
DEV int lds_byte(int r, int c) { const int st = (r >> 4) * 2 + (c >> 5), rr = r & 15, cc = c & 31, ob = rr * 64 + cc * 2; return st * 1024 + (ob ^ (((ob >> 9) & 1) << 5)); }
DEV int perm32(int rho) { const int n = rho >> 4, i = rho & 15; return 8 * (i >> 2) + 4 * n + (i & 3); }
DEV void stage_rc(int b, int& R, int& C) { const int st = b / 1024, sb = b % 1024, swz = sb ^ (((sb >> 9) & 1) << 5); R = (st >> 1) * 16 + swz / 64; C = (st & 1) * 32 + (swz % 64) / 2; }
typedef int i32x8 __attribute__((ext_vector_type(8)));
typedef int i32x4v __attribute__((ext_vector_type(4)));
DEV i32x8 cat8(const bf16x8 a, const bf16x8 b) { const i32x4v x = __builtin_bit_cast(i32x4v, a), y = __builtin_bit_cast(i32x4v, b); return __builtin_shufflevector(x, y, 0, 1, 2, 3, 4, 5, 6, 7); }
DEV void mfma_q(f32x4& acc, const i32x8 b, const i32x8 a, const int one) {
    asm volatile("v_mfma_scale_f32_16x16x128_f8f6f4 %0, %1, %2, %0, %3, %3 op_sel_hi:[0,0,0]" : "+v"(acc) : "v"(b), "v"(a), "v"(one));
}
struct Unit { const char* aMat; const char* bBase; int pm, pn, kind, nt, perm, bslot; };
DEV void tile_from_L(int Lg, int nM, int nN, int& pm, int& pn) {
    const int nwg = nM * nN; int wgid = Lg; { const int q = nwg / NXCD, r = nwg % NXCD, xcd = wgid % NXCD, off = wgid / NXCD; wgid = (xcd < r ? xcd * (q + 1) : r * (q + 1) + (xcd - r) * q) + off; }
    const int nig = WGM * nN, gid = wgid / nig, fm = gid * WGM, gsz = (nM - fm) < WGM ? (nM - fm) : WGM;
    pm = fm + ((wgid % nig) % gsz); pn = (wgid % nig) / gsz;
}
template <class Epi, class Sched>
DEV void gemm_phase(LAS unsigned char* lds, const Sched& S, const Epi& E, const int ldb, const int wvx) {
    constexpr bool FP8 = Sched::FP8;
    constexpr int PERMC = Sched::PERMC;
    constexpr bool GATHER = Sched::GATHER;
    const int tid = TID, wid = __builtin_amdgcn_readfirstlane(tid >> 6), lane = tid & 63, wr = wid >> 2, wc = wid & 3, fr = lane & 15, fq = lane >> 4;
    unsigned voffB[2], voffBp[2], voffA[2];
#pragma unroll
    for (int i = 0; i < 2; ++i) { int R_, C_; stage_rc(tid * 16 + i * 8192, R_, C_); voffB[i] = (unsigned)(R_ * ldb + C_) * 2u; voffA[i] = (unsigned)(R_ * ldb + C_) * 2u;
        voffBp[i] = (unsigned)(((R_ & ~31) + perm32(R_ & 31)) * ldb + C_) * 2u; }
    const size_t kstep = (size_t)(BK * 2);
    const size_t hstepB = (size_t)HALF * ldb * 2;
    const unsigned ldsw = (unsigned)wid * 1024u;
    const int aoff = lds_byte(wr * 64 + fr, fq * 8), boff = lds_byte(wc * 32 + fr, fq * 8);
#define PG_SA(b, h) (((b) * 2 + (h)) * HTB)
#define PG_SB(b, h) ((4 + (b) * 2 + (h)) * HTB)
#define PG_STAGE(bufoff, gbase, voff) do { const char* gb_ = (const char*)(gbase); asm("" : "+s"(gb_));   _Pragma("unroll") for (int _i = 0; _i < 2; ++_i) { \
        unsigned vo_ = (voff)[_i]; asm volatile("" : "+v"(vo_)); __builtin_amdgcn_global_load_lds((const unsigned*)(gb_ + vo_), (LAS unsigned*)(lds + (bufoff) + ldsw + _i * 8192), 16, 0, 0); } } while (0)
#define PG_STAGE_A(bufoff, gbase, h, og) do { if constexpr (GATHER) PG_STAGE(bufoff, gbase, (og)[h]); else PG_STAGE(bufoff, (gbase) + (h) * hstepB, voffA); } while (0)
#define PG_LDA(dst, b, h) do { _Pragma("unroll") for (int m = 0; m < 4; ++m) _Pragma("unroll") for (int k = 0; k < 2; ++k) dst[m][k] = *(const LAS bf16x8*)(lds + PG_SA(b, h) + aoff + m * 2048 + k * 1024); } while (0)
#define PG_LDB(dst, b, h) do { _Pragma("unroll") for (int n = 0; n < 2; ++n) _Pragma("unroll") for (int k = 0; k < 2; ++k) dst[n][k] = *(const LAS bf16x8*)(lds + PG_SB(b, h) + boff + n * 2048 + k * 1024); } while (0)
#define PG_MMA(ai, bj, At, Bt) do { __builtin_amdgcn_s_setprio(1); if constexpr (FP8) { _Pragma("unroll") for (int m = 0; m < 4; ++m) _Pragma("unroll") for (int n = 0; n < 2; ++n) \
        mfma_q(acc[ai][bj][m][n], cat8(Bt[n][0], Bt[n][1]), cat8(At[m][0], At[m][1]), qone); } \
        else { _Pragma("unroll") for (int m = 0; m < 4; ++m) _Pragma("unroll") for (int n = 0; n < 2; ++n) _Pragma("unroll") for (int k = 0; k < 2; ++k) \
        acc[ai][bj][m][n] = __builtin_amdgcn_mfma_f32_16x16x32_bf16(Bt[n][k], At[m][k], acc[ai][bj][m][n], 0, 0, 0); } __builtin_amdgcn_s_setprio(0); } while (0)
#define PG_WAIT_V(n) asm volatile("s_waitcnt vmcnt(" #n ")" ::: "memory")
#define PG_WAIT_L(n) asm volatile("s_waitcnt lgkmcnt(" #n ")" ::: "memory")
#define PG_BAR __builtin_amdgcn_s_barrier()
#define PG_SCHED __builtin_amdgcn_sched_barrier(0)
    Unit cur, nxt; int ui = 0;
    constexpr bool DYN = Sched::DYN;
    volatile LAS int* dslot = (volatile LAS int*)(lds + 131072 + 1024);
    if constexpr (DYN) {
        if (tid == 0) dslot[0] = S.grab();
        __syncthreads();
        const int L0 = __builtin_amdgcn_readfirstlane(dslot[0]);
        __syncthreads();
        if (!S.decode(L0, cur)) return;
    } else { if (!S.next(0, cur)) return; }
    int qone = 0x7F7F7F7F; if constexpr (FP8) asm volatile("" : "+v"(qone));
    LAS unsigned char* bslots = lds + 131072 + 4096;
    cur.bslot = 0;
    if constexpr (Epi::BIASL) { if (wid == 0) __builtin_amdgcn_global_load_lds((const unsigned*)E.bias_src(cur, lane), (LAS unsigned*)(bslots), 16, 0, 0); }
    f32x4 acc[2][2][4][2];
#pragma unroll
    for (int a = 0; a < 2; ++a)
#pragma unroll
        for (int b = 0; b < 2; ++b)
#pragma unroll
            for (int m = 0; m < 4; ++m)
#pragma unroll
                for (int n = 0; n < 2; ++n) acc[a][b][m][n] = (f32x4){0.f, 0.f, 0.f, 0.f};
    bf16x8 At[4][2], B0[2][2], B1[2][2];
    unsigned offC[2][2], offK[2][2];
    constexpr bool KEEPK = GATHER && !FP8;
    if constexpr (GATHER) { S.aoff(cur, tid, offC);
        if constexpr (KEEPK) {
#pragma unroll
        for (int h = 0; h < 2; ++h)
#pragma unroll
            for (int i = 0; i < 2; ++i) offK[h][i] = offC[h][i]; } }
    const char* cA = cur.aMat; const char* cB = cur.bBase;
    unsigned vbc[2];
#pragma unroll
    for (int i = 0; i < 2; ++i) vbc[i] = PERMC == 0 ? voffB[i] : PERMC == 1 ? voffBp[i] : cur.perm ? voffBp[i] : voffB[i];
    PG_STAGE(PG_SB(0, 0), cB, vbc); PG_STAGE(PG_SB(0, 1), cB + hstepB, vbc); PG_STAGE_A(PG_SA(0, 0), cA, 0, offC); PG_STAGE_A(PG_SA(0, 1), cA, 1, offC);
    if (wr == 1) PG_BAR;
    PG_WAIT_V(2); PG_BAR;
    PG_STAGE(PG_SB(1, 0), cB + kstep, vbc); PG_STAGE_A(PG_SA(1, 0), cA + kstep, 0, offC); PG_STAGE(PG_SB(1, 1), cB + hstepB + kstep, vbc);
    PG_WAIT_V(6); PG_BAR;
    for (;;) {
        bool has_next = false; const char* nA = cA; const char* nB = cB; int tk_ = 0;
        if constexpr (DYN) { if (tid == 0) tk_ = S.grab(); }
        else { has_next = S.next(ui + 1, nxt); nA = has_next ? nxt.aMat : cA; nB = has_next ? nxt.bBase : cB; }
        nxt.bslot = cur.bslot == 2 ? 0 : cur.bslot + 1;
        if constexpr (Epi::BIASL && !DYN) { if (has_next && wid == 0) __builtin_amdgcn_global_load_lds((const unsigned*)E.bias_src(nxt, lane), (LAS unsigned*)(bslots + nxt.bslot * 1024), 16, 0, 0); }
        const int nt = cur.nt;
        for (int t = 0; t < nt; t += 2) {
            const bool last = (t == nt - 2);
            if constexpr (DYN) {
                if (t == 2) { if (tid == 0) dslot[(ui + 1) & 1] = tk_; }
                if (t == 4) { const int Ln = __builtin_amdgcn_readfirstlane(dslot[(ui + 1) & 1]); has_next = S.decode(Ln, nxt); nA = has_next ? nxt.aMat : cA; nB = has_next ? nxt.bBase : cB; }
            }
            if constexpr (Epi::HAS_MID) { if (t == 8 || t == 12) E.mid(acc, cur, t, wr, wc, fr, fq); }
            const char* a1 = cA + (size_t)(t + 1) * kstep;
            const char* a2 = last ? nA : cA + (size_t)(t + 2) * kstep; const char* b2 = last ? nB : cB + (size_t)(t + 2) * kstep;
            const char* a3 = a2 + kstep; const char* b3 = b2 + kstep;
            unsigned vb2[2];
            { const int pf_ = (last && has_next) ? nxt.perm : cur.perm;
#pragma unroll
              for (int i = 0; i < 2; ++i) vb2[i] = PERMC == 0 ? voffB[i] : PERMC == 1 ? voffBp[i] : pf_ ? voffBp[i] : voffB[i]; }
            unsigned o2[2][2];
            if constexpr (GATHER) {
                if (last && has_next) { S.aoff(nxt, tid, o2);
                    if constexpr (KEEPK) {
#pragma unroll
                    for (int h = 0; h < 2; ++h)
#pragma unroll
                        for (int i = 0; i < 2; ++i) offK[h][i] = o2[h][i]; } }
                else {
#pragma unroll
                    for (int h = 0; h < 2; ++h)
#pragma unroll
                        for (int i = 0; i < 2; ++i) o2[h][i] = offC[h][i];
                }
            }
            PG_LDB(B0, 0, 0); PG_LDB(B1, 0, 1); PG_SCHED; PG_LDA(At, 0, 0); PG_STAGE_A(PG_SA(1, 1), a1, 1, offC);
            PG_WAIT_V(8); PG_WAIT_L(0); PG_BAR; PG_MMA(0, 0, At, B0); PG_MMA(0, 1, At, B1); PG_BAR; PG_SCHED;
            PG_LDA(At, 0, 1); PG_STAGE(PG_SB(0, 0), b2, vb2); PG_STAGE(PG_SB(0, 1), b2 + hstepB, vb2); PG_STAGE_A(PG_SA(0, 0), a2, 0, o2);
            PG_WAIT_V(8); PG_WAIT_L(0); PG_BAR; PG_MMA(1, 0, At, B0); PG_MMA(1, 1, At, B1); PG_BAR; PG_SCHED;
            PG_LDB(B0, 1, 0); PG_LDB(B1, 1, 1); PG_SCHED; PG_LDA(At, 1, 0); PG_STAGE_A(PG_SA(0, 1), a2, 1, o2);
            PG_WAIT_V(8); PG_WAIT_L(0); PG_BAR; PG_MMA(0, 0, At, B0); PG_MMA(0, 1, At, B1); PG_BAR; PG_SCHED;
            PG_LDA(At, 1, 1); PG_STAGE(PG_SB(1, 0), b3, vb2); PG_STAGE(PG_SB(1, 1), b3 + hstepB, vb2); PG_STAGE_A(PG_SA(1, 0), a3, 0, o2);
            PG_WAIT_V(8); PG_WAIT_L(0); PG_BAR; PG_MMA(1, 0, At, B0); PG_MMA(1, 1, At, B1); PG_BAR; PG_SCHED;
        }
        if (wr == 0) PG_BAR;
        if constexpr (FP8) asm volatile("s_nop 15\n\ts_nop 7" ::: "memory");
        if constexpr (Epi::ACCS != 1.f) {
#pragma unroll
            for (int a = 0; a < 2; ++a)
#pragma unroll
                for (int b = 0; b < 2; ++b)
#pragma unroll
                    for (int m = 0; m < 4; ++m)
#pragma unroll
                        for (int n = 0; n < 2; ++n) acc[a][b][m][n] *= Epi::ACCS; }
        E(acc, cur, wr, wc, fr, fq);
        if (!has_next) break;
#pragma unroll
        for (int a = 0; a < 2; ++a)
#pragma unroll
            for (int b = 0; b < 2; ++b)
#pragma unroll
                for (int m = 0; m < 4; ++m)
#pragma unroll
                    for (int n = 0; n < 2; ++n) acc[a][b][m][n] = (f32x4){0.f, 0.f, 0.f, 0.f};
        cur = nxt; cA = nA; cB = nB; ++ui;
        if constexpr (KEEPK) {
#pragma unroll
            for (int h = 0; h < 2; ++h)
#pragma unroll
                for (int i = 0; i < 2; ++i) offC[h][i] = offK[h][i]; }
        else if constexpr (GATHER) S.aoff(cur, tid, offC);
        if (wr == 1) PG_BAR;
    }
    PG_WAIT_V(0);
    PG_BAR;
#undef PG_SA
#undef PG_SB
#undef PG_STAGE
#undef PG_STAGE_A
#undef PG_LDA
#undef PG_LDB
#undef PG_MMA
#undef PG_WAIT_V
#undef PG_WAIT_L
#undef PG_BAR
#undef PG_SCHED
}
}

DEV __amdgpu_buffer_rsrc_t mk_rsrc(const void* ptr, unsigned bytes) { return __builtin_amdgcn_make_buffer_rsrc((void*)ptr, (short)0, (int)bytes, 0x00020000); }
DEV void st_bf16x4(__amdgpu_buffer_rsrc_t rs, int voff, int soff, const f32x4 v) { u32x2 w; w.x = pk2(v[0], v[1]); w.y = pk2(v[2], v[3]); __builtin_amdgcn_raw_buffer_store_b64(w, rs, voff, soff, 0); }
DEV void stg_bf16x8(bf16_t* ptr, const f32x4 a, const f32x4 b) { u32x4 w; w.x = pk2(a[0], a[1]); w.y = pk2(a[2], a[3]); w.z = pk2(b[0], b[1]); w.w = pk2(b[2], b[3]); *(u32x4*)ptr = w; }
DEV f32x4 ld_bf16x4(const bf16_t* ptr) { const u32x2 w = *(const u32x2*)ptr; return (f32x4){bf2f((bf16_t)(w.x & 0xffff)), bf2f((bf16_t)(w.x >> 16)), bf2f((bf16_t)(w.y & 0xffff)), bf2f((bf16_t)(w.y >> 16))}; }

struct SchedA {
    const char* hbf; const char* wtin; const char* wtt; int G, c;
    static constexpr bool GATHER = false, FP8 = INP_FP8 == 1; static constexpr int PERMC = -1; static constexpr bool DYN = false;
    static constexpr int DR = FP8 ? D / 2 : D;
    static constexpr int NM = TA / 256, NN = NIN / 256 - 1, N1 = NM * NN, N2 = 3 * NM;
    DEV bool next(int i, pg::Unit& u) const {
        const int Lg = i * G + c; if (Lg >= N1 + N2) return false;
        u.nt = FP8 ? 8 : 16;
        if (Lg < N1) { pg::tile_from_L(Lg, NM, NN, u.pm, u.pn); if (u.pn >= 6) ++u.pn; u.kind = 0; u.perm = (u.pn == 3 || u.pn >= 6) ? 1 : 0; u.aMat = hbf + (size_t)u.pm * 256 * DR * 2; u.bBase = wtin + (size_t)u.pn * 256 * DR * 2; }
        else { const int r = Lg - N1; u.pm = r % 3; u.pn = r / 3; u.kind = 1; u.perm = 0; u.aMat = wtt + (size_t)u.pm * 256 * DR * 2; u.bBase = hbf + (size_t)u.pn * 256 * DR * 2; }
        return true;
    }
    DEV void aoff(const pg::Unit& u, const int tid, unsigned (&off)[2][2]) const {
        int R[2], C[2];
#pragma unroll
        for (int i = 0; i < 2; ++i) pg::stage_rc(tid * 16 + i * 8192, R[i], C[i]);
#pragma unroll
        for (int h = 0; h < 2; ++h)
#pragma unroll
            for (int i = 0; i < 2; ++i) off[h][i] = (unsigned)((u.pm * 256 + h * 128 + R[i]) * D + C[i]) * 2u;
    }
};
struct EpiA {
    static constexpr bool HAS_MID = false, BIASL = false; static constexpr float ACCS = INP_FP8 == 1 ? 1.f / QW : 1.f;
    const P& p; int l;
    DEV void operator()(const f32x4 (&acc)[2][2][4][2], const pg::Unit& u, int wr, int wc, int fr, int fq) const {
        if (u.kind == 0) {
            const __amdgpu_buffer_rsrc_t rs = mk_rsrc(p.ws + OFF_PROJ, (unsigned)((size_t)TA * NIN * 2));
            const bool isctx = u.pm * 256 >= TL;
            const f32x2* taba = (const f32x2*)(p.ws + OFF_TABA); const f32x2* tabr = (const f32x2*)(p.ws + OFF_TABR);
            if (u.perm) {
#pragma unroll
                for (int bj = 0; bj < 2; ++bj) {
                    const int cb = u.pn * 256 + bj * 128;
                    const int reg = cb < C_RGF ? 1 : cb < C_GA ? 3 : 4;
#pragma unroll
                    for (int ai = 0; ai < 2; ++ai)
#pragma unroll
                        for (int m = 0; m < 4; ++m) {
                            f32x4 o1 = acc[ai][bj][m][0], o2 = acc[ai][bj][m][1];
                            if (reg == 3) {
#pragma unroll
                                for (int i = 0; i < 4; ++i) { o1[i] = siluf_(o1[i]); o2[i] = siluf_(o2[i]); }
                            } else if (reg == 4) {
#pragma unroll
                                for (int i = 0; i < 4; ++i) { o1[i] = sigmoidf_(o1[i]); o2[i] = sigmoidf_(o2[i]); }
                            }
                            stg_bf16x8((bf16_t*)(p.ws + OFF_PROJ) + (size_t)(u.pm * 256 + ai * 128 + wr * 64 + m * 16 + fr) * NIN + cb + wc * 32 + 8 * fq, o1, o2);
                        }
                }
            } else {
#pragma unroll
            for (int bj = 0; bj < 2; ++bj) {
                const int cb = u.pn * 256 + bj * 128;
                const int reg = cb < C_V ? 0 : cb < C_RQ ? 1 : cb < C_RV ? 2 : cb < C_RGF ? 1 : cb < C_GA ? 3 : 4;
#pragma unroll
                for (int ai = 0; ai < 2; ++ai)
#pragma unroll
                    for (int m = 0; m < 4; ++m) {
                        const int row = u.pm * 256 + ai * 128 + wr * 64 + m * 16 + fr, pos = isctx ? 0 : (row & (L - 1));
                        f32x4 x1 = acc[ai][bj][m][0], x2 = acc[ai][bj][m][1], o1, o2;
                        if (reg == 0 || reg == 2) {
                            const f32x2* tp = reg == 0 ? ((wc & 1) ? taba + 256 * 16 + (pos & 63) * 16 : taba + (pos >> 6) * 16) + 4 * fq : tabr + pos * 32 + (wc & 1) * 16 + 4 * fq;
                            const f32x4 t0 = *(const f32x4*)tp, t1 = *(const f32x4*)(tp + 2);
                            const f32x4 cs = (f32x4){t0[0], t0[2], t1[0], t1[2]}, sn = (f32x4){t0[1], t0[3], t1[1], t1[3]};
                            o1 = x1 * cs - x2 * sn; o2 = x1 * sn + x2 * cs;
                            if (reg == 0 && cb < C_K) { o1 = o1 * (0.125f * LOG2E); o2 = o2 * (0.125f * LOG2E); }
                            else if (reg == 2 && cb >= C_RK) { o1 = o1 * 0.125f; o2 = o2 * 0.125f; }
                        } else if (reg == 1) { o1 = x1; o2 = x2; }
                        else if (reg == 3) {
#pragma unroll
                            for (int i = 0; i < 4; ++i) { o1[i] = siluf_(x1[i]); o2[i] = siluf_(x2[i]); }
                        } else {
#pragma unroll
                            for (int i = 0; i < 4; ++i) { o1[i] = sigmoidf_(x1[i]); o2[i] = sigmoidf_(x2[i]); }
                        }
                        const int so = ((u.pm * 256 + ai * 128 + m * 16) * NIN + cb) * 2;
                        st_bf16x4(rs, ((wr * 64 + fr) * NIN + wc * 32 + 4 * fq) * 2, so, o1);
                        st_bf16x4(rs, ((wr * 64 + fr) * NIN + wc * 32 + 4 * fq) * 2, so + 32, o2);
                    }
            }
            }
        } else {
            bf16_t* projT = (bf16_t*)(p.ws + OFF_PROJT);
            if (u.pm < 2) {
#pragma unroll
                for (int ai = 0; ai < 2; ++ai) {
                    if (u.pm == 0 && ai == 1) continue;
#pragma unroll
                    for (int m = 0; m < 4; ++m) {
                        const int row = u.pm * 256 + ai * 128 + wr * 64 + m * 16 + fr;
#pragma unroll
                        for (int bj = 0; bj < 2; ++bj)
#pragma unroll
                            for (int n = 0; n < 2; ++n) {
                                const int tok = u.pn * 256 + bj * 128 + wc * 32 + 16 * n + 4 * fq; const f32x4 v = acc[ai][bj][m][n];
                                u32x2 w; w.x = pk2(v[0], v[1]); w.y = pk2(v[2], v[3]);
                                *(u32x2*)(projT + (size_t)row * TA + tok) = w;
                            }
                    }
                }
            } else {
                const float* tcos = (const float*)(p.ws + OFF_TABRT); const float* tsin = tcos + (size_t)32 * L;
                const __amdgpu_buffer_rsrc_t rsT = __builtin_amdgcn_make_buffer_rsrc((void*)projT, (short)0, (int)(TROWS * TA * 2), 0x00020000);
                const int voT = ((wr * 64 + fr) * TA + wc * 32 + 4 * fq) * 2, sbase = u.pn * 256;
#pragma unroll
                for (int bj = 0; bj < 2; ++bj)
#pragma unroll
                    for (int n = 0; n < 2; ++n) {
                        const int tok0 = u.pn * 256 + bj * 128 + wc * 32 + 16 * n + 4 * fq, jj = tok0 & 127; const bool isctx = u.pn * 256 >= TL; const int pos = tok0 & (L - 1);
#pragma unroll
                        for (int ai = 0; ai < 2; ++ai) {
                            const int hh = 2 * ai + wr;
                            const f32x4 wf = *(const f32x4*)((const float*)(p.ws + OFF_TABW) + ((l * 2 + 0) * 4 + hh) * 128 + jj) * 0.125f;
                            const f32x4 wb = *(const f32x4*)((const float*)(p.ws + OFF_TABW) + ((l * 2 + 1) * 4 + hh) * 128 + jj) * 0.125f;
#pragma unroll
                            for (int mp = 0; mp < 2; ++mp) {
                                const int prow = ai * 128 + wr * 64 + mp * 32 + fr, f = mp * 16 + fr;
                                f32x4 cs = (f32x4){1.f, 1.f, 1.f, 1.f}, sn = (f32x4){0.f, 0.f, 0.f, 0.f};
                                if (!isctx) { cs = *(const f32x4*)(tcos + (size_t)f * L + pos); sn = *(const f32x4*)(tsin + (size_t)f * L + pos); }
                                const f32x4 x1 = acc[ai][bj][2 * mp][n], x2 = acc[ai][bj][2 * mp + 1][n];
                                const f32x4 o1 = x1 * cs - x2 * sn, o2 = x1 * sn + x2 * cs;
                                const f32x4 a1 = o1 * wf, a2 = o2 * wf, b1 = o1 * wb, b2 = o2 * wb;
                                u32x2 w; const int so = ((ai * 128 + mp * 32) * TA + sbase + bj * 128 + 16 * n) * 2;
                                w.x = pk2(a1[0], a1[1]); w.y = pk2(a1[2], a1[3]); __builtin_amdgcn_raw_buffer_store_b64(w, rsT, voT, so + (T_RKF * TA) * 2, 0);
                                w.x = pk2(a2[0], a2[1]); w.y = pk2(a2[2], a2[3]); __builtin_amdgcn_raw_buffer_store_b64(w, rsT, voT, so + ((T_RKF + 16) * TA) * 2, 0);
                                w.x = pk2(b1[0], b1[1]); w.y = pk2(b1[2], b1[3]); __builtin_amdgcn_raw_buffer_store_b64(w, rsT, voT, so + (T_RKB * TA) * 2, 0);
                                w.x = pk2(b2[0], b2[1]); w.y = pk2(b2[2], b2[3]); __builtin_amdgcn_raw_buffer_store_b64(w, rsT, voT, so + ((T_RKB + 16) * TA) * 2, 0);
                            }
                        }
                    }
            }
        }
    }
};
template <bool Q>
struct SchedAM {
    const char* hb; const char* wt; const char* wtt; unsigned* ctr; int xcd;
    static constexpr bool GATHER = false, FP8 = Q, DYN = true; static constexpr int PERMC = Q ? 1 : -1;
    static constexpr int DR = Q ? D / 2 : D;
    static constexpr int NM = TA / 256, NN = Q ? 12 : 8, N1 = NM * NN, N2 = Q ? 0 : 3 * NM;
    DEV int grab() const { return (int)__hip_atomic_fetch_add(ctr + xcd * 16, 1u, __ATOMIC_RELAXED, __HIP_MEMORY_SCOPE_AGENT); }
    DEV bool decode(int k, pg::Unit& u) const {
        const int Lg = k * 8 + xcd; if (Lg >= N1 + N2) return false;
        u.nt = Q ? 8 : 16;
        if (Lg < N1) { pg::tile_from_L(Lg, NM, NN, u.pm, u.pn); u.kind = 0; u.aMat = hb + (size_t)u.pm * 256 * DR * 2;
            if (Q) { u.bBase = wt + (size_t)u.pn * 256 * DR * 2; u.pn += 9; u.perm = 1; }
            else { if (u.pn >= 6) ++u.pn; u.perm = (u.pn == 3 || u.pn >= 6) ? 1 : 0; u.bBase = wt + (size_t)u.pn * 256 * DR * 2; } }
        else { const int r = Lg - N1; u.pm = r % 3; u.pn = r / 3; u.kind = 1; u.perm = 0; u.aMat = wtt + (size_t)u.pm * 256 * DR * 2; u.bBase = hb + (size_t)u.pn * 256 * DR * 2; }
        return true;
    }
    DEV bool next(int i, pg::Unit& u) const { return false; }
    DEV void aoff(const pg::Unit& u, const int tid, unsigned (&off)[2][2]) const { off[0][0] = off[0][1] = off[1][0] = off[1][1] = 0u; }
};
struct EpiAQ : EpiA { static constexpr float ACCS = 1.f / QW; };
#ifndef NCONV_
#define NCONV_ 96
#endif
constexpr int NCONV = NCONV_;
DEV void stage_inproj_mixed(const P& p, int l, int bid, int nb, unsigned char* lds, int wvx) {
    unsigned* ctr = (unsigned*)(p.ws + OFF_CTL) + CW_DYN + l * 256;
    if (NCONV > 0 && bid >= nb - NCONV) { stage_prep_experts(p, l, bid - (nb - NCONV), NCONV, lds, wvx); __syncthreads(); }
    { SchedAM<false> S{(const char*)(p.ws + OFF_HBF), (const char*)(p.ws + OFF_WTIN) + (size_t)l * NIN * D * 2, (const char*)(p.ws + OFF_WTT) + (size_t)l * 768 * D * 2, ctr, bid & 7};
      EpiA E{p, l};
      pg::gemm_phase<EpiA, SchedAM<false>>((LAS unsigned char*)lds, S, E, D, wvx); }
    __syncthreads();
    { SchedAM<true> S{(const char*)(p.ws + OFF_HQ), (const char*)(p.ws + OFF_WTINQ) + (size_t)l * (NIN - C_GA) * D, nullptr, ctr + 128, bid & 7};
      EpiAQ E{{p, l}};
      pg::gemm_phase<EpiAQ, SchedAM<true>>((LAS unsigned char*)lds, S, E, D / 2, wvx); }
}
DEV void stage_inproj_fast(const P& p, int l, int bid, int nb, unsigned char* lds, int wvx) {
#if INP_FP8 == 2
    stage_inproj_mixed(p, l, bid, nb, lds, wvx); return;
#endif
    SchedA S{(const char*)(p.ws + OFF_HBF), (const char*)(p.ws + OFF_WTIN) + (size_t)l * NIN * SchedA::DR * 2, (const char*)(p.ws + OFF_WTT) + (size_t)l * 768 * SchedA::DR * 2, nb, bid};
    EpiA E{p, l};
    pg::gemm_phase<EpiA, SchedA>((LAS unsigned char*)lds, S, E, SchedA::DR, wvx);
}

DEV void moe_tiles(const P& p, int l, LAS int* tstart, LAS int* cnt, int wvx) {
    const int tid = TID;
    if (tid < 64) {
        unsigned* cntg = (unsigned*)(p.ws + OFF_CTL) + CW_CNT + l * 32;
        const int c = tid < 32 ? (int)__hip_atomic_load(cntg + (tid & 31), __ATOMIC_RELAXED, __HIP_MEMORY_SCOPE_AGENT) : 0;
        const int nt = (c + 255) >> 8; int incl = nt;
#pragma unroll
        for (int o = 1; o < 32; o <<= 1) { const int t = __shfl_up(incl, o); if ((tid & 63) >= o) incl += t; }
        if (tid < 32) { cnt[tid] = c; tstart[tid] = incl - nt; if (tid == 31) tstart[32] = incl; }
    }
    __syncthreads();
}
template <int NN, bool GATHER_, bool FP8_>
struct SchedMoe {
    static constexpr bool GATHER = GATHER_, FP8 = FP8_; static constexpr int PERMC = GATHER_ ? 0 : 1; static constexpr bool DYN = false;
    static constexpr int DR = FP8_ ? D / 2 : D;
    const char* amat; const char* wt; const int* list_tok; const LAS int* tstart; const LAS int* cnt; int G, c;
    DEV bool next(int i, pg::Unit& u) const {
        const int ntile = __builtin_amdgcn_readfirstlane(tstart[32]); const int Lg = i * G + c; if (Lg >= ntile * NN) return false;
        pg::tile_from_L(Lg, ntile, NN, u.pm, u.pn);
        int e = 0;
        for (int j = 1; j < 32; ++j) e = (u.pm >= __builtin_amdgcn_readfirstlane(tstart[j])) ? j : e;
        u.kind = e; u.nt = FP8_ ? 8 : 16; u.perm = GATHER_ ? 0 : 1; u.aMat = GATHER_ ? amat : amat + (size_t)u.pm * 256 * DR * 2; u.bBase = wt + ((size_t)e * NN * 256 + (size_t)u.pn * 256) * DR * 2;
        return true;
    }
    DEV void aoff(const pg::Unit& u, const int tid, unsigned (&off)[2][2]) const {
        int R[2], C[2];
#pragma unroll
        for (int i = 0; i < 2; ++i) pg::stage_rc(tid * 16 + i * 8192, R[i], C[i]);
#pragma unroll
        for (int h = 0; h < 2; ++h)
#pragma unroll
            for (int i = 0; i < 2; ++i) {
                if (GATHER) { const int e = u.kind, ts = __builtin_amdgcn_readfirstlane(tstart[e]), ce = __builtin_amdgcn_readfirstlane(cnt[e]), pos = (u.pm - ts) * 256 + h * 128 + R[i]; const int tok = list_tok[e * CAP + (pos < ce ? pos : ce - 1)]; off[h][i] = (unsigned)(tok * DR + C[i]) * 2u; }
                else off[h][i] = (unsigned)((u.pm * 256 + h * 128 + R[i]) * DR + C[i]) * 2u;
            }
    }
};
struct EpiM1 {
    static constexpr bool HAS_MID = false, BIASL = true; static constexpr float ACCS = 1.f;
    const P& p; int l; LAS unsigned char* bl;
    DEV const float* bias_src(const pg::Unit& u, int lane) const { return p.b1 + ((size_t)l * NEXP + u.kind) * 2048 + 128 * u.pn + (lane < 32 ? 4 * lane : 1024 + 4 * (lane - 32)); }
    DEV void operator()(const f32x4 (&acc)[2][2][4][2], const pg::Unit& u, int wr, int wc, int fr, int fq) const {
        bf16_t* act = (bf16_t*)(p.ws + OFF_ACT);
        const float* b1 = p.b1 + ((size_t)l * NEXP + u.kind) * 2048;
        const int q = fq == 1 ? 2 : fq == 2 ? 1 : fq;
        f32x4 bgv[2], blv[2];
#pragma unroll
        for (int bj = 0; bj < 2; ++bj) { const LAS float* sl = (const LAS float*)(bl + u.bslot * 1024) + 16 * (4 * bj + wc) + 4 * q; bgv[bj] = *(const LAS f32x4*)sl; blv[bj] = *(const LAS f32x4*)(sl + 128); }
        const int hi = fq >> 1;
        const int ccol = 16 * (8 * u.pn + 4 * hi + wc) + 8 * (fq & 1);
        constexpr float S1 = MOE_FP8 >= 1 ? 1.f / QW : 1.f;
#pragma unroll
        for (int ai = 0; ai < 2; ++ai)
#pragma unroll
            for (int m = 0; m < 4; ++m) {
#if MOE_FP8 >= 2
                unsigned q0 = 0, q1 = 0;
#pragma unroll
                for (int bj = 0; bj < 2; ++bj) {
                    f32x4 o;
#pragma unroll
                    for (int i = 0; i < 4; ++i) {
                        float glu = acc[ai][bj][m][0][i] * S1 + bgv[bj][i], lin = acc[ai][bj][m][1][i] * S1 + blv[bj][i];
                        glu = fminf(glu, 7.f); lin = fminf(fmaxf(lin, -7.f), 7.f);
                        o[i] = QA * glu * sigmoidf_(1.702f * glu) * (lin + 1.f);
                    }
                    if (bj == 0) q0 = pk4q(o[0], o[1], o[2], o[3]); else q1 = pk4q(o[0], o[1], o[2], o[3]);
                }
                { const auto r = __builtin_amdgcn_permlane32_swap(q0, q1, false, false); q0 = r[0]; q1 = r[1]; }
                u32x2 wq; wq.x = q0; wq.y = q1;
                *(u32x2*)((unsigned char*)act + (size_t)(u.pm * 256 + ai * 128 + wr * 64 + m * 16 + fr) * D + ccol) = wq;
            }
#else
                unsigned w0[2], w1[2];
#pragma unroll
                for (int bj = 0; bj < 2; ++bj) {
                    f32x4 o;
#pragma unroll
                    for (int i = 0; i < 4; ++i) {
                        float glu = acc[ai][bj][m][0][i] * S1 + bgv[bj][i], lin = acc[ai][bj][m][1][i] * S1 + blv[bj][i];
                        glu = fminf(glu, 7.f); lin = fminf(fmaxf(lin, -7.f), 7.f);
                        o[i] = glu * sigmoidf_(1.702f * glu) * (lin + 1.f);
                    }
                    if (bj == 0) { w0[0] = pk2(o[0], o[1]); w0[1] = pk2(o[2], o[3]); } else { w1[0] = pk2(o[0], o[1]); w1[1] = pk2(o[2], o[3]); }
                }
#pragma unroll
                for (int k = 0; k < 2; ++k) { const auto r = __builtin_amdgcn_permlane32_swap(w0[k], w1[k], false, false); w0[k] = r[0]; w1[k] = r[1]; }
                u32x4 w; w.x = w0[0]; w.y = w0[1]; w.z = w1[0]; w.w = w1[1];
                *(u32x4*)(act + (size_t)(u.pm * 256 + ai * 128 + wr * 64 + m * 16 + fr) * D + ccol) = w;
            }
#endif
    }
};
struct EpiM2 {
    static constexpr bool HAS_MID = false, BIASL = true; static constexpr float ACCS = 1.f;
    const P& p; int l; LAS unsigned char* bl;
    DEV const float* bias_src(const pg::Unit& u, int lane) const { return p.b2 + ((size_t)l * NEXP + u.kind) * D + 256 * u.pn + 4 * lane; }
    DEV void operator()(const f32x4 (&acc)[2][2][4][2], const pg::Unit& u, int wr, int wc, int fr, int fq) const {
        const __amdgpu_buffer_rsrc_t rs = mk_rsrc(p.ws + OFF_YB, (unsigned)((size_t)PMAX * D * 2));
        const float* b2 = p.b2 + ((size_t)l * NEXP + u.kind) * D;
        const int vo = ((wr * 64 + fr) * D + wc * 32 + 8 * fq) * 2;
        f32x4 bv[2][2];
#pragma unroll
        for (int bj = 0; bj < 2; ++bj)
#pragma unroll
            for (int n = 0; n < 2; ++n) bv[bj][n] = *(const LAS f32x4*)((const LAS float*)(bl + u.bslot * 1024) + bj * 128 + wc * 32 + 8 * fq + 4 * n);
#pragma unroll
        for (int bj = 0; bj < 2; ++bj)
#pragma unroll
            for (int ai = 0; ai < 2; ++ai)
#pragma unroll
                for (int m = 0; m < 4; ++m)
                    { constexpr float S2 = MOE_FP8 >= 2 ? 1.f / (QW * QA) : 1.f; const f32x4 a_ = acc[ai][bj][m][0] * S2 + bv[bj][0], b_ = acc[ai][bj][m][1] * S2 + bv[bj][1]; u32x4 w_; w_.x = pk2(a_[0], a_[1]); w_.y = pk2(a_[2], a_[3]); w_.z = pk2(b_[0], b_[1]); w_.w = pk2(b_[2], b_[3]);
                      *(u32x4*)((bf16_t*)(p.ws + OFF_YB) + (size_t)(u.pm * 256 + ai * 128 + wr * 64 + m * 16 + fr) * D + u.pn * 256 + bj * 128 + wc * 32 + 8 * fq) = w_; }
    }
};
DEV void stage_moe1_fast(const P& p, int l, int bid, int nb, unsigned char* lds, int wvx) {
    LAS int* tstart = (LAS int*)((LAS unsigned char*)lds + 131072); LAS int* cnt = tstart + 40;
    moe_tiles(p, l, tstart, cnt, wvx);
    constexpr bool Q = MOE_FP8 >= 1;
    SchedMoe<8, true, Q> S{(const char*)(p.ws + OFF_HBF), (const char*)(p.ws + OFF_WT1) + (size_t)l * NEXP * 2048 * D * (Q ? 1 : 2), (const int*)(p.ws + OFF_TK + (size_t)l * TK_LAYER) + 3 * TA * 4, tstart, cnt, nb, bid};
    EpiM1 E{p, l, (LAS unsigned char*)lds + 131072 + 4096};
    pg::gemm_phase<EpiM1, SchedMoe<8, true, Q>>((LAS unsigned char*)lds, S, E, Q ? D / 2 : D, wvx);
}
DEV void stage_moe2_fast(const P& p, int l, int bid, int nb, unsigned char* lds, int wvx) {
    LAS int* tstart = (LAS int*)((LAS unsigned char*)lds + 131072); LAS int* cnt = tstart + 40;
    moe_tiles(p, l, tstart, cnt, wvx);
    constexpr bool Q = MOE_FP8 >= 2;
    SchedMoe<4, false, Q> S{(const char*)(p.ws + OFF_ACT), (const char*)(p.ws + OFF_WT2) + (size_t)l * NEXP * D * D * (Q ? 1 : 2), nullptr, tstart, cnt, nb, bid};
    EpiM2 E{p, l, (LAS unsigned char*)lds + 131072 + 4096};
    pg::gemm_phase<EpiM2, SchedMoe<4, false, Q>>((LAS unsigned char*)lds, S, E, Q ? D / 2 : D, wvx);
}

struct SchedMerge {
    const char* mix; const char* wtm; int G, c, NM;
    static constexpr bool GATHER = false, FP8 = false; static constexpr int PERMC = -1; static constexpr bool DYN = false;
    static constexpr int NN = D / 256;
    DEV bool next(int i, pg::Unit& u) const {
        const int Lt = i * G + c; if (Lt >= NM * NN) return false;
        pg::tile_from_L(Lt, NM, NN, u.pm, u.pn);
        u.kind = 0; u.nt = 16; u.perm = 1; u.aMat = mix + (size_t)u.pm * 256 * D * 2; u.bBase = wtm + (size_t)u.pn * 256 * D * 2;
        return true;
    }
    DEV void aoff(const pg::Unit& u, const int tid, unsigned (&off)[2][2]) const {}
};
struct EpiMerge {
    static constexpr bool HAS_MID = true, BIASL = false; static constexpr float ACCS = 1.f;
    const P& p;
    DEV void mid(f32x4 (&acc)[2][2][4][2], const pg::Unit& u, int t, int wr, int wc, int fr, int fq) const {
        const bf16_t* proj = (const bf16_t*)(p.ws + OFF_PROJ);
        const int cnum = C_GA + (t == 8 ? 0 : 1024), cden = cnum + 1024;
#pragma unroll
        for (int ai = 0; ai < 2; ++ai)
#pragma unroll
            for (int m = 0; m < 4; ++m) {
                const bf16_t* rowp = proj + (size_t)(u.pm * 256 + ai * 128 + wr * 64 + m * 16 + fr) * NIN + u.pn * 256 + wc * 32 + 8 * fq;
#pragma unroll
                for (int bj = 0; bj < 2; ++bj) {
                    const u32x4 gnw = *(const u32x4*)(rowp + cnum + bj * 128), gdw = *(const u32x4*)(rowp + cden + bj * 128);
                    const unsigned gn_[4] = {gnw.x, gnw.y, gnw.z, gnw.w}, gd_[4] = {gdw.x, gdw.y, gdw.z, gdw.w};
#pragma unroll
                    for (int n = 0; n < 2; ++n)
#pragma unroll
                        for (int i = 0; i < 4; ++i) {
                            const unsigned wn = gn_[2 * n + (i >> 1)], wd = gd_[2 * n + (i >> 1)];
                            const float gnf = bf2f((bf16_t)((i & 1) ? (wn >> 16) : (wn & 0xffff))), gdf = bf2f((bf16_t)((i & 1) ? (wd >> 16) : (wd & 0xffff)));
                            acc[ai][bj][m][n][i] *= gnf * __builtin_amdgcn_rcpf(fmaxf(gdf, 1e-30f));
                        }
                }
            }
    }
    DEV void operator()(const f32x4 (&acc)[2][2][4][2], const pg::Unit& u, int wr, int wc, int fr, int fq) const {
        const bf16_t* proj = (const bf16_t*)(p.ws + OFF_PROJ);
        bf16_t* mo = (bf16_t*)(p.ws + OFF_M);
        u32x4 gw[2][4][2];
#pragma unroll
        for (int ai = 0; ai < 2; ++ai)
#pragma unroll
            for (int m = 0; m < 4; ++m) {
                const bf16_t* rowp = proj + (size_t)(u.pm * 256 + ai * 128 + wr * 64 + m * 16 + fr) * NIN + C_GA + 2048 + u.pn * 256 + wc * 32 + 8 * fq;
#pragma unroll
                for (int bj = 0; bj < 2; ++bj) gw[ai][m][bj] = *(const u32x4*)(rowp + bj * 128);
            }
#pragma unroll
        for (int ai = 0; ai < 2; ++ai)
#pragma unroll
            for (int m = 0; m < 4; ++m)
#pragma unroll
                for (int bj = 0; bj < 2; ++bj) {
                    const u32x4 w = gw[ai][m][bj];
                    const f32x4 g0 = (f32x4){bf2f((bf16_t)(w.x & 0xffff)), bf2f((bf16_t)(w.x >> 16)), bf2f((bf16_t)(w.y & 0xffff)), bf2f((bf16_t)(w.y >> 16))};
                    const f32x4 g1 = (f32x4){bf2f((bf16_t)(w.z & 0xffff)), bf2f((bf16_t)(w.z >> 16)), bf2f((bf16_t)(w.w & 0xffff)), bf2f((bf16_t)(w.w >> 16))};
#if OUT_FP8
                    { const f32x4 a_ = g0 * acc[ai][bj][m][0] * QM, b_ = g1 * acc[ai][bj][m][1] * QM; u32x2 wq; wq.x = pk4q(a_[0], a_[1], a_[2], a_[3]); wq.y = pk4q(b_[0], b_[1], b_[2], b_[3]);
                      *(u32x2*)((unsigned char*)mo + (size_t)(u.pm * 256 + ai * 128 + wr * 64 + m * 16 + fr) * D + u.pn * 256 + bj * 128 + wc * 32 + 8 * fq) = wq; }
#else
                    stg_bf16x8(mo + (size_t)(u.pm * 256 + ai * 128 + wr * 64 + m * 16 + fr) * D + u.pn * 256 + bj * 128 + wc * 32 + 8 * fq, g0 * acc[ai][bj][m][0], g1 * acc[ai][bj][m][1]);
#endif
                }
    }
};
DEV void stage_merge_fast(const P& p, int l, int bid, int nb, unsigned char* lds, int wvx) {
    SchedMerge S{(const char*)(p.ws + OFF_MIX), (const char*)(p.ws + OFF_WTM) + (size_t)l * D * D * 2, nb, bid, TL / 256};
    EpiMerge E{p};
    pg::gemm_phase<EpiMerge, SchedMerge>((LAS unsigned char*)lds, S, E, D, wvx);
}
struct SchedOut {
    const char* a; const char* wt; int G, c, NM;
    static constexpr bool GATHER = false, FP8 = OUT_FP8 != 0; static constexpr int PERMC = 0; static constexpr bool DYN = false;
    static constexpr int NN = D / 256, DR = FP8 ? D / 2 : D;
    DEV bool next(int i, pg::Unit& u) const {
        const int Lt = i * G + c; if (Lt >= NM * NN) return false;
        pg::tile_from_L(Lt, NM, NN, u.pm, u.pn);
        u.kind = 0; u.nt = FP8 ? 8 : 16; u.perm = 0; u.aMat = a + (size_t)u.pm * 256 * DR * 2; u.bBase = wt + (size_t)u.pn * 256 * DR * 2;
        return true;
    }
    DEV void aoff(const pg::Unit& u, const int tid, unsigned (&off)[2][2]) const {
        int R[2], C[2];
#pragma unroll
        for (int i = 0; i < 2; ++i) pg::stage_rc(tid * 16 + i * 8192, R[i], C[i]);
#pragma unroll
        for (int h = 0; h < 2; ++h)
#pragma unroll
            for (int i = 0; i < 2; ++i) off[h][i] = (unsigned)((u.pm * 256 + h * 128 + R[i]) * D + C[i]) * 2u;
    }
};
struct EpiOut {
    static constexpr bool HAS_MID = false, BIASL = false; static constexpr float ACCS = OUT_FP8 ? 1.f / (QW * QM) : 1.f;
    const P& p; int l;
    DEV void operator()(const f32x4 (&acc)[2][2][4][2], const pg::Unit& u, int wr, int wc, int fr, int fq) const {
        float* xr = (float*)(p.ws + OFF_XR);
        const int row00 = u.pm * 256; const int s = row_mod(row00);
        const float* g1 = modp(p, l, s, 2);
        const float* xbase = l == 0 ? (row00 < TL ? p.x : p.ctx - (size_t)TL * D) : xr;
        float sq[8] = {0.f, 0.f, 0.f, 0.f, 0.f, 0.f, 0.f, 0.f};
#pragma unroll
        for (int bj = 0; bj < 2; ++bj)
#pragma unroll
            for (int n = 0; n < 2; ++n) {
                const int c = u.pn * 256 + bj * 128 + wc * 32 + 16 * n + 4 * fq;
                const f32x4 gvn = *(const f32x4*)(g1 + c);
                f32x4 xin[8];
#pragma unroll
                for (int ai = 0; ai < 2; ++ai)
#pragma unroll
                    for (int m = 0; m < 4; ++m) xin[ai * 4 + m] = *(const f32x4*)(xbase + (size_t)(row00 + ai * 128 + wr * 64 + m * 16 + fr) * D + c);
#pragma unroll
                for (int ai = 0; ai < 2; ++ai)
#pragma unroll
                    for (int m = 0; m < 4; ++m) { const f32x4 xn = xin[ai * 4 + m] + gvn * acc[ai][bj][m][n];
                        *(f32x4*)(xr + (size_t)(row00 + ai * 128 + wr * 64 + m * 16 + fr) * D + c) = xn;
                        sq[ai * 4 + m] += (xn.x * xn.x + xn.y * xn.y) + (xn.z * xn.z + xn.w * xn.w); }
            }
        float* rowsq = (float*)(p.ws + OFF_ROWSQ);
#pragma unroll
        for (int i = 0; i < 8; ++i) { float v = sq[i]; v += __shfl_xor(v, 16); v += __shfl_xor(v, 32);
            if (fq == 0) rowsq[(size_t)(row00 + (i >> 2) * 128 + wr * 64 + (i & 3) * 16 + fr) * 16 + u.pn * 4 + wc] = v; }
    }
};
DEV void stage_out_fast(const P& p, int l, int bid, int nb, unsigned char* lds, int wvx) {
    SchedOut S{(const char*)(p.ws + OFF_M), OUT_FP8 ? (const char*)(p.ws + OFF_WTOQ) + (size_t)l * D * D : (const char*)(p.ws + OFF_WTO) + (size_t)l * D * D * 2, nb, bid, TL / 256};
    EpiOut E{p, l};
    pg::gemm_phase<EpiOut, SchedOut>((LAS unsigned char*)lds, S, E, SchedOut::DR, wvx);
}


DEV void stage_merge_ctx(const P& p, int l, int bid, int nb, int wvx) {
    const int tid_ = TID, lane = tid_ & 63, wave = tid_ >> 6, r16 = lane & 15, q4 = lane >> 4;
    const bf16_t* mix = (const bf16_t*)(p.ws + OFF_MIX); const bf16_t* wt = (const bf16_t*)(p.ws + OFF_WTM) + (size_t)l * D * D;
    const bf16_t* proj = (const bf16_t*)(p.ws + OFF_PROJ); bf16_t* mo = (bf16_t*)(p.ws + OFF_M);
    constexpr int TN = D / 32, TM = TC / 32;
    const int gw = bid * NWAVES + wave; if (gw & 3) return;
    for (int t = gw >> 2; t < TM * TN; t += (nb * NWAVES) >> 2) {
        const int tm = t / TN, tn = t % TN, row0 = TL + tm * 32, col0 = tn * 32;
        f32x4 msum[2][2]; zero_acc(msum);
#pragma unroll
        for (int br = 0; br < 3; ++br) {
            const int k0 = br == 0 ? 0 : (br == 1 ? 512 : 768), kl = br == 0 ? 512 : 256;
            f32x4 acc[2][2]; zero_acc(acc);
            mma_tile32(mix + (size_t)(row0 + r16) * D + k0 + 8 * q4, mix + (size_t)(row0 + 16 + r16) * D + k0 + 8 * q4,
                       wt + (size_t)(col0 + r16) * D + k0 + 8 * q4, wt + (size_t)(col0 + 16 + r16) * D + k0 + 8 * q4, kl, acc);
#pragma unroll
            for (int mt = 0; mt < 2; ++mt)
#pragma unroll
                for (int nt = 0; nt < 2; ++nt)
#pragma unroll
                    for (int j = 0; j < 4; ++j) {
                        const int row = row0 + 16 * mt + 4 * q4 + j, col = col0 + 16 * nt + r16;
                        msum[mt][nt][j] += bf2f(proj[(size_t)row * NIN + C_GA + br * 1024 + col]) * acc[mt][nt][j];
                    }
        }
#pragma unroll
        for (int mt = 0; mt < 2; ++mt)
#pragma unroll
            for (int nt = 0; nt < 2; ++nt)
#pragma unroll
                for (int j = 0; j < 4; ++j) mo[(size_t)(row0 + 16 * mt + 4 * q4 + j) * D + col0 + 16 * nt + r16] = f2bf(msum[mt][nt][j]);
    }
}
DEV void stage_out_ctx(const P& p, int l, int bid, int nb, int wvx) {
    const int tid_ = TID, lane = tid_ & 63, wave = tid_ >> 6, r16 = lane & 15, q4 = lane >> 4;
    const bf16_t* mo = (const bf16_t*)(p.ws + OFF_M); const bf16_t* wt = (const bf16_t*)(p.ws + OFF_WTO) + (size_t)l * D * D;
    float* xr = (float*)(p.ws + OFF_XR);
    constexpr int TN = D / 32, TM = TC / 32;
    const int gw = bid * NWAVES + wave; if (gw & 3) return;
    for (int t = gw >> 2; t < TM * TN; t += (nb * NWAVES) >> 2) {
        const int tm = t / TN, tn = t % TN, row0 = TL + tm * 32, col0 = tn * 32;
        f32x4 acc[2][2]; zero_acc(acc);
        mma_tile32(mo + (size_t)(row0 + r16) * D + 8 * q4, mo + (size_t)(row0 + 16 + r16) * D + 8 * q4,
                   wt + (size_t)(col0 + r16) * D + 8 * q4, wt + (size_t)(col0 + 16 + r16) * D + 8 * q4, D, acc);
#pragma unroll
        for (int mt = 0; mt < 2; ++mt)
#pragma unroll
            for (int nt = 0; nt < 2; ++nt)
#pragma unroll
                for (int j = 0; j < 4; ++j) {
                    const int row = row0 + 16 * mt + 4 * q4 + j, col = col0 + 16 * nt + r16;
                    xr[(size_t)row * D + col] = p.ctx[(size_t)(row - TL) * D + col] + modp(p, l, 2, 2)[col] * acc[mt][nt][j];
                }
    }
}

constexpr size_t OFF_SPREV = OFF_ACT;
DEV void chunk_chain(int cidx, int& b, int& nf, int& nbk) {
    if (cidx < 256) { b = cidx >> 7; const int nl = cidx & 127; nf = 2 + nl; nbk = 2 + (127 - nl); }
    else { const int cc = cidx - 256; b = cc >> 1; const int nc = cc & 1; nf = nc; nbk = 1 - nc; }
}
DEV void stage_ret_kv(const P& p, int l, int bid, int nb, int wvx) {
    const int tid_ = TID, lane = tid_ & 63, wave = tid_ >> 6, r16 = lane & 15, q4 = lane >> 4;
    const bf16_t* projT = (const bf16_t*)(p.ws + OFF_PROJT); float* kvbuf = (float*)(p.ws + OFF_KV);
    for (int t = bid * NWAVES + wave; t < 260 * 8 * 4; t += nb * NWAVES) {
        const int unit = t >> 2, quad = t & 3, e0 = (quad >> 1) * 32, d0 = (quad & 1) * 32;
        const int cidx = unit >> 3, h = (unit >> 1) & 3, dir = unit & 1, row0 = cidx * 128;
        int b, nf, nbk; chunk_chain(cidx, b, nf, nbk);
        const bf16_t* va = projT + (size_t)(T_RV + h * 64 + e0 + r16) * TA + row0 + 8 * q4;
        const bf16_t* kb = projT + (size_t)((dir ? T_RKB : T_RKF) + h * 64 + d0 + r16) * TA + row0 + 8 * q4;
        f32x4 acc[2][2]; zero_acc(acc);
        mma_tile32(va, va + (size_t)16 * TA, kb, kb + (size_t)16 * TA, 128, acc);
        float* dst = kvbuf + ((size_t)(((b * 4 + h) * 2 + dir) * 130 + (dir ? nbk : nf))) * 4096;
#pragma unroll
        for (int mt = 0; mt < 2; ++mt)
#pragma unroll
            for (int nt = 0; nt < 2; ++nt)
#pragma unroll
                for (int j = 0; j < 4; ++j) dst[(e0 + 16 * mt + 4 * q4 + j) * 64 + d0 + 16 * nt + r16] = acc[mt][nt][j];
    }
}
DEV void stage_ret_scan(const P& p, int l, int bid, int nb, int wvx) {
    const float* kvbuf = (const float*)(p.ws + OFF_KV); unsigned* sprev = (unsigned*)(p.ws + OFF_SPREV);
    for (int gt = bid * NTHREADS + TID; gt < 16 * 2048; gt += nb * NTHREADS) {
        const int chain = gt >> 11, i2 = gt & 2047, h = (chain >> 1) & 3, dir = chain & 1;
        const float gC = __expf(128.f * log_g(p, l, dir, h));
        const f32x2* src = (const f32x2*)(kvbuf + (size_t)chain * 130 * 4096) + i2; unsigned* dst = sprev + (size_t)chain * 130 * 2048 + i2;
        f32x2 s = (f32x2){0.f, 0.f};
        for (int n0 = 0; n0 < 130; n0 += 10) {
            f32x2 kv[10];
#pragma unroll
            for (int u = 0; u < 10; ++u) kv[u] = src[(size_t)(n0 + u) * 2048];
#pragma unroll
            for (int u = 0; u < 10; ++u) { dst[(size_t)(n0 + u) * 2048] = pk2(s.x, s.y); s = s * gC + kv[u]; }
        }
    }
}
DEV bf16x8 pack_b(const f32x4 a, const f32x4 b) {
    u32x4 w; w.x = pk2(a[0], a[1]); w.y = pk2(a[2], a[3]); w.z = pk2(b[0], b[1]); w.w = pk2(b[2], b[3]);
    return __builtin_bit_cast(bf16x8, w);
}
DEV bf16x8 ldv_frag(const bf16_t* rowp  , int q4) {
    const u32x2 a = *(const u32x2*)(rowp + 4 * q4), b = *(const u32x2*)(rowp + 16 + 4 * q4);
    u32x4 w; w.x = a.x; w.y = a.y; w.z = b.x; w.w = b.y; return __builtin_bit_cast(bf16x8, w);
}
constexpr int RO_K = 0, RO_V = 128 * 144, RO_S = RO_V + 64 * 272, RO_END = RO_S + 2 * 64 * 144;
DEV void stage_ret_out(const P& p, int l, int bid, int nb, unsigned char* lds_, int wvx) {
    const int tid_ = TID, lane = tid_ & 63, wave = tid_ >> 6, r16 = lane & 15, q4 = lane >> 4;
    LAS unsigned char* lds = (LAS unsigned char*)lds_;
    const bf16_t* proj = (const bf16_t*)(p.ws + OFF_PROJ); const bf16_t* projT = (const bf16_t*)(p.ws + OFF_PROJT);
    const bf16_t* sprev = (const bf16_t*)(p.ws + OFF_SPREV); bf16_t* mix = (bf16_t*)(p.ws + OFF_MIX);
    const int nunits = (l == 0 ? 260 : 256) * 4;
    u32x4 pre[6];
#define RO_LOAD(unit_) do { const int cidx_ = (unit_) >> 2, h_ = (unit_) & 3, row0_ = cidx_ * 128; int b_, nf_, nbk_; chunk_chain(cidx_, b_, nf_, nbk_); \
        _Pragma("unroll") for (int i_ = 0; i_ < 2; ++i_) { const int pc = tid_ + 512 * i_; \
            pre[i_] = *(const u32x4*)(proj + (size_t)(row0_ + (pc >> 3)) * NIN + C_RK + h_ * 64 + (pc & 7) * 8); \
            pre[2 + i_] = *(const u32x4*)(projT + (size_t)(T_RV + h_ * 64 + (pc >> 4)) * TA + row0_ + (pc & 15) * 8); \
            const int dir_ = pc >> 9, pp = pc & 511; \
            pre[4 + i_] = *(const u32x4*)(sprev + ((size_t)(((b_ * 4 + h_) * 2 + dir_) * 130 + (dir_ ? nbk_ : nf_))) * 4096 + (pp >> 3) * 64 + (pp & 7) * 8); } } while (0)
#define RO_WRITE() do { _Pragma("unroll") for (int i_ = 0; i_ < 2; ++i_) { const int pc = tid_ + 512 * i_; \
            *(LAS u32x4*)(lds + RO_K + (pc >> 3) * 144 + (pc & 7) * 16) = pre[i_]; \
            *(LAS u32x4*)(lds + RO_V + (pc >> 4) * 272 + (pc & 15) * 16) = pre[2 + i_]; \
            const int dir_ = pc >> 9, pp = pc & 511; \
            *(LAS u32x4*)(lds + RO_S + dir_ * 64 * 144 + (pp >> 3) * 144 + (pp & 7) * 16) = pre[4 + i_]; } } while (0)
    for (int unit = bid; unit < nunits; unit += nb) {
        RO_LOAD(unit);
        __syncthreads();
        RO_WRITE();
        __syncthreads();
        const int cidx = unit >> 2, h = unit & 3, row0 = cidx * 128;
        const int irow = row0 + 16 * wave + r16, ii = 16 * wave + r16;
        const float lgf = log_g(p, l, 0, h), lgb = log_g(p, l, 1, h);
        bf16x8 qf[2];
#pragma unroll
        for (int ks = 0; ks < 2; ++ks) qf[ks] = *(const bf16x8*)(proj + (size_t)irow * NIN + C_RQ + h * 64 + 32 * ks + 8 * q4);
        f32x4 st[8];
#pragma unroll
        for (int mt = 0; mt < 8; ++mt) {
            st[mt] = (f32x4){0.f, 0.f, 0.f, 0.f};
#pragma unroll
            for (int ks = 0; ks < 2; ++ks) {
                const bf16x8 kf = *(const LAS bf16x8*)(lds + RO_K + (16 * mt + r16) * 144 + ks * 64 + q4 * 16);
                st[mt] = __builtin_amdgcn_mfma_f32_16x16x32_bf16(kf, qf[ks], st[mt], 0, 0, 0);
            }
        }
        float outv[4][4];
#pragma unroll
        for (int mt = 0; mt < 4; ++mt)
#pragma unroll
            for (int jj = 0; jj < 4; ++jj) outv[mt][jj] = 0.f;
#pragma nounroll
        for (int dir = 0; dir < 2; ++dir) {
            const float lg = dir ? lgb : lgf;
            f32x4 y[4];
#pragma unroll
            for (int mt = 0; mt < 4; ++mt) {
                y[mt] = (f32x4){0.f, 0.f, 0.f, 0.f};
#pragma unroll
                for (int ks = 0; ks < 2; ++ks) {
                    const bf16x8 sf = *(const LAS bf16x8*)(lds + RO_S + dir * 64 * 144 + (16 * mt + r16) * 144 + ks * 64 + q4 * 16);
                    y[mt] = __builtin_amdgcn_mfma_f32_16x16x32_bf16(sf, qf[ks], y[mt], 0, 0, 0);
                }
            }
            const float cs = __expf(lg * (float)(dir ? 128 - ii : ii + 1));
#pragma unroll
            for (int mt = 0; mt < 4; ++mt) y[mt] = y[mt] * cs;
#pragma unroll
            for (int s = 0; s < 4; ++s) {
                f32x4 pa, pb;
#pragma unroll
                for (int jj = 0; jj < 4; ++jj) {
                    const int ja = 32 * s + 4 * q4 + jj, jb = ja + 16;
                    const int da = dir ? ja - ii : ii - ja, db = dir ? jb - ii : ii - jb;
                    pa[jj] = da >= 0 ? st[2 * s][jj] * __expf(lg * (float)da) : 0.f;
                    pb[jj] = db >= 0 ? st[2 * s + 1][jj] * __expf(lg * (float)db) : 0.f;
                }
                const bf16x8 pf = pack_b(pa, pb);
#pragma unroll
                for (int mt = 0; mt < 4; ++mt) {
                    const LAS unsigned char* vp = lds + RO_V + (16 * mt + r16) * 272 + (32 * s + 4 * q4) * 2;
                    const u32x2 va = *(const LAS u32x2*)vp, vb = *(const LAS u32x2*)(vp + 32);
                    u32x4 vw; vw.x = va.x; vw.y = va.y; vw.z = vb.x; vw.w = vb.y;
                    y[mt] = __builtin_amdgcn_mfma_f32_16x16x32_bf16(__builtin_bit_cast(bf16x8, vw), pf, y[mt], 0, 0, 0);
                }
            }
            float sm = 0.f;
#pragma unroll
            for (int mt = 0; mt < 4; ++mt) sm += (y[mt][0] + y[mt][1]) + (y[mt][2] + y[mt][3]);
            sm += __shfl_xor(sm, 16); sm += __shfl_xor(sm, 32);
            const float mu = sm * (1.f / 64.f); float qv = 0.f;
#pragma unroll
            for (int mt = 0; mt < 4; ++mt) { const f32x4 dd = y[mt] - mu; qv += (dd[0] * dd[0] + dd[1] * dd[1]) + (dd[2] * dd[2] + dd[3] * dd[3]); }
            qv += __shfl_xor(qv, 16); qv += __shfl_xor(qv, 32);
            const float rs = rsqrtf(qv * (1.f / 64.f) + 1e-5f);
#pragma unroll
            for (int mt = 0; mt < 4; ++mt) {
                const f32x4 g = ld_bf16x4(proj + (size_t)irow * NIN + (dir ? C_RGB : C_RGF) + h * 64 + 16 * mt + 4 * q4);
#pragma unroll
                for (int jj = 0; jj < 4; ++jj) outv[mt][jj] += (y[mt][jj] - mu) * rs * g[jj];
            }
        }
#pragma unroll
        for (int mt = 0; mt < 4; ++mt) { u32x2 w; w.x = pk2(outv[mt][0], outv[mt][1]); w.y = pk2(outv[mt][2], outv[mt][3]);
            *(u32x2*)(mix + (size_t)irow * D + MX_RET + h * 64 + 16 * mt + 4 * q4) = w; }
    }
    __syncthreads();
#undef RO_LOAD
#undef RO_WRITE
}

#ifndef ATT_THR
#define ATT_THR 11.5f
#endif
constexpr int AT_K = 0, AT_V = 128 * 144, AT_END = AT_V + 64 * 272;
DEV void stage_attn_fast(const P& p, int l, int bid, int nb, unsigned char* lds_, int wvx) {
    const int tid_ = TID, lane = tid_ & 63, wave = tid_ >> 6, r16 = lane & 15, q4 = lane >> 4;
    LAS unsigned char* lds = (LAS unsigned char*)lds_;
    const bf16_t* proj = (const bf16_t*)(p.ws + OFF_PROJ); const bf16_t* projT = (const bf16_t*)(p.ws + OFF_PROJT); bf16_t* mix = (bf16_t*)(p.ws + OFF_MIX);
    constexpr int BIG = 1 << 20;
    constexpr int NQT = 4;
    for (int it = bid; it < (l == 0 ? 520 : 512); it += nb) {
        const int grp = it, g = wave >> 1, hq = wave & 1;
        int hk, qrow0, cbase, nblk = -1, lbase = 0;
        if (grp < 512) { const int b = grp >> 8; nblk = (grp >> 1) & 127; hk = grp & 1; lbase = b * L; qrow0 = lbase + nblk * 128 + 64 * hq; cbase = TL + b * LC; }
        else { const int gg = grp - 512, cb = gg >> 2, qb = (gg >> 1) & 1; hk = gg & 1; qrow0 = TL + cb * LC + qb * 128 + 64 * hq; cbase = TL + cb * LC; }
        const int h = hk * 4 + g;
        bf16x8 qf[NQT][2];
#pragma unroll
        for (int nt = 0; nt < NQT; ++nt)
#pragma unroll
            for (int ks = 0; ks < 2; ++ks) qf[nt][ks] = *(const bf16x8*)(proj + (size_t)(qrow0 + 16 * nt + r16) * NIN + C_Q + h * 64 + 32 * ks + 8 * q4);
        const float sink = p.sinks[l * 8 + h] * LOG2E;
        float mrun[NQT], lrun[NQT];
#pragma unroll
        for (int nt = 0; nt < NQT; ++nt) { mrun[nt] = sink; lrun[nt] = (q4 == 0) ? 1.f : 0.f; }
        f32x4 o[4][NQT];
#pragma unroll
        for (int mt = 0; mt < 4; ++mt)
#pragma unroll
            for (int nt = 0; nt < NQT; ++nt) o[mt][nt] = (f32x4){0.f, 0.f, 0.f, 0.f};
        u32x4 pre[4];
#define AT_CHUNK_OK(c) ((c) == 0 ? nblk >= 1 : (c) == 1 ? nblk >= 0 : (c) == 2 ? (nblk >= 0 && nblk < 127) : true)
#define AT_CHUNK_ROW(c) ((c) < 3 ? lbase + (nblk - 1 + (c)) * 128 : cbase + ((c) - 3) * 128)
#define AT_LOAD(c) do { const int kr_ = AT_CHUNK_ROW(c); _Pragma("unroll") for (int i_ = 0; i_ < 2; ++i_) { const int pc = tid_ + 512 * i_; \
            pre[i_] = *(const u32x4*)(proj + (size_t)(kr_ + (pc >> 3)) * NIN + C_K + hk * 64 + (pc & 7) * 8); \
            pre[2 + i_] = *(const u32x4*)(projT + (size_t)(T_V + hk * 64 + (pc >> 4)) * TA + kr_ + (pc & 15) * 8); } } while (0)
#define AT_WRITE() do { _Pragma("unroll") for (int i_ = 0; i_ < 2; ++i_) { const int pc = tid_ + 512 * i_; \
            *(LAS u32x4*)(lds + AT_K + (pc >> 3) * 144 + (pc & 7) * 16) = pre[i_]; \
            *(LAS u32x4*)(lds + AT_V + (pc >> 4) * 272 + (pc & 15) * 16) = pre[2 + i_]; } } while (0)
        int c = 0; while (c < 5 && !AT_CHUNK_OK(c)) ++c;
        if (c < 5) AT_LOAD(c);
        while (c < 5) {
            int cn = c + 1; while (cn < 5 && !AT_CHUNK_OK(cn)) ++cn;
            __syncthreads();
            AT_WRITE();
            __syncthreads();
            if (cn < 5) AT_LOAD(cn);
            const int clo = c == 0 ? 0 : -BIG, chi = c == 2 ? 0 : BIG;
            const int sb0 = c == 0 ? 2 * hq : 0, sb1 = c == 2 ? 2 * hq + 1 : 3;
            for (int sb = sb0; sb <= sb1; ++sb) {
                const int dl0 = 32 * sb - 64 * hq;
                f32x4 sa[2][NQT];
#pragma unroll
                for (int mt = 0; mt < 2; ++mt) {
                    bf16x8 kf[2];
#pragma unroll
                    for (int ks = 0; ks < 2; ++ks) kf[ks] = *(const LAS bf16x8*)(lds + AT_K + (32 * sb + 16 * mt + r16) * 144 + ks * 64 + q4 * 16);
#pragma unroll
                    for (int nt = 0; nt < NQT; ++nt) {
                        sa[mt][nt] = (f32x4){0.f, 0.f, 0.f, 0.f};
#pragma unroll
                        for (int ks = 0; ks < 2; ++ks) sa[mt][nt] = __builtin_amdgcn_mfma_f32_16x16x32_bf16(kf[ks], qf[nt][ks], sa[mt][nt], 0, 0, 0);
                    }
                }
                bf16x8 pf[NQT];
                float lmax[NQT];
                if (c == 0 || c == 2) {
#pragma unroll
                    for (int nt = 0; nt < NQT; ++nt) {
                        float bm = -1e30f;
#pragma unroll
                        for (int mt = 0; mt < 2; ++mt)
#pragma unroll
                            for (int jj = 0; jj < 4; ++jj) {
                                const int dl = dl0 + 16 * mt + 4 * q4 + jj - (16 * nt + r16);
                                const float sv = (dl >= clo && dl <= chi) ? sa[mt][nt][jj] : -1e30f;
                                sa[mt][nt][jj] = sv; bm = fmaxf(bm, sv);
                            }
                        lmax[nt] = bm;
                    }
                } else {
#pragma unroll
                    for (int nt = 0; nt < NQT; ++nt)
                        lmax[nt] = fmaxf(fmaxf(fmaxf(sa[0][nt][0], sa[0][nt][1]), fmaxf(sa[0][nt][2], sa[0][nt][3])), fmaxf(fmaxf(sa[1][nt][0], sa[1][nt][1]), fmaxf(sa[1][nt][2], sa[1][nt][3])));
                }
                bool need = false;
#pragma unroll
                for (int nt = 0; nt < NQT; ++nt) need = need || (lmax[nt] > mrun[nt] + ATT_THR);
                if (__any(need)) {
#pragma unroll
                    for (int nt = 0; nt < NQT; ++nt) {
                        float bm = lmax[nt];
                        bm = fmaxf(bm, __shfl_xor(bm, 16)); bm = fmaxf(bm, __shfl_xor(bm, 32));
                        const float mn = fmaxf(mrun[nt], bm), sc = __builtin_amdgcn_exp2f(mrun[nt] - mn);
                        mrun[nt] = mn; lrun[nt] *= sc;
#pragma unroll
                        for (int mt = 0; mt < 4; ++mt) o[mt][nt] = o[mt][nt] * sc;
                    }
                }
#pragma unroll
                for (int nt = 0; nt < NQT; ++nt) {
                    float ps = 0.f;
#pragma unroll
                    for (int mt = 0; mt < 2; ++mt)
#pragma unroll
                        for (int jj = 0; jj < 4; ++jj) { const float pe = __builtin_amdgcn_exp2f(sa[mt][nt][jj] - mrun[nt]); sa[mt][nt][jj] = pe; ps += pe; }
                    lrun[nt] += ps;
                    pf[nt] = pack_b(sa[0][nt], sa[1][nt]);
                }
#pragma unroll
                for (int mt = 0; mt < 4; ++mt) {
                    const LAS unsigned char* vp = lds + AT_V + (16 * mt + r16) * 272 + (32 * sb + 4 * q4) * 2;
                    const u32x2 va = *(const LAS u32x2*)vp, vb = *(const LAS u32x2*)(vp + 32);
                    u32x4 vw; vw.x = va.x; vw.y = va.y; vw.z = vb.x; vw.w = vb.y;
                    const bf16x8 vf = __builtin_bit_cast(bf16x8, vw);
#pragma unroll
                    for (int nt = 0; nt < NQT; ++nt) o[mt][nt] = __builtin_amdgcn_mfma_f32_16x16x32_bf16(vf, pf[nt], o[mt][nt], 0, 0, 0);
                }
            }
            c = cn;
        }
#undef AT_CHUNK_OK
#undef AT_CHUNK_ROW
#undef AT_LOAD
#undef AT_WRITE
#pragma unroll
        for (int nt = 0; nt < NQT; ++nt) {
            float lt = lrun[nt]; lt += __shfl_xor(lt, 16); lt += __shfl_xor(lt, 32);
            const float inv = 1.f / lt;
#pragma unroll
            for (int mt = 0; mt < 4; ++mt) { const f32x4 v = o[mt][nt] * inv; u32x2 w; w.x = pk2(v[0], v[1]); w.y = pk2(v[2], v[3]);
                *(u32x2*)(mix + (size_t)(qrow0 + 16 * nt + r16) * D + MX_ATTN + h * 64 + 16 * mt + 4 * q4) = w; }
        }
    }
    __syncthreads();
}

#define XB_TMO      128
#define XB_XCNT(j)  (256  + 64 * (j))
#define XB_XSUB(j)  (1280 + 64 * (j))
#define XB_XGEN(j)  (2304 + 64 * (j))
#define XB_TOP      3328
#define XB_TOPGEN   3392
#define XCD_BAR_WORDS 3456
#define XB_SPIN_CAP (1u << 18)
__device__ __forceinline__ unsigned xb_ld(unsigned* p)              { return __hip_atomic_load(p, __ATOMIC_RELAXED, __HIP_MEMORY_SCOPE_AGENT); }
__device__ __forceinline__ unsigned xb_add(unsigned* p, unsigned v) { return __hip_atomic_fetch_add(p, v, __ATOMIC_RELAXED, __HIP_MEMORY_SCOPE_AGENT); }
__device__ __forceinline__ unsigned xb_xcc_id() { return (unsigned)__builtin_amdgcn_s_getreg((3 << 11) | 20) & 0xFu; }
#define XB_SPIN(cond, bar) do { unsigned _sp = 0; while (cond) { __builtin_amdgcn_s_sleep(1); \
    if ((++_sp & 255u) == 0u) { if (xb_ld(&(bar)[XB_TMO])) break; if (_sp > XB_SPIN_CAP) { atomicAdd(&(bar)[XB_TMO], 1u); break; } } } } while (0)
struct XcdBarrier { unsigned* bar; unsigned x; volatile LAS unsigned* st; };
__device__ __forceinline__ XcdBarrier xcd_barrier_post(unsigned* bar, volatile LAS unsigned* st, const int wvx) {
    XcdBarrier b; b.bar = bar; b.x = xb_xcc_id(); b.st = st;
    if (TID == 0) (void)xb_add(&bar[XB_XCNT(b.x)], 1u);
    return b;
}
__device__ __forceinline__ void xcd_barrier_complete(unsigned* bar, unsigned x, unsigned& nloc, unsigned& nx) {
    const unsigned G = gridDim.x * gridDim.y * gridDim.z;
    unsigned sum, cnt, mine, sp = 0u;
    for (;;) {
        sum = 0u; cnt = 0u; mine = 0u;
#pragma unroll
        for (unsigned j = 0; j < 16; ++j) { const unsigned c = xb_ld(&bar[XB_XCNT(j)]); sum += c; cnt += (c > 0u) ? 1u : 0u; mine = (j == x) ? c : mine; }
        if (sum == G) break;
        __builtin_amdgcn_s_sleep(1);
        if ((++sp & 255u) == 0u) { if (xb_ld(&bar[XB_TMO])) break; if (sp > XB_SPIN_CAP) { atomicAdd(&bar[XB_TMO], 1u); break; } }
    }
    nloc = mine > 0u ? mine : 1u; nx = cnt > 0u ? cnt : 1u;
}
__device__ __forceinline__ void xcd_barrier(const XcdBarrier& b, const int wvx) {
    asm volatile("s_waitcnt vmcnt(0)" ::: "memory");
    __syncthreads();
    if (TID == 0) {
        unsigned* bar = b.bar;
        __builtin_amdgcn_s_waitcnt(0);
        unsigned nloc = b.st[0], nx = b.st[1];
        if (nloc == 0u) { xcd_barrier_complete(bar, b.x, nloc, nx); b.st[0] = nloc; b.st[1] = nx; }
        const unsigned old = xb_add(&bar[XB_XSUB(b.x)], 1u);
        const unsigned gen = old / nloc;
        if (old + 1u == (gen + 1u) * nloc) {
            __builtin_amdgcn_fence(__ATOMIC_RELEASE, "agent");
            asm volatile("s_waitcnt vmcnt(0)" ::: "memory");
            const unsigned og = xb_add(&bar[XB_TOP], 1u);
            const unsigned tg = og / nx;
            if (og + 1u == (tg + 1u) * nx) xb_add(&bar[XB_TOPGEN], 1u);
            else XB_SPIN(xb_ld(&bar[XB_TOPGEN]) == tg, bar);
            __builtin_amdgcn_fence(__ATOMIC_ACQUIRE, "agent");
            xb_add(&bar[XB_XGEN(b.x)], 1u);
            asm volatile("s_waitcnt vmcnt(0)" ::: "memory");
        } else {
            XB_SPIN(xb_ld(&bar[XB_XGEN(b.x)]) == gen, bar);
            __builtin_amdgcn_fence(__ATOMIC_ACQUIRE, "agent");
            asm volatile("s_waitcnt vmcnt(0)" ::: "memory");
        }
    }
    __syncthreads();
}

constexpr int NPL = 10;
constexpr int NPHASES = 2 + 2 * NPL;
constexpr int CW_BAR = 4096;
constexpr int LDS_BARW = LDS_BYTES - 16;
__global__ void __launch_bounds__(NTHREADS, 2) mk_fwd(P p) {
    extern __shared__ __attribute__((aligned(16))) unsigned char lds[];
    const int bid = blockIdx.x, nb = gridDim.x;
    const int wvx = __builtin_amdgcn_readfirstlane((int)(threadIdx.x >> 6));
    if (TID == 0) { ((volatile LAS unsigned*)(lds + LDS_BARW))[0] = 0u; ((volatile LAS unsigned*)(lds + LDS_BARW))[1] = 0u; }
    __syncthreads();
    const bool multi = (p.ph_hi - p.ph_lo) > 1;
    XcdBarrier bar; bar.bar = (unsigned*)(p.ws + OFF_CTL) + CW_BAR; bar.x = 0; bar.st = (volatile LAS unsigned*)(lds + LDS_BARW);
    if (multi) bar = xcd_barrier_post((unsigned*)(p.ws + OFF_CTL) + CW_BAR, (volatile LAS unsigned*)(lds + LDS_BARW), wvx);
#define IN(k) (p.ph_lo <= (k) && (k) < p.ph_hi)
#define STAGE(call) do { const P& q = p; const int ll = l; call; } while (0)
#define SEAM(k) do { if (IN(k) && IN((k) + 1)) xcd_barrier(bar, wvx); } while (0)
#ifndef PHMASK
#define PHMASK 0xFFFF
#endif
#define PHON(b) ((PHMASK >> (b)) & 1)
#ifndef DUPMASK
#define DUPMASK 0
#endif
#define DUPN(b) (1 + ((DUPMASK >> (b)) & 1))
    if (PHON(0) && IN(0)) { const int l = 0; for (int r_ = 0; r_ < DUPN(0); ++r_) { STAGE(stage_prep(q, bid, nb, lds, wvx)); __syncthreads(); } } SEAM(0);
    if (PHON(1) && IN(1)) { const int l = 0; STAGE(stage_norm0(q, bid, nb, wvx)); } SEAM(1);
    { constexpr int l = 0; const int pb = 2 + l * NPL;
        if (PHON(2) && IN(pb + 0)) { for (int r_ = 0; r_ < DUPN(2); ++r_) { STAGE(stage_inproj_fast(q, ll, bid, nb, lds, wvx)); __syncthreads(); } } SEAM(pb + 0);
        if (PHON(3) && IN(pb + 1)) { for (int r_ = 0; r_ < DUPN(3); ++r_) { if (l == 0) { if (bid >= 8) STAGE(stage_ret_kv(q, ll, bid - 8, nb - 8, wvx)); } else STAGE(stage_ret_kv(q, ll, bid, nb, wvx));     STAGE(stage_attn_fast(q, ll, bid, nb, lds, wvx)); __syncthreads(); } } SEAM(pb + 1);
        if (PHON(4) && IN(pb + 2)) { for (int r_ = 0; r_ < DUPN(4); ++r_) { if (bid < 64) STAGE(stage_ret_scan(q, ll, bid, 64, wvx)); else STAGE(stage_pool_diff(q, ll, bid - 64, nb - 64, wvx));     __syncthreads(); } } SEAM(pb + 2);
        if (PHON(5) && IN(pb + 3)) { for (int r_ = 0; r_ < DUPN(5); ++r_) { STAGE(stage_ret_out(q, ll, bid, nb, lds, wvx)); __syncthreads(); } } SEAM(pb + 3);
        if (PHON(6) && IN(pb + 4)) { for (int r_ = 0; r_ < DUPN(6); ++r_) { STAGE(stage_merge_fast(q, ll, bid, nb, lds, wvx)); if (l == 0) STAGE(stage_merge_ctx(q, ll, bid, nb, wvx)); __syncthreads(); } } SEAM(pb + 4);
        if (PHON(7) && IN(pb + 5)) { STAGE(stage_out_fast(q, ll, bid, nb, lds, wvx)); if (l == 0) STAGE(stage_out_ctx(q, ll, bid, nb, wvx)); } SEAM(pb + 5);
        if (PHON(8) && IN(pb + 6)) { if (INP_FP8 != 2 || NCONV_ == 0) { STAGE(stage_prep_experts(q, ll, bid, nb, lds, wvx)); __syncthreads(); } if (ROUTE_MFMA) STAGE(stage_route_mfma(q, ll, bid, nb, lds, wvx)); else STAGE(stage_route(q, ll, bid, nb, lds, wvx)); } SEAM(pb + 6);
        if (PHON(9) && IN(pb + 7)) { for (int r_ = 0; r_ < DUPN(9); ++r_) { STAGE(stage_moe1_fast(q, ll, bid, nb, lds, wvx)); __syncthreads(); } } SEAM(pb + 7);
        if (PHON(10) && IN(pb + 8)) { for (int r_ = 0; r_ < DUPN(10); ++r_) { STAGE(stage_moe2_fast(q, ll, bid, nb, lds, wvx)); __syncthreads(); } } SEAM(pb + 8);
        if (PHON(11) && IN(pb + 9)) { STAGE(stage_combine(q, ll, bid, nb, lds, wvx)); } SEAM(pb + 9);
     }
    { constexpr int l = 1; const int pb = 2 + l * NPL;
        if (PHON(2) && IN(pb + 0)) { for (int r_ = 0; r_ < DUPN(2); ++r_) { STAGE(stage_inproj_fast(q, ll, bid, nb, lds, wvx)); __syncthreads(); } } SEAM(pb + 0);
        if (PHON(3) && IN(pb + 1)) { for (int r_ = 0; r_ < DUPN(3); ++r_) { if (l == 0) { if (bid >= 8) STAGE(stage_ret_kv(q, ll, bid - 8, nb - 8, wvx)); } else STAGE(stage_ret_kv(q, ll, bid, nb, wvx));     STAGE(stage_attn_fast(q, ll, bid, nb, lds, wvx)); __syncthreads(); } } SEAM(pb + 1);
        if (PHON(4) && IN(pb + 2)) { for (int r_ = 0; r_ < DUPN(4); ++r_) { if (bid < 64) STAGE(stage_ret_scan(q, ll, bid, 64, wvx)); else STAGE(stage_pool_diff(q, ll, bid - 64, nb - 64, wvx));     __syncthreads(); } } SEAM(pb + 2);
        if (PHON(5) && IN(pb + 3)) { for (int r_ = 0; r_ < DUPN(5); ++r_) { STAGE(stage_ret_out(q, ll, bid, nb, lds, wvx)); __syncthreads(); } } SEAM(pb + 3);
        if (PHON(6) && IN(pb + 4)) { for (int r_ = 0; r_ < DUPN(6); ++r_) { STAGE(stage_merge_fast(q, ll, bid, nb, lds, wvx)); if (l == 0) STAGE(stage_merge_ctx(q, ll, bid, nb, wvx)); __syncthreads(); } } SEAM(pb + 4);
        if (PHON(7) && IN(pb + 5)) { STAGE(stage_out_fast(q, ll, bid, nb, lds, wvx)); if (l == 0) STAGE(stage_out_ctx(q, ll, bid, nb, wvx)); } SEAM(pb + 5);
        if (PHON(8) && IN(pb + 6)) { if (INP_FP8 != 2 || NCONV_ == 0) { STAGE(stage_prep_experts(q, ll, bid, nb, lds, wvx)); __syncthreads(); } if (ROUTE_MFMA) STAGE(stage_route_mfma(q, ll, bid, nb, lds, wvx)); else STAGE(stage_route(q, ll, bid, nb, lds, wvx)); } SEAM(pb + 6);
        if (PHON(9) && IN(pb + 7)) { for (int r_ = 0; r_ < DUPN(9); ++r_) { STAGE(stage_moe1_fast(q, ll, bid, nb, lds, wvx)); __syncthreads(); } } SEAM(pb + 7);
        if (PHON(10) && IN(pb + 8)) { for (int r_ = 0; r_ < DUPN(10); ++r_) { STAGE(stage_moe2_fast(q, ll, bid, nb, lds, wvx)); __syncthreads(); } } SEAM(pb + 8);
        if (PHON(11) && IN(pb + 9)) { STAGE(stage_combine(q, ll, bid, nb, lds, wvx)); } SEAM(pb + 9);
     }
#undef IN
#undef SEAM
}

#ifndef MK_CUTS
#define MK_CUTS 1
#endif
extern "C" void kernel_launch(void* const* d_in, const int* in_sizes, int n_in, void* d_out, int out_size, void* d_ws, size_t ws_size, hipStream_t stream) {
    static int grid = 0;
    if (grid == 0) {
        if (n_in != 24 || out_size != TL * D || ws_size < WS_END) { fprintf(stderr, "kernel_launch: unexpected shapes: n_in %d out %d ws %zu (need %zu)\n", n_in, out_size, ws_size, (size_t)WS_END); grid = -1; return; }
        int dev = 0, cus = 0, per_cu = 0;
        if (hipGetDevice(&dev) != hipSuccess || hipDeviceGetAttribute(&cus, hipDeviceAttributeMultiprocessorCount, dev) != hipSuccess) { grid = -1; return; }
        if (hipFuncSetAttribute((const void*)mk_fwd, hipFuncAttributeMaxDynamicSharedMemorySize, LDS_BYTES) != hipSuccess) { fprintf(stderr, "kernel_launch: hipFuncSetAttribute failed\n"); grid = -1; return; }
        if (hipOccupancyMaxActiveBlocksPerMultiprocessor(&per_cu, (const void*)mk_fwd, NTHREADS, LDS_BYTES) != hipSuccess || per_cu < 1) { fprintf(stderr, "kernel_launch: occupancy query says %d blocks per CU\n", per_cu); (void)hipGetLastError(); }
        grid = cus > 0 ? cus : 256;
    }
    if (grid < 0) return;
    (void)hipMemsetAsync((char*)d_ws + OFF_CTL, 0, CTL_BYTES, stream);
    P p; memset(&p, 0, sizeof(p));
    const float** f = (const float**)&p;
    for (int i = 0; i < 24; ++i) f[i] = (const float*)d_in[i];
    p.out = (float*)d_out; p.ws = (unsigned char*)d_ws;
    for (int i = 0; i < 32; ++i) p.inv_ret[i] = 1.0 / pow(10000.0, (double)((float)i / 31.0f));
    for (int i = 0; i < 16; ++i) p.inv_ax[i] = pow(10000.0, -(double)(2 * i) / 32.0);
#if MK_CUTS
    p.ph_lo = 0; p.ph_hi = NPHASES;
    hipLaunchKernelGGL(mk_fwd, dim3(grid), dim3(NTHREADS), LDS_BYTES, stream, p);
#else
    for (int ph = 0; ph < NPHASES; ++ph) { p.ph_lo = ph; p.ph_hi = ph + 1; hipLaunchKernelGGL(mk_fwd, dim3(grid), dim3(NTHREADS), LDS_BYTES, stream, p); }
#endif
}
```

```cpp
#include <hip/hip_runtime.h>
#include <stdint.h>
#include <stdio.h>
#include <string.h>
#include <math.h>
#include <type_traits>

#define DEV __device__ __forceinline__
#define LAS __attribute__((address_space(3)))
typedef unsigned short bf16_t;
typedef short bf16x8 __attribute__((ext_vector_type(8)));
typedef float f32x4 __attribute__((ext_vector_type(4)));
typedef float f32x2 __attribute__((ext_vector_type(2)));
typedef unsigned u32x4 __attribute__((ext_vector_type(4)));
typedef unsigned u32x2 __attribute__((ext_vector_type(2)));

constexpr int D = 1024, NBATCH = 2, L = 16384, LC = 256, TL = NBATCH * L, TC = NBATCH * LC, TA = TL + TC;
constexpr int NIN = 5376, NEXP = 32, CAP = TA, PMAX = 141312;
constexpr int C_Q = 0, C_K = 512, C_V = 640, C_U = 768, C_RQ = 1024, C_RK = 1280, C_RV = 1536, C_RGF = 1792, C_RGB = 2048, C_GA = 2304;
constexpr int T_V = 0, T_RV = 256, T_RKF = 512, T_RKB = 768, TROWS = 1024;
constexpr int MX_ATTN = 0, MX_POOL = 512, MX_RET = 768;
constexpr int NTHREADS = 512, NWAVES = 8;

constexpr size_t MiB = 1u << 20;
constexpr size_t OFF_CTL = 0, CTL_BYTES = 1 * MiB;
constexpr size_t OFF_MOD = 1 * MiB;
constexpr size_t OFF_TABR = 2 * MiB;
constexpr size_t OFF_TABA = 6 * MiB;
constexpr size_t OFF_TABW = 6 * MiB + 512 * 1024;
constexpr size_t OFF_WTIN = 7 * MiB;
constexpr size_t OFF_WTT = 28 * MiB;
constexpr size_t OFF_WTM = 31 * MiB;
constexpr size_t OFF_WTO = 35 * MiB;
constexpr size_t OFF_WT1 = 40 * MiB;
constexpr size_t OFF_WT2 = 296 * MiB;
constexpr size_t OFF_HBF = 424 * MiB;
constexpr size_t OFF_XR = 489 * MiB;
constexpr size_t OFF_TK = 1840 * MiB;
constexpr size_t OFF_PROJ = 627 * MiB;
constexpr size_t OFF_PROJT = 969 * MiB;
constexpr size_t OFF_MIX = 1034 * MiB;
constexpr size_t OFF_M = 1099 * MiB;
constexpr size_t OFF_HQ = 1164 * MiB;
constexpr size_t OFF_WTOQ = 1212 * MiB;
constexpr size_t OFF_ROWSQ = 1216 * MiB;
constexpr size_t OFF_WTINQ = 1204 * MiB;
constexpr size_t OFF_KV = 1229 * MiB;
constexpr size_t OFF_TABRT = 1272 * MiB;
constexpr size_t OFF_ACT = 1280 * MiB;
constexpr size_t OFF_YB = 1556 * MiB;
constexpr size_t WS_END = 1856 * MiB;
constexpr size_t TK_LAYER = 8 * MiB;
constexpr int CW_CNT = 65536;
constexpr int CW_DYN = 66560;

constexpr int LDS_BYTES = 147456;
constexpr float LOG2E = 1.4426950408889634f;
#ifndef MOE_FP8
#define MOE_FP8 2
#endif
#ifndef INP_FP8
#define INP_FP8 2
#endif
#ifndef OUT_FP8
#define OUT_FP8 0
#endif
constexpr float QW = 32.f, QA = 4.f, QM = 8.f;

struct P {
    const float *x, *c, *ctx, *c_ctx, *w_mod, *b_mod, *norm1, *norm2, *w_in, *sinks, *pool_w, *pool_scale, *ret_decay, *w_o_attn, *w_o_pool, *w_o_ret,
        *w_out, *w_router, *b_router, *w1, *b1, *w2, *b2, *final_norm;
    float* out;
    unsigned char* ws;
    double inv_ret[32];
    double inv_ax[16];
    int ph_lo, ph_hi;
};

DEV float bf2f(bf16_t b) { return __uint_as_float(((unsigned)b) << 16); }
typedef __bf16 bf16x2_t __attribute__((ext_vector_type(2)));
DEV unsigned pk2(float lo, float hi) { f32x2 v = {lo, hi}; bf16x2_t b = __builtin_convertvector(v, bf16x2_t); return __builtin_bit_cast(unsigned, b); }
DEV bf16_t f2bf(float f) { return (bf16_t)(pk2(f, 0.f) & 0xffffu); }
DEV unsigned pk4q(float a, float b, float c, float d) { int w = 0; w = __builtin_amdgcn_cvt_pk_fp8_f32(a, b, w, false); w = __builtin_amdgcn_cvt_pk_fp8_f32(c, d, w, true); return (unsigned)w; }
DEV float sigmoidf_(float x) { return __builtin_amdgcn_rcpf(1.f + __expf(-x)); }
DEV float siluf_(float x) { return x * __builtin_amdgcn_rcpf(1.f + __expf(-x)); }
DEV float rdl(float v, int l) { return __uint_as_float((unsigned)__builtin_amdgcn_readlane((int)__float_as_uint(v), l)); }
DEV int lane_id() { int r; asm volatile("v_mbcnt_lo_u32_b32 %0, -1, 0\n\tv_mbcnt_hi_u32_b32 %0, -1, %0" : "=v"(r)); return r; }
#define TID (wvx * 64 + lane_id())
DEV float wave_sum(float v) {
#pragma unroll
    for (int o = 1; o < 64; o <<= 1) v += __shfl_xor(v, o);
    return v;
}
DEV int row_mod(int r) { return r < TL ? (r >= L ? 1 : 0) : 2; }
DEV const float* in_row(const P& p, int r) { return r < TL ? p.x + (size_t)r * D : p.ctx + (size_t)(r - TL) * D; }
DEV const float* modp(const P& p, int l, int s, int part) { return (const float*)(p.ws + OFF_MOD) + ((size_t)(l * 3 + s) * 6 + part) * D; }

template <class Dst>
DEV void transpose_item(const float* W, int N, int kb, int nb, float* scr  , int lane, Dst dst) {
    const int k0 = 64 * kb + 16 * (lane >> 4), n0 = 64 * nb + 4 * (lane & 15);
    f32x4 v[16];
#pragma unroll
    for (int i = 0; i < 16; ++i) v[i] = *(const f32x4*)(W + (size_t)(k0 + i) * N + n0);
#pragma unroll
    for (int j = 0; j < 4; ++j) {
        u32x4 o0, o1;
        o0.x = pk2(v[0][j], v[1][j]); o0.y = pk2(v[2][j], v[3][j]); o0.z = pk2(v[4][j], v[5][j]); o0.w = pk2(v[6][j], v[7][j]);
        o1.x = pk2(v[8][j], v[9][j]); o1.y = pk2(v[10][j], v[11][j]); o1.z = pk2(v[12][j], v[13][j]); o1.w = pk2(v[14][j], v[15][j]);
        bf16_t* d0 = dst(n0 + j, 0); if (d0) { *(u32x4*)(d0 + k0) = o0; *(u32x4*)(d0 + k0 + 8) = o1; }
        bf16_t* d1 = dst(n0 + j, 1); if (d1) { *(u32x4*)(d1 + k0) = o0; *(u32x4*)(d1 + k0 + 8) = o1; }
    }
}
DEV float log_g(const P& p, int l, int dir, int h) { const float x = p.ret_decay[(l * 2 + dir) * 4 + h]; return -log1pf(__expf(-x)); }
DEV int ret_phys(int d) { return ((d >> 4) & 1) * 32 + (d >> 5) * 16 + (d & 15); }

template <bool NT>
DEV void titem_load(const float* W, int N, int kb, int nb, int lane, f32x4 (&v)[16]) {
    const int k0 = 64 * kb, n0 = 64 * nb;
#pragma unroll
    for (int i = 0; i < 16; ++i) {
        const int kk = 16 * (lane >> 4) + i, c4 = (lane & 15) * 4;
        const f32x4* src = (const f32x4*)(W + (size_t)(k0 + kk) * N + n0 + c4);
        v[i] = NT ? __builtin_nontemporal_load(src) : *src;
    }
}
template <class Dst>
DEV void titem_finish_q(const f32x4 (&v)[16], int kb, int nb, float* scr  , int lane, float sc, Dst dst) {
    const int k0 = 64 * kb + 16 * (lane >> 4), n0 = 64 * nb + 4 * (lane & 15);
#pragma unroll
    for (int j = 0; j < 4; ++j) {
        u32x4 o;
        o.x = pk4q(v[0][j] * sc, v[1][j] * sc, v[2][j] * sc, v[3][j] * sc); o.y = pk4q(v[4][j] * sc, v[5][j] * sc, v[6][j] * sc, v[7][j] * sc);
        o.z = pk4q(v[8][j] * sc, v[9][j] * sc, v[10][j] * sc, v[11][j] * sc); o.w = pk4q(v[12][j] * sc, v[13][j] * sc, v[14][j] * sc, v[15][j] * sc);
        unsigned char* d0 = dst(n0 + j, 0); if (d0) *(u32x4*)(d0 + k0) = o;
        unsigned char* d1 = dst(n0 + j, 1); if (d1) *(u32x4*)(d1 + k0) = o;
    }
}
template <class Dst>
DEV void transpose_item_q(const float* W, int N, int kb, int nb, float* scr, int lane, float sc, Dst dst) {
    f32x4 v[16]; titem_load<false>(W, N, kb, nb, lane, v); titem_finish_q(v, kb, nb, scr, lane, sc, dst);
}

DEV void stage_prep(const P& p, int bid, int nb, unsigned char* lds, int wvx) {
    const int tid = TID, lane = tid & 63, wave = tid >> 6;
    float* scr = (float*)lds + wave * (64 * 65);
    unsigned char* ws = p.ws;
    constexpr int I_IN = 16 * 84, I_OA = 8 * 16, I_OR = 4 * 16, I_OUT = 16 * 16, I_W1 = 16 * 32, I_W2 = 16 * 16;
    constexpr int PER_LAYER = I_IN + I_OA + I_OR + I_OUT;
    const int gw = bid * NWAVES + wave, ngw = nb * NWAVES;
    for (int it = gw; it < 2 * PER_LAYER; it += ngw) {
        const int l = it / PER_LAYER; int r = it % PER_LAYER;
#if INP_FP8 == 2
        if (r < I_IN && (r % 84) >= C_GA / 64) {
            unsigned char* wq = ws + OFF_WTINQ + (size_t)l * (NIN - C_GA) * D;
            transpose_item_q(p.w_in + (size_t)l * D * NIN, NIN, r / 84, r % 84, scr, lane, QW, [&](int n, int which) -> unsigned char* { return which ? (unsigned char*)nullptr : wq + (size_t)(n - C_GA) * D; });
            continue; }
#endif
#if INP_FP8 == 1
        if (r < I_IN) {
            unsigned char* wt = ws + OFF_WTIN + (size_t)l * NIN * D; unsigned char* wtt = ws + OFF_WTT + (size_t)l * 768 * D;
            transpose_item_q(p.w_in + (size_t)l * D * NIN, NIN, r / 84, r % 84, scr, lane, QW, [&](int n, int which) -> unsigned char* {
                int pr = n;
                if (n >= C_RQ && n < C_RV) pr = (n & ~63) + ret_phys(n & 63);
                if (which == 0) return wt + (size_t)pr * D;
                int tr = -1;
                if (n >= C_V && n < C_U) tr = n - C_V;
                else if (n >= C_K && n < C_V) tr = 128 + (n - C_K);
                else if (n >= C_RV && n < C_RGF) tr = 256 + (n - C_RV);
                else if (n >= C_RK && n < C_RV) tr = 512 + (pr - C_RK);
                return tr < 0 ? (unsigned char*)nullptr : wtt + (size_t)tr * D; });
            continue; }
#endif
        if (r < I_IN) {
            bf16_t* wt = (bf16_t*)(ws + OFF_WTIN) + (size_t)l * NIN * D; bf16_t* wtt = (bf16_t*)(ws + OFF_WTT) + (size_t)l * 768 * D;
            transpose_item(p.w_in + (size_t)l * D * NIN, NIN, r / 84, r % 84, scr, lane, [&](int n, int which) -> bf16_t* {
                int pr = n;
                if (n >= C_RQ && n < C_RV) pr = (n & ~63) + ret_phys(n & 63);
                if (which == 0) return wt + (size_t)pr * D;
                int tr = -1;
                if (n >= C_V && n < C_U) tr = n - C_V;
                else if (n >= C_K && n < C_V) tr = 128 + (n - C_K);
                else if (n >= C_RV && n < C_RGF) tr = 256 + (n - C_RV);
                else if (n >= C_RK && n < C_RV) tr = 512 + (pr - C_RK);
                return tr < 0 ? (bf16_t*)nullptr : wtt + (size_t)tr * D; });
            continue; }
        r -= I_IN;
        if (r < I_OA) { bf16_t* wt = (bf16_t*)(ws + OFF_WTM) + (size_t)l * D * D;
            transpose_item(p.w_o_attn + (size_t)l * 512 * D, D, r / 16, r % 16, scr, lane, [&](int n, int which) -> bf16_t* { return which ? (bf16_t*)nullptr : wt + (size_t)n * D + MX_ATTN; }); continue; }
        r -= I_OA;
        if (r < I_OR) { bf16_t* wt = (bf16_t*)(ws + OFF_WTM) + (size_t)l * D * D;
            transpose_item(p.w_o_ret + (size_t)l * 256 * D, D, r / 16, r % 16, scr, lane, [&](int n, int which) -> bf16_t* { return which ? (bf16_t*)nullptr : wt + (size_t)n * D + MX_RET; }); continue; }
        r -= I_OR;
#if OUT_FP8
        if (r < I_OUT) { unsigned char* wq = ws + OFF_WTOQ + (size_t)l * D * D;
            transpose_item_q(p.w_out + (size_t)l * D * D, D, r / 16, r % 16, scr, lane, QW, [&](int n, int which) -> unsigned char* { return which ? (unsigned char*)nullptr : wq + (size_t)n * D; }); }
#endif
        if (r < I_OUT) { bf16_t* wt = (bf16_t*)(ws + OFF_WTO) + (size_t)l * D * D;
            transpose_item(p.w_out + (size_t)l * D * D, D, r / 16, r % 16, scr, lane, [&](int n, int which) -> bf16_t* { return which ? (bf16_t*)nullptr : wt + (size_t)n * D; }); continue; }
    }
    const int gt = bid * NTHREADS + tid, ngt = nb * NTHREADS;
    for (int it = gt; it < 2 * 256 * D; it += ngt) {
        const int l = it / (256 * D), c = (it / D) % 256, n = it % D, g = c >> 6, cl = c & 63;
        const float* pw = p.pool_w + (((size_t)l * 4 + g) * 64 + cl) * 64; const float* ps = p.pool_scale + l * 256 + g * 64; const float* wo = p.w_o_pool + ((size_t)l * 256 + g * 64) * D + n;
        float s = 0.f;
        for (int e = 0; e < 64; ++e) s += pw[e] * ps[e] * wo[(size_t)e * D];
        ((bf16_t*)(ws + OFF_WTM))[(size_t)l * D * D + (size_t)n * D + MX_POOL + c] = f2bf(s);
    }
    {
        float* sl = (float*)(lds + 8 * 64 * 65 * 4);
        __syncthreads();
        for (int i = tid; i < 3 * D; i += NTHREADS) { const int s = i / D, k = i % D; const float v = s < 2 ? p.c[s * D + k] : p.c_ctx[k]; sl[i] = siluf_(v); }
        __syncthreads();
        float* mod = (float*)(ws + OFF_MOD);
        float* red = (float*)lds;
        for (int blk = bid; blk < 2 * 96; blk += nb) {
            const int l = blk / 96, n = (blk % 96) * 64 + (tid & 63), ks = tid >> 6;
            const float* w = p.w_mod + (size_t)l * D * 6 * D + (size_t)(128 * ks) * 6 * D + n; const float* s0 = sl + 128 * ks; float a0 = 0.f, a1 = 0.f, a2 = 0.f;
#pragma unroll 16
            for (int k = 0; k < 128; ++k) { const float wv = w[(size_t)k * 6 * D]; a0 += s0[k] * wv; a1 += s0[D + k] * wv; a2 += s0[2 * D + k] * wv; }
            red[(ks * 3 + 0) * 64 + (tid & 63)] = a0; red[(ks * 3 + 1) * 64 + (tid & 63)] = a1; red[(ks * 3 + 2) * 64 + (tid & 63)] = a2;
            __syncthreads();
            if (tid < 192) { const int sI = tid >> 6, nn = tid & 63; float a = 0.f;
#pragma unroll
                for (int q = 0; q < 8; ++q) a += red[(q * 3 + sI) * 64 + nn];
                const int nc = (blk % 96) * 64 + nn; mod[(size_t)(l * 3 + sI) * 6 * D + nc] = a + p.b_mod[l * 6 * D + nc]; }
            __syncthreads();
        }
    }
    {
        f32x2* tr = (f32x2*)(ws + OFF_TABR);
        const double TWO_PI = 6.283185307179586476925286766559, INV_2PI = 0.15915494309189533576888376337251;
        for (int it = gt; it < L * 32 + 256 * 16 + 64 * 16; it += ngt) {
            double ang; f32x2* dst;
            if (it < L * 32) { ang = (double)(it >> 5) * p.inv_ret[it & 31]; dst = tr + it; }
            else { const int j = it - L * 32; const int pos = j < 256 * 16 ? (j >> 4) : ((j - 256 * 16) >> 4); ang = (double)pos * p.inv_ax[j & 15]; dst = (f32x2*)(ws + OFF_TABA) + j; }
            const double n = rint(ang * INV_2PI); const float r = (float)(ang - n * TWO_PI);
            const float cv = __cosf(r), sv = __sinf(r);
            *dst = (f32x2){cv, sv};
            if (it < L * 32) { float* tt = (float*)(ws + OFF_TABRT); tt[(size_t)(it & 31) * L + (it >> 5)] = cv; tt[(size_t)(32 + (it & 31)) * L + (it >> 5)] = sv; }
        }
        for (int it = gt; it < 2 * 2 * 4 * 128; it += ngt) {
            const int j = it & 127, h = (it >> 7) & 3, dir = (it >> 9) & 1, l = it >> 10; const float lg = log_g(p, l, dir, h);
            ((float*)(ws + OFF_TABW))[it] = __expf(lg * (float)(dir == 0 ? 127 - j : j));
        }
    }
}


DEV void stage_prep_experts(const P& p, int l, int bid, int nb, unsigned char* lds, int wvx) {
    const int tid = TID, lane = tid & 63, wave = tid >> 6;
    float* scr = (float*)lds + wave * (64 * 65);
    unsigned char* ws = p.ws;
    constexpr int I_W1 = 16 * 32, I_W2 = 16 * 16;
    const int gw = bid * NWAVES + wave, ngw = nb * NWAVES;
#if MOE_FP8 >= 2
    auto src = [&](int it, const float*& W, int& N, int& kb, int& nbk) { const int e = it / (I_W1 + I_W2), r = it % (I_W1 + I_W2);
        if (r < I_W1) { W = p.w1 + ((size_t)l * NEXP + e) * D * 2048; N = 2048; kb = r / 32; nbk = r % 32; }
        else { W = p.w2 + ((size_t)l * NEXP + e) * D * D; N = D; kb = (r - I_W1) / 16; nbk = (r - I_W1) % 16; } };
    f32x4 va[16], vb[16];
    int it = gw;
    if (it < NEXP * (I_W1 + I_W2)) { const float* W; int N, kb, nbk; src(it, W, N, kb, nbk); titem_load<true>(W, N, kb, nbk, lane, va); }
    for (; it < NEXP * (I_W1 + I_W2); it += ngw) {
        const int itn = it + ngw;
        if (itn < NEXP * (I_W1 + I_W2)) { const float* W; int N, kb, nbk; src(itn, W, N, kb, nbk); titem_load<true>(W, N, kb, nbk, lane, vb); }
        const int e = it / (I_W1 + I_W2), r = it % (I_W1 + I_W2);
        if (r < I_W1) {
            unsigned char* wq = ws + OFF_WT1 + ((size_t)l * NEXP + e) * 2048 * D;
            titem_finish_q(va, r / 32, r % 32, scr, lane, QW, [&](int n, int which) -> unsigned char* {
                const int j = n & 1023, jq = (j >> 2) & 3, pq = jq == 1 ? 2 : jq == 2 ? 1 : jq;
                const int pr = 32 * (j >> 4) + (n >= 1024 ? 16 : 0) + 4 * pq + (j & 3);
                return which ? (unsigned char*)nullptr : wq + (size_t)pr * D; });
        } else {
            unsigned char* wq = ws + OFF_WT2 + ((size_t)l * NEXP + e) * D * D;
            titem_finish_q(va, (r - I_W1) / 16, (r - I_W1) % 16, scr, lane, QW, [&](int n, int which) -> unsigned char* { return which ? (unsigned char*)nullptr : wq + (size_t)n * D; });
        }
#pragma unroll
        for (int i = 0; i < 16; ++i) va[i] = vb[i];
    }
#else
    for (int it = gw; it < NEXP * (I_W1 + I_W2); it += ngw) {
        int r = it;
        const int e = r / (I_W1 + I_W2); r %= (I_W1 + I_W2);
        if (r < I_W1) {
#if MOE_FP8 >= 1
            unsigned char* wq = ws + OFF_WT1 + ((size_t)l * NEXP + e) * 2048 * D;
            transpose_item_q(p.w1 + ((size_t)l * NEXP + e) * D * 2048, 2048, r / 32, r % 32, scr, lane, QW, [&](int n, int which) -> unsigned char* {
                const int j = n & 1023, jq = (j >> 2) & 3, pq = jq == 1 ? 2 : jq == 2 ? 1 : jq;
                const int pr = 32 * (j >> 4) + (n >= 1024 ? 16 : 0) + 4 * pq + (j & 3);
                return which ? (unsigned char*)nullptr : wq + (size_t)pr * D; });
#else
            bf16_t* wt = (bf16_t*)(ws + OFF_WT1) + ((size_t)l * NEXP + e) * 2048 * D;
            transpose_item(p.w1 + ((size_t)l * NEXP + e) * D * 2048, 2048, r / 32, r % 32, scr, lane, [&](int n, int which) -> bf16_t* {
                const int j = n & 1023, jq = (j >> 2) & 3, pq = jq == 1 ? 2 : jq == 2 ? 1 : jq;
                const int pr = 32 * (j >> 4) + (n >= 1024 ? 16 : 0) + 4 * pq + (j & 3);
                return which ? (bf16_t*)nullptr : wt + (size_t)pr * D; });
#endif
            continue; }
        r -= I_W1;
#if MOE_FP8 >= 2
        { unsigned char* wq = ws + OFF_WT2 + ((size_t)l * NEXP + e) * D * D;
            transpose_item_q(p.w2 + ((size_t)l * NEXP + e) * D * D, D, r / 16, r % 16, scr, lane, QW, [&](int n, int which) -> unsigned char* { return which ? (unsigned char*)nullptr : wq + (size_t)n * D; }); }
#else
        { bf16_t* wt = (bf16_t*)(ws + OFF_WT2) + ((size_t)l * NEXP + e) * D * D;
            transpose_item(p.w2 + ((size_t)l * NEXP + e) * D * D, D, r / 16, r % 16, scr, lane, [&](int n, int which) -> bf16_t* { return which ? (bf16_t*)nullptr : wt + (size_t)n * D; }); }
#endif
    }
#endif
}

DEV void norm_store(const f32x4 (&v)[4], const float* gamma, const float* sc, const float* sh, bf16_t* orow, unsigned char* qrow, int lane) {
    float s = 0.f;
#pragma unroll
    for (int j = 0; j < 4; ++j) s += (v[j].x * v[j].x + v[j].y * v[j].y) + (v[j].z * v[j].z + v[j].w * v[j].w);
    const float rstd = rsqrtf(wave_sum(s) * (1.f / D) + 1e-6f);
    f32x4 g[4], a[4], b[4];
#pragma unroll
    for (int j = 0; j < 4; ++j) { const int k = 4 * lane + 256 * j; g[j] = *(const f32x4*)(gamma + k); a[j] = *(const f32x4*)(sc + k); b[j] = *(const f32x4*)(sh + k); }
#pragma unroll
    for (int j = 0; j < 4; ++j) {
        const int k = 4 * lane + 256 * j;
        f32x4 y = v[j] * rstd * g[j] * (a[j] + 1.f) + b[j];
#if INP_FP8 == 1
        *(unsigned*)((unsigned char*)orow + k) = pk4q(y.x, y.y, y.z, y.w);
#else
        u32x2 o; o.x = pk2(y.x, y.y); o.y = pk2(y.z, y.w);
        *(u32x2*)(orow + k) = o;
#if INP_FP8 == 2
        *(unsigned*)(qrow + k) = pk4q(y.x, y.y, y.z, y.w);
#endif
#endif
    }
}
constexpr size_t OFF_GM2 = OFF_MOD + 512 * 1024;
DEV void stage_norm0(const P& p, int bid, int nb, int wvx) {
    const int tid_ = TID, lane = tid_ & 63, wave = tid_ >> 6;
    if (bid == nb - 1) { float* gm2 = (float*)(p.ws + OFF_GM2);
        for (int i = tid_; i < 2 * 3 * D; i += NTHREADS) { const int l = i / (3 * D), s = (i / D) % 3, k = i % D; gm2[i] = p.norm2[l * D + k] * (modp(p, l, s, 4)[k] + 1.f); } }
    bf16_t* hbf = (bf16_t*)(p.ws + OFF_HBF);
    int r = bid * NWAVES + wave; f32x4 v[4], vn[4];
    if (r < TA) {
#pragma unroll
        for (int j = 0; j < 4; ++j) v[j] = *(const f32x4*)(in_row(p, r) + 4 * lane + 256 * j);
    }
    for (; r < TA; r += nb * NWAVES) {
        const int rn = r + nb * NWAVES;
        if (rn < TA) {
#pragma unroll
            for (int j = 0; j < 4; ++j) vn[j] = *(const f32x4*)(in_row(p, rn) + 4 * lane + 256 * j);
        }
        const int s = row_mod(r);
        norm_store(v, p.norm1, modp(p, 0, s, 1), modp(p, 0, s, 0), hbf + (size_t)r * (INP_FP8 == 1 ? D / 2 : D), p.ws + OFF_HQ + (size_t)r * D, lane);
#pragma unroll
        for (int j = 0; j < 4; ++j) v[j] = vn[j];
    }
}

DEV void mma_tile32(const bf16_t* a0, const bf16_t* a1, const bf16_t* b0, const bf16_t* b1, int K, f32x4 (&acc)[2][2]) {
#pragma unroll 4
    for (int k = 0; k < K; k += 32) {
        const bf16x8 fa0 = *(const bf16x8*)(a0 + k), fa1 = *(const bf16x8*)(a1 + k), fb0 = *(const bf16x8*)(b0 + k), fb1 = *(const bf16x8*)(b1 + k);
        acc[0][0] = __builtin_amdgcn_mfma_f32_16x16x32_bf16(fa0, fb0, acc[0][0], 0, 0, 0);
        acc[0][1] = __builtin_amdgcn_mfma_f32_16x16x32_bf16(fa0, fb1, acc[0][1], 0, 0, 0);
        acc[1][0] = __builtin_amdgcn_mfma_f32_16x16x32_bf16(fa1, fb0, acc[1][0], 0, 0, 0);
        acc[1][1] = __builtin_amdgcn_mfma_f32_16x16x32_bf16(fa1, fb1, acc[1][1], 0, 0, 0);
    }
}
DEV void zero_acc(f32x4 (&acc)[2][2]) {
#pragma unroll
    for (int a = 0; a < 2; ++a)
#pragma unroll
        for (int b = 0; b < 2; ++b) acc[a][b] = (f32x4){0.f, 0.f, 0.f, 0.f};
}

DEV f32x2 ax_cs(const P& p, int row, int sub, int f) {
    if (row >= TL) return (f32x2){1.f, 0.f};
    const int l = row & (L - 1); const f32x2* ta = (const f32x2*)(p.ws + OFF_TABA);
    return sub == 0 ? ta[(l >> 6) * 16 + f] : ta[256 * 16 + (l & 63) * 16 + f];
}
DEV f32x2 ret_cs(const P& p, int row, int f) {
    if (row >= TL) return (f32x2){1.f, 0.f};
    return ((const f32x2*)(p.ws + OFF_TABR))[(row & (L - 1)) * 32 + f];
}

DEV void inproj_pair(const P& p, int row, int c1, float x1, float x2, float& o1, float& o2) {
    const int f16 = c1 & 15;
    if (c1 < C_V) {
        const f32x2 cs = ax_cs(p, row, (c1 >> 5) & 1, f16);
        o1 = x1 * cs.x - x2 * cs.y; o2 = x1 * cs.y + x2 * cs.x;
        if (c1 < C_K) { o1 *= 0.125f; o2 *= 0.125f; }
    } else if (c1 < C_RQ) { o1 = x1; o2 = x2; }
    else if (c1 < C_RV) {
        const f32x2 cs = ret_cs(p, row, ((c1 >> 5) & 1) * 16 + f16);
        o1 = x1 * cs.x - x2 * cs.y; o2 = x1 * cs.y + x2 * cs.x;
        if (c1 >= C_RK) { o1 *= 0.125f; o2 *= 0.125f; }
    } else if (c1 < C_RGF) { o1 = x1; o2 = x2; }
    else if (c1 < C_GA) { o1 = siluf_(x1); o2 = siluf_(x2); }
    else { o1 = sigmoidf_(x1); o2 = sigmoidf_(x2); }
}


DEV void stage_pool_diff(const P& p, int l, int bid, int nb, int wvx) {
    const int NR = l == 0 ? TA : TL;
    const bf16_t* proj = (const bf16_t*)(p.ws + OFF_PROJ); bf16_t* mix = (bf16_t*)(p.ws + OFF_MIX);
    for (int it = bid * NTHREADS + TID; it < 4 * NR * 8; it += nb * NTHREADS) {
        const int g = it / (NR * 8), rem = it % (NR * 8), row = rem >> 3, c = g * 64 + (rem & 7) * 8, w = __builtin_amdgcn_readfirstlane(2 << g);
        int s0, len; if (row < TL) { s0 = row & ~(L - 1); len = L; } else { s0 = TL + (((row - TL) >> 8) << 8); len = LC; }
        const int t = row - s0, lo0 = t - w / 2;
        float acc[8];
#pragma unroll
        for (int j = 0; j < 8; ++j) acc[j] = 0.f;
        bf16x8 own = *(const bf16x8*)(proj + (size_t)row * NIN + C_U + c);
#pragma unroll
        for (int i = 0; i < 16; ++i) {
            {
                const int pos = lo0 + i; const bool ok = i < w && pos >= 0 && pos < len;
                const bf16x8 v = *(const bf16x8*)(proj + (size_t)(s0 + (ok ? pos : t)) * NIN + C_U + c);
                const float mk = ok ? 1.f : 0.f;
#pragma unroll
                for (int j = 0; j < 8; ++j) acc[j] += mk * bf2f((bf16_t)v[j]);
            }
        }
        int lo = lo0 < 0 ? 0 : lo0, hi = lo0 + w > len ? len : lo0 + w;
        const float inv = 1.f / (float)(hi - lo);
        float d[8];
#pragma unroll
        for (int j = 0; j < 8; ++j) d[j] = acc[j] * inv - bf2f((bf16_t)own[j]);
        u32x4 o; o.x = pk2(d[0], d[1]); o.y = pk2(d[2], d[3]); o.z = pk2(d[4], d[5]); o.w = pk2(d[6], d[7]);
        *(u32x4*)(mix + (size_t)row * D + MX_POOL + c) = o;
    }
}


constexpr int MAXENT = 640;
DEV void stage_route(const P& p, int l, int bid, int nb, unsigned char* lds, int wvx) {
    const int tid = TID, lane = tid & 63, wave = tid >> 6;
    float* wl = (float*)lds;
    int* lcnt = (int*)(lds + 131072); int* lbase = lcnt + 32; int* ent = lbase + 32;
    const float* wr = p.w_router + (size_t)l * D * NEXP;
    for (int k = tid; k < D; k += NTHREADS) {
#pragma unroll
        for (int e4 = 0; e4 < 8; ++e4) { const f32x4 w = *(const f32x4*)(wr + (size_t)k * NEXP + 4 * e4);
            wl[(4 * e4 + 0) * D + k] = w.x; wl[(4 * e4 + 1) * D + k] = w.y; wl[(4 * e4 + 2) * D + k] = w.z; wl[(4 * e4 + 3) * D + k] = w.w; }
    }
    for (int i = tid; i < 32; i += NTHREADS) lcnt[i] = 0;
    for (int i = tid; i < MAXENT; i += NTHREADS) ent[i] = -1;
    __syncthreads();
    const float* xr = (const float*)(p.ws + OFF_XR); bf16_t* hbf = (bf16_t*)(p.ws + OFF_HBF);
    int* tk_e = (int*)(p.ws + OFF_TK + (size_t)l * TK_LAYER); float* tk_w = (float*)(tk_e + TA * 4); int* tk_pos = (int*)(tk_w + TA * 4); int* list_tok = tk_pos + TA * 4;
    unsigned* cntg = (unsigned*)(p.ws + OFF_CTL) + CW_CNT + l * 32;
    const int NR = l == 0 ? TA : TL, ngw = nb * NWAVES, gw = bid * NWAVES + wave;
    const int t_begin = (int)(((long long)gw * NR) / ngw), t_end = (int)(((long long)(gw + 1) * NR) / ngw);
    const float* gamma = p.norm2 + l * D;
    f32x4 gam[4];
#pragma unroll
    for (int j = 0; j < 4; ++j) gam[j] = *(const f32x4*)(gamma + 4 * lane + 256 * j);
    for (int t0 = t_begin; t0 < t_end; t0 += 4) {
        f32x4 v[4][4]; int tok[4]; float ss[4];
#pragma unroll
        for (int u = 0; u < 4; ++u) { tok[u] = t0 + u < t_end ? t0 + u : t_end - 1; ss[u] = 0.f;
#pragma unroll
            for (int j = 0; j < 4; ++j) { v[u][j] = *(const f32x4*)(xr + (size_t)tok[u] * D + 4 * lane + 256 * j); ss[u] += (v[u][j].x * v[u][j].x + v[u][j].y * v[u][j].y) + (v[u][j].z * v[u][j].z + v[u][j].w * v[u][j].w); } }
        const int s0 = row_mod(tok[0]);
        f32x4 scv[4], shv[4];
#pragma unroll
        for (int j = 0; j < 4; ++j) { scv[j] = *(const f32x4*)(modp(p, l, s0, 4) + 4 * lane + 256 * j); shv[j] = *(const f32x4*)(modp(p, l, s0, 3) + 4 * lane + 256 * j); }
#pragma unroll
        for (int o = 1; o < 64; o <<= 1) {
#pragma unroll
            for (int u = 0; u < 4; ++u) ss[u] += __shfl_xor(ss[u], o); }
#pragma unroll
        for (int u = 0; u < 4; ++u) {
            const float rstd = rsqrtf(ss[u] * (1.f / D) + 1e-6f); const int sm = row_mod(tok[u]);
            f32x4 av[4], bv[4];
            if (sm != s0) {
                const float* sc = modp(p, l, sm, 4); const float* sh = modp(p, l, sm, 3);
#pragma unroll
                for (int j = 0; j < 4; ++j) { av[j] = *(const f32x4*)(sc + 4 * lane + 256 * j); bv[j] = *(const f32x4*)(sh + 4 * lane + 256 * j); }
            } else {
#pragma unroll
                for (int j = 0; j < 4; ++j) { av[j] = scv[j]; bv[j] = shv[j]; }
            }
#pragma unroll
            for (int j = 0; j < 4; ++j) { const int k = 4 * lane + 256 * j;
                const f32x4 g = gam[j], a = av[j], b = bv[j];
                v[u][j] = v[u][j] * rstd * g * (a + 1.f) + b;
#if MOE_FP8 >= 1
                if (t0 + u < t_end) *(unsigned*)((unsigned char*)hbf + (size_t)tok[u] * D + k) = pk4q(v[u][j].x, v[u][j].y, v[u][j].z, v[u][j].w); }
#else
                u32x2 o; o.x = pk2(v[u][j].x, v[u][j].y); o.y = pk2(v[u][j].z, v[u][j].w);
                if (t0 + u < t_end) *(u32x2*)(hbf + (size_t)tok[u] * D + k) = o; }
#endif
        }
        float lgc[4] = {0.f, 0.f, 0.f, 0.f};
        const int e8 = lane & 7, ut = (lane >> 3) & 3;
#pragma nounroll
        for (int c = 0; c < 4; ++c) {
            float val[32];
#pragma unroll
            for (int x = 0; x < 8; ++x) {
                f32x4 w[4];
#pragma unroll
                for (int j = 0; j < 4; ++j) w[j] = *(const f32x4*)(wl + (8 * c + x) * D + 4 * lane + 256 * j);
#pragma unroll
                for (int u = 0; u < 4; ++u) { float a = 0.f;
#pragma unroll
                    for (int j = 0; j < 4; ++j) a += (v[u][j].x * w[j].x + v[u][j].y * w[j].y) + (v[u][j].z * w[j].z + v[u][j].w * w[j].w);
                    val[u * 8 + x] = a; }
            }
            float v16[16], v8[8], v4[4], v2[2];
#define RT_STAGE(dst, src, n, b) do { const bool hi_ = (lane >> (b)) & 1; _Pragma("unroll") for (int i_ = 0; i_ < (n); ++i_) { const float lo_v = (src)[2 * i_], hi_v = (src)[2 * i_ + 1]; \
                const float keep = hi_ ? hi_v : lo_v, send = hi_ ? lo_v : hi_v; (dst)[i_] = keep + __shfl_xor(send, 1 << (b)); } } while (0)
            RT_STAGE(v16, val, 16, 0); RT_STAGE(v8, v16, 8, 1); RT_STAGE(v4, v8, 4, 2); RT_STAGE(v2, v4, 2, 3);
            float v1; { const bool hi_ = (lane >> 4) & 1; const float keep = hi_ ? v2[1] : v2[0], send = hi_ ? v2[0] : v2[1]; v1 = keep + __shfl_xor(send, 16); }
#undef RT_STAGE
            { const float lv = v1 + __shfl_xor(v1, 32) + p.b_router[l * NEXP + 8 * c + e8];
#pragma unroll
              for (int cc = 0; cc < 4; ++cc) lgc[cc] = (cc == c) ? lv : lgc[cc]; }
        }
        int te[4]; float tv[4];
#pragma unroll
        for (int k = 0; k < 4; ++k) {
            float bv = lgc[0]; int be = e8;
#pragma unroll
            for (int c = 1; c < 4; ++c) { const bool t = lgc[c] > bv; bv = t ? lgc[c] : bv; be = t ? 8 * c + e8 : be; }
#pragma unroll
            for (int d = 1; d < 8; d <<= 1) { const float ov = __shfl_xor(bv, d); const int oe = __shfl_xor(be, d); const bool t = (ov > bv) || (ov == bv && oe < be); bv = t ? ov : bv; be = t ? oe : be; }
            te[k] = be; tv[k] = bv;
#pragma unroll
            for (int c = 0; c < 4; ++c) lgc[c] = (be == 8 * c + e8) ? -INFINITY : lgc[c];
        }
        float ex[4], es = 0.f;
#pragma unroll
        for (int k = 0; k < 4; ++k) { ex[k] = __expf(tv[k] - tv[0]); es += ex[k]; }
        if (lane < 32 && e8 < 4 && t0 + ut < t_end) {
            const int e = e8 == 0 ? te[0] : e8 == 1 ? te[1] : e8 == 2 ? te[2] : te[3];
            const float wgt = (e8 == 0 ? ex[0] : e8 == 1 ? ex[1] : e8 == 2 ? ex[2] : ex[3]) / es;
            const int rank = atomicAdd(&lcnt[e], 1);
            const int tk = t0 + ut, lid = wave * 72 + (tk - t_begin) * 4 + e8;
            ent[lid] = e | (rank << 8);
            tk_e[tk * 4 + e8] = e; tk_w[tk * 4 + e8] = wgt;
        }
    }
    __syncthreads();
    if (tid < 32) lbase[tid] = (int)atomicAdd(&cntg[tid], (unsigned)lcnt[tid]);
    __syncthreads();
    for (int lid = tid; lid < 8 * 72; lid += NTHREADS) {
        const int en = ent[lid]; if (en < 0) continue;
        const int e = en & 255, rank = en >> 8, wv = lid / 72, rem = lid % 72, k = rem & 3;
        const int tb = (int)(((long long)(bid * NWAVES + wv) * NR) / ngw);
        const int tokk = tb + (rem >> 2), pos = lbase[e] + rank;
        tk_pos[tokk * 4 + k] = pos; list_tok[e * CAP + pos] = tokk;
    }
}

DEV void moe_prefix(const P& p, int l, int* pstart, int* cnt, int wvx) {
    const int tid = TID;
    if (tid < 64) {
        unsigned* cntg = (unsigned*)(p.ws + OFF_CTL) + CW_CNT + l * 32;
        const int c = tid < 32 ? (int)__hip_atomic_load(cntg + (tid & 31), __ATOMIC_RELAXED, __HIP_MEMORY_SCOPE_AGENT) : 0;
        const int pad = (c + 255) & ~255; int incl = pad;
#pragma unroll
        for (int o = 1; o < 32; o <<= 1) { const int t = __shfl_up(incl, o); if ((tid & 63) >= o) incl += t; }
        if (tid < 32) { cnt[tid] = c; pstart[tid] = incl - pad; if (tid == 31) pstart[32] = incl; }
    }
    __syncthreads();
}
#ifndef ROUTE_MFMA
#define ROUTE_MFMA 1
#endif
constexpr int RW_STRIDE = 2064, RW_LO = 32 * RW_STRIDE, RT_TAB = 2 * RW_LO, RT_MAXENT = 1024;
DEV void stage_route_mfma(const P& p, int l, int bid, int nb, unsigned char* lds_, int wvx) {
    const int tid = TID, lane = tid & 63, wave = tid >> 6, fr = lane & 15, fq = lane >> 4;
    LAS unsigned char* lds = (LAS unsigned char*)lds_;
    int* lcnt = (int*)(lds_ + RT_TAB); int* lbase = lcnt + 32; int* ent = lbase + 32; int* enttok = ent + RT_MAXENT;
    const float* wr = p.w_router + (size_t)l * D * NEXP;
    for (int k = tid; k < D; k += NTHREADS) {
#pragma unroll
        for (int e4 = 0; e4 < 8; ++e4) { const f32x4 w = *(const f32x4*)(wr + (size_t)k * NEXP + 4 * e4);
#pragma unroll
            for (int j = 0; j < 4; ++j) { const float wv = w[j]; const bf16_t h = f2bf(wv); const bf16_t lo = f2bf(wv - bf2f(h));
                *(LAS bf16_t*)(lds + (4 * e4 + j) * RW_STRIDE + 2 * k) = h; *(LAS bf16_t*)(lds + RW_LO + (4 * e4 + j) * RW_STRIDE + 2 * k) = lo; } }
    }
    for (int i = tid; i < 32; i += NTHREADS) lcnt[i] = 0;
    for (int i = tid; i < RT_MAXENT; i += NTHREADS) ent[i] = -1;
    __syncthreads();
    const float* xr = (const float*)(p.ws + OFF_XR); unsigned char* h2q = p.ws + OFF_HBF;
    int* tk_e = (int*)(p.ws + OFF_TK + (size_t)l * TK_LAYER); float* tk_w = (float*)(tk_e + TA * 4); int* tk_pos = (int*)(tk_w + TA * 4); int* list_tok = tk_pos + TA * 4;
    unsigned* cntg = (unsigned*)(p.ws + OFF_CTL) + CW_CNT + l * 32;
    const int NR = l == 0 ? TA : TL, ntile = NR / 16, ngw = nb * NWAVES, gw = bid * NWAVES + wave;
    auto body = [&](auto ntc) {
        constexpr int NT = decltype(ntc)::value;
        int tk[NT]; const float* xrow[NT]; const float* gmp[NT]; const float* shp[NT]; float rstd[NT]; unsigned char* hq[NT]; f32x4 acc[NT][2];
#pragma unroll
        for (int u = 0; u < NT; ++u) {
            const int tile = gw + u * ngw, sm = row_mod(tile * 16);
            tk[u] = tile * 16 + fr; xrow[u] = xr + (size_t)tk[u] * D + 8 * fq; hq[u] = h2q + (size_t)tk[u] * D + 8 * fq;
            gmp[u] = (const float*)(p.ws + OFF_GM2) + (size_t)(l * 3 + sm) * D + 8 * fq; shp[u] = modp(p, l, sm, 3) + 8 * fq;
            float ss = 0.f;
            if (tile * 16 < TL) { const f32x4 q = *(const f32x4*)((const float*)(p.ws + OFF_ROWSQ) + (size_t)tk[u] * 16 + 4 * fq); ss = (q.x + q.y) + (q.z + q.w); }
            else {
#pragma unroll 8
                for (int s = 0; s < 32; ++s) { const f32x4 a = *(const f32x4*)(xrow[u] + 32 * s), b = *(const f32x4*)(xrow[u] + 32 * s + 4);
                    ss += (a.x * a.x + a.y * a.y) + (a.z * a.z + a.w * a.w) + (b.x * b.x + b.y * b.y) + (b.z * b.z + b.w * b.w); }
            }
            ss += __shfl_xor(ss, 16); ss += __shfl_xor(ss, 32);
            rstd[u] = rsqrtf(ss * (1.f / D) + 1e-6f);
            acc[u][0] = (f32x4){0.f, 0.f, 0.f, 0.f}; acc[u][1] = acc[u][0];
        }
#pragma unroll 4
        for (int s = 0; s < 32; ++s) {
            bf16x8 yh[NT], yl[NT];
#pragma unroll
            for (int u = 0; u < NT; ++u) {
                f32x4 y[2];
#pragma unroll
                for (int c = 0; c < 2; ++c) { const int k = 32 * s + 4 * c; y[c] = *(const f32x4*)(xrow[u] + k) * rstd[u] * *(const f32x4*)(gmp[u] + k) + *(const f32x4*)(shp[u] + k); }
                u32x2 q8; q8.x = pk4q(y[0].x, y[0].y, y[0].z, y[0].w); q8.y = pk4q(y[1].x, y[1].y, y[1].z, y[1].w);
                *(u32x2*)(hq[u] + 32 * s) = q8;
                u32x4 hw, lw;
                hw.x = pk2(y[0].x, y[0].y); hw.y = pk2(y[0].z, y[0].w); hw.z = pk2(y[1].x, y[1].y); hw.w = pk2(y[1].z, y[1].w);
                lw.x = pk2(y[0].x - bf2f((bf16_t)(hw.x & 0xffff)), y[0].y - bf2f((bf16_t)(hw.x >> 16))); lw.y = pk2(y[0].z - bf2f((bf16_t)(hw.y & 0xffff)), y[0].w - bf2f((bf16_t)(hw.y >> 16)));
                lw.z = pk2(y[1].x - bf2f((bf16_t)(hw.z & 0xffff)), y[1].y - bf2f((bf16_t)(hw.z >> 16))); lw.w = pk2(y[1].z - bf2f((bf16_t)(hw.w & 0xffff)), y[1].w - bf2f((bf16_t)(hw.w >> 16)));
                yh[u] = __builtin_bit_cast(bf16x8, hw); yl[u] = __builtin_bit_cast(bf16x8, lw);
            }
#pragma unroll
            for (int et = 0; et < 2; ++et) {
                const bf16x8 ah = *(const LAS bf16x8*)(lds + (16 * et + fr) * RW_STRIDE + (4 * s + fq) * 16), al = *(const LAS bf16x8*)(lds + RW_LO + (16 * et + fr) * RW_STRIDE + (4 * s + fq) * 16);
#pragma unroll
                for (int u = 0; u < NT; ++u) {
                    acc[u][et] = __builtin_amdgcn_mfma_f32_16x16x32_bf16(ah, yh[u], acc[u][et], 0, 0, 0);
                    acc[u][et] = __builtin_amdgcn_mfma_f32_16x16x32_bf16(ah, yl[u], acc[u][et], 0, 0, 0);
                    acc[u][et] = __builtin_amdgcn_mfma_f32_16x16x32_bf16(al, yh[u], acc[u][et], 0, 0, 0);
                }
            }
        }
#pragma unroll
        for (int u = 0; u < NT; ++u) {
            float lg[8];
#pragma unroll
            for (int et = 0; et < 2; ++et) { const f32x4 bb = *(const f32x4*)(p.b_router + l * NEXP + 16 * et + 4 * fq);
#pragma unroll
                for (int j = 0; j < 4; ++j) lg[4 * et + j] = acc[u][et][j] + bb[j]; }
            int te[4]; float tv[4];
#pragma unroll
            for (int k = 0; k < 4; ++k) {
                float bv = lg[0]; int be = 4 * fq;
#pragma unroll
                for (int i = 1; i < 8; ++i) { const int ei = 16 * (i >> 2) + 4 * fq + (i & 3); const bool t = lg[i] > bv; bv = t ? lg[i] : bv; be = t ? ei : be; }
#pragma unroll
                for (int d = 16; d < 64; d <<= 1) { const float ov = __shfl_xor(bv, d); const int oe = __shfl_xor(be, d); const bool t = (ov > bv) || (ov == bv && oe < be); bv = t ? ov : bv; be = t ? oe : be; }
                te[k] = be; tv[k] = bv;
#pragma unroll
                for (int i = 0; i < 8; ++i) { const int ei = 16 * (i >> 2) + 4 * fq + (i & 3); lg[i] = (be == ei) ? -INFINITY : lg[i]; }
            }
            float ex[4], es = 0.f;
#pragma unroll
            for (int k = 0; k < 4; ++k) { ex[k] = __expf(tv[k] - tv[0]); es += ex[k]; }
            {
                const int e = fq == 0 ? te[0] : fq == 1 ? te[1] : fq == 2 ? te[2] : te[3];
                const float wgt = (fq == 0 ? ex[0] : fq == 1 ? ex[1] : fq == 2 ? ex[2] : ex[3]) / es;
                const int rank = atomicAdd(&lcnt[e], 1);
                const int lid = wave * 128 + u * 64 + fr * 4 + fq;
                ent[lid] = e | (rank << 8); enttok[lid] = tk[u];
                tk_e[tk[u] * 4 + fq] = e; tk_w[tk[u] * 4 + fq] = wgt;
            }
        }
    };
    if (gw + ngw < ntile) body(std::integral_constant<int, 2>{}); else if (gw < ntile) body(std::integral_constant<int, 1>{});
    __syncthreads();
    if (tid < 32) lbase[tid] = (int)atomicAdd(&cntg[tid], (unsigned)lcnt[tid]);
    __syncthreads();
    for (int lid = tid; lid < RT_MAXENT; lid += NTHREADS) {
        const int en = ent[lid]; if (en < 0) continue;
        const int e = en & 255, rank = en >> 8, tokk = enttok[lid], k = lid & 3, pos = lbase[e] + rank;
        tk_pos[tokk * 4 + k] = pos; list_tok[e * CAP + pos] = tokk;
    }
}

DEV void stage_combine(const P& p, int l, int bid, int nb, unsigned char* lds, int wvx) {
    const int tid_ = TID, lane = tid_ & 63, wave = tid_ >> 6;
    int* pstart = (int*)lds; int* cnt = pstart + 40;
    moe_prefix(p, l, pstart, cnt, wvx);
    float* xr = (float*)(p.ws + OFF_XR); const bf16_t* yb = (const bf16_t*)(p.ws + OFF_YB); bf16_t* hbf = (bf16_t*)(p.ws + OFF_HBF);
    const int* tk_e = (const int*)(p.ws + OFF_TK + (size_t)l * TK_LAYER); const float* tk_w = (const float*)(tk_e + TA * 4); const int* tk_pos = (const int*)(tk_w + TA * 4);
    const int NR = l == 0 ? TA : TL;
    int row = bid * NWAVES + wave;
    int ce[4], cp[4]; float cw[4]; f32x4 xv[4];
    if (row < NR) {
#pragma unroll
        for (int k = 0; k < 4; ++k) { ce[k] = tk_e[row * 4 + k]; cw[k] = tk_w[row * 4 + k]; cp[k] = tk_pos[row * 4 + k]; }
#pragma unroll
        for (int j = 0; j < 4; ++j) xv[j] = *(const f32x4*)(xr + (size_t)row * D + 4 * lane + 256 * j);
    }
    for (; row < NR; row += nb * NWAVES) {
        const int s = row_mod(row); const float* g2 = modp(p, l, s, 5);
        size_t slot[4];
#pragma unroll
        for (int k = 0; k < 4; ++k) slot[k] = (size_t)(pstart[ce[k]] + cp[k]);
        u32x2 yv[4][4];
#pragma unroll
        for (int k = 0; k < 4; ++k)
#pragma unroll
            for (int j = 0; j < 4; ++j) yv[k][j] = *(const u32x2*)(yb + slot[k] * D + 4 * lane + 256 * j);
        float w4[4]; f32x4 xc[4];
#pragma unroll
        for (int k = 0; k < 4; ++k) w4[k] = cw[k];
#pragma unroll
        for (int j = 0; j < 4; ++j) xc[j] = xv[j];
        const int rown = row + nb * NWAVES;
        if (rown < NR) {
#pragma unroll
            for (int k = 0; k < 4; ++k) { ce[k] = tk_e[rown * 4 + k]; cw[k] = tk_w[rown * 4 + k]; cp[k] = tk_pos[rown * 4 + k]; }
#pragma unroll
            for (int j = 0; j < 4; ++j) xv[j] = *(const f32x4*)(xr + (size_t)rown * D + 4 * lane + 256 * j);
        }
        f32x4 a[4];
#pragma unroll
        for (int j = 0; j < 4; ++j) a[j] = (f32x4){0.f, 0.f, 0.f, 0.f};
#pragma unroll
        for (int k = 0; k < 4; ++k) {
            const float w = w4[k];
#pragma unroll
            for (int j = 0; j < 4; ++j) { const u32x2 y = yv[k][j];
                a[j].x += w * bf2f((bf16_t)(y.x & 0xffff)); a[j].y += w * bf2f((bf16_t)(y.x >> 16)); a[j].z += w * bf2f((bf16_t)(y.y & 0xffff)); a[j].w += w * bf2f((bf16_t)(y.y >> 16)); }
        }
        f32x4 v[4];
#pragma unroll
        for (int j = 0; j < 4; ++j) { const int k = 4 * lane + 256 * j; v[j] = xc[j] + *(const f32x4*)(g2 + k) * a[j]; }
        if (l == 0) {
#pragma unroll
            for (int j = 0; j < 4; ++j) *(f32x4*)(xr + (size_t)row * D + 4 * lane + 256 * j) = v[j];
            norm_store(v, p.norm1 + D, modp(p, 1, s, 1), modp(p, 1, s, 0), hbf + (size_t)row * (INP_FP8 == 1 ? D / 2 : D), p.ws + OFF_HQ + (size_t)row * D, lane);
        } else if (row < TL) {
            float ss = 0.f;
#pragma unroll
            for (int j = 0; j < 4; ++j) ss += (v[j].x * v[j].x + v[j].y * v[j].y) + (v[j].z * v[j].z + v[j].w * v[j].w);
            const float rstd = rsqrtf(wave_sum(ss) * (1.f / D) + 1e-6f);
#pragma unroll
            for (int j = 0; j < 4; ++j) { const int k = 4 * lane + 256 * j; *(f32x4*)(p.out + (size_t)row * D + k) = v[j] * rstd * *(const f32x4*)(p.final_norm + k); }
        }
    }
}

namespace pg {
#define LAS __attribute__((address_space(3)))
constexpr int BM = 256, BK = 64, HALF = 128, HTB = HALF * BK * 2, STAGE_BYTES = 8 * HTB, NXCD = 8, WGM = 4;
DEV int lds_byte(int r, int c) { const int st = (r >> 4) * 2 + (c >> 5), rr = r & 15, cc = c & 31, ob = rr * 64 + cc * 2; return st * 1024 + (ob ^ (((ob >> 9) & 1) << 5)); }
DEV int perm32(int rho) { const int n = rho >> 4, i = rho & 15; return 8 * (i >> 2) + 4 * n + (i & 3); }
DEV void stage_rc(int b, int& R, int& C) { const int st = b / 1024, sb = b % 1024, swz = sb ^ (((sb >> 9) & 1) << 5); R = (st >> 1) * 16 + swz / 64; C = (st & 1) * 32 + (swz % 64) / 2; }
typedef int i32x8 __attribute__((ext_vector_type(8)));
typedef int i32x4v __attribute__((ext_vector_type(4)));
DEV i32x8 cat8(const bf16x8 a, const bf16x8 b) { const i32x4v x = __builtin_bit_cast(i32x4v, a), y = __builtin_bit_cast(i32x4v, b); return __builtin_shufflevector(x, y, 0, 1, 2, 3, 4, 5, 6, 7); }
DEV void mfma_q(f32x4& acc, const i32x8 b, const i32x8 a, const int one) {
    asm volatile("v_mfma_scale_f32_16x16x128_f8f6f4 %0, %1, %2, %0, %3, %3 op_sel_hi:[0,0,0]" : "+v"(acc) : "v"(b), "v"(a), "v"(one));
}
struct Unit { const char* aMat; const char* bBase; int pm, pn, kind, nt, perm, bslot; };
DEV void tile_from_L(int Lg, int nM, int nN, int& pm, int& pn) {
    const int nwg = nM * nN; int wgid = Lg; { const int q = nwg / NXCD, r = nwg % NXCD, xcd = wgid % NXCD, off = wgid / NXCD; wgid = (xcd < r ? xcd * (q + 1) : r * (q + 1) + (xcd - r) * q) + off; }
    const int nig = WGM * nN, gid = wgid / nig, fm = gid * WGM, gsz = (nM - fm) < WGM ? (nM - fm) : WGM;
    pm = fm + ((wgid % nig) % gsz); pn = (wgid % nig) / gsz;
}
template <class Epi, class Sched>
DEV void gemm_phase(LAS unsigned char* lds, const Sched& S, const Epi& E, const int ldb, const int wvx) {
    constexpr bool FP8 = Sched::FP8;
    constexpr int PERMC = Sched::PERMC;
    constexpr bool GATHER = Sched::GATHER;
    const int tid = TID, wid = __builtin_amdgcn_readfirstlane(tid >> 6), lane = tid & 63, wr = wid >> 2, wc = wid & 3, fr = lane & 15, fq = lane >> 4;
    unsigned voffB[2], voffBp[2], voffA[2];
#pragma unroll
    for (int i = 0; i < 2; ++i) { int R_, C_; stage_rc(tid * 16 + i * 8192, R_, C_); voffB[i] = (unsigned)(R_ * ldb + C_) * 2u; voffA[i] = (unsigned)(R_ * ldb + C_) * 2u;
        voffBp[i] = (unsigned)(((R_ & ~31) + perm32(R_ & 31)) * ldb + C_) * 2u; }
    const size_t kstep = (size_t)(BK * 2);
    const size_t hstepB = (size_t)HALF * ldb * 2;
    const unsigned ldsw = (unsigned)wid * 1024u;
    const int aoff = lds_byte(wr * 64 + fr, fq * 8), boff = lds_byte(wc * 32 + fr, fq * 8);
#define PG_SA(b, h) (((b) * 2 + (h)) * HTB)
#define PG_SB(b, h) ((4 + (b) * 2 + (h)) * HTB)
#define PG_STAGE(bufoff, gbase, voff) do { const char* gb_ = (const char*)(gbase); asm("" : "+s"(gb_));   _Pragma("unroll") for (int _i = 0; _i < 2; ++_i) { \
        unsigned vo_ = (voff)[_i]; asm volatile("" : "+v"(vo_)); __builtin_amdgcn_global_load_lds((const unsigned*)(gb_ + vo_), (LAS unsigned*)(lds + (bufoff) + ldsw + _i * 8192), 16, 0, 0); } } while (0)
#define PG_STAGE_A(bufoff, gbase, h, og) do { if constexpr (GATHER) PG_STAGE(bufoff, gbase, (og)[h]); else PG_STAGE(bufoff, (gbase) + (h) * hstepB, voffA); } while (0)
#define PG_LDA(dst, b, h) do { _Pragma("unroll") for (int m = 0; m < 4; ++m) _Pragma("unroll") for (int k = 0; k < 2; ++k) dst[m][k] = *(const LAS bf16x8*)(lds + PG_SA(b, h) + aoff + m * 2048 + k * 1024); } while (0)
#define PG_LDB(dst, b, h) do { _Pragma("unroll") for (int n = 0; n < 2; ++n) _Pragma("unroll") for (int k = 0; k < 2; ++k) dst[n][k] = *(const LAS bf16x8*)(lds + PG_SB(b, h) + boff + n * 2048 + k * 1024); } while (0)
#define PG_MMA(ai, bj, At, Bt) do { __builtin_amdgcn_s_setprio(1); if constexpr (FP8) { _Pragma("unroll") for (int m = 0; m < 4; ++m) _Pragma("unroll") for (int n = 0; n < 2; ++n) \
        mfma_q(acc[ai][bj][m][n], cat8(Bt[n][0], Bt[n][1]), cat8(At[m][0], At[m][1]), qone); } \
        else { _Pragma("unroll") for (int m = 0; m < 4; ++m) _Pragma("unroll") for (int n = 0; n < 2; ++n) _Pragma("unroll") for (int k = 0; k < 2; ++k) \
        acc[ai][bj][m][n] = __builtin_amdgcn_mfma_f32_16x16x32_bf16(Bt[n][k], At[m][k], acc[ai][bj][m][n], 0, 0, 0); } __builtin_amdgcn_s_setprio(0); } while (0)
#define PG_WAIT_V(n) asm volatile("s_waitcnt vmcnt(" #n ")" ::: "memory")
#define PG_WAIT_L(n) asm volatile("s_waitcnt lgkmcnt(" #n ")" ::: "memory")
#define PG_BAR __builtin_amdgcn_s_barrier()
#define PG_SCHED __builtin_amdgcn_sched_barrier(0)
    Unit cur, nxt; int ui = 0;
    constexpr bool DYN = Sched::DYN;
    volatile LAS int* dslot = (volatile LAS int*)(lds + 131072 + 1024);
    if constexpr (DYN) {
        if (tid == 0) dslot[0] = S.grab();
        __syncthreads();
        const int L0 = __builtin_amdgcn_readfirstlane(dslot[0]);
        __syncthreads();
        if (!S.decode(L0, cur)) return;
    } else { if (!S.next(0, cur)) return; }
    int qone = 0x7F7F7F7F; if constexpr (FP8) asm volatile("" : "+v"(qone));
    LAS unsigned char* bslots = lds + 131072 + 4096;
    cur.bslot = 0;
    if constexpr (Epi::BIASL) { if (wid == 0) __builtin_amdgcn_global_load_lds((const unsigned*)E.bias_src(cur, lane), (LAS unsigned*)(bslots), 16, 0, 0); }
    f32x4 acc[2][2][4][2];
#pragma unroll
    for (int a = 0; a < 2; ++a)
#pragma unroll
        for (int b = 0; b < 2; ++b)
#pragma unroll
            for (int m = 0; m < 4; ++m)
#pragma unroll
                for (int n = 0; n < 2; ++n) acc[a][b][m][n] = (f32x4){0.f, 0.f, 0.f, 0.f};
    bf16x8 At[4][2], B0[2][2], B1[2][2];
    unsigned offC[2][2], offK[2][2];
    constexpr bool KEEPK = GATHER && !FP8;
    if constexpr (GATHER) { S.aoff(cur, tid, offC);
        if constexpr (KEEPK) {
#pragma unroll
        for (int h = 0; h < 2; ++h)
#pragma unroll
            for (int i = 0; i < 2; ++i) offK[h][i] = offC[h][i]; } }
    const char* cA = cur.aMat; const char* cB = cur.bBase;
    unsigned vbc[2];
#pragma unroll
    for (int i = 0; i < 2; ++i) vbc[i] = PERMC == 0 ? voffB[i] : PERMC == 1 ? voffBp[i] : cur.perm ? voffBp[i] : voffB[i];
    PG_STAGE(PG_SB(0, 0), cB, vbc); PG_STAGE(PG_SB(0, 1), cB + hstepB, vbc); PG_STAGE_A(PG_SA(0, 0), cA, 0, offC); PG_STAGE_A(PG_SA(0, 1), cA, 1, offC);
    if (wr == 1) PG_BAR;
    PG_WAIT_V(2); PG_BAR;
    PG_STAGE(PG_SB(1, 0), cB + kstep, vbc); PG_STAGE_A(PG_SA(1, 0), cA + kstep, 0, offC); PG_STAGE(PG_SB(1, 1), cB + hstepB + kstep, vbc);
    PG_WAIT_V(6); PG_BAR;
    for (;;) {
        bool has_next = false; const char* nA = cA; const char* nB = cB; int tk_ = 0;
        if constexpr (DYN) { if (tid == 0) tk_ = S.grab(); }
        else { has_next = S.next(ui + 1, nxt); nA = has_next ? nxt.aMat : cA; nB = has_next ? nxt.bBase : cB; }
        nxt.bslot = cur.bslot == 2 ? 0 : cur.bslot + 1;
        if constexpr (Epi::BIASL && !DYN) { if (has_next && wid == 0) __builtin_amdgcn_global_load_lds((const unsigned*)E.bias_src(nxt, lane), (LAS unsigned*)(bslots + nxt.bslot * 1024), 16, 0, 0); }
        const int nt = cur.nt;
        for (int t = 0; t < nt; t += 2) {
            const bool last = (t == nt - 2);
            if constexpr (DYN) {
                if (t == 2) { if (tid == 0) dslot[(ui + 1) & 1] = tk_; }
                if (t == 4) { const int Ln = __builtin_amdgcn_readfirstlane(dslot[(ui + 1) & 1]); has_next = S.decode(Ln, nxt); nA = has_next ? nxt.aMat : cA; nB = has_next ? nxt.bBase : cB; }
            }
            if constexpr (Epi::HAS_MID) { if (t == 8 || t == 12) E.mid(acc, cur, t, wr, wc, fr, fq); }
            const char* a1 = cA + (size_t)(t + 1) * kstep;
            const char* a2 = last ? nA : cA + (size_t)(t + 2) * kstep; const char* b2 = last ? nB : cB + (size_t)(t + 2) * kstep;
            const char* a3 = a2 + kstep; const char* b3 = b2 + kstep;
            unsigned vb2[2];
            { const int pf_ = (last && has_next) ? nxt.perm : cur.perm;
#pragma unroll
              for (int i = 0; i < 2; ++i) vb2[i] = PERMC == 0 ? voffB[i] : PERMC == 1 ? voffBp[i] : pf_ ? voffBp[i] : voffB[i]; }
            unsigned o2[2][2];
            if constexpr (GATHER) {
                if (last && has_next) { S.aoff(nxt, tid, o2);
                    if constexpr (KEEPK) {
#pragma unroll
                    for (int h = 0; h < 2; ++h)
#pragma unroll
                        for (int i = 0; i < 2; ++i) offK[h][i] = o2[h][i]; } }
                else {
#pragma unroll
                    for (int h = 0; h < 2; ++h)
#pragma unroll
                        for (int i = 0; i < 2; ++i) o2[h][i] = offC[h][i];
                }
            }
            PG_LDB(B0, 0, 0); PG_LDB(B1, 0, 1); PG_SCHED; PG_LDA(At, 0, 0); PG_STAGE_A(PG_SA(1, 1), a1, 1, offC);
            PG_WAIT_V(8); PG_WAIT_L(0); PG_BAR; PG_MMA(0, 0, At, B0); PG_MMA(0, 1, At, B1); PG_BAR; PG_SCHED;
            PG_LDA(At, 0, 1); PG_STAGE(PG_SB(0, 0), b2, vb2); PG_STAGE(PG_SB(0, 1), b2 + hstepB, vb2); PG_STAGE_A(PG_SA(0, 0), a2, 0, o2);
            PG_WAIT_V(8); PG_WAIT_L(0); PG_BAR; PG_MMA(1, 0, At, B0); PG_MMA(1, 1, At, B1); PG_BAR; PG_SCHED;
            PG_LDB(B0, 1, 0); PG_LDB(B1, 1, 1); PG_SCHED; PG_LDA(At, 1, 0); PG_STAGE_A(PG_SA(0, 1), a2, 1, o2);
            PG_WAIT_V(8); PG_WAIT_L(0); PG_BAR; PG_MMA(0, 0, At, B0); PG_MMA(0, 1, At, B1); PG_BAR; PG_SCHED;
            PG_LDA(At, 1, 1); PG_STAGE(PG_SB(1, 0), b3, vb2); PG_STAGE(PG_SB(1, 1), b3 + hstepB, vb2); PG_STAGE_A(PG_SA(1, 0), a3, 0, o2);
            PG_WAIT_V(8); PG_WAIT_L(0); PG_BAR; PG_MMA(1, 0, At, B0); PG_MMA(1, 1, At, B1); PG_BAR; PG_SCHED;
        }
        if (wr == 0) PG_BAR;
        if constexpr (FP8) asm volatile("s_nop 15\n\ts_nop 7" ::: "memory");
        if constexpr (Epi::ACCS != 1.f) {
#pragma unroll
            for (int a = 0; a < 2; ++a)
#pragma unroll
                for (int b = 0; b < 2; ++b)
#pragma unroll
                    for (int m = 0; m < 4; ++m)
#pragma unroll
                        for (int n = 0; n < 2; ++n) acc[a][b][m][n] *= Epi::ACCS; }
        E(acc, cur, wr, wc, fr, fq);
        if (!has_next) break;
#pragma unroll
        for (int a = 0; a < 2; ++a)
#pragma unroll
            for (int b = 0; b < 2; ++b)
#pragma unroll
                for (int m = 0; m < 4; ++m)
#pragma unroll
                    for (int n = 0; n < 2; ++n) acc[a][b][m][n] = (f32x4){0.f, 0.f, 0.f, 0.f};
        cur = nxt; cA = nA; cB = nB; ++ui;
        if constexpr (KEEPK) {
#pragma unroll
            for (int h = 0; h < 2; ++h)
#pragma unroll
                for (int i = 0; i < 2; ++i) offC[h][i] = offK[h][i]; }
        else if constexpr (GATHER) S.aoff(cur, tid, offC);
        if (wr == 1) PG_BAR;
    }
    PG_WAIT_V(0);
    PG_BAR;
#undef PG_SA
#undef PG_SB
#undef PG_STAGE
#undef PG_STAGE_A
#undef PG_LDA
#undef PG_LDB
#undef PG_MMA
#undef PG_WAIT_V
#undef PG_WAIT_L
#undef PG_BAR
#undef PG_SCHED
}
}

DEV __amdgpu_buffer_rsrc_t mk_rsrc(const void* ptr, unsigned bytes) { return __builtin_amdgcn_make_buffer_rsrc((void*)ptr, (short)0, (int)bytes, 0x00020000); }
DEV void st_bf16x4(__amdgpu_buffer_rsrc_t rs, int voff, int soff, const f32x4 v) { u32x2 w; w.x = pk2(v[0], v[1]); w.y = pk2(v[2], v[3]); __builtin_amdgcn_raw_buffer_store_b64(w, rs, voff, soff, 0); }
DEV void stg_bf16x8(bf16_t* ptr, const f32x4 a, const f32x4 b) { u32x4 w; w.x = pk2(a[0], a[1]); w.y = pk2(a[2], a[3]); w.z = pk2(b[0], b[1]); w.w = pk2(b[2], b[3]); *(u32x4*)ptr = w; }
DEV f32x4 ld_bf16x4(const bf16_t* ptr) { const u32x2 w = *(const u32x2*)ptr; return (f32x4){bf2f((bf16_t)(w.x & 0xffff)), bf2f((bf16_t)(w.x >> 16)), bf2f((bf16_t)(w.y & 0xffff)), bf2f((bf16_t)(w.y >> 16))}; }

struct SchedA {
    const char* hbf; const char* wtin; const char* wtt; int G, c;
    static constexpr bool GATHER = false, FP8 = INP_FP8 == 1; static constexpr int PERMC = -1; static constexpr bool DYN = false;
    static constexpr int DR = FP8 ? D / 2 : D;
    static constexpr int NM = TA / 256, NN = NIN / 256 - 1, N1 = NM * NN, N2 = 3 * NM;
    DEV bool next(int i, pg::Unit& u) const {
        const int Lg = i * G + c; if (Lg >= N1 + N2) return false;
        u.nt = FP8 ? 8 : 16;
        if (Lg < N1) { pg::tile_from_L(Lg, NM, NN, u.pm, u.pn); if (u.pn >= 6) ++u.pn; u.kind = 0; u.perm = (u.pn == 3 || u.pn >= 6) ? 1 : 0; u.aMat = hbf + (size_t)u.pm * 256 * DR * 2; u.bBase = wtin + (size_t)u.pn * 256 * DR * 2; }
        else { const int r = Lg - N1; u.pm = r % 3; u.pn = r / 3; u.kind = 1; u.perm = 0; u.aMat = wtt + (size_t)u.pm * 256 * DR * 2; u.bBase = hbf + (size_t)u.pn * 256 * DR * 2; }
        return true;
    }
    DEV void aoff(const pg::Unit& u, const int tid, unsigned (&off)[2][2]) const {
        int R[2], C[2];
#pragma unroll
        for (int i = 0; i < 2; ++i) pg::stage_rc(tid * 16 + i * 8192, R[i], C[i]);
#pragma unroll
        for (int h = 0; h < 2; ++h)
#pragma unroll
            for (int i = 0; i < 2; ++i) off[h][i] = (unsigned)((u.pm * 256 + h * 128 + R[i]) * D + C[i]) * 2u;
    }
};
struct EpiA {
    static constexpr bool HAS_MID = false, BIASL = false; static constexpr float ACCS = INP_FP8 == 1 ? 1.f / QW : 1.f;
    const P& p; int l;
    DEV void operator()(const f32x4 (&acc)[2][2][4][2], const pg::Unit& u, int wr, int wc, int fr, int fq) const {
        if (u.kind == 0) {
            const __amdgpu_buffer_rsrc_t rs = mk_rsrc(p.ws + OFF_PROJ, (unsigned)((size_t)TA * NIN * 2));
            const bool isctx = u.pm * 256 >= TL;
            const f32x2* taba = (const f32x2*)(p.ws + OFF_TABA); const f32x2* tabr = (const f32x2*)(p.ws + OFF_TABR);
            if (u.perm) {
#pragma unroll
                for (int bj = 0; bj < 2; ++bj) {
                    const int cb = u.pn * 256 + bj * 128;
                    const int reg = cb < C_RGF ? 1 : cb < C_GA ? 3 : 4;
#pragma unroll
                    for (int ai = 0; ai < 2; ++ai)
#pragma unroll
                        for (int m = 0; m < 4; ++m) {
                            f32x4 o1 = acc[ai][bj][m][0], o2 = acc[ai][bj][m][1];
                            if (reg == 3) {
#pragma unroll
                                for (int i = 0; i < 4; ++i) { o1[i] = siluf_(o1[i]); o2[i] = siluf_(o2[i]); }
                            } else if (reg == 4) {
#pragma unroll
                                for (int i = 0; i < 4; ++i) { o1[i] = sigmoidf_(o1[i]); o2[i] = sigmoidf_(o2[i]); }
                            }
                            stg_bf16x8((bf16_t*)(p.ws + OFF_PROJ) + (size_t)(u.pm * 256 + ai * 128 + wr * 64 + m * 16 + fr) * NIN + cb + wc * 32 + 8 * fq, o1, o2);
                        }
                }
            } else {
#pragma unroll
            for (int bj = 0; bj < 2; ++bj) {
                const int cb = u.pn * 256 + bj * 128;
                const int reg = cb < C_V ? 0 : cb < C_RQ ? 1 : cb < C_RV ? 2 : cb < C_RGF ? 1 : cb < C_GA ? 3 : 4;
#pragma unroll
                for (int ai = 0; ai < 2; ++ai)
#pragma unroll
                    for (int m = 0; m < 4; ++m) {
                        const int row = u.pm * 256 + ai * 128 + wr * 64 + m * 16 + fr, pos = isctx ? 0 : (row & (L - 1));
                        f32x4 x1 = acc[ai][bj][m][0], x2 = acc[ai][bj][m][1], o1, o2;
                        if (reg == 0 || reg == 2) {
                            const f32x2* tp = reg == 0 ? ((wc & 1) ? taba + 256 * 16 + (pos & 63) * 16 : taba + (pos >> 6) * 16) + 4 * fq : tabr + pos * 32 + (wc & 1) * 16 + 4 * fq;
                            const f32x4 t0 = *(const f32x4*)tp, t1 = *(const f32x4*)(tp + 2);
                            const f32x4 cs = (f32x4){t0[0], t0[2], t1[0], t1[2]}, sn = (f32x4){t0[1], t0[3], t1[1], t1[3]};
                            o1 = x1 * cs - x2 * sn; o2 = x1 * sn + x2 * cs;
                            if (reg == 0 && cb < C_K) { o1 = o1 * (0.125f * LOG2E); o2 = o2 * (0.125f * LOG2E); }
                            else if (reg == 2 && cb >= C_RK) { o1 = o1 * 0.125f; o2 = o2 * 0.125f; }
                        } else if (reg == 1) { o1 = x1; o2 = x2; }
                        else if (reg == 3) {
#pragma unroll
                            for (int i = 0; i < 4; ++i) { o1[i] = siluf_(x1[i]); o2[i] = siluf_(x2[i]); }
                        } else {
#pragma unroll
                            for (int i = 0; i < 4; ++i) { o1[i] = sigmoidf_(x1[i]); o2[i] = sigmoidf_(x2[i]); }
                        }
                        const int so = ((u.pm * 256 + ai * 128 + m * 16) * NIN + cb) * 2;
                        st_bf16x4(rs, ((wr * 64 + fr) * NIN + wc * 32 + 4 * fq) * 2, so, o1);
                        st_bf16x4(rs, ((wr * 64 + fr) * NIN + wc * 32 + 4 * fq) * 2, so + 32, o2);
                    }
            }
            }
        } else {
            bf16_t* projT = (bf16_t*)(p.ws + OFF_PROJT);
            if (u.pm < 2) {
#pragma unroll
                for (int ai = 0; ai < 2; ++ai) {
                    if (u.pm == 0 && ai == 1) continue;
#pragma unroll
                    for (int m = 0; m < 4; ++m) {
                        const int row = u.pm * 256 + ai * 128 + wr * 64 + m * 16 + fr;
#pragma unroll
                        for (int bj = 0; bj < 2; ++bj)
#pragma unroll
                            for (int n = 0; n < 2; ++n) {
                                const int tok = u.pn * 256 + bj * 128 + wc * 32 + 16 * n + 4 * fq; const f32x4 v = acc[ai][bj][m][n];
                                u32x2 w; w.x = pk2(v[0], v[1]); w.y = pk2(v[2], v[3]);
                                *(u32x2*)(projT + (size_t)row * TA + tok) = w;
                            }
                    }
                }
            } else {
                const float* tcos = (const float*)(p.ws + OFF_TABRT); const float* tsin = tcos + (size_t)32 * L;
                const __amdgpu_buffer_rsrc_t rsT = __builtin_amdgcn_make_buffer_rsrc((void*)projT, (short)0, (int)(TROWS * TA * 2), 0x00020000);
                const int voT = ((wr * 64 + fr) * TA + wc * 32 + 4 * fq) * 2, sbase = u.pn * 256;
#pragma unroll
                for (int bj = 0; bj < 2; ++bj)
#pragma unroll
                    for (int n = 0; n < 2; ++n) {
                        const int tok0 = u.pn * 256 + bj * 128 + wc * 32 + 16 * n + 4 * fq, jj = tok0 & 127; const bool isctx = u.pn * 256 >= TL; const int pos = tok0 & (L - 1);
#pragma unroll
                        for (int ai = 0; ai < 2; ++ai) {
                            const int hh = 2 * ai + wr;
                            const f32x4 wf = *(const f32x4*)((const float*)(p.ws + OFF_TABW) + ((l * 2 + 0) * 4 + hh) * 128 + jj) * 0.125f;
                            const f32x4 wb = *(const f32x4*)((const float*)(p.ws + OFF_TABW) + ((l * 2 + 1) * 4 + hh) * 128 + jj) * 0.125f;
#pragma unroll
                            for (int mp = 0; mp < 2; ++mp) {
                                const int prow = ai * 128 + wr * 64 + mp * 32 + fr, f = mp * 16 + fr;
                                f32x4 cs = (f32x4){1.f, 1.f, 1.f, 1.f}, sn = (f32x4){0.f, 0.f, 0.f, 0.f};
                                if (!isctx) { cs = *(const f32x4*)(tcos + (size_t)f * L + pos); sn = *(const f32x4*)(tsin + (size_t)f * L + pos); }
                                const f32x4 x1 = acc[ai][bj][2 * mp][n], x2 = acc[ai][bj][2 * mp + 1][n];
                                const f32x4 o1 = x1 * cs - x2 * sn, o2 = x1 * sn + x2 * cs;
                                const f32x4 a1 = o1 * wf, a2 = o2 * wf, b1 = o1 * wb, b2 = o2 * wb;
                                u32x2 w; const int so = ((ai * 128 + mp * 32) * TA + sbase + bj * 128 + 16 * n) * 2;
                                w.x = pk2(a1[0], a1[1]); w.y = pk2(a1[2], a1[3]); __builtin_amdgcn_raw_buffer_store_b64(w, rsT, voT, so + (T_RKF * TA) * 2, 0);
                                w.x = pk2(a2[0], a2[1]); w.y = pk2(a2[2], a2[3]); __builtin_amdgcn_raw_buffer_store_b64(w, rsT, voT, so + ((T_RKF + 16) * TA) * 2, 0);
                                w.x = pk2(b1[0], b1[1]); w.y = pk2(b1[2], b1[3]); __builtin_amdgcn_raw_buffer_store_b64(w, rsT, voT, so + (T_RKB * TA) * 2, 0);
                                w.x = pk2(b2[0], b2[1]); w.y = pk2(b2[2], b2[3]); __builtin_amdgcn_raw_buffer_store_b64(w, rsT, voT, so + ((T_RKB + 16) * TA) * 2, 0);
                            }
                        }
                    }
            }
        }
    }
};
template <bool Q>
struct SchedAM {
    const char* hb; const char* wt; const char* wtt; unsigned* ctr; int xcd;
    static constexpr bool GATHER = false, FP8 = Q, DYN = true; static constexpr int PERMC = Q ? 1 : -1;
    static constexpr int DR = Q ? D / 2 : D;
    static constexpr int NM = TA / 256, NN = Q ? 12 : 8, N1 = NM * NN, N2 = Q ? 0 : 2 * NM;
    DEV int grab() const { return (int)__hip_atomic_fetch_add(ctr + xcd * 16, 1u, __ATOMIC_RELAXED, __HIP_MEMORY_SCOPE_AGENT); }
    DEV bool decode(int k, pg::Unit& u) const {
        const int Lg = k * 8 + xcd; if (Lg >= N1 + N2) return false;
        u.nt = Q ? 8 : 16;
        if (Lg < N1) { pg::tile_from_L(Lg, NM, NN, u.pm, u.pn); u.kind = 0; u.aMat = hb + (size_t)u.pm * 256 * DR * 2;
            if (Q) { u.bBase = wt + (size_t)u.pn * 256 * DR * 2; u.pn += 9; u.perm = 1; }
            else { if (u.pn >= 6) ++u.pn; u.perm = (u.pn == 3 || u.pn >= 6) ? 1 : 0; u.bBase = wt + (size_t)u.pn * 256 * DR * 2; } }
        else { const int r = Lg - N1; u.pm = 1 + (r & 1); u.pn = r >> 1; u.kind = 1; u.perm = 0; u.aMat = wtt + (size_t)u.pm * 256 * DR * 2; u.bBase = hb + (size_t)u.pn * 256 * DR * 2; }
        return true;
    }
    DEV bool next(int i, pg::Unit& u) const { return false; }
    DEV void aoff(const pg::Unit& u, const int tid, unsigned (&off)[2][2]) const { off[0][0] = off[0][1] = off[1][0] = off[1][1] = 0u; }
};
struct EpiAQ : EpiA { static constexpr float ACCS = 1.f / QW; };
#ifndef NCONV_
#define NCONV_ 96
#endif
constexpr int NCONV = NCONV_;
DEV void stage_inproj_mixed(const P& p, int l, int bid, int nb, unsigned char* lds, int wvx) {
    unsigned* ctr = (unsigned*)(p.ws + OFF_CTL) + CW_DYN + l * 256;
    if (NCONV > 0 && bid >= nb - NCONV) { stage_prep_experts(p, l, bid - (nb - NCONV), NCONV, lds, wvx); __syncthreads(); }
    { SchedAM<false> S{(const char*)(p.ws + OFF_HBF), (const char*)(p.ws + OFF_WTIN) + (size_t)l * NIN * D * 2, (const char*)(p.ws + OFF_WTT) + (size_t)l * 768 * D * 2, ctr, bid & 7};
      EpiA E{p, l};
      pg::gemm_phase<EpiA, SchedAM<false>>((LAS unsigned char*)lds, S, E, D, wvx); }
    __syncthreads();
    { SchedAM<true> S{(const char*)(p.ws + OFF_HQ), (const char*)(p.ws + OFF_WTINQ) + (size_t)l * (NIN - C_GA) * D, nullptr, ctr + 128, bid & 7};
      EpiAQ E{{p, l}};
      pg::gemm_phase<EpiAQ, SchedAM<true>>((LAS unsigned char*)lds, S, E, D / 2, wvx); }
}
DEV void stage_inproj_fast(const P& p, int l, int bid, int nb, unsigned char* lds, int wvx) {
#if INP_FP8 == 2
    stage_inproj_mixed(p, l, bid, nb, lds, wvx); return;
#endif
    SchedA S{(const char*)(p.ws + OFF_HBF), (const char*)(p.ws + OFF_WTIN) + (size_t)l * NIN * SchedA::DR * 2, (const char*)(p.ws + OFF_WTT) + (size_t)l * 768 * SchedA::DR * 2, nb, bid};
    EpiA E{p, l};
    pg::gemm_phase<EpiA, SchedA>((LAS unsigned char*)lds, S, E, SchedA::DR, wvx);
}

DEV void moe_tiles(const P& p, int l, LAS int* tstart, LAS int* cnt, int wvx) {
    const int tid = TID;
    if (tid < 64) {
        unsigned* cntg = (unsigned*)(p.ws + OFF_CTL) + CW_CNT + l * 32;
        const int c = tid < 32 ? (int)__hip_atomic_load(cntg + (tid & 31), __ATOMIC_RELAXED, __HIP_MEMORY_SCOPE_AGENT) : 0;
        const int nt = (c + 255) >> 8; int incl = nt;
#pragma unroll
        for (int o = 1; o < 32; o <<= 1) { const int t = __shfl_up(incl, o); if ((tid & 63) >= o) incl += t; }
        if (tid < 32) { cnt[tid] = c; tstart[tid] = incl - nt; if (tid == 31) tstart[32] = incl; }
    }
    __syncthreads();
}
template <int NN, bool GATHER_, bool FP8_>
struct SchedMoe {
    static constexpr bool GATHER = GATHER_, FP8 = FP8_; static constexpr int PERMC = GATHER_ ? 0 : 1; static constexpr bool DYN = false;
    static constexpr int DR = FP8_ ? D / 2 : D;
    const char* amat; const char* wt; const int* list_tok; const LAS int* tstart; const LAS int* cnt; int G, c;
    DEV bool next(int i, pg::Unit& u) const {
        const int ntile = __builtin_amdgcn_readfirstlane(tstart[32]); const int Lg = i * G + c; if (Lg >= ntile * NN) return false;
        pg::tile_from_L(Lg, ntile, NN, u.pm, u.pn);
        int e = 0;
        for (int j = 1; j < 32; ++j) e = (u.pm >= __builtin_amdgcn_readfirstlane(tstart[j])) ? j : e;
        u.kind = e; u.nt = FP8_ ? 8 : 16; u.perm = GATHER_ ? 0 : 1; u.aMat = GATHER_ ? amat : amat + (size_t)u.pm * 256 * DR * 2; u.bBase = wt + ((size_t)e * NN * 256 + (size_t)u.pn * 256) * DR * 2;
        return true;
    }
    DEV void aoff(const pg::Unit& u, const int tid, unsigned (&off)[2][2]) const {
        int R[2], C[2];
#pragma unroll
        for (int i = 0; i < 2; ++i) pg::stage_rc(tid * 16 + i * 8192, R[i], C[i]);
#pragma unroll
        for (int h = 0; h < 2; ++h)
#pragma unroll
            for (int i = 0; i < 2; ++i) {
                if (GATHER) { const int e = u.kind, ts = __builtin_amdgcn_readfirstlane(tstart[e]), ce = __builtin_amdgcn_readfirstlane(cnt[e]), pos = (u.pm - ts) * 256 + h * 128 + R[i]; const int tok = list_tok[e * CAP + (pos < ce ? pos : ce - 1)]; off[h][i] = (unsigned)(tok * DR + C[i]) * 2u; }
                else off[h][i] = (unsigned)((u.pm * 256 + h * 128 + R[i]) * DR + C[i]) * 2u;
            }
    }
};
struct EpiM1 {
    static constexpr bool HAS_MID = false, BIASL = true; static constexpr float ACCS = 1.f;
    const P& p; int l; LAS unsigned char* bl;
    DEV const float* bias_src(const pg::Unit& u, int lane) const { return p.b1 + ((size_t)l * NEXP + u.kind) * 2048 + 128 * u.pn + (lane < 32 ? 4 * lane : 1024 + 4 * (lane - 32)); }
    DEV void operator()(const f32x4 (&acc)[2][2][4][2], const pg::Unit& u, int wr, int wc, int fr, int fq) const {
        bf16_t* act = (bf16_t*)(p.ws + OFF_ACT);
        const float* b1 = p.b1 + ((size_t)l * NEXP + u.kind) * 2048;
        const int q = fq == 1 ? 2 : fq == 2 ? 1 : fq;
        f32x4 bgv[2], blv[2];
#pragma unroll
        for (int bj = 0; bj < 2; ++bj) { const LAS float* sl = (const LAS float*)(bl + u.bslot * 1024) + 16 * (4 * bj + wc) + 4 * q; bgv[bj] = *(const LAS f32x4*)sl; blv[bj] = *(const LAS f32x4*)(sl + 128); }
        const int hi = fq >> 1;
        const int ccol = 16 * (8 * u.pn + 4 * hi + wc) + 8 * (fq & 1);
        constexpr float S1 = MOE_FP8 >= 1 ? 1.f / QW : 1.f;
#pragma unroll
        for (int ai = 0; ai < 2; ++ai)
#pragma unroll
            for (int m = 0; m < 4; ++m) {
#if MOE_FP8 >= 2
                unsigned q0 = 0, q1 = 0;
#pragma unroll
                for (int bj = 0; bj < 2; ++bj) {
                    f32x4 o;
#pragma unroll
                    for (int i = 0; i < 4; ++i) {
                        float glu = acc[ai][bj][m][0][i] * S1 + bgv[bj][i], lin = acc[ai][bj][m][1][i] * S1 + blv[bj][i];
                        glu = fminf(glu, 7.f); lin = fminf(fmaxf(lin, -7.f), 7.f);
                        o[i] = QA * glu * sigmoidf_(1.702f * glu) * (lin + 1.f);
                    }
                    if (bj == 0) q0 = pk4q(o[0], o[1], o[2], o[3]); else q1 = pk4q(o[0], o[1], o[2], o[3]);
                }
                { const auto r = __builtin_amdgcn_permlane32_swap(q0, q1, false, false); q0 = r[0]; q1 = r[1]; }
                u32x2 wq; wq.x = q0; wq.y = q1;
                *(u32x2*)((unsigned char*)act + (size_t)(u.pm * 256 + ai * 128 + wr * 64 + m * 16 + fr) * D + ccol) = wq;
            }
#else
                unsigned w0[2], w1[2];
#pragma unroll
                for (int bj = 0; bj < 2; ++bj) {
                    f32x4 o;
#pragma unroll
                    for (int i = 0; i < 4; ++i) {
                        float glu = acc[ai][bj][m][0][i] * S1 + bgv[bj][i], lin = acc[ai][bj][m][1][i] * S1 + blv[bj][i];
                        glu = fminf(glu, 7.f); lin = fminf(fmaxf(lin, -7.f), 7.f);
                        o[i] = glu * sigmoidf_(1.702f * glu) * (lin + 1.f);
                    }
                    if (bj == 0) { w0[0] = pk2(o[0], o[1]); w0[1] = pk2(o[2], o[3]); } else { w1[0] = pk2(o[0], o[1]); w1[1] = pk2(o[2], o[3]); }
                }
#pragma unroll
                for (int k = 0; k < 2; ++k) { const auto r = __builtin_amdgcn_permlane32_swap(w0[k], w1[k], false, false); w0[k] = r[0]; w1[k] = r[1]; }
                u32x4 w; w.x = w0[0]; w.y = w0[1]; w.z = w1[0]; w.w = w1[1];
                *(u32x4*)(act + (size_t)(u.pm * 256 + ai * 128 + wr * 64 + m * 16 + fr) * D + ccol) = w;
            }
#endif
    }
};
struct EpiM2 {
    static constexpr bool HAS_MID = false, BIASL = true; static constexpr float ACCS = 1.f;
    const P& p; int l; LAS unsigned char* bl;
    DEV const float* bias_src(const pg::Unit& u, int lane) const { return p.b2 + ((size_t)l * NEXP + u.kind) * D + 256 * u.pn + 4 * lane; }
    DEV void operator()(const f32x4 (&acc)[2][2][4][2], const pg::Unit& u, int wr, int wc, int fr, int fq) const {
        const __amdgpu_buffer_rsrc_t rs = mk_rsrc(p.ws + OFF_YB, (unsigned)((size_t)PMAX * D * 2));
        const float* b2 = p.b2 + ((size_t)l * NEXP + u.kind) * D;
        const int vo = ((wr * 64 + fr) * D + wc * 32 + 8 * fq) * 2;
        f32x4 bv[2][2];
#pragma unroll
        for (int bj = 0; bj < 2; ++bj)
#pragma unroll
            for (int n = 0; n < 2; ++n) bv[bj][n] = *(const LAS f32x4*)((const LAS float*)(bl + u.bslot * 1024) + bj * 128 + wc * 32 + 8 * fq + 4 * n);
#pragma unroll
        for (int bj = 0; bj < 2; ++bj)
#pragma unroll
            for (int ai = 0; ai < 2; ++ai)
#pragma unroll
                for (int m = 0; m < 4; ++m)
                    { constexpr float S2 = MOE_FP8 >= 2 ? 1.f / (QW * QA) : 1.f; const f32x4 a_ = acc[ai][bj][m][0] * S2 + bv[bj][0], b_ = acc[ai][bj][m][1] * S2 + bv[bj][1]; u32x4 w_; w_.x = pk2(a_[0], a_[1]); w_.y = pk2(a_[2], a_[3]); w_.z = pk2(b_[0], b_[1]); w_.w = pk2(b_[2], b_[3]);
                      *(u32x4*)((bf16_t*)(p.ws + OFF_YB) + (size_t)(u.pm * 256 + ai * 128 + wr * 64 + m * 16 + fr) * D + u.pn * 256 + bj * 128 + wc * 32 + 8 * fq) = w_; }
    }
};
DEV void stage_moe1_fast(const P& p, int l, int bid, int nb, unsigned char* lds, int wvx) {
    LAS int* tstart = (LAS int*)((LAS unsigned char*)lds + 131072); LAS int* cnt = tstart + 40;
    moe_tiles(p, l, tstart, cnt, wvx);
    constexpr bool Q = MOE_FP8 >= 1;
    SchedMoe<8, true, Q> S{(const char*)(p.ws + OFF_HBF), (const char*)(p.ws + OFF_WT1) + (size_t)l * NEXP * 2048 * D * (Q ? 1 : 2), (const int*)(p.ws + OFF_TK + (size_t)l * TK_LAYER) + 3 * TA * 4, tstart, cnt, nb, bid};
    EpiM1 E{p, l, (LAS unsigned char*)lds + 131072 + 4096};
    pg::gemm_phase<EpiM1, SchedMoe<8, true, Q>>((LAS unsigned char*)lds, S, E, Q ? D / 2 : D, wvx);
}
DEV void stage_moe2_fast(const P& p, int l, int bid, int nb, unsigned char* lds, int wvx) {
    LAS int* tstart = (LAS int*)((LAS unsigned char*)lds + 131072); LAS int* cnt = tstart + 40;
    moe_tiles(p, l, tstart, cnt, wvx);
    constexpr bool Q = MOE_FP8 >= 2;
    SchedMoe<4, false, Q> S{(const char*)(p.ws + OFF_ACT), (const char*)(p.ws + OFF_WT2) + (size_t)l * NEXP * D * D * (Q ? 1 : 2), nullptr, tstart, cnt, nb, bid};
    EpiM2 E{p, l, (LAS unsigned char*)lds + 131072 + 4096};
    pg::gemm_phase<EpiM2, SchedMoe<4, false, Q>>((LAS unsigned char*)lds, S, E, Q ? D / 2 : D, wvx);
}

struct SchedMerge {
    const char* mix; const char* wtm; int G, c, NM;
    static constexpr bool GATHER = false, FP8 = false; static constexpr int PERMC = -1; static constexpr bool DYN = false;
    static constexpr int NN = D / 256;
    DEV bool next(int i, pg::Unit& u) const {
        const int Lt = i * G + c; if (Lt >= NM * NN) return false;
        pg::tile_from_L(Lt, NM, NN, u.pm, u.pn);
        u.kind = 0; u.nt = 16; u.perm = 1; u.aMat = mix + (size_t)u.pm * 256 * D * 2; u.bBase = wtm + (size_t)u.pn * 256 * D * 2;
        return true;
    }
    DEV void aoff(const pg::Unit& u, const int tid, unsigned (&off)[2][2]) const {}
};
struct EpiMerge {
    static constexpr bool HAS_MID = true, BIASL = false; static constexpr float ACCS = 1.f;
    const P& p;
    DEV void mid(f32x4 (&acc)[2][2][4][2], const pg::Unit& u, int t, int wr, int wc, int fr, int fq) const {
        const bf16_t* proj = (const bf16_t*)(p.ws + OFF_PROJ);
        const int cnum = C_GA + (t == 8 ? 0 : 1024), cden = cnum + 1024;
#pragma unroll
        for (int ai = 0; ai < 2; ++ai)
#pragma unroll
            for (int m = 0; m < 4; ++m) {
                const bf16_t* rowp = proj + (size_t)(u.pm * 256 + ai * 128 + wr * 64 + m * 16 + fr) * NIN + u.pn * 256 + wc * 32 + 8 * fq;
#pragma unroll
                for (int bj = 0; bj < 2; ++bj) {
                    const u32x4 gnw = *(const u32x4*)(rowp + cnum + bj * 128), gdw = *(const u32x4*)(rowp + cden + bj * 128);
                    const unsigned gn_[4] = {gnw.x, gnw.y, gnw.z, gnw.w}, gd_[4] = {gdw.x, gdw.y, gdw.z, gdw.w};
#pragma unroll
                    for (int n = 0; n < 2; ++n)
#pragma unroll
                        for (int i = 0; i < 4; ++i) {
                            const unsigned wn = gn_[2 * n + (i >> 1)], wd = gd_[2 * n + (i >> 1)];
                            const float gnf = bf2f((bf16_t)((i & 1) ? (wn >> 16) : (wn & 0xffff))), gdf = bf2f((bf16_t)((i & 1) ? (wd >> 16) : (wd & 0xffff)));
                            acc[ai][bj][m][n][i] *= gnf * __builtin_amdgcn_rcpf(fmaxf(gdf, 1e-30f));
                        }
                }
            }
    }
    DEV void operator()(const f32x4 (&acc)[2][2][4][2], const pg::Unit& u, int wr, int wc, int fr, int fq) const {
        const bf16_t* proj = (const bf16_t*)(p.ws + OFF_PROJ);
        bf16_t* mo = (bf16_t*)(p.ws + OFF_M);
        u32x4 gw[2][4][2];
#pragma unroll
        for (int ai = 0; ai < 2; ++ai)
#pragma unroll
            for (int m = 0; m < 4; ++m) {
                const bf16_t* rowp = proj + (size_t)(u.pm * 256 + ai * 128 + wr * 64 + m * 16 + fr) * NIN + C_GA + 2048 + u.pn * 256 + wc * 32 + 8 * fq;
#pragma unroll
                for (int bj = 0; bj < 2; ++bj) gw[ai][m][bj] = *(const u32x4*)(rowp + bj * 128);
            }
#pragma unroll
        for (int ai = 0; ai < 2; ++ai)
#pragma unroll
            for (int m = 0; m < 4; ++m)
#pragma unroll
                for (int bj = 0; bj < 2; ++bj) {
                    const u32x4 w = gw[ai][m][bj];
                    const f32x4 g0 = (f32x4){bf2f((bf16_t)(w.x & 0xffff)), bf2f((bf16_t)(w.x >> 16)), bf2f((bf16_t)(w.y & 0xffff)), bf2f((bf16_t)(w.y >> 16))};
                    const f32x4 g1 = (f32x4){bf2f((bf16_t)(w.z & 0xffff)), bf2f((bf16_t)(w.z >> 16)), bf2f((bf16_t)(w.w & 0xffff)), bf2f((bf16_t)(w.w >> 16))};
#if OUT_FP8
                    { const f32x4 a_ = g0 * acc[ai][bj][m][0] * QM, b_ = g1 * acc[ai][bj][m][1] * QM; u32x2 wq; wq.x = pk4q(a_[0], a_[1], a_[2], a_[3]); wq.y = pk4q(b_[0], b_[1], b_[2], b_[3]);
                      *(u32x2*)((unsigned char*)mo + (size_t)(u.pm * 256 + ai * 128 + wr * 64 + m * 16 + fr) * D + u.pn * 256 + bj * 128 + wc * 32 + 8 * fq) = wq; }
#else
                    stg_bf16x8(mo + (size_t)(u.pm * 256 + ai * 128 + wr * 64 + m * 16 + fr) * D + u.pn * 256 + bj * 128 + wc * 32 + 8 * fq, g0 * acc[ai][bj][m][0], g1 * acc[ai][bj][m][1]);
#endif
                }
    }
};
DEV void stage_merge_fast(const P& p, int l, int bid, int nb, unsigned char* lds, int wvx) {
    SchedMerge S{(const char*)(p.ws + OFF_MIX), (const char*)(p.ws + OFF_WTM) + (size_t)l * D * D * 2, nb, bid, TL / 256};
    EpiMerge E{p};
    pg::gemm_phase<EpiMerge, SchedMerge>((LAS unsigned char*)lds, S, E, D, wvx);
}
struct SchedOut {
    const char* a; const char* wt; int G, c, NM;
    static constexpr bool GATHER = false, FP8 = OUT_FP8 != 0; static constexpr int PERMC = 0; static constexpr bool DYN = false;
    static constexpr int NN = D / 256, DR = FP8 ? D / 2 : D;
    DEV bool next(int i, pg::Unit& u) const {
        const int Lt = i * G + c; if (Lt >= NM * NN) return false;
        pg::tile_from_L(Lt, NM, NN, u.pm, u.pn);
        u.kind = 0; u.nt = FP8 ? 8 : 16; u.perm = 0; u.aMat = a + (size_t)u.pm * 256 * DR * 2; u.bBase = wt + (size_t)u.pn * 256 * DR * 2;
        return true;
    }
    DEV void aoff(const pg::Unit& u, const int tid, unsigned (&off)[2][2]) const {
        int R[2], C[2];
#pragma unroll
        for (int i = 0; i < 2; ++i) pg::stage_rc(tid * 16 + i * 8192, R[i], C[i]);
#pragma unroll
        for (int h = 0; h < 2; ++h)
#pragma unroll
            for (int i = 0; i < 2; ++i) off[h][i] = (unsigned)((u.pm * 256 + h * 128 + R[i]) * D + C[i]) * 2u;
    }
};
struct EpiOut {
    static constexpr bool HAS_MID = false, BIASL = false; static constexpr float ACCS = OUT_FP8 ? 1.f / (QW * QM) : 1.f;
    const P& p; int l;
    DEV void operator()(const f32x4 (&acc)[2][2][4][2], const pg::Unit& u, int wr, int wc, int fr, int fq) const {
        float* xr = (float*)(p.ws + OFF_XR);
        const int row00 = u.pm * 256; const int s = row_mod(row00);
        const float* g1 = modp(p, l, s, 2);
        const float* xbase = l == 0 ? (row00 < TL ? p.x : p.ctx - (size_t)TL * D) : xr;
        float sq[8] = {0.f, 0.f, 0.f, 0.f, 0.f, 0.f, 0.f, 0.f};
#pragma unroll
        for (int bj = 0; bj < 2; ++bj)
#pragma unroll
            for (int n = 0; n < 2; ++n) {
                const int c = u.pn * 256 + bj * 128 + wc * 32 + 16 * n + 4 * fq;
                const f32x4 gvn = *(const f32x4*)(g1 + c);
                f32x4 xin[8];
#pragma unroll
                for (int ai = 0; ai < 2; ++ai)
#pragma unroll
                    for (int m = 0; m < 4; ++m) xin[ai * 4 + m] = *(const f32x4*)(xbase + (size_t)(row00 + ai * 128 + wr * 64 + m * 16 + fr) * D + c);
#pragma unroll
                for (int ai = 0; ai < 2; ++ai)
#pragma unroll
                    for (int m = 0; m < 4; ++m) { const f32x4 xn = xin[ai * 4 + m] + gvn * acc[ai][bj][m][n];
                        *(f32x4*)(xr + (size_t)(row00 + ai * 128 + wr * 64 + m * 16 + fr) * D + c) = xn;
                        sq[ai * 4 + m] += (xn.x * xn.x + xn.y * xn.y) + (xn.z * xn.z + xn.w * xn.w); }
            }
        float* rowsq = (float*)(p.ws + OFF_ROWSQ);
#pragma unroll
        for (int i = 0; i < 8; ++i) { float v = sq[i]; v += __shfl_xor(v, 16); v += __shfl_xor(v, 32);
            if (fq == 0) rowsq[(size_t)(row00 + (i >> 2) * 128 + wr * 64 + (i & 3) * 16 + fr) * 16 + u.pn * 4 + wc] = v; }
    }
};
DEV void stage_out_fast(const P& p, int l, int bid, int nb, unsigned char* lds, int wvx) {
    SchedOut S{(const char*)(p.ws + OFF_M), OUT_FP8 ? (const char*)(p.ws + OFF_WTOQ) + (size_t)l * D * D : (const char*)(p.ws + OFF_WTO) + (size_t)l * D * D * 2, nb, bid, TL / 256};
    EpiOut E{p, l};
    pg::gemm_phase<EpiOut, SchedOut>((LAS unsigned char*)lds, S, E, SchedOut::DR, wvx);
}


DEV void stage_merge_ctx(const P& p, int l, int bid, int nb, int wvx) {
    const int tid_ = TID, lane = tid_ & 63, wave = tid_ >> 6, r16 = lane & 15, q4 = lane >> 4;
    const bf16_t* mix = (const bf16_t*)(p.ws + OFF_MIX); const bf16_t* wt = (const bf16_t*)(p.ws + OFF_WTM) + (size_t)l * D * D;
    const bf16_t* proj = (const bf16_t*)(p.ws + OFF_PROJ); bf16_t* mo = (bf16_t*)(p.ws + OFF_M);
    constexpr int TN = D / 32, TM = TC / 32;
    const int gw = bid * NWAVES + wave; if (gw & 3) return;
    for (int t = gw >> 2; t < TM * TN; t += (nb * NWAVES) >> 2) {
        const int tm = t / TN, tn = t % TN, row0 = TL + tm * 32, col0 = tn * 32;
        f32x4 msum[2][2]; zero_acc(msum);
#pragma unroll
        for (int br = 0; br < 3; ++br) {
            const int k0 = br == 0 ? 0 : (br == 1 ? 512 : 768), kl = br == 0 ? 512 : 256;
            f32x4 acc[2][2]; zero_acc(acc);
            mma_tile32(mix + (size_t)(row0 + r16) * D + k0 + 8 * q4, mix + (size_t)(row0 + 16 + r16) * D + k0 + 8 * q4,
                       wt + (size_t)(col0 + r16) * D + k0 + 8 * q4, wt + (size_t)(col0 + 16 + r16) * D + k0 + 8 * q4, kl, acc);
#pragma unroll
            for (int mt = 0; mt < 2; ++mt)
#pragma unroll
                for (int nt = 0; nt < 2; ++nt)
#pragma unroll
                    for (int j = 0; j < 4; ++j) {
                        const int row = row0 + 16 * mt + 4 * q4 + j, col = col0 + 16 * nt + r16;
                        msum[mt][nt][j] += bf2f(proj[(size_t)row * NIN + C_GA + br * 1024 + col]) * acc[mt][nt][j];
                    }
        }
#pragma unroll
        for (int mt = 0; mt < 2; ++mt)
#pragma unroll
            for (int nt = 0; nt < 2; ++nt)
#pragma unroll
                for (int j = 0; j < 4; ++j) mo[(size_t)(row0 + 16 * mt + 4 * q4 + j) * D + col0 + 16 * nt + r16] = f2bf(msum[mt][nt][j]);
    }
}
DEV void stage_out_ctx(const P& p, int l, int bid, int nb, int wvx) {
    const int tid_ = TID, lane = tid_ & 63, wave = tid_ >> 6, r16 = lane & 15, q4 = lane >> 4;
    const bf16_t* mo = (const bf16_t*)(p.ws + OFF_M); const bf16_t* wt = (const bf16_t*)(p.ws + OFF_WTO) + (size_t)l * D * D;
    float* xr = (float*)(p.ws + OFF_XR);
    constexpr int TN = D / 32, TM = TC / 32;
    const int gw = bid * NWAVES + wave; if (gw & 3) return;
    for (int t = gw >> 2; t < TM * TN; t += (nb * NWAVES) >> 2) {
        const int tm = t / TN, tn = t % TN, row0 = TL + tm * 32, col0 = tn * 32;
        f32x4 acc[2][2]; zero_acc(acc);
        mma_tile32(mo + (size_t)(row0 + r16) * D + 8 * q4, mo + (size_t)(row0 + 16 + r16) * D + 8 * q4,
                   wt + (size_t)(col0 + r16) * D + 8 * q4, wt + (size_t)(col0 + 16 + r16) * D + 8 * q4, D, acc);
#pragma unroll
        for (int mt = 0; mt < 2; ++mt)
#pragma unroll
            for (int nt = 0; nt < 2; ++nt)
#pragma unroll
                for (int j = 0; j < 4; ++j) {
                    const int row = row0 + 16 * mt + 4 * q4 + j, col = col0 + 16 * nt + r16;
                    xr[(size_t)row * D + col] = p.ctx[(size_t)(row - TL) * D + col] + modp(p, l, 2, 2)[col] * acc[mt][nt][j];
                }
    }
}

constexpr size_t OFF_SPREV = OFF_ACT;
DEV void chunk_chain(int cidx, int& b, int& nf, int& nbk) {
    if (cidx < 256) { b = cidx >> 7; const int nl = cidx & 127; nf = 2 + nl; nbk = 2 + (127 - nl); }
    else { const int cc = cidx - 256; b = cc >> 1; const int nc = cc & 1; nf = nc; nbk = 1 - nc; }
}
DEV void stage_ret_kv(const P& p, int l, int bid, int nb, int wvx) {
    const int tid_ = TID, lane = tid_ & 63, wave = tid_ >> 6, r16 = lane & 15, q4 = lane >> 4;
    const bf16_t* projT = (const bf16_t*)(p.ws + OFF_PROJT); float* kvbuf = (float*)(p.ws + OFF_KV);
    for (int t = bid * NWAVES + wave; t < 260 * 8 * 4; t += nb * NWAVES) {
        const int unit = t >> 2, quad = t & 3, e0 = (quad >> 1) * 32, d0 = (quad & 1) * 32;
        const int cidx = unit >> 3, h = (unit >> 1) & 3, dir = unit & 1, row0 = cidx * 128;
        int b, nf, nbk; chunk_chain(cidx, b, nf, nbk);
        const bf16_t* va = projT + (size_t)(T_RV + h * 64 + e0 + r16) * TA + row0 + 8 * q4;
        const bf16_t* kb = projT + (size_t)((dir ? T_RKB : T_RKF) + h * 64 + d0 + r16) * TA + row0 + 8 * q4;
        f32x4 acc[2][2]; zero_acc(acc);
        mma_tile32(va, va + (size_t)16 * TA, kb, kb + (size_t)16 * TA, 128, acc);
        float* dst = kvbuf + ((size_t)(((b * 4 + h) * 2 + dir) * 130 + (dir ? nbk : nf))) * 4096;
#pragma unroll
        for (int mt = 0; mt < 2; ++mt)
#pragma unroll
            for (int nt = 0; nt < 2; ++nt)
#pragma unroll
                for (int j = 0; j < 4; ++j) dst[(e0 + 16 * mt + 4 * q4 + j) * 64 + d0 + 16 * nt + r16] = acc[mt][nt][j];
    }
}
DEV void stage_ret_scan(const P& p, int l, int bid, int nb, int wvx) {
    const float* kvbuf = (const float*)(p.ws + OFF_KV); unsigned* sprev = (unsigned*)(p.ws + OFF_SPREV);
    for (int gt = bid * NTHREADS + TID; gt < 16 * 2048; gt += nb * NTHREADS) {
        const int chain = gt >> 11, i2 = gt & 2047, h = (chain >> 1) & 3, dir = chain & 1;
        const float gC = __expf(128.f * log_g(p, l, dir, h));
        const f32x2* src = (const f32x2*)(kvbuf + (size_t)chain * 130 * 4096) + i2; unsigned* dst = sprev + (size_t)chain * 130 * 2048 + i2;
        f32x2 s = (f32x2){0.f, 0.f};
        for (int n0 = 0; n0 < 130; n0 += 10) {
            f32x2 kv[10];
#pragma unroll
            for (int u = 0; u < 10; ++u) kv[u] = src[(size_t)(n0 + u) * 2048];
#pragma unroll
            for (int u = 0; u < 10; ++u) { dst[(size_t)(n0 + u) * 2048] = pk2(s.x, s.y); s = s * gC + kv[u]; }
        }
    }
}
typedef short s16x4 __attribute__((ext_vector_type(4)));
DEV u32x2 lds_tr16(const LAS unsigned char* a) { const s16x4 v = __builtin_amdgcn_ds_read_tr16_b64_v4i16((LAS s16x4*)a); return __builtin_bit_cast(u32x2, v); }
DEV bf16x8 pack_b(const f32x4 a, const f32x4 b) {
    u32x4 w; w.x = pk2(a[0], a[1]); w.y = pk2(a[2], a[3]); w.z = pk2(b[0], b[1]); w.w = pk2(b[2], b[3]);
    return __builtin_bit_cast(bf16x8, w);
}
DEV bf16x8 ldv_frag(const bf16_t* rowp  , int q4) {
    const u32x2 a = *(const u32x2*)(rowp + 4 * q4), b = *(const u32x2*)(rowp + 16 + 4 * q4);
    u32x4 w; w.x = a.x; w.y = a.y; w.z = b.x; w.w = b.y; return __builtin_bit_cast(bf16x8, w);
}
constexpr int RO_K = 0, RO_V = 128 * 144, RO_S = RO_V + 64 * 272, RO_END = RO_S + 2 * 64 * 144;
DEV void stage_ret_out(const P& p, int l, int bid, int nb, unsigned char* lds_, int wvx) {
    const int tid_ = TID, lane = tid_ & 63, wave = tid_ >> 6, r16 = lane & 15, q4 = lane >> 4;
    LAS unsigned char* lds = (LAS unsigned char*)lds_;
    const bf16_t* proj = (const bf16_t*)(p.ws + OFF_PROJ); const bf16_t* projT = (const bf16_t*)(p.ws + OFF_PROJT);
    const bf16_t* sprev = (const bf16_t*)(p.ws + OFF_SPREV); bf16_t* mix = (bf16_t*)(p.ws + OFF_MIX);
    const int nunits = (l == 0 ? 260 : 256) * 4;
    u32x4 pre[6];
#define RO_LOAD(unit_) do { const int cidx_ = (unit_) >> 2, h_ = (unit_) & 3, row0_ = cidx_ * 128; int b_, nf_, nbk_; chunk_chain(cidx_, b_, nf_, nbk_); \
        _Pragma("unroll") for (int i_ = 0; i_ < 2; ++i_) { const int pc = tid_ + 512 * i_; \
            pre[i_] = *(const u32x4*)(proj + (size_t)(row0_ + (pc >> 3)) * NIN + C_RK + h_ * 64 + (pc & 7) * 8); \
            pre[2 + i_] = *(const u32x4*)(projT + (size_t)(T_RV + h_ * 64 + (pc >> 4)) * TA + row0_ + (pc & 15) * 8); \
            const int dir_ = pc >> 9, pp = pc & 511; \
            pre[4 + i_] = *(const u32x4*)(sprev + ((size_t)(((b_ * 4 + h_) * 2 + dir_) * 130 + (dir_ ? nbk_ : nf_))) * 4096 + (pp >> 3) * 64 + (pp & 7) * 8); } } while (0)
#define RO_WRITE() do { _Pragma("unroll") for (int i_ = 0; i_ < 2; ++i_) { const int pc = tid_ + 512 * i_; \
            *(LAS u32x4*)(lds + RO_K + (pc >> 3) * 144 + (pc & 7) * 16) = pre[i_]; \
            *(LAS u32x4*)(lds + RO_V + (pc >> 4) * 272 + (pc & 15) * 16) = pre[2 + i_]; \
            const int dir_ = pc >> 9, pp = pc & 511; \
            *(LAS u32x4*)(lds + RO_S + dir_ * 64 * 144 + (pp >> 3) * 144 + (pp & 7) * 16) = pre[4 + i_]; } } while (0)
    for (int unit = bid; unit < nunits; unit += nb) {
        RO_LOAD(unit);
        __syncthreads();
        RO_WRITE();
        __syncthreads();
        const int cidx = unit >> 2, h = unit & 3, row0 = cidx * 128;
        const int irow = row0 + 16 * wave + r16, ii = 16 * wave + r16;
        const float lgf = log_g(p, l, 0, h), lgb = log_g(p, l, 1, h);
        bf16x8 qf[2];
#pragma unroll
        for (int ks = 0; ks < 2; ++ks) qf[ks] = *(const bf16x8*)(proj + (size_t)irow * NIN + C_RQ + h * 64 + 32 * ks + 8 * q4);
        f32x4 st[8];
#pragma unroll
        for (int mt = 0; mt < 8; ++mt) {
            st[mt] = (f32x4){0.f, 0.f, 0.f, 0.f};
#pragma unroll
            for (int ks = 0; ks < 2; ++ks) {
                const bf16x8 kf = *(const LAS bf16x8*)(lds + RO_K + (16 * mt + r16) * 144 + ks * 64 + q4 * 16);
                st[mt] = __builtin_amdgcn_mfma_f32_16x16x32_bf16(kf, qf[ks], st[mt], 0, 0, 0);
            }
        }
        float outv[4][4];
#pragma unroll
        for (int mt = 0; mt < 4; ++mt)
#pragma unroll
            for (int jj = 0; jj < 4; ++jj) outv[mt][jj] = 0.f;
#pragma nounroll
        for (int dir = 0; dir < 2; ++dir) {
            const float lg = dir ? lgb : lgf;
            f32x4 y[4];
#pragma unroll
            for (int mt = 0; mt < 4; ++mt) {
                y[mt] = (f32x4){0.f, 0.f, 0.f, 0.f};
#pragma unroll
                for (int ks = 0; ks < 2; ++ks) {
                    const bf16x8 sf = *(const LAS bf16x8*)(lds + RO_S + dir * 64 * 144 + (16 * mt + r16) * 144 + ks * 64 + q4 * 16);
                    y[mt] = __builtin_amdgcn_mfma_f32_16x16x32_bf16(sf, qf[ks], y[mt], 0, 0, 0);
                }
            }
            const float cs = __expf(lg * (float)(dir ? 128 - ii : ii + 1));
#pragma unroll
            for (int mt = 0; mt < 4; ++mt) y[mt] = y[mt] * cs;
#pragma unroll
            for (int s = 0; s < 4; ++s) {
                f32x4 pa, pb;
#pragma unroll
                for (int jj = 0; jj < 4; ++jj) {
                    const int ja = 32 * s + 4 * q4 + jj, jb = ja + 16;
                    const int da = dir ? ja - ii : ii - ja, db = dir ? jb - ii : ii - jb;
                    pa[jj] = da >= 0 ? st[2 * s][jj] * __expf(lg * (float)da) : 0.f;
                    pb[jj] = db >= 0 ? st[2 * s + 1][jj] * __expf(lg * (float)db) : 0.f;
                }
                const bf16x8 pf = pack_b(pa, pb);
#pragma unroll
                for (int mt = 0; mt < 4; ++mt) {
                    const LAS unsigned char* vp = lds + RO_V + (16 * mt + r16) * 272 + (32 * s + 4 * q4) * 2;
                    const u32x2 va = *(const LAS u32x2*)vp, vb = *(const LAS u32x2*)(vp + 32);
                    u32x4 vw; vw.x = va.x; vw.y = va.y; vw.z = vb.x; vw.w = vb.y;
                    y[mt] = __builtin_amdgcn_mfma_f32_16x16x32_bf16(__builtin_bit_cast(bf16x8, vw), pf, y[mt], 0, 0, 0);
                }
            }
            float sm = 0.f;
#pragma unroll
            for (int mt = 0; mt < 4; ++mt) sm += (y[mt][0] + y[mt][1]) + (y[mt][2] + y[mt][3]);
            sm += __shfl_xor(sm, 16); sm += __shfl_xor(sm, 32);
            const float mu = sm * (1.f / 64.f); float qv = 0.f;
#pragma unroll
            for (int mt = 0; mt < 4; ++mt) { const f32x4 dd = y[mt] - mu; qv += (dd[0] * dd[0] + dd[1] * dd[1]) + (dd[2] * dd[2] + dd[3] * dd[3]); }
            qv += __shfl_xor(qv, 16); qv += __shfl_xor(qv, 32);
            const float rs = rsqrtf(qv * (1.f / 64.f) + 1e-5f);
#pragma unroll
            for (int mt = 0; mt < 4; ++mt) {
                const f32x4 g = ld_bf16x4(proj + (size_t)irow * NIN + (dir ? C_RGB : C_RGF) + h * 64 + 16 * mt + 4 * q4);
#pragma unroll
                for (int jj = 0; jj < 4; ++jj) outv[mt][jj] += (y[mt][jj] - mu) * rs * g[jj];
            }
        }
#pragma unroll
        for (int mt = 0; mt < 4; ++mt) { u32x2 w; w.x = pk2(outv[mt][0], outv[mt][1]); w.y = pk2(outv[mt][2], outv[mt][3]);
            *(u32x2*)(mix + (size_t)irow * D + MX_RET + h * 64 + 16 * mt + 4 * q4) = w; }
    }
    __syncthreads();
#undef RO_LOAD
#undef RO_WRITE
}

#ifndef ATT_THR
#define ATT_THR 11.5f
#endif
constexpr int AT_K = 0, AT_V = 128 * 144, AT_VS = 160, AT_END = AT_V + 128 * AT_VS;
DEV void stage_attn_fast(const P& p, int l, int bid, int nb, unsigned char* lds_, int wvx) {
    const int tid_ = TID, lane = tid_ & 63, wave = tid_ >> 6, r16 = lane & 15, q4 = lane >> 4;
    LAS unsigned char* lds = (LAS unsigned char*)lds_;
    const bf16_t* proj = (const bf16_t*)(p.ws + OFF_PROJ); const bf16_t* projT = (const bf16_t*)(p.ws + OFF_PROJT); bf16_t* mix = (bf16_t*)(p.ws + OFF_MIX);
    constexpr int BIG = 1 << 20;
    constexpr int NQT = 4;
    for (int it = bid; it < (l == 0 ? 520 : 512); it += nb) {
        const int grp = it, g = wave >> 1, hq = wave & 1;
        int hk, qrow0, cbase, nblk = -1, lbase = 0;
        if (grp < 512) { const int b = grp >> 8; nblk = (grp >> 1) & 127; hk = grp & 1; lbase = b * L; qrow0 = lbase + nblk * 128 + 64 * hq; cbase = TL + b * LC; }
        else { const int gg = grp - 512, cb = gg >> 2, qb = (gg >> 1) & 1; hk = gg & 1; qrow0 = TL + cb * LC + qb * 128 + 64 * hq; cbase = TL + cb * LC; }
        const int h = hk * 4 + g;
        bf16x8 qf[NQT][2];
#pragma unroll
        for (int nt = 0; nt < NQT; ++nt)
#pragma unroll
            for (int ks = 0; ks < 2; ++ks) qf[nt][ks] = *(const bf16x8*)(proj + (size_t)(qrow0 + 16 * nt + r16) * NIN + C_Q + h * 64 + 32 * ks + 8 * q4);
        const float sink = p.sinks[l * 8 + h] * LOG2E;
        float mrun[NQT], lrun[NQT];
#pragma unroll
        for (int nt = 0; nt < NQT; ++nt) { mrun[nt] = sink; lrun[nt] = (q4 == 0) ? 1.f : 0.f; }
        f32x4 o[4][NQT];
#pragma unroll
        for (int mt = 0; mt < 4; ++mt)
#pragma unroll
            for (int nt = 0; nt < NQT; ++nt) o[mt][nt] = (f32x4){0.f, 0.f, 0.f, 0.f};
        u32x4 pre[4];
#define AT_CHUNK_OK(c) ((c) == 0 ? nblk >= 1 : (c) == 1 ? nblk >= 0 : (c) == 2 ? (nblk >= 0 && nblk < 127) : true)
#define AT_CHUNK_ROW(c) ((c) < 3 ? lbase + (nblk - 1 + (c)) * 128 : cbase + ((c) - 3) * 128)
#define AT_LOAD(c) do { const int kr_ = AT_CHUNK_ROW(c); _Pragma("unroll") for (int i_ = 0; i_ < 2; ++i_) { const int pc = tid_ + 512 * i_; \
            pre[i_] = *(const u32x4*)(proj + (size_t)(kr_ + (pc >> 3)) * NIN + C_K + hk * 64 + (pc & 7) * 8); \
            pre[2 + i_] = *(const u32x4*)(proj + (size_t)(kr_ + (pc >> 3)) * NIN + C_V + hk * 64 + (pc & 7) * 8); } } while (0)
#define AT_WRITE() do { _Pragma("unroll") for (int i_ = 0; i_ < 2; ++i_) { const int pc = tid_ + 512 * i_; \
            *(LAS u32x4*)(lds + AT_K + (pc >> 3) * 144 + (pc & 7) * 16) = pre[i_]; \
            *(LAS u32x4*)(lds + AT_V + (pc >> 3) * AT_VS + (pc & 7) * 16) = pre[2 + i_]; } } while (0)
        int c = 0; while (c < 5 && !AT_CHUNK_OK(c)) ++c;
        if (c < 5) AT_LOAD(c);
        while (c < 5) {
            int cn = c + 1; while (cn < 5 && !AT_CHUNK_OK(cn)) ++cn;
            __syncthreads();
            AT_WRITE();
            __syncthreads();
            if (cn < 5) AT_LOAD(cn);
            const int clo = c == 0 ? 0 : -BIG, chi = c == 2 ? 0 : BIG;
            const int sb0 = c == 0 ? 2 * hq : 0, sb1 = c == 2 ? 2 * hq + 1 : 3;
            for (int sb = sb0; sb <= sb1; ++sb) {
                const int dl0 = 32 * sb - 64 * hq;
                f32x4 sa[2][NQT];
#pragma unroll
                for (int mt = 0; mt < 2; ++mt) {
                    bf16x8 kf[2];
#pragma unroll
                    for (int ks = 0; ks < 2; ++ks) kf[ks] = *(const LAS bf16x8*)(lds + AT_K + (32 * sb + 16 * mt + r16) * 144 + ks * 64 + q4 * 16);
#pragma unroll
                    for (int nt = 0; nt < NQT; ++nt) {
                        sa[mt][nt] = (f32x4){0.f, 0.f, 0.f, 0.f};
#pragma unroll
                        for (int ks = 0; ks < 2; ++ks) sa[mt][nt] = __builtin_amdgcn_mfma_f32_16x16x32_bf16(kf[ks], qf[nt][ks], sa[mt][nt], 0, 0, 0);
                    }
                }
                bf16x8 pf[NQT];
                float lmax[NQT];
                if (c == 0 || c == 2) {
#pragma unroll
                    for (int nt = 0; nt < NQT; ++nt) {
                        float bm = -1e30f;
#pragma unroll
                        for (int mt = 0; mt < 2; ++mt)
#pragma unroll
                            for (int jj = 0; jj < 4; ++jj) {
                                const int dl = dl0 + 16 * mt + 4 * q4 + jj - (16 * nt + r16);
                                const float sv = (dl >= clo && dl <= chi) ? sa[mt][nt][jj] : -1e30f;
                                sa[mt][nt][jj] = sv; bm = fmaxf(bm, sv);
                            }
                        lmax[nt] = bm;
                    }
                } else {
#pragma unroll
                    for (int nt = 0; nt < NQT; ++nt)
                        lmax[nt] = fmaxf(fmaxf(fmaxf(sa[0][nt][0], sa[0][nt][1]), fmaxf(sa[0][nt][2], sa[0][nt][3])), fmaxf(fmaxf(sa[1][nt][0], sa[1][nt][1]), fmaxf(sa[1][nt][2], sa[1][nt][3])));
                }
                bool need = false;
#pragma unroll
                for (int nt = 0; nt < NQT; ++nt) need = need || (lmax[nt] > mrun[nt] + ATT_THR);
                if (__any(need)) {
#pragma unroll
                    for (int nt = 0; nt < NQT; ++nt) {
                        float bm = lmax[nt];
                        bm = fmaxf(bm, __shfl_xor(bm, 16)); bm = fmaxf(bm, __shfl_xor(bm, 32));
                        const float mn = fmaxf(mrun[nt], bm), sc = __builtin_amdgcn_exp2f(mrun[nt] - mn);
                        mrun[nt] = mn; lrun[nt] *= sc;
#pragma unroll
                        for (int mt = 0; mt < 4; ++mt) o[mt][nt] = o[mt][nt] * sc;
                    }
                }
#pragma unroll
                for (int nt = 0; nt < NQT; ++nt) {
                    float ps = 0.f;
#pragma unroll
                    for (int mt = 0; mt < 2; ++mt)
#pragma unroll
                        for (int jj = 0; jj < 4; ++jj) { const float pe = __builtin_amdgcn_exp2f(sa[mt][nt][jj] - mrun[nt]); sa[mt][nt][jj] = pe; ps += pe; }
                    lrun[nt] += ps;
                    pf[nt] = pack_b(sa[0][nt], sa[1][nt]);
                }
#pragma unroll
                for (int mt = 0; mt < 4; ++mt) {
                    const LAS unsigned char* vp = lds + AT_V + (32 * sb + 4 * q4 + (r16 >> 2)) * AT_VS + (16 * mt + 4 * (r16 & 3)) * 2;
                    const u32x2 va = lds_tr16(vp), vb = lds_tr16(vp + 16 * AT_VS);
                    u32x4 vw; vw.x = va.x; vw.y = va.y; vw.z = vb.x; vw.w = vb.y;
                    const bf16x8 vf = __builtin_bit_cast(bf16x8, vw);
#pragma unroll
                    for (int nt = 0; nt < NQT; ++nt) o[mt][nt] = __builtin_amdgcn_mfma_f32_16x16x32_bf16(vf, pf[nt], o[mt][nt], 0, 0, 0);
                }
            }
            c = cn;
        }
#undef AT_CHUNK_OK
#undef AT_CHUNK_ROW
#undef AT_LOAD
#undef AT_WRITE
#pragma unroll
        for (int nt = 0; nt < NQT; ++nt) {
            float lt = lrun[nt]; lt += __shfl_xor(lt, 16); lt += __shfl_xor(lt, 32);
            const float inv = 1.f / lt;
#pragma unroll
            for (int mt = 0; mt < 4; ++mt) { const f32x4 v = o[mt][nt] * inv; u32x2 w; w.x = pk2(v[0], v[1]); w.y = pk2(v[2], v[3]);
                *(u32x2*)(mix + (size_t)(qrow0 + 16 * nt + r16) * D + MX_ATTN + h * 64 + 16 * mt + 4 * q4) = w; }
        }
    }
    __syncthreads();
}

#define XB_TMO      128
#define XB_XCNT(j)  (256  + 64 * (j))
#define XB_XSUB(j)  (1280 + 64 * (j))
#define XB_XGEN(j)  (2304 + 64 * (j))
#define XB_TOP      3328
#define XB_TOPGEN   3392
#define XCD_BAR_WORDS 3456
#define XB_SPIN_CAP (1u << 18)
__device__ __forceinline__ unsigned xb_ld(unsigned* p)              { return __hip_atomic_load(p, __ATOMIC_RELAXED, __HIP_MEMORY_SCOPE_AGENT); }
__device__ __forceinline__ unsigned xb_add(unsigned* p, unsigned v) { return __hip_atomic_fetch_add(p, v, __ATOMIC_RELAXED, __HIP_MEMORY_SCOPE_AGENT); }
__device__ __forceinline__ unsigned xb_xcc_id() { return (unsigned)__builtin_amdgcn_s_getreg((3 << 11) | 20) & 0xFu; }
#define XB_SPIN(cond, bar) do { unsigned _sp = 0; while (cond) { __builtin_amdgcn_s_sleep(1); \
    if ((++_sp & 255u) == 0u) { if (xb_ld(&(bar)[XB_TMO])) break; if (_sp > XB_SPIN_CAP) { atomicAdd(&(bar)[XB_TMO], 1u); break; } } } } while (0)
struct XcdBarrier { unsigned* bar; unsigned x; volatile LAS unsigned* st; };
__device__ __forceinline__ XcdBarrier xcd_barrier_post(unsigned* bar, volatile LAS unsigned* st, const int wvx) {
    XcdBarrier b; b.bar = bar; b.x = xb_xcc_id(); b.st = st;
    if (TID == 0) (void)xb_add(&bar[XB_XCNT(b.x)], 1u);
    return b;
}
__device__ __forceinline__ void xcd_barrier_complete(unsigned* bar, unsigned x, unsigned& nloc, unsigned& nx) {
    const unsigned G = gridDim.x * gridDim.y * gridDim.z;
    unsigned sum, cnt, mine, sp = 0u;
    for (;;) {
        sum = 0u; cnt = 0u; mine = 0u;
#pragma unroll
        for (unsigned j = 0; j < 16; ++j) { const unsigned c = xb_ld(&bar[XB_XCNT(j)]); sum += c; cnt += (c > 0u) ? 1u : 0u; mine = (j == x) ? c : mine; }
        if (sum == G) break;
        __builtin_amdgcn_s_sleep(1);
        if ((++sp & 255u) == 0u) { if (xb_ld(&bar[XB_TMO])) break; if (sp > XB_SPIN_CAP) { atomicAdd(&bar[XB_TMO], 1u); break; } }
    }
    nloc = mine > 0u ? mine : 1u; nx = cnt > 0u ? cnt : 1u;
}
__device__ __forceinline__ void xcd_barrier(const XcdBarrier& b, const int wvx) {
    asm volatile("s_waitcnt vmcnt(0)" ::: "memory");
    __syncthreads();
    if (TID == 0) {
        unsigned* bar = b.bar;
        __builtin_amdgcn_s_waitcnt(0);
        unsigned nloc = b.st[0], nx = b.st[1];
        if (nloc == 0u) { xcd_barrier_complete(bar, b.x, nloc, nx); b.st[0] = nloc; b.st[1] = nx; }
        const unsigned old = xb_add(&bar[XB_XSUB(b.x)], 1u);
        const unsigned gen = old / nloc;
        if (old + 1u == (gen + 1u) * nloc) {
            __builtin_amdgcn_fence(__ATOMIC_RELEASE, "agent");
            asm volatile("s_waitcnt vmcnt(0)" ::: "memory");
            const unsigned og = xb_add(&bar[XB_TOP], 1u);
            const unsigned tg = og / nx;
            if (og + 1u == (tg + 1u) * nx) xb_add(&bar[XB_TOPGEN], 1u);
            else XB_SPIN(xb_ld(&bar[XB_TOPGEN]) == tg, bar);
            __builtin_amdgcn_fence(__ATOMIC_ACQUIRE, "agent");
            xb_add(&bar[XB_XGEN(b.x)], 1u);
            asm volatile("s_waitcnt vmcnt(0)" ::: "memory");
        } else {
            XB_SPIN(xb_ld(&bar[XB_XGEN(b.x)]) == gen, bar);
            __builtin_amdgcn_fence(__ATOMIC_ACQUIRE, "agent");
            asm volatile("s_waitcnt vmcnt(0)" ::: "memory");
        }
    }
    __syncthreads();
}

constexpr int NPL = 10;
constexpr int NPHASES = 2 + 2 * NPL;
constexpr int CW_BAR = 4096;
constexpr int LDS_BARW = LDS_BYTES - 16;
__global__ void __launch_bounds__(NTHREADS, 2) mk_fwd(P p) {
    extern __shared__ __attribute__((aligned(16))) unsigned char lds[];
    const int bid = blockIdx.x, nb = gridDim.x;
    const int wvx = __builtin_amdgcn_readfirstlane((int)(threadIdx.x >> 6));
    if (TID == 0) { ((volatile LAS unsigned*)(lds + LDS_BARW))[0] = 0u; ((volatile LAS unsigned*)(lds + LDS_BARW))[1] = 0u; }
    __syncthreads();
    const bool multi = (p.ph_hi - p.ph_lo) > 1;
    XcdBarrier bar; bar.bar = (unsigned*)(p.ws + OFF_CTL) + CW_BAR; bar.x = 0; bar.st = (volatile LAS unsigned*)(lds + LDS_BARW);
    if (multi) bar = xcd_barrier_post((unsigned*)(p.ws + OFF_CTL) + CW_BAR, (volatile LAS unsigned*)(lds + LDS_BARW), wvx);
#define IN(k) (p.ph_lo <= (k) && (k) < p.ph_hi)
#define STAGE(call) do { const P& q = p; const int ll = l; call; } while (0)
#define SEAM(k) do { if (IN(k) && IN((k) + 1)) xcd_barrier(bar, wvx); } while (0)
#ifndef PHMASK
#define PHMASK 0xFFFF
#endif
#define PHON(b) ((PHMASK >> (b)) & 1)
#ifndef DUPMASK
#define DUPMASK 0
#endif
#define DUPN(b) (1 + ((DUPMASK >> (b)) & 1))
    if (PHON(0) && IN(0)) { const int l = 0; for (int r_ = 0; r_ < DUPN(0); ++r_) { STAGE(stage_prep(q, bid, nb, lds, wvx)); __syncthreads(); } } SEAM(0);
    if (PHON(1) && IN(1)) { const int l = 0; STAGE(stage_norm0(q, bid, nb, wvx)); } SEAM(1);
    { constexpr int l = 0; const int pb = 2 + l * NPL;
        if (PHON(2) && IN(pb + 0)) { for (int r_ = 0; r_ < DUPN(2); ++r_) { STAGE(stage_inproj_fast(q, ll, bid, nb, lds, wvx)); __syncthreads(); } } SEAM(pb + 0);
        if (PHON(3) && IN(pb + 1)) { for (int r_ = 0; r_ < DUPN(3); ++r_) { if (l == 0) { if (bid >= 8) STAGE(stage_ret_kv(q, ll, bid - 8, nb - 8, wvx)); } else STAGE(stage_ret_kv(q, ll, bid, nb, wvx));     STAGE(stage_attn_fast(q, ll, bid, nb, lds, wvx)); __syncthreads(); } } SEAM(pb + 1);
        if (PHON(4) && IN(pb + 2)) { for (int r_ = 0; r_ < DUPN(4); ++r_) { if (bid < 64) STAGE(stage_ret_scan(q, ll, bid, 64, wvx)); else STAGE(stage_pool_diff(q, ll, bid - 64, nb - 64, wvx));     __syncthreads(); } } SEAM(pb + 2);
        if (PHON(5) && IN(pb + 3)) { for (int r_ = 0; r_ < DUPN(5); ++r_) { STAGE(stage_ret_out(q, ll, bid, nb, lds, wvx)); __syncthreads(); } } SEAM(pb + 3);
        if (PHON(6) && IN(pb + 4)) { for (int r_ = 0; r_ < DUPN(6); ++r_) { STAGE(stage_merge_fast(q, ll, bid, nb, lds, wvx)); if (l == 0) STAGE(stage_merge_ctx(q, ll, bid, nb, wvx)); __syncthreads(); } } SEAM(pb + 4);
        if (PHON(7) && IN(pb + 5)) { STAGE(stage_out_fast(q, ll, bid, nb, lds, wvx)); if (l == 0) STAGE(stage_out_ctx(q, ll, bid, nb, wvx)); } SEAM(pb + 5);
        if (PHON(8) && IN(pb + 6)) { if (INP_FP8 != 2 || NCONV_ == 0) { STAGE(stage_prep_experts(q, ll, bid, nb, lds, wvx)); __syncthreads(); } if (ROUTE_MFMA) STAGE(stage_route_mfma(q, ll, bid, nb, lds, wvx)); else STAGE(stage_route(q, ll, bid, nb, lds, wvx)); } SEAM(pb + 6);
        if (PHON(9) && IN(pb + 7)) { for (int r_ = 0; r_ < DUPN(9); ++r_) { STAGE(stage_moe1_fast(q, ll, bid, nb, lds, wvx)); __syncthreads(); } } SEAM(pb + 7);
        if (PHON(10) && IN(pb + 8)) { for (int r_ = 0; r_ < DUPN(10); ++r_) { STAGE(stage_moe2_fast(q, ll, bid, nb, lds, wvx)); __syncthreads(); } } SEAM(pb + 8);
        if (PHON(11) && IN(pb + 9)) { STAGE(stage_combine(q, ll, bid, nb, lds, wvx)); } SEAM(pb + 9);
     }
    { constexpr int l = 1; const int pb = 2 + l * NPL;
        if (PHON(2) && IN(pb + 0)) { for (int r_ = 0; r_ < DUPN(2); ++r_) { STAGE(stage_inproj_fast(q, ll, bid, nb, lds, wvx)); __syncthreads(); } } SEAM(pb + 0);
        if (PHON(3) && IN(pb + 1)) { for (int r_ = 0; r_ < DUPN(3); ++r_) { if (l == 0) { if (bid >= 8) STAGE(stage_ret_kv(q, ll, bid - 8, nb - 8, wvx)); } else STAGE(stage_ret_kv(q, ll, bid, nb, wvx));     STAGE(stage_attn_fast(q, ll, bid, nb, lds, wvx)); __syncthreads(); } } SEAM(pb + 1);
        if (PHON(4) && IN(pb + 2)) { for (int r_ = 0; r_ < DUPN(4); ++r_) { if (bid < 64) STAGE(stage_ret_scan(q, ll, bid, 64, wvx)); else STAGE(stage_pool_diff(q, ll, bid - 64, nb - 64, wvx));     __syncthreads(); } } SEAM(pb + 2);
        if (PHON(5) && IN(pb + 3)) { for (int r_ = 0; r_ < DUPN(5); ++r_) { STAGE(stage_ret_out(q, ll, bid, nb, lds, wvx)); __syncthreads(); } } SEAM(pb + 3);
        if (PHON(6) && IN(pb + 4)) { for (int r_ = 0; r_ < DUPN(6); ++r_) { STAGE(stage_merge_fast(q, ll, bid, nb, lds, wvx)); if (l == 0) STAGE(stage_merge_ctx(q, ll, bid, nb, wvx)); __syncthreads(); } } SEAM(pb + 4);
        if (PHON(7) && IN(pb + 5)) { STAGE(stage_out_fast(q, ll, bid, nb, lds, wvx)); if (l == 0) STAGE(stage_out_ctx(q, ll, bid, nb, wvx)); } SEAM(pb + 5);
        if (PHON(8) && IN(pb + 6)) { if (INP_FP8 != 2 || NCONV_ == 0) { STAGE(stage_prep_experts(q, ll, bid, nb, lds, wvx)); __syncthreads(); } if (ROUTE_MFMA) STAGE(stage_route_mfma(q, ll, bid, nb, lds, wvx)); else STAGE(stage_route(q, ll, bid, nb, lds, wvx)); } SEAM(pb + 6);
        if (PHON(9) && IN(pb + 7)) { for (int r_ = 0; r_ < DUPN(9); ++r_) { STAGE(stage_moe1_fast(q, ll, bid, nb, lds, wvx)); __syncthreads(); } } SEAM(pb + 7);
        if (PHON(10) && IN(pb + 8)) { for (int r_ = 0; r_ < DUPN(10); ++r_) { STAGE(stage_moe2_fast(q, ll, bid, nb, lds, wvx)); __syncthreads(); } } SEAM(pb + 8);
        if (PHON(11) && IN(pb + 9)) { STAGE(stage_combine(q, ll, bid, nb, lds, wvx)); } SEAM(pb + 9);
     }
#undef IN
#undef SEAM
}

#ifndef MK_CUTS
#define MK_CUTS 1
#endif
extern "C" void kernel_launch(void* const* d_in, const int* in_sizes, int n_in, void* d_out, int out_size, void* d_ws, size_t ws_size, hipStream_t stream) {
    static int grid = 0;
    if (grid == 0) {
        if (n_in != 24 || out_size != TL * D || ws_size < WS_END) { fprintf(stderr, "kernel_launch: unexpected shapes: n_in %d out %d ws %zu (need %zu)\n", n_in, out_size, ws_size, (size_t)WS_END); grid = -1; return; }
        int dev = 0, cus = 0, per_cu = 0;
        if (hipGetDevice(&dev) != hipSuccess || hipDeviceGetAttribute(&cus, hipDeviceAttributeMultiprocessorCount, dev) != hipSuccess) { grid = -1; return; }
        if (hipFuncSetAttribute((const void*)mk_fwd, hipFuncAttributeMaxDynamicSharedMemorySize, LDS_BYTES) != hipSuccess) { fprintf(stderr, "kernel_launch: hipFuncSetAttribute failed\n"); grid = -1; return; }
        if (hipOccupancyMaxActiveBlocksPerMultiprocessor(&per_cu, (const void*)mk_fwd, NTHREADS, LDS_BYTES) != hipSuccess || per_cu < 1) { fprintf(stderr, "kernel_launch: occupancy query says %d blocks per CU\n", per_cu); (void)hipGetLastError(); }
        grid = cus > 0 ? cus : 256;
    }
    if (grid < 0) return;
    (void)hipMemsetAsync((char*)d_ws + OFF_CTL, 0, CTL_BYTES, stream);
    P p; memset(&p, 0, sizeof(p));
    const float** f = (const float**)&p;
    for (int i = 0; i < 24; ++i) f[i] = (const float*)d_in[i];
    p.out = (float*)d_out; p.ws = (unsigned char*)d_ws;
    for (int i = 0; i < 32; ++i) p.inv_ret[i] = 1.0 / pow(10000.0, (double)((float)i / 31.0f));
    for (int i = 0; i < 16; ++i) p.inv_ax[i] = pow(10000.0, -(double)(2 * i) / 32.0);
#if MK_CUTS
    p.ph_lo = 0; p.ph_hi = NPHASES;
    hipLaunchKernelGGL(mk_fwd, dim3(grid), dim3(NTHREADS), LDS_BYTES, stream, p);
#else
    for (int ph = 0; ph < NPHASES; ++ph) { p.ph_lo = ph; p.ph_hi = ph + 1; hipLaunchKernelGGL(mk_fwd, dim3(grid), dim3(NTHREADS), LDS_BYTES, stream, p); }
#endif
}
```

```cpp
#include <hip/hip_runtime.h>
#include <stdint.h>
#include <stdio.h>
#include <string.h>
#include <math.h>
#include <type_traits>

#define DEV __device__ __forceinline__
#define LAS __attribute__((address_space(3)))
typedef unsigned short bf16_t;
typedef short bf16x8 __attribute__((ext_vector_type(8)));
typedef float f32x4 __attribute__((ext_vector_type(4)));
typedef float f32x2 __attribute__((ext_vector_type(2)));
typedef unsigned u32x4 __attribute__((ext_vector_type(4)));
typedef unsigned u32x2 __attribute__((ext_vector_type(2)));

constexpr int D = 1024, NBATCH = 2, L = 16384, LC = 256, TL = NBATCH * L, TC = NBATCH * LC, TA = TL + TC;
constexpr int NIN = 5376, NEXP = 32, CAP = TA, PMAX = 141312;
constexpr int C_Q = 0, C_K = 512, C_V = 640, C_U = 768, C_RQ = 1024, C_RK = 1280, C_RV = 1536, C_RGF = 1792, C_RGB = 2048, C_GA = 2304;
constexpr int T_V = 0, T_RV = 256, T_RKF = 512, T_RKB = 768, TROWS = 1024;
constexpr int MX_ATTN = 0, MX_POOL = 512, MX_RET = 768;
constexpr int NTHREADS = 512, NWAVES = 8;

constexpr size_t MiB = 1u << 20;
constexpr size_t OFF_CTL = 0, CTL_BYTES = 1 * MiB;
constexpr size_t OFF_MOD = 1 * MiB;
constexpr size_t OFF_TABR = 2 * MiB;
constexpr size_t OFF_TABA = 6 * MiB;
constexpr size_t OFF_TABW = 6 * MiB + 512 * 1024;
constexpr size_t OFF_WTIN = 7 * MiB;
constexpr size_t OFF_WTT = 28 * MiB;
constexpr size_t OFF_WTM = 31 * MiB;
constexpr size_t OFF_WTO = 35 * MiB;
constexpr size_t OFF_WT1 = 40 * MiB;
constexpr size_t OFF_WT2 = 296 * MiB;
constexpr size_t OFF_HBF = 424 * MiB;
constexpr size_t OFF_XR = 489 * MiB;
constexpr size_t OFF_TK = 1840 * MiB;
constexpr size_t OFF_PROJ = 627 * MiB;
constexpr size_t OFF_PROJT = 969 * MiB;
constexpr size_t OFF_MIX = 1034 * MiB;
constexpr size_t OFF_M = 1099 * MiB;
constexpr size_t OFF_HQ = 1164 * MiB;
constexpr size_t OFF_WTOQ = 1212 * MiB;
constexpr size_t OFF_ROWSQ = 1216 * MiB;
constexpr size_t OFF_WTINQ = 1204 * MiB;
constexpr size_t OFF_KV = 1229 * MiB;
constexpr size_t OFF_TABRT = 1272 * MiB;
constexpr size_t OFF_ACT = 1280 * MiB;
constexpr size_t OFF_YB = 1556 * MiB;
constexpr size_t WS_END = 1856 * MiB;
constexpr size_t TK_LAYER = 8 * MiB;
constexpr int CW_CNT = 65536;
constexpr int CW_DYN = 66560;

constexpr int LDS_BYTES = 147456;
constexpr float LOG2E = 1.4426950408889634f;
#ifndef MOE_FP8
#define MOE_FP8 2
#endif
#ifndef INP_FP8
#define INP_FP8 2
#endif
#ifndef OUT_FP8
#define OUT_FP8 0
#endif
constexpr float QW = 32.f, QA = 4.f, QM = 8.f;

struct P {
    const float *x, *c, *ctx, *c_ctx, *w_mod, *b_mod, *norm1, *norm2, *w_in, *sinks, *pool_w, *pool_scale, *ret_decay, *w_o_attn, *w_o_pool, *w_o_ret,
        *w_out, *w_router, *b_router, *w1, *b1, *w2, *b2, *final_norm;
    float* out;
    unsigned char* ws;
    double inv_ret[32];
    double inv_ax[16];
    int ph_lo, ph_hi;
};

DEV float bf2f(bf16_t b) { return __uint_as_float(((unsigned)b) << 16); }
typedef __bf16 bf16x2_t __attribute__((ext_vector_type(2)));
DEV unsigned pk2(float lo, float hi) { f32x2 v = {lo, hi}; bf16x2_t b = __builtin_convertvector(v, bf16x2_t); return __builtin_bit_cast(unsigned, b); }
DEV bf16_t f2bf(float f) { return (bf16_t)(pk2(f, 0.f) & 0xffffu); }
DEV unsigned pk4q(float a, float b, float c, float d) { int w = 0; w = __builtin_amdgcn_cvt_pk_fp8_f32(a, b, w, false); w = __builtin_amdgcn_cvt_pk_fp8_f32(c, d, w, true); return (unsigned)w; }
DEV float sigmoidf_(float x) { return __builtin_amdgcn_rcpf(1.f + __expf(-x)); }
DEV float siluf_(float x) { return x * __builtin_amdgcn_rcpf(1.f + __expf(-x)); }
DEV float rdl(float v, int l) { return __uint_as_float((unsigned)__builtin_amdgcn_readlane((int)__float_as_uint(v), l)); }
DEV int lane_id() { int r; asm volatile("v_mbcnt_lo_u32_b32 %0, -1, 0\n\tv_mbcnt_hi_u32_b32 %0, -1, %0" : "=v"(r)); return r; }
#define TID (wvx * 64 + lane_id())
DEV float wave_sum(float v) {
#pragma unroll
    for (int o = 1; o < 64; o <<= 1) v += __shfl_xor(v, o);
    return v;
}
DEV int row_mod(int r) { return r < TL ? (r >= L ? 1 : 0) : 2; }
DEV const float* in_row(const P& p, int r) { return r < TL ? p.x + (size_t)r * D : p.ctx + (size_t)(r - TL) * D; }
DEV const float* modp(const P& p, int l, int s, int part) { return (const float*)(p.ws + OFF_MOD) + ((size_t)(l * 3 + s) * 6 + part) * D; }

template <class Dst>
DEV void transpose_item(const float* W, int N, int kb, int nb, float* scr  , int lane, Dst dst) {
    const int k0 = 64 * kb + 16 * (lane >> 4), n0 = 64 * nb + 4 * (lane & 15);
    f32x4 v[16];
#pragma unroll
    for (int i = 0; i < 16; ++i) v[i] = *(const f32x4*)(W + (size_t)(k0 + i) * N + n0);
#pragma unroll
    for (int j = 0; j < 4; ++j) {
        u32x4 o0, o1;
        o0.x = pk2(v[0][j], v[1][j]); o0.y = pk2(v[2][j], v[3][j]); o0.z = pk2(v[4][j], v[5][j]); o0.w = pk2(v[6][j], v[7][j]);
        o1.x = pk2(v[8][j], v[9][j]); o1.y = pk2(v[10][j], v[11][j]); o1.z = pk2(v[12][j], v[13][j]); o1.w = pk2(v[14][j], v[15][j]);
        bf16_t* d0 = dst(n0 + j, 0); if (d0) { *(u32x4*)(d0 + k0) = o0; *(u32x4*)(d0 + k0 + 8) = o1; }
        bf16_t* d1 = dst(n0 + j, 1); if (d1) { *(u32x4*)(d1 + k0) = o0; *(u32x4*)(d1 + k0 + 8) = o1; }
    }
}
DEV float log_g(const P& p, int l, int dir, int h) { const float x = p.ret_decay[(l * 2 + dir) * 4 + h]; return -log1pf(__expf(-x)); }
DEV int ret_phys(int d) { return ((d >> 4) & 1) * 32 + (d >> 5) * 16 + (d & 15); }

template <bool NT>
DEV void titem_load(const float* W, int N, int kb, int nb, int lane, f32x4 (&v)[16]) {
    const int k0 = 64 * kb, n0 = 64 * nb;
#pragma unroll
    for (int i = 0; i < 16; ++i) {
        const int kk = 16 * (lane >> 4) + i, c4 = (lane & 15) * 4;
        const f32x4* src = (const f32x4*)(W + (size_t)(k0 + kk) * N + n0 + c4);
        v[i] = NT ? __builtin_nontemporal_load(src) : *src;
    }
}
template <class Dst>
DEV void titem_finish_q(const f32x4 (&v)[16], int kb, int nb, float* scr  , int lane, float sc, Dst dst) {
    const int k0 = 64 * kb + 16 * (lane >> 4), n0 = 64 * nb + 4 * (lane & 15);
#pragma unroll
    for (int j = 0; j < 4; ++j) {
        u32x4 o;
        o.x = pk4q(v[0][j] * sc, v[1][j] * sc, v[2][j] * sc, v[3][j] * sc); o.y = pk4q(v[4][j] * sc, v[5][j] * sc, v[6][j] * sc, v[7][j] * sc);
        o.z = pk4q(v[8][j] * sc, v[9][j] * sc, v[10][j] * sc, v[11][j] * sc); o.w = pk4q(v[12][j] * sc, v[13][j] * sc, v[14][j] * sc, v[15][j] * sc);
        unsigned char* d0 = dst(n0 + j, 0); if (d0) *(u32x4*)(d0 + k0) = o;
        unsigned char* d1 = dst(n0 + j, 1); if (d1) *(u32x4*)(d1 + k0) = o;
    }
}
template <class Dst>
DEV void transpose_item_q(const float* W, int N, int kb, int nb, float* scr, int lane, float sc, Dst dst) {
    f32x4 v[16]; titem_load<false>(W, N, kb, nb, lane, v); titem_finish_q(v, kb, nb, scr, lane, sc, dst);
}

DEV void stage_prep(const P& p, int bid, int nb, unsigned char* lds, int wvx) {
    const int tid = TID, lane = tid & 63, wave = tid >> 6;
    float* scr = (float*)lds + wave * (64 * 65);
    unsigned char* ws = p.ws;
    constexpr int I_IN = 16 * 84, I_OA = 8 * 16, I_OR = 4 * 16, I_OUT = 16 * 16, I_W1 = 16 * 32, I_W2 = 16 * 16;
    constexpr int PER_LAYER = I_IN + I_OA + I_OR + I_OUT;
    const int gw = bid * NWAVES + wave, ngw = nb * NWAVES;
    for (int it = gw; it < 2 * PER_LAYER; it += ngw) {
        const int l = it / PER_LAYER; int r = it % PER_LAYER;
#if INP_FP8 == 2
        if (r < I_IN && (r % 84) >= C_GA / 64) {
            unsigned char* wq = ws + OFF_WTINQ + (size_t)l * (NIN - C_GA) * D;
            transpose_item_q(p.w_in + (size_t)l * D * NIN, NIN, r / 84, r % 84, scr, lane, QW, [&](int n, int which) -> unsigned char* { return which ? (unsigned char*)nullptr : wq + (size_t)(n - C_GA) * D; });
            continue; }
#endif
#if INP_FP8 == 1
        if (r < I_IN) {
            unsigned char* wt = ws + OFF_WTIN + (size_t)l * NIN * D; unsigned char* wtt = ws + OFF_WTT + (size_t)l * 768 * D;
            transpose_item_q(p.w_in + (size_t)l * D * NIN, NIN, r / 84, r % 84, scr, lane, QW, [&](int n, int which) -> unsigned char* {
                int pr = n;
                if (n >= C_RQ && n < C_RV) pr = (n & ~63) + ret_phys(n & 63);
                if (which == 0) return wt + (size_t)pr * D;
                int tr = -1;
                if (n >= C_V && n < C_U) tr = n - C_V;
                else if (n >= C_K && n < C_V) tr = 128 + (n - C_K);
                else if (n >= C_RV && n < C_RGF) tr = 256 + (n - C_RV);
                else if (n >= C_RK && n < C_RV) tr = 512 + (pr - C_RK);
                return tr < 0 ? (unsigned char*)nullptr : wtt + (size_t)tr * D; });
            continue; }
#endif
        if (r < I_IN) {
            bf16_t* wt = (bf16_t*)(ws + OFF_WTIN) + (size_t)l * NIN * D; bf16_t* wtt = (bf16_t*)(ws + OFF_WTT) + (size_t)l * 768 * D;
            transpose_item(p.w_in + (size_t)l * D * NIN, NIN, r / 84, r % 84, scr, lane, [&](int n, int which) -> bf16_t* {
                int pr = n;
                if (n >= C_RQ && n < C_RV) pr = (n & ~63) + ret_phys(n & 63);
                if (which == 0) return wt + (size_t)pr * D;
                int tr = -1;
                if (n >= C_V && n < C_U) tr = n - C_V;
                else if (n >= C_K && n < C_V) tr = 128 + (n - C_K);
                else if (n >= C_RV && n < C_RGF) tr = 256 + (n - C_RV);
                else if (n >= C_RK && n < C_RV) tr = 512 + (pr - C_RK);
                return tr < 0 ? (bf16_t*)nullptr : wtt + (size_t)tr * D; });
            continue; }
        r -= I_IN;
        if (r < I_OA) { bf16_t* wt = (bf16_t*)(ws + OFF_WTM) + (size_t)l * D * D;
            transpose_item(p.w_o_attn + (size_t)l * 512 * D, D, r / 16, r % 16, scr, lane, [&](int n, int which) -> bf16_t* { return which ? (bf16_t*)nullptr : wt + (size_t)n * D + MX_ATTN; }); continue; }
        r -= I_OA;
        if (r < I_OR) { bf16_t* wt = (bf16_t*)(ws + OFF_WTM) + (size_t)l * D * D;
            transpose_item(p.w_o_ret + (size_t)l * 256 * D, D, r / 16, r % 16, scr, lane, [&](int n, int which) -> bf16_t* { return which ? (bf16_t*)nullptr : wt + (size_t)n * D + MX_RET; }); continue; }
        r -= I_OR;
#if OUT_FP8
        if (r < I_OUT) { unsigned char* wq = ws + OFF_WTOQ + (size_t)l * D * D;
            transpose_item_q(p.w_out + (size_t)l * D * D, D, r / 16, r % 16, scr, lane, QW, [&](int n, int which) -> unsigned char* { return which ? (unsigned char*)nullptr : wq + (size_t)n * D; }); }
#endif
        if (r < I_OUT) { bf16_t* wt = (bf16_t*)(ws + OFF_WTO) + (size_t)l * D * D;
            transpose_item(p.w_out + (size_t)l * D * D, D, r / 16, r % 16, scr, lane, [&](int n, int which) -> bf16_t* { return which ? (bf16_t*)nullptr : wt + (size_t)n * D; }); continue; }
    }
    const int gt = bid * NTHREADS + tid, ngt = nb * NTHREADS;
    for (int it = gt; it < 2 * 256 * D; it += ngt) {
        const int l = it / (256 * D), c = (it / D) % 256, n = it % D, g = c >> 6, cl = c & 63;
        const float* pw = p.pool_w + (((size_t)l * 4 + g) * 64 + cl) * 64; const float* ps = p.pool_scale + l * 256 + g * 64; const float* wo = p.w_o_pool + ((size_t)l * 256 + g * 64) * D + n;
        float s = 0.f;
        for (int e = 0; e < 64; ++e) s += pw[e] * ps[e] * wo[(size_t)e * D];
        ((bf16_t*)(ws + OFF_WTM))[(size_t)l * D * D + (size_t)n * D + MX_POOL + c] = f2bf(s);
    }
    {
        float* sl = (float*)(lds + 8 * 64 * 65 * 4);
        __syncthreads();
        for (int i = tid; i < 3 * D; i += NTHREADS) { const int s = i / D, k = i % D; const float v = s < 2 ? p.c[s * D + k] : p.c_ctx[k]; sl[i] = siluf_(v); }
        __syncthreads();
        float* mod = (float*)(ws + OFF_MOD);
        float* red = (float*)lds;
        for (int blk = bid; blk < 2 * 96; blk += nb) {
            const int l = blk / 96, n = (blk % 96) * 64 + (tid & 63), ks = tid >> 6;
            const float* w = p.w_mod + (size_t)l * D * 6 * D + (size_t)(128 * ks) * 6 * D + n; const float* s0 = sl + 128 * ks; float a0 = 0.f, a1 = 0.f, a2 = 0.f;
#pragma unroll 16
            for (int k = 0; k < 128; ++k) { const float wv = w[(size_t)k * 6 * D]; a0 += s0[k] * wv; a1 += s0[D + k] * wv; a2 += s0[2 * D + k] * wv; }
            red[(ks * 3 + 0) * 64 + (tid & 63)] = a0; red[(ks * 3 + 1) * 64 + (tid & 63)] = a1; red[(ks * 3 + 2) * 64 + (tid & 63)] = a2;
            __syncthreads();
            if (tid < 192) { const int sI = tid >> 6, nn = tid & 63; float a = 0.f;
#pragma unroll
                for (int q = 0; q < 8; ++q) a += red[(q * 3 + sI) * 64 + nn];
                const int nc = (blk % 96) * 64 + nn; mod[(size_t)(l * 3 + sI) * 6 * D + nc] = a + p.b_mod[l * 6 * D + nc]; }
            __syncthreads();
        }
    }
    {
        f32x2* tr = (f32x2*)(ws + OFF_TABR);
        const double TWO_PI = 6.283185307179586476925286766559, INV_2PI = 0.15915494309189533576888376337251;
        for (int it = gt; it < L * 32 + 256 * 16 + 64 * 16; it += ngt) {
            double ang; f32x2* dst;
            if (it < L * 32) { ang = (double)(it >> 5) * p.inv_ret[it & 31]; dst = tr + it; }
            else { const int j = it - L * 32; const int pos = j < 256 * 16 ? (j >> 4) : ((j - 256 * 16) >> 4); ang = (double)pos * p.inv_ax[j & 15]; dst = (f32x2*)(ws + OFF_TABA) + j; }
            const double n = rint(ang * INV_2PI); const float r = (float)(ang - n * TWO_PI);
            const float cv = __cosf(r), sv = __sinf(r);
            *dst = (f32x2){cv, sv};
            if (it < L * 32) { float* tt = (float*)(ws + OFF_TABRT); tt[(size_t)(it & 31) * L + (it >> 5)] = cv; tt[(size_t)(32 + (it & 31)) * L + (it >> 5)] = sv; }
        }
        for (int it = gt; it < 2 * 2 * 4 * 128; it += ngt) {
            const int j = it & 127, h = (it >> 7) & 3, dir = (it >> 9) & 1, l = it >> 10; const float lg = log_g(p, l, dir, h);
            ((float*)(ws + OFF_TABW))[it] = __expf(lg * (float)(dir == 0 ? 127 - j : j));
        }
    }
}


DEV void stage_prep_experts(const P& p, int l, int bid, int nb, unsigned char* lds, int wvx) {
    const int tid = TID, lane = tid & 63, wave = tid >> 6;
    float* scr = (float*)lds + wave * (64 * 65);
    unsigned char* ws = p.ws;
    constexpr int I_W1 = 16 * 32, I_W2 = 16 * 16;
    const int gw = bid * NWAVES + wave, ngw = nb * NWAVES;
#if MOE_FP8 >= 2
    auto src = [&](int it, const float*& W, int& N, int& kb, int& nbk) { const int e = it / (I_W1 + I_W2), r = it % (I_W1 + I_W2);
        if (r < I_W1) { W = p.w1 + ((size_t)l * NEXP + e) * D * 2048; N = 2048; kb = r / 32; nbk = r % 32; }
        else { W = p.w2 + ((size_t)l * NEXP + e) * D * D; N = D; kb = (r - I_W1) / 16; nbk = (r - I_W1) % 16; } };
    f32x4 va[16], vb[16];
    int it = gw;
    if (it < NEXP * (I_W1 + I_W2)) { const float* W; int N, kb, nbk; src(it, W, N, kb, nbk); titem_load<true>(W, N, kb, nbk, lane, va); }
    for (; it < NEXP * (I_W1 + I_W2); it += ngw) {
        const int itn = it + ngw;
        if (itn < NEXP * (I_W1 + I_W2)) { const float* W; int N, kb, nbk; src(itn, W, N, kb, nbk); titem_load<true>(W, N, kb, nbk, lane, vb); }
        const int e = it / (I_W1 + I_W2), r = it % (I_W1 + I_W2);
        if (r < I_W1) {
            unsigned char* wq = ws + OFF_WT1 + ((size_t)l * NEXP + e) * 2048 * D;
            titem_finish_q(va, r / 32, r % 32, scr, lane, QW, [&](int n, int which) -> unsigned char* {
                const int j = n & 1023, jq = (j >> 2) & 3, pq = jq == 1 ? 2 : jq == 2 ? 1 : jq;
                const int pr = 32 * (j >> 4) + (n >= 1024 ? 16 : 0) + 4 * pq + (j & 3);
                return which ? (unsigned char*)nullptr : wq + (size_t)pr * D; });
        } else {
            unsigned char* wq = ws + OFF_WT2 + ((size_t)l * NEXP + e) * D * D;
            titem_finish_q(va, (r - I_W1) / 16, (r - I_W1) % 16, scr, lane, QW, [&](int n, int which) -> unsigned char* { return which ? (unsigned char*)nullptr : wq + (size_t)n * D; });
        }
#pragma unroll
        for (int i = 0; i < 16; ++i) va[i] = vb[i];
    }
#else
    for (int it = gw; it < NEXP * (I_W1 + I_W2); it += ngw) {
        int r = it;
        const int e = r / (I_W1 + I_W2); r %= (I_W1 + I_W2);
        if (r < I_W1) {
#if MOE_FP8 >= 1
            unsigned char* wq = ws + OFF_WT1 + ((size_t)l * NEXP + e) * 2048 * D;
            transpose_item_q(p.w1 + ((size_t)l * NEXP + e) * D * 2048, 2048, r / 32, r % 32, scr, lane, QW, [&](int n, int which) -> unsigned char* {
                const int j = n & 1023, jq = (j >> 2) & 3, pq = jq == 1 ? 2 : jq == 2 ? 1 : jq;
                const int pr = 32 * (j >> 4) + (n >= 1024 ? 16 : 0) + 4 * pq + (j & 3);
                return which ? (unsigned char*)nullptr : wq + (size_t)pr * D; });
#else
            bf16_t* wt = (bf16_t*)(ws + OFF_WT1) + ((size_t)l * NEXP + e) * 2048 * D;
            transpose_item(p.w1 + ((size_t)l * NEXP + e) * D * 2048, 2048, r / 32, r % 32, scr, lane, [&](int n, int which) -> bf16_t* {
                const int j = n & 1023, jq = (j >> 2) & 3, pq = jq == 1 ? 2 : jq == 2 ? 1 : jq;
                const int pr = 32 * (j >> 4) + (n >= 1024 ? 16 : 0) + 4 * pq + (j & 3);
                return which ? (bf16_t*)nullptr : wt + (size_t)pr * D; });
#endif
            continue; }
        r -= I_W1;
#if MOE_FP8 >= 2
        { unsigned char* wq = ws + OFF_WT2 + ((size_t)l * NEXP + e) * D * D;
            transpose_item_q(p.w2 + ((size_t)l * NEXP + e) * D * D, D, r / 16, r % 16, scr, lane, QW, [&](int n, int which) -> unsigned char* { return which ? (unsigned char*)nullptr : wq + (size_t)n * D; }); }
#else
        { bf16_t* wt = (bf16_t*)(ws + OFF_WT2) + ((size_t)l * NEXP + e) * D * D;
            transpose_item(p.w2 + ((size_t)l * NEXP + e) * D * D, D, r / 16, r % 16, scr, lane, [&](int n, int which) -> bf16_t* { return which ? (bf16_t*)nullptr : wt + (size_t)n * D; }); }
#endif
    }
#endif
}

DEV void norm_store(const f32x4 (&v)[4], const float* gamma, const float* sc, const float* sh, bf16_t* orow, unsigned char* qrow, int lane) {
    float s = 0.f;
#pragma unroll
    for (int j = 0; j < 4; ++j) s += (v[j].x * v[j].x + v[j].y * v[j].y) + (v[j].z * v[j].z + v[j].w * v[j].w);
    const float rstd = rsqrtf(wave_sum(s) * (1.f / D) + 1e-6f);
    f32x4 g[4], a[4], b[4];
#pragma unroll
    for (int j = 0; j < 4; ++j) { const int k = 4 * lane + 256 * j; g[j] = *(const f32x4*)(gamma + k); a[j] = *(const f32x4*)(sc + k); b[j] = *(const f32x4*)(sh + k); }
#pragma unroll
    for (int j = 0; j < 4; ++j) {
        const int k = 4 * lane + 256 * j;
        f32x4 y = v[j] * rstd * g[j] * (a[j] + 1.f) + b[j];
#if INP_FP8 == 1
        *(unsigned*)((unsigned char*)orow + k) = pk4q(y.x, y.y, y.z, y.w);
#else
        u32x2 o; o.x = pk2(y.x, y.y); o.y = pk2(y.z, y.w);
        *(u32x2*)(orow + k) = o;
#if INP_FP8 == 2
        *(unsigned*)(qrow + k) = pk4q(y.x, y.y, y.z, y.w);
#endif
#endif
    }
}
constexpr size_t OFF_GM2 = OFF_MOD + 512 * 1024;
DEV void stage_norm0(const P& p, int bid, int nb, int wvx) {
    const int tid_ = TID, lane = tid_ & 63, wave = tid_ >> 6;
    if (bid == nb - 1) { float* gm2 = (float*)(p.ws + OFF_GM2);
        for (int i = tid_; i < 2 * 3 * D; i += NTHREADS) { const int l = i / (3 * D), s = (i / D) % 3, k = i % D; gm2[i] = p.norm2[l * D + k] * (modp(p, l, s, 4)[k] + 1.f); } }
    bf16_t* hbf = (bf16_t*)(p.ws + OFF_HBF);
    int r = bid * NWAVES + wave; f32x4 v[4], vn[4];
    if (r < TA) {
#pragma unroll
        for (int j = 0; j < 4; ++j) v[j] = *(const f32x4*)(in_row(p, r) + 4 * lane + 256 * j);
    }
    for (; r < TA; r += nb * NWAVES) {
        const int rn = r + nb * NWAVES;
        if (rn < TA) {
#pragma unroll
            for (int j = 0; j < 4; ++j) vn[j] = *(const f32x4*)(in_row(p, rn) + 4 * lane + 256 * j);
        }
        const int s = row_mod(r);
        norm_store(v, p.norm1, modp(p, 0, s, 1), modp(p, 0, s, 0), hbf + (size_t)r * (INP_FP8 == 1 ? D / 2 : D), p.ws + OFF_HQ + (size_t)r * D, lane);
#pragma unroll
        for (int j = 0; j < 4; ++j) v[j] = vn[j];
    }
}

typedef short s16x4 __attribute__((ext_vector_type(4)));
DEV u32x2 lds_tr16(const LAS unsigned char* a) { const s16x4 v = __builtin_amdgcn_ds_read_tr16_b64_v4i16((LAS s16x4*)a); return __builtin_bit_cast(u32x2, v); }
DEV void mma_tile32(const bf16_t* a0, const bf16_t* a1, const bf16_t* b0, const bf16_t* b1, int K, f32x4 (&acc)[2][2]) {
#pragma unroll 4
    for (int k = 0; k < K; k += 32) {
        const bf16x8 fa0 = *(const bf16x8*)(a0 + k), fa1 = *(const bf16x8*)(a1 + k), fb0 = *(const bf16x8*)(b0 + k), fb1 = *(const bf16x8*)(b1 + k);
        acc[0][0] = __builtin_amdgcn_mfma_f32_16x16x32_bf16(fa0, fb0, acc[0][0], 0, 0, 0);
        acc[0][1] = __builtin_amdgcn_mfma_f32_16x16x32_bf16(fa0, fb1, acc[0][1], 0, 0, 0);
        acc[1][0] = __builtin_amdgcn_mfma_f32_16x16x32_bf16(fa1, fb0, acc[1][0], 0, 0, 0);
        acc[1][1] = __builtin_amdgcn_mfma_f32_16x16x32_bf16(fa1, fb1, acc[1][1], 0, 0, 0);
    }
}
DEV void zero_acc(f32x4 (&acc)[2][2]) {
#pragma unroll
    for (int a = 0; a < 2; ++a)
#pragma unroll
        for (int b = 0; b < 2; ++b) acc[a][b] = (f32x4){0.f, 0.f, 0.f, 0.f};
}

DEV f32x2 ax_cs(const P& p, int row, int sub, int f) {
    if (row >= TL) return (f32x2){1.f, 0.f};
    const int l = row & (L - 1); const f32x2* ta = (const f32x2*)(p.ws + OFF_TABA);
    return sub == 0 ? ta[(l >> 6) * 16 + f] : ta[256 * 16 + (l & 63) * 16 + f];
}
DEV f32x2 ret_cs(const P& p, int row, int f) {
    if (row >= TL) return (f32x2){1.f, 0.f};
    return ((const f32x2*)(p.ws + OFF_TABR))[(row & (L - 1)) * 32 + f];
}

DEV void inproj_pair(const P& p, int row, int c1, float x1, float x2, float& o1, float& o2) {
    const int f16 = c1 & 15;
    if (c1 < C_V) {
        const f32x2 cs = ax_cs(p, row, (c1 >> 5) & 1, f16);
        o1 = x1 * cs.x - x2 * cs.y; o2 = x1 * cs.y + x2 * cs.x;
        if (c1 < C_K) { o1 *= 0.125f; o2 *= 0.125f; }
    } else if (c1 < C_RQ) { o1 = x1; o2 = x2; }
    else if (c1 < C_RV) {
        const f32x2 cs = ret_cs(p, row, ((c1 >> 5) & 1) * 16 + f16);
        o1 = x1 * cs.x - x2 * cs.y; o2 = x1 * cs.y + x2 * cs.x;
        if (c1 >= C_RK) { o1 *= 0.125f; o2 *= 0.125f; }
    } else if (c1 < C_RGF) { o1 = x1; o2 = x2; }
    else if (c1 < C_GA) { o1 = siluf_(x1); o2 = siluf_(x2); }
    else { o1 = sigmoidf_(x1); o2 = sigmoidf_(x2); }
}


DEV void stage_pool_diff(const P& p, int l, int bid, int nb, int wvx) {
    const int NR = l == 0 ? TA : TL;
    const bf16_t* proj = (const bf16_t*)(p.ws + OFF_PROJ); bf16_t* mix = (bf16_t*)(p.ws + OFF_MIX);
    for (int it = bid * NTHREADS + TID; it < 4 * NR * 8; it += nb * NTHREADS) {
        const int g = it / (NR * 8), rem = it % (NR * 8), row = rem >> 3, c = g * 64 + (rem & 7) * 8, w = __builtin_amdgcn_readfirstlane(2 << g);
        int s0, len; if (row < TL) { s0 = row & ~(L - 1); len = L; } else { s0 = TL + (((row - TL) >> 8) << 8); len = LC; }
        const int t = row - s0, lo0 = t - w / 2;
        float acc[8];
#pragma unroll
        for (int j = 0; j < 8; ++j) acc[j] = 0.f;
        bf16x8 own = *(const bf16x8*)(proj + (size_t)row * NIN + C_U + c);
#pragma unroll
        for (int i = 0; i < 16; ++i) {
            {
                const int pos = lo0 + i; const bool ok = i < w && pos >= 0 && pos < len;
                const bf16x8 v = *(const bf16x8*)(proj + (size_t)(s0 + (ok ? pos : t)) * NIN + C_U + c);
                const float mk = ok ? 1.f : 0.f;
#pragma unroll
                for (int j = 0; j < 8; ++j) acc[j] += mk * bf2f((bf16_t)v[j]);
            }
        }
        int lo = lo0 < 0 ? 0 : lo0, hi = lo0 + w > len ? len : lo0 + w;
        const float inv = 1.f / (float)(hi - lo);
        float d[8];
#pragma unroll
        for (int j = 0; j < 8; ++j) d[j] = acc[j] * inv - bf2f((bf16_t)own[j]);
        u32x4 o; o.x = pk2(d[0], d[1]); o.y = pk2(d[2], d[3]); o.z = pk2(d[4], d[5]); o.w = pk2(d[6], d[7]);
        *(u32x4*)(mix + (size_t)row * D + MX_POOL + c) = o;
    }
}


constexpr int MAXENT = 640;
DEV void stage_route(const P& p, int l, int bid, int nb, unsigned char* lds, int wvx) {
    const int tid = TID, lane = tid & 63, wave = tid >> 6;
    float* wl = (float*)lds;
    int* lcnt = (int*)(lds + 131072); int* lbase = lcnt + 32; int* ent = lbase + 32;
    const float* wr = p.w_router + (size_t)l * D * NEXP;
    for (int k = tid; k < D; k += NTHREADS) {
#pragma unroll
        for (int e4 = 0; e4 < 8; ++e4) { const f32x4 w = *(const f32x4*)(wr + (size_t)k * NEXP + 4 * e4);
            wl[(4 * e4 + 0) * D + k] = w.x; wl[(4 * e4 + 1) * D + k] = w.y; wl[(4 * e4 + 2) * D + k] = w.z; wl[(4 * e4 + 3) * D + k] = w.w; }
    }
    for (int i = tid; i < 32; i += NTHREADS) lcnt[i] = 0;
    for (int i = tid; i < MAXENT; i += NTHREADS) ent[i] = -1;
    __syncthreads();
    const float* xr = (const float*)(p.ws + OFF_XR); bf16_t* hbf = (bf16_t*)(p.ws + OFF_HBF);
    int* tk_e = (int*)(p.ws + OFF_TK + (size_t)l * TK_LAYER); float* tk_w = (float*)(tk_e + TA * 4); int* tk_pos = (int*)(tk_w + TA * 4); int* list_tok = tk_pos + TA * 4;
    unsigned* cntg = (unsigned*)(p.ws + OFF_CTL) + CW_CNT + l * 32;
    const int NR = l == 0 ? TA : TL, ngw = nb * NWAVES, gw = bid * NWAVES + wave;
    const int t_begin = (int)(((long long)gw * NR) / ngw), t_end = (int)(((long long)(gw + 1) * NR) / ngw);
    const float* gamma = p.norm2 + l * D;
    f32x4 gam[4];
#pragma unroll
    for (int j = 0; j < 4; ++j) gam[j] = *(const f32x4*)(gamma + 4 * lane + 256 * j);
    for (int t0 = t_begin; t0 < t_end; t0 += 4) {
        f32x4 v[4][4]; int tok[4]; float ss[4];
#pragma unroll
        for (int u = 0; u < 4; ++u) { tok[u] = t0 + u < t_end ? t0 + u : t_end - 1; ss[u] = 0.f;
#pragma unroll
            for (int j = 0; j < 4; ++j) { v[u][j] = *(const f32x4*)(xr + (size_t)tok[u] * D + 4 * lane + 256 * j); ss[u] += (v[u][j].x * v[u][j].x + v[u][j].y * v[u][j].y) + (v[u][j].z * v[u][j].z + v[u][j].w * v[u][j].w); } }
        const int s0 = row_mod(tok[0]);
        f32x4 scv[4], shv[4];
#pragma unroll
        for (int j = 0; j < 4; ++j) { scv[j] = *(const f32x4*)(modp(p, l, s0, 4) + 4 * lane + 256 * j); shv[j] = *(const f32x4*)(modp(p, l, s0, 3) + 4 * lane + 256 * j); }
#pragma unroll
        for (int o = 1; o < 64; o <<= 1) {
#pragma unroll
            for (int u = 0; u < 4; ++u) ss[u] += __shfl_xor(ss[u], o); }
#pragma unroll
        for (int u = 0; u < 4; ++u) {
            const float rstd = rsqrtf(ss[u] * (1.f / D) + 1e-6f); const int sm = row_mod(tok[u]);
            f32x4 av[4], bv[4];
            if (sm != s0) {
                const float* sc = modp(p, l, sm, 4); const float* sh = modp(p, l, sm, 3);
#pragma unroll
                for (int j = 0; j < 4; ++j) { av[j] = *(const f32x4*)(sc + 4 * lane + 256 * j); bv[j] = *(const f32x4*)(sh + 4 * lane + 256 * j); }
            } else {
#pragma unroll
                for (int j = 0; j < 4; ++j) { av[j] = scv[j]; bv[j] = shv[j]; }
            }
#pragma unroll
            for (int j = 0; j < 4; ++j) { const int k = 4 * lane + 256 * j;
                const f32x4 g = gam[j], a = av[j], b = bv[j];
                v[u][j] = v[u][j] * rstd * g * (a + 1.f) + b;
#if MOE_FP8 >= 1
                if (t0 + u < t_end) *(unsigned*)((unsigned char*)hbf + (size_t)tok[u] * D + k) = pk4q(v[u][j].x, v[u][j].y, v[u][j].z, v[u][j].w); }
#else
                u32x2 o; o.x = pk2(v[u][j].x, v[u][j].y); o.y = pk2(v[u][j].z, v[u][j].w);
                if (t0 + u < t_end) *(u32x2*)(hbf + (size_t)tok[u] * D + k) = o; }
#endif
        }
        float lgc[4] = {0.f, 0.f, 0.f, 0.f};
        const int e8 = lane & 7, ut = (lane >> 3) & 3;
#pragma nounroll
        for (int c = 0; c < 4; ++c) {
            float val[32];
#pragma unroll
            for (int x = 0; x < 8; ++x) {
                f32x4 w[4];
#pragma unroll
                for (int j = 0; j < 4; ++j) w[j] = *(const f32x4*)(wl + (8 * c + x) * D + 4 * lane + 256 * j);
#pragma unroll
                for (int u = 0; u < 4; ++u) { float a = 0.f;
#pragma unroll
                    for (int j = 0; j < 4; ++j) a += (v[u][j].x * w[j].x + v[u][j].y * w[j].y) + (v[u][j].z * w[j].z + v[u][j].w * w[j].w);
                    val[u * 8 + x] = a; }
            }
            float v16[16], v8[8], v4[4], v2[2];
#define RT_STAGE(dst, src, n, b) do { const bool hi_ = (lane >> (b)) & 1; _Pragma("unroll") for (int i_ = 0; i_ < (n); ++i_) { const float lo_v = (src)[2 * i_], hi_v = (src)[2 * i_ + 1]; \
                const float keep = hi_ ? hi_v : lo_v, send = hi_ ? lo_v : hi_v; (dst)[i_] = keep + __shfl_xor(send, 1 << (b)); } } while (0)
            RT_STAGE(v16, val, 16, 0); RT_STAGE(v8, v16, 8, 1); RT_STAGE(v4, v8, 4, 2); RT_STAGE(v2, v4, 2, 3);
            float v1; { const bool hi_ = (lane >> 4) & 1; const float keep = hi_ ? v2[1] : v2[0], send = hi_ ? v2[0] : v2[1]; v1 = keep + __shfl_xor(send, 16); }
#undef RT_STAGE
            { const float lv = v1 + __shfl_xor(v1, 32) + p.b_router[l * NEXP + 8 * c + e8];
#pragma unroll
              for (int cc = 0; cc < 4; ++cc) lgc[cc] = (cc == c) ? lv : lgc[cc]; }
        }
        int te[4]; float tv[4];
#pragma unroll
        for (int k = 0; k < 4; ++k) {
            float bv = lgc[0]; int be = e8;
#pragma unroll
            for (int c = 1; c < 4; ++c) { const bool t = lgc[c] > bv; bv = t ? lgc[c] : bv; be = t ? 8 * c + e8 : be; }
#pragma unroll
            for (int d = 1; d < 8; d <<= 1) { const float ov = __shfl_xor(bv, d); const int oe = __shfl_xor(be, d); const bool t = (ov > bv) || (ov == bv && oe < be); bv = t ? ov : bv; be = t ? oe : be; }
            te[k] = be; tv[k] = bv;
#pragma unroll
            for (int c = 0; c < 4; ++c) lgc[c] = (be == 8 * c + e8) ? -INFINITY : lgc[c];
        }
        float ex[4], es = 0.f;
#pragma unroll
        for (int k = 0; k < 4; ++k) { ex[k] = __expf(tv[k] - tv[0]); es += ex[k]; }
        if (lane < 32 && e8 < 4 && t0 + ut < t_end) {
            const int e = e8 == 0 ? te[0] : e8 == 1 ? te[1] : e8 == 2 ? te[2] : te[3];
            const float wgt = (e8 == 0 ? ex[0] : e8 == 1 ? ex[1] : e8 == 2 ? ex[2] : ex[3]) / es;
            const int rank = atomicAdd(&lcnt[e], 1);
            const int tk = t0 + ut, lid = wave * 72 + (tk - t_begin) * 4 + e8;
            ent[lid] = e | (rank << 8);
            tk_e[tk * 4 + e8] = e; tk_w[tk * 4 + e8] = wgt;
        }
    }
    __syncthreads();
    if (tid < 32) lbase[tid] = (int)atomicAdd(&cntg[tid], (unsigned)lcnt[tid]);
    __syncthreads();
    for (int lid = tid; lid < 8 * 72; lid += NTHREADS) {
        const int en = ent[lid]; if (en < 0) continue;
        const int e = en & 255, rank = en >> 8, wv = lid / 72, rem = lid % 72, k = rem & 3;
        const int tb = (int)(((long long)(bid * NWAVES + wv) * NR) / ngw);
        const int tokk = tb + (rem >> 2), pos = lbase[e] + rank;
        tk_pos[tokk * 4 + k] = pos; list_tok[e * CAP + pos] = tokk;
    }
}

DEV void moe_prefix(const P& p, int l, int* pstart, int* cnt, int wvx) {
    const int tid = TID;
    if (tid < 64) {
        unsigned* cntg = (unsigned*)(p.ws + OFF_CTL) + CW_CNT + l * 32;
        const int c = tid < 32 ? (int)__hip_atomic_load(cntg + (tid & 31), __ATOMIC_RELAXED, __HIP_MEMORY_SCOPE_AGENT) : 0;
        const int pad = (c + 255) & ~255; int incl = pad;
#pragma unroll
        for (int o = 1; o < 32; o <<= 1) { const int t = __shfl_up(incl, o); if ((tid & 63) >= o) incl += t; }
        if (tid < 32) { cnt[tid] = c; pstart[tid] = incl - pad; if (tid == 31) pstart[32] = incl; }
    }
    __syncthreads();
}
#ifndef ROUTE_MFMA
#define ROUTE_MFMA 1
#endif
constexpr int RW_STRIDE = 2064, RW_LO = 32 * RW_STRIDE, RT_TAB = 2 * RW_LO, RT_MAXENT = 1024;
DEV void stage_route_mfma(const P& p, int l, int bid, int nb, unsigned char* lds_, int wvx) {
    const int tid = TID, lane = tid & 63, wave = tid >> 6, fr = lane & 15, fq = lane >> 4;
    LAS unsigned char* lds = (LAS unsigned char*)lds_;
    int* lcnt = (int*)(lds_ + RT_TAB); int* lbase = lcnt + 32; int* ent = lbase + 32; int* enttok = ent + RT_MAXENT;
    const float* wr = p.w_router + (size_t)l * D * NEXP;
    for (int k = tid; k < D; k += NTHREADS) {
#pragma unroll
        for (int e4 = 0; e4 < 8; ++e4) { const f32x4 w = *(const f32x4*)(wr + (size_t)k * NEXP + 4 * e4);
#pragma unroll
            for (int j = 0; j < 4; ++j) { const float wv = w[j]; const bf16_t h = f2bf(wv); const bf16_t lo = f2bf(wv - bf2f(h));
                *(LAS bf16_t*)(lds + (4 * e4 + j) * RW_STRIDE + 2 * k) = h; *(LAS bf16_t*)(lds + RW_LO + (4 * e4 + j) * RW_STRIDE + 2 * k) = lo; } }
    }
    for (int i = tid; i < 32; i += NTHREADS) lcnt[i] = 0;
    for (int i = tid; i < RT_MAXENT; i += NTHREADS) ent[i] = -1;
    __syncthreads();
    const float* xr = (const float*)(p.ws + OFF_XR); unsigned char* h2q = p.ws + OFF_HBF;
    int* tk_e = (int*)(p.ws + OFF_TK + (size_t)l * TK_LAYER); float* tk_w = (float*)(tk_e + TA * 4); int* tk_pos = (int*)(tk_w + TA * 4); int* list_tok = tk_pos + TA * 4;
    unsigned* cntg = (unsigned*)(p.ws + OFF_CTL) + CW_CNT + l * 32;
    const int NR = l == 0 ? TA : TL, ntile = NR / 16, ngw = nb * NWAVES, gw = bid * NWAVES + wave;
    auto body = [&](auto ntc) {
        constexpr int NT = decltype(ntc)::value;
        int tk[NT]; const float* xrow[NT]; const float* gmp[NT]; const float* shp[NT]; float rstd[NT]; unsigned char* hq[NT]; f32x4 acc[NT][2];
#pragma unroll
        for (int u = 0; u < NT; ++u) {
            const int tile = gw + u * ngw, sm = row_mod(tile * 16);
            tk[u] = tile * 16 + fr; xrow[u] = xr + (size_t)tk[u] * D + 8 * fq; hq[u] = h2q + (size_t)tk[u] * D + 8 * fq;
            gmp[u] = (const float*)(p.ws + OFF_GM2) + (size_t)(l * 3 + sm) * D + 8 * fq; shp[u] = modp(p, l, sm, 3) + 8 * fq;
            float ss = 0.f;
            if (tile * 16 < TL) { const f32x4 q = *(const f32x4*)((const float*)(p.ws + OFF_ROWSQ) + (size_t)tk[u] * 16 + 4 * fq); ss = (q.x + q.y) + (q.z + q.w); }
            else {
#pragma unroll 8
                for (int s = 0; s < 32; ++s) { const f32x4 a = *(const f32x4*)(xrow[u] + 32 * s), b = *(const f32x4*)(xrow[u] + 32 * s + 4);
                    ss += (a.x * a.x + a.y * a.y) + (a.z * a.z + a.w * a.w) + (b.x * b.x + b.y * b.y) + (b.z * b.z + b.w * b.w); }
            }
            ss += __shfl_xor(ss, 16); ss += __shfl_xor(ss, 32);
            rstd[u] = rsqrtf(ss * (1.f / D) + 1e-6f);
            acc[u][0] = (f32x4){0.f, 0.f, 0.f, 0.f}; acc[u][1] = acc[u][0];
        }
#pragma unroll 4
        for (int s = 0; s < 32; ++s) {
            bf16x8 yh[NT], yl[NT];
#pragma unroll
            for (int u = 0; u < NT; ++u) {
                f32x4 y[2];
#pragma unroll
                for (int c = 0; c < 2; ++c) { const int k = 32 * s + 4 * c; y[c] = *(const f32x4*)(xrow[u] + k) * rstd[u] * *(const f32x4*)(gmp[u] + k) + *(const f32x4*)(shp[u] + k); }
                u32x2 q8; q8.x = pk4q(y[0].x, y[0].y, y[0].z, y[0].w); q8.y = pk4q(y[1].x, y[1].y, y[1].z, y[1].w);
                *(u32x2*)(hq[u] + 32 * s) = q8;
                u32x4 hw, lw;
                hw.x = pk2(y[0].x, y[0].y); hw.y = pk2(y[0].z, y[0].w); hw.z = pk2(y[1].x, y[1].y); hw.w = pk2(y[1].z, y[1].w);
                lw.x = pk2(y[0].x - bf2f((bf16_t)(hw.x & 0xffff)), y[0].y - bf2f((bf16_t)(hw.x >> 16))); lw.y = pk2(y[0].z - bf2f((bf16_t)(hw.y & 0xffff)), y[0].w - bf2f((bf16_t)(hw.y >> 16)));
                lw.z = pk2(y[1].x - bf2f((bf16_t)(hw.z & 0xffff)), y[1].y - bf2f((bf16_t)(hw.z >> 16))); lw.w = pk2(y[1].z - bf2f((bf16_t)(hw.w & 0xffff)), y[1].w - bf2f((bf16_t)(hw.w >> 16)));
                yh[u] = __builtin_bit_cast(bf16x8, hw); yl[u] = __builtin_bit_cast(bf16x8, lw);
            }
#pragma unroll
            for (int et = 0; et < 2; ++et) {
                const bf16x8 ah = *(const LAS bf16x8*)(lds + (16 * et + fr) * RW_STRIDE + (4 * s + fq) * 16), al = *(const LAS bf16x8*)(lds + RW_LO + (16 * et + fr) * RW_STRIDE + (4 * s + fq) * 16);
#pragma unroll
                for (int u = 0; u < NT; ++u) {
                    acc[u][et] = __builtin_amdgcn_mfma_f32_16x16x32_bf16(ah, yh[u], acc[u][et], 0, 0, 0);
                    acc[u][et] = __builtin_amdgcn_mfma_f32_16x16x32_bf16(ah, yl[u], acc[u][et], 0, 0, 0);
                    acc[u][et] = __builtin_amdgcn_mfma_f32_16x16x32_bf16(al, yh[u], acc[u][et], 0, 0, 0);
                }
            }
        }
#pragma unroll
        for (int u = 0; u < NT; ++u) {
            float lg[8];
#pragma unroll
            for (int et = 0; et < 2; ++et) { const f32x4 bb = *(const f32x4*)(p.b_router + l * NEXP + 16 * et + 4 * fq);
#pragma unroll
                for (int j = 0; j < 4; ++j) lg[4 * et + j] = acc[u][et][j] + bb[j]; }
            int te[4]; float tv[4];
#pragma unroll
            for (int k = 0; k < 4; ++k) {
                float bv = lg[0]; int be = 4 * fq;
#pragma unroll
                for (int i = 1; i < 8; ++i) { const int ei = 16 * (i >> 2) + 4 * fq + (i & 3); const bool t = lg[i] > bv; bv = t ? lg[i] : bv; be = t ? ei : be; }
#pragma unroll
                for (int d = 16; d < 64; d <<= 1) { const float ov = __shfl_xor(bv, d); const int oe = __shfl_xor(be, d); const bool t = (ov > bv) || (ov == bv && oe < be); bv = t ? ov : bv; be = t ? oe : be; }
                te[k] = be; tv[k] = bv;
#pragma unroll
                for (int i = 0; i < 8; ++i) { const int ei = 16 * (i >> 2) + 4 * fq + (i & 3); lg[i] = (be == ei) ? -INFINITY : lg[i]; }
            }
            float ex[4], es = 0.f;
#pragma unroll
            for (int k = 0; k < 4; ++k) { ex[k] = __expf(tv[k] - tv[0]); es += ex[k]; }
            {
                const int e = fq == 0 ? te[0] : fq == 1 ? te[1] : fq == 2 ? te[2] : te[3];
                const float wgt = (fq == 0 ? ex[0] : fq == 1 ? ex[1] : fq == 2 ? ex[2] : ex[3]) / es;
                const int rank = atomicAdd(&lcnt[e], 1);
                const int lid = wave * 128 + u * 64 + fr * 4 + fq;
                ent[lid] = e | (rank << 8); enttok[lid] = tk[u];
                tk_e[tk[u] * 4 + fq] = e; tk_w[tk[u] * 4 + fq] = wgt;
            }
        }
    };
    if (gw + ngw < ntile) body(std::integral_constant<int, 2>{}); else if (gw < ntile) body(std::integral_constant<int, 1>{});
    __syncthreads();
    if (tid < 32) lbase[tid] = (int)atomicAdd(&cntg[tid], (unsigned)lcnt[tid]);
    __syncthreads();
    for (int lid = tid; lid < RT_MAXENT; lid += NTHREADS) {
        const int en = ent[lid]; if (en < 0) continue;
        const int e = en & 255, rank = en >> 8, tokk = enttok[lid], k = lid & 3, pos = lbase[e] + rank;
        tk_pos[tokk * 4 + k] = pos; list_tok[e * CAP + pos] = tokk;
    }
}

DEV void stage_combine(const P& p, int l, int bid, int nb, unsigned char* lds, int wvx) {
    const int tid_ = TID, lane = tid_ & 63, wave = tid_ >> 6;
    int* pstart = (int*)lds; int* cnt = pstart + 40;
    moe_prefix(p, l, pstart, cnt, wvx);
    float* xr = (float*)(p.ws + OFF_XR); const bf16_t* yb = (const bf16_t*)(p.ws + OFF_YB); bf16_t* hbf = (bf16_t*)(p.ws + OFF_HBF);
    const int* tk_e = (const int*)(p.ws + OFF_TK + (size_t)l * TK_LAYER); const float* tk_w = (const float*)(tk_e + TA * 4); const int* tk_pos = (const int*)(tk_w + TA * 4);
    const int NR = l == 0 ? TA : TL;
    int row = bid * NWAVES + wave;
    int ce[4], cp[4]; float cw[4]; f32x4 xv[4];
    if (row < NR) {
#pragma unroll
        for (int k = 0; k < 4; ++k) { ce[k] = tk_e[row * 4 + k]; cw[k] = tk_w[row * 4 + k]; cp[k] = tk_pos[row * 4 + k]; }
#pragma unroll
        for (int j = 0; j < 4; ++j) xv[j] = *(const f32x4*)(xr + (size_t)row * D + 4 * lane + 256 * j);
    }
    for (; row < NR; row += nb * NWAVES) {
        const int s = row_mod(row); const float* g2 = modp(p, l, s, 5);
        size_t slot[4];
#pragma unroll
        for (int k = 0; k < 4; ++k) slot[k] = (size_t)(pstart[ce[k]] + cp[k]);
        u32x2 yv[4][4];
#pragma unroll
        for (int k = 0; k < 4; ++k)
#pragma unroll
            for (int j = 0; j < 4; ++j) yv[k][j] = *(const u32x2*)(yb + slot[k] * D + 4 * lane + 256 * j);
        float w4[4]; f32x4 xc[4];
#pragma unroll
        for (int k = 0; k < 4; ++k) w4[k] = cw[k];
#pragma unroll
        for (int j = 0; j < 4; ++j) xc[j] = xv[j];
        const int rown = row + nb * NWAVES;
        if (rown < NR) {
#pragma unroll
            for (int k = 0; k < 4; ++k) { ce[k] = tk_e[rown * 4 + k]; cw[k] = tk_w[rown * 4 + k]; cp[k] = tk_pos[rown * 4 + k]; }
#pragma unroll
            for (int j = 0; j < 4; ++j) xv[j] = *(const f32x4*)(xr + (size_t)rown * D + 4 * lane + 256 * j);
        }
        f32x4 a[4];
#pragma unroll
        for (int j = 0; j < 4; ++j) a[j] = (f32x4){0.f, 0.f, 0.f, 0.f};
#pragma unroll
        for (int k = 0; k < 4; ++k) {
            const float w = w4[k];
#pragma unroll
            for (int j = 0; j < 4; ++j) { const u32x2 y = yv[k][j];
                a[j].x += w * bf2f((bf16_t)(y.x & 0xffff)); a[j].y += w * bf2f((bf16_t)(y.x >> 16)); a[j].z += w * bf2f((bf16_t)(y.y & 0xffff)); a[j].w += w * bf2f((bf16_t)(y.y >> 16)); }
        }
        f32x4 v[4];
#pragma unroll
        for (int j = 0; j < 4; ++j) { const int k = 4 * lane + 256 * j; v[j] = xc[j] + *(const f32x4*)(g2 + k) * a[j]; }
        if (l == 0) {
#pragma unroll
            for (int j = 0; j < 4; ++j) *(f32x4*)(xr + (size_t)row * D + 4 * lane + 256 * j) = v[j];
            norm_store(v, p.norm1 + D, modp(p, 1, s, 1), modp(p, 1, s, 0), hbf + (size_t)row * (INP_FP8 == 1 ? D / 2 : D), p.ws + OFF_HQ + (size_t)row * D, lane);
        } else if (row < TL) {
            float ss = 0.f;
#pragma unroll
            for (int j = 0; j < 4; ++j) ss += (v[j].x * v[j].x + v[j].y * v[j].y) + (v[j].z * v[j].z + v[j].w * v[j].w);
            const float rstd = rsqrtf(wave_sum(ss) * (1.f / D) + 1e-6f);
#pragma unroll
            for (int j = 0; j < 4; ++j) { const int k = 4 * lane + 256 * j; *(f32x4*)(p.out + (size_t)row * D + k) = v[j] * rstd * *(const f32x4*)(p.final_norm + k); }
        }
    }
}

namespace pg {
#define LAS __attribute__((address_space(3)))
constexpr int BM = 256, BK = 64, HALF = 128, HTB = HALF * BK * 2, STAGE_BYTES = 8 * HTB, NXCD = 8, WGM = 4;
DEV int lds_byte(int r, int c) { const int st = (r >> 4) * 2 + (c >> 5), rr = r & 15, cc = c & 31, ob = rr * 64 + cc * 2; return st * 1024 + (ob ^ (((ob >> 9) & 1) << 5)); }
DEV int perm32(int rho) { const int n = rho >> 4, i = rho & 15; return 8 * (i >> 2) + 4 * n + (i & 3); }
DEV void stage_rc(int b, int& R, int& C) { const int st = b / 1024, sb = b % 1024, swz = sb ^ (((sb >> 9) & 1) << 5); R = (st >> 1) * 16 + swz / 64; C = (st & 1) * 32 + (swz % 64) / 2; }
typedef int i32x8 __attribute__((ext_vector_type(8)));
typedef int i32x4v __attribute__((ext_vector_type(4)));
DEV i32x8 cat8(const bf16x8 a, const bf16x8 b) { const i32x4v x = __builtin_bit_cast(i32x4v, a), y = __builtin_bit_cast(i32x4v, b); return __builtin_shufflevector(x, y, 0, 1, 2, 3, 4, 5, 6, 7); }
DEV void mfma_q(f32x4& acc, const i32x8 b, const i32x8 a, const int one) {
    asm volatile("v_mfma_scale_f32_16x16x128_f8f6f4 %0, %1, %2, %0, %3, %3 op_sel_hi:[0,0,0]" : "+v"(acc) : "v"(b), "v"(a), "v"(one));
}
struct Unit { const char* aMat; const char* bBase; int pm, pn, kind, nt, perm, bslot; };
DEV void tile_from_L(int Lg, int nM, int nN, int& pm, int& pn) {
    const int nwg = nM * nN; int wgid = Lg; { const int q = nwg / NXCD, r = nwg % NXCD, xcd = wgid % NXCD, off = wgid / NXCD; wgid = (xcd < r ? xcd * (q + 1) : r * (q + 1) + (xcd - r) * q) + off; }
    const int nig = WGM * nN, gid = wgid / nig, fm = gid * WGM, gsz = (nM - fm) < WGM ? (nM - fm) : WGM;
    pm = fm + ((wgid % nig) % gsz); pn = (wgid % nig) / gsz;
}
template <class Epi, class Sched>
DEV void gemm_phase(LAS unsigned char* lds, const Sched& S, const Epi& E, const int ldb, const int wvx) {
    constexpr bool FP8 = Sched::FP8;
    constexpr int PERMC = Sched::PERMC;
    constexpr bool GATHER = Sched::GATHER;
    const int tid = TID, wid = __builtin_amdgcn_readfirstlane(tid >> 6), lane = tid & 63, wr = wid >> 2, wc = wid & 3, fr = lane & 15, fq = lane >> 4;
    unsigned voffB[2], voffBp[2], voffA[2];
#pragma unroll
    for (int i = 0; i < 2; ++i) { int R_, C_; stage_rc(tid * 16 + i * 8192, R_, C_); voffB[i] = (unsigned)(R_ * ldb + C_) * 2u; voffA[i] = (unsigned)(R_ * ldb + C_) * 2u;
        voffBp[i] = (unsigned)(((R_ & ~31) + perm32(R_ & 31)) * ldb + C_) * 2u; }
    const size_t kstep = (size_t)(BK * 2);
    const size_t hstepB = (size_t)HALF * ldb * 2;
    const unsigned ldsw = (unsigned)wid * 1024u;
    const int aoff = lds_byte(wr * 64 + fr, fq * 8), boff = lds_byte(wc * 32 + fr, fq * 8);
#define PG_SA(b, h) (((b) * 2 + (h)) * HTB)
#define PG_SB(b, h) ((4 + (b) * 2 + (h)) * HTB)
#define PG_STAGE(bufoff, gbase, voff) do { const char* gb_ = (const char*)(gbase); asm("" : "+s"(gb_));   _Pragma("unroll") for (int _i = 0; _i < 2; ++_i) { \
        unsigned vo_ = (voff)[_i]; asm volatile("" : "+v"(vo_)); __builtin_amdgcn_global_load_lds((const unsigned*)(gb_ + vo_), (LAS unsigned*)(lds + (bufoff) + ldsw + _i * 8192), 16, 0, 0); } } while (0)
#define PG_STAGE_A(bufoff, gbase, h, og) do { if constexpr (GATHER) PG_STAGE(bufoff, gbase, (og)[h]); else PG_STAGE(bufoff, (gbase) + (h) * hstepB, voffA); } while (0)
#define PG_LDA(dst, b, h) do { _Pragma("unroll") for (int m = 0; m < 4; ++m) _Pragma("unroll") for (int k = 0; k < 2; ++k) dst[m][k] = *(const LAS bf16x8*)(lds + PG_SA(b, h) + aoff + m * 2048 + k * 1024); } while (0)
#define PG_LDB(dst, b, h) do { _Pragma("unroll") for (int n = 0; n < 2; ++n) _Pragma("unroll") for (int k = 0; k < 2; ++k) dst[n][k] = *(const LAS bf16x8*)(lds + PG_SB(b, h) + boff + n * 2048 + k * 1024); } while (0)
#define PG_MMA(ai, bj, At, Bt) do { __builtin_amdgcn_s_setprio(1); if constexpr (FP8) { _Pragma("unroll") for (int m = 0; m < 4; ++m) _Pragma("unroll") for (int n = 0; n < 2; ++n) \
        mfma_q(acc[ai][bj][m][n], cat8(Bt[n][0], Bt[n][1]), cat8(At[m][0], At[m][1]), qone); } \
        else { _Pragma("unroll") for (int m = 0; m < 4; ++m) _Pragma("unroll") for (int n = 0; n < 2; ++n) _Pragma("unroll") for (int k = 0; k < 2; ++k) \
        acc[ai][bj][m][n] = __builtin_amdgcn_mfma_f32_16x16x32_bf16(Bt[n][k], At[m][k], acc[ai][bj][m][n], 0, 0, 0); } __builtin_amdgcn_s_setprio(0); } while (0)
#define PG_WAIT_V(n) asm volatile("s_waitcnt vmcnt(" #n ")" ::: "memory")
#define PG_WAIT_L(n) asm volatile("s_waitcnt lgkmcnt(" #n ")" ::: "memory")
#define PG_BAR __builtin_amdgcn_s_barrier()
#define PG_SCHED __builtin_amdgcn_sched_barrier(0)
    Unit cur, nxt; int ui = 0;
    constexpr bool DYN = Sched::DYN;
    volatile LAS int* dslot = (volatile LAS int*)(lds + 131072 + 1024);
    if constexpr (DYN) {
        if (tid == 0) dslot[0] = S.grab();
        __syncthreads();
        const int L0 = __builtin_amdgcn_readfirstlane(dslot[0]);
        __syncthreads();
        if (!S.decode(L0, cur)) return;
    } else { if (!S.next(0, cur)) return; }
    int qone = 0x7F7F7F7F; if constexpr (FP8) asm volatile("" : "+v"(qone));
    LAS unsigned char* bslots = lds + 131072 + 4096;
    cur.bslot = 0;
    if constexpr (Epi::BIASL) { if (wid == 0) __builtin_amdgcn_global_load_lds((const unsigned*)E.bias_src(cur, lane), (LAS unsigned*)(bslots), 16, 0, 0); }
    f32x4 acc[2][2][4][2];
#pragma unroll
    for (int a = 0; a < 2; ++a)
#pragma unroll
        for (int b = 0; b < 2; ++b)
#pragma unroll
            for (int m = 0; m < 4; ++m)
#pragma unroll
                for (int n = 0; n < 2; ++n) acc[a][b][m][n] = (f32x4){0.f, 0.f, 0.f, 0.f};
    bf16x8 At[4][2], B0[2][2], B1[2][2];
    unsigned offC[2][2], offK[2][2];
    constexpr bool KEEPK = GATHER && !FP8;
    if constexpr (GATHER) { S.aoff(cur, tid, offC);
        if constexpr (KEEPK) {
#pragma unroll
        for (int h = 0; h < 2; ++h)
#pragma unroll
            for (int i = 0; i < 2; ++i) offK[h][i] = offC[h][i]; } }
    const char* cA = cur.aMat; const char* cB = cur.bBase;
    unsigned vbc[2];
#pragma unroll
    for (int i = 0; i < 2; ++i) vbc[i] = PERMC == 0 ? voffB[i] : PERMC == 1 ? voffBp[i] : cur.perm ? voffBp[i] : voffB[i];
    PG_STAGE(PG_SB(0, 0), cB, vbc); PG_STAGE(PG_SB(0, 1), cB + hstepB, vbc); PG_STAGE_A(PG_SA(0, 0), cA, 0, offC); PG_STAGE_A(PG_SA(0, 1), cA, 1, offC);
    if (wr == 1) PG_BAR;
    PG_WAIT_V(2); PG_BAR;
    PG_STAGE(PG_SB(1, 0), cB + kstep, vbc); PG_STAGE_A(PG_SA(1, 0), cA + kstep, 0, offC); PG_STAGE(PG_SB(1, 1), cB + hstepB + kstep, vbc);
    PG_WAIT_V(6); PG_BAR;
    for (;;) {
        bool has_next = false; const char* nA = cA; const char* nB = cB; int tk_ = 0;
        if constexpr (DYN) { if (tid == 0) tk_ = S.grab(); }
        else { has_next = S.next(ui + 1, nxt); nA = has_next ? nxt.aMat : cA; nB = has_next ? nxt.bBase : cB; }
        nxt.bslot = cur.bslot == 2 ? 0 : cur.bslot + 1;
        if constexpr (Epi::BIASL && !DYN) { if (has_next && wid == 0) __builtin_amdgcn_global_load_lds((const unsigned*)E.bias_src(nxt, lane), (LAS unsigned*)(bslots + nxt.bslot * 1024), 16, 0, 0); }
        const int nt = cur.nt;
        for (int t = 0; t < nt; t += 2) {
            const bool last = (t == nt - 2);
            if constexpr (DYN) {
                if (t == 2) { if (tid == 0) dslot[(ui + 1) & 1] = tk_; }
                if (t == 4) { const int Ln = __builtin_amdgcn_readfirstlane(dslot[(ui + 1) & 1]); has_next = S.decode(Ln, nxt); nA = has_next ? nxt.aMat : cA; nB = has_next ? nxt.bBase : cB; }
            }
            if constexpr (Epi::HAS_MID) { if (t == 8 || t == 12) E.mid(acc, cur, t, wr, wc, fr, fq); }
            const char* a1 = cA + (size_t)(t + 1) * kstep;
            const char* a2 = last ? nA : cA + (size_t)(t + 2) * kstep; const char* b2 = last ? nB : cB + (size_t)(t + 2) * kstep;
            const char* a3 = a2 + kstep; const char* b3 = b2 + kstep;
            unsigned vb2[2];
            { const int pf_ = (last && has_next) ? nxt.perm : cur.perm;
#pragma unroll
              for (int i = 0; i < 2; ++i) vb2[i] = PERMC == 0 ? voffB[i] : PERMC == 1 ? voffBp[i] : pf_ ? voffBp[i] : voffB[i]; }
            unsigned o2[2][2];
            if constexpr (GATHER) {
                if (last && has_next) { S.aoff(nxt, tid, o2);
                    if constexpr (KEEPK) {
#pragma unroll
                    for (int h = 0; h < 2; ++h)
#pragma unroll
                        for (int i = 0; i < 2; ++i) offK[h][i] = o2[h][i]; } }
                else {
#pragma unroll
                    for (int h = 0; h < 2; ++h)
#pragma unroll
                        for (int i = 0; i < 2; ++i) o2[h][i] = offC[h][i];
                }
            }
            PG_LDB(B0, 0, 0); PG_LDB(B1, 0, 1); PG_SCHED; PG_LDA(At, 0, 0); PG_STAGE_A(PG_SA(1, 1), a1, 1, offC);
            PG_WAIT_V(8); PG_WAIT_L(0); PG_BAR; PG_MMA(0, 0, At, B0); PG_MMA(0, 1, At, B1); PG_BAR; PG_SCHED;
            PG_LDA(At, 0, 1); PG_STAGE(PG_SB(0, 0), b2, vb2); PG_STAGE(PG_SB(0, 1), b2 + hstepB, vb2); PG_STAGE_A(PG_SA(0, 0), a2, 0, o2);
            PG_WAIT_V(8); PG_WAIT_L(0); PG_BAR; PG_MMA(1, 0, At, B0); PG_MMA(1, 1, At, B1); PG_BAR; PG_SCHED;
            PG_LDB(B0, 1, 0); PG_LDB(B1, 1, 1); PG_SCHED; PG_LDA(At, 1, 0); PG_STAGE_A(PG_SA(0, 1), a2, 1, o2);
            PG_WAIT_V(8); PG_WAIT_L(0); PG_BAR; PG_MMA(0, 0, At, B0); PG_MMA(0, 1, At, B1); PG_BAR; PG_SCHED;
            PG_LDA(At, 1, 1); PG_STAGE(PG_SB(1, 0), b3, vb2); PG_STAGE(PG_SB(1, 1), b3 + hstepB, vb2); PG_STAGE_A(PG_SA(1, 0), a3, 0, o2);
            PG_WAIT_V(8); PG_WAIT_L(0); PG_BAR; PG_MMA(1, 0, At, B0); PG_MMA(1, 1, At, B1); PG_BAR; PG_SCHED;
        }
        if (wr == 0) PG_BAR;
        if constexpr (FP8) asm volatile("s_nop 15\n\ts_nop 7" ::: "memory");
        if constexpr (Epi::ACCS != 1.f) {
#pragma unroll
            for (int a = 0; a < 2; ++a)
#pragma unroll
                for (int b = 0; b < 2; ++b)
#pragma unroll
                    for (int m = 0; m < 4; ++m)
#pragma unroll
                        for (int n = 0; n < 2; ++n) acc[a][b][m][n] *= Epi::ACCS; }
        E(acc, cur, wr, wc, fr, fq);
        if (!has_next) break;
#pragma unroll
        for (int a = 0; a < 2; ++a)
#pragma unroll
            for (int b = 0; b < 2; ++b)
#pragma unroll
                for (int m = 0; m < 4; ++m)
#pragma unroll
                    for (int n = 0; n < 2; ++n) acc[a][b][m][n] = (f32x4){0.f, 0.f, 0.f, 0.f};
        cur = nxt; cA = nA; cB = nB; ++ui;
        if constexpr (KEEPK) {
#pragma unroll
            for (int h = 0; h < 2; ++h)
#pragma unroll
                for (int i = 0; i < 2; ++i) offC[h][i] = offK[h][i]; }
        else if constexpr (GATHER) S.aoff(cur, tid, offC);
        if (wr == 1) PG_BAR;
    }
    PG_WAIT_V(0);
    PG_BAR;
#undef PG_SA
#undef PG_SB
#undef PG_STAGE
#undef PG_STAGE_A
#undef PG_LDA
#undef PG_LDB
#undef PG_MMA
#undef PG_WAIT_V
#undef PG_WAIT_L
#undef PG_BAR
#undef PG_SCHED
}
}

DEV __amdgpu_buffer_rsrc_t mk_rsrc(const void* ptr, unsigned bytes) { return __builtin_amdgcn_make_buffer_rsrc((void*)ptr, (short)0, (int)bytes, 0x00020000); }
DEV void st_bf16x4(__amdgpu_buffer_rsrc_t rs, int voff, int soff, const f32x4 v) { u32x2 w; w.x = pk2(v[0], v[1]); w.y = pk2(v[2], v[3]); __builtin_amdgcn_raw_buffer_store_b64(w, rs, voff, soff, 0); }
DEV void stg_bf16x8(bf16_t* ptr, const f32x4 a, const f32x4 b) { u32x4 w; w.x = pk2(a[0], a[1]); w.y = pk2(a[2], a[3]); w.z = pk2(b[0], b[1]); w.w = pk2(b[2], b[3]); *(u32x4*)ptr = w; }
DEV f32x4 ld_bf16x4(const bf16_t* ptr) { const u32x2 w = *(const u32x2*)ptr; return (f32x4){bf2f((bf16_t)(w.x & 0xffff)), bf2f((bf16_t)(w.x >> 16)), bf2f((bf16_t)(w.y & 0xffff)), bf2f((bf16_t)(w.y >> 16))}; }

struct SchedA {
    const char* hbf; const char* wtin; const char* wtt; int G, c;
    static constexpr bool GATHER = false, FP8 = INP_FP8 == 1; static constexpr int PERMC = -1; static constexpr bool DYN = false;
    static constexpr int DR = FP8 ? D / 2 : D;
    static constexpr int NM = TA / 256, NN = NIN / 256 - 1, N1 = NM * NN, N2 = 3 * NM;
    DEV bool next(int i, pg::Unit& u) const {
        const int Lg = i * G + c; if (Lg >= N1 + N2) return false;
        u.nt = FP8 ? 8 : 16;
        if (Lg < N1) { pg::tile_from_L(Lg, NM, NN, u.pm, u.pn); if (u.pn >= 6) ++u.pn; u.kind = 0; u.perm = (u.pn == 3 || u.pn >= 6) ? 1 : 0; u.aMat = hbf + (size_t)u.pm * 256 * DR * 2; u.bBase = wtin + (size_t)u.pn * 256 * DR * 2; }
        else { const int r = Lg - N1; u.pm = r % 3; u.pn = r / 3; u.kind = 1; u.perm = 0; u.aMat = wtt + (size_t)u.pm * 256 * DR * 2; u.bBase = hbf + (size_t)u.pn * 256 * DR * 2; }
        return true;
    }
    DEV void aoff(const pg::Unit& u, const int tid, unsigned (&off)[2][2]) const {
        int R[2], C[2];
#pragma unroll
        for (int i = 0; i < 2; ++i) pg::stage_rc(tid * 16 + i * 8192, R[i], C[i]);
#pragma unroll
        for (int h = 0; h < 2; ++h)
#pragma unroll
            for (int i = 0; i < 2; ++i) off[h][i] = (unsigned)((u.pm * 256 + h * 128 + R[i]) * D + C[i]) * 2u;
    }
};
struct EpiA {
    static constexpr bool HAS_MID = false, BIASL = false; static constexpr float ACCS = INP_FP8 == 1 ? 1.f / QW : 1.f;
    const P& p; int l;
    DEV void operator()(const f32x4 (&acc)[2][2][4][2], const pg::Unit& u, int wr, int wc, int fr, int fq) const {
        if (u.kind == 0) {
            const __amdgpu_buffer_rsrc_t rs = mk_rsrc(p.ws + OFF_PROJ, (unsigned)((size_t)TA * NIN * 2));
            const bool isctx = u.pm * 256 >= TL;
            const f32x2* taba = (const f32x2*)(p.ws + OFF_TABA); const f32x2* tabr = (const f32x2*)(p.ws + OFF_TABR);
            if (u.perm) {
#pragma unroll
                for (int bj = 0; bj < 2; ++bj) {
                    const int cb = u.pn * 256 + bj * 128;
                    const int reg = cb < C_RGF ? 1 : cb < C_GA ? 3 : 4;
#pragma unroll
                    for (int ai = 0; ai < 2; ++ai)
#pragma unroll
                        for (int m = 0; m < 4; ++m) {
                            f32x4 o1 = acc[ai][bj][m][0], o2 = acc[ai][bj][m][1];
                            if (reg == 3) {
#pragma unroll
                                for (int i = 0; i < 4; ++i) { o1[i] = siluf_(o1[i]); o2[i] = siluf_(o2[i]); }
                            } else if (reg == 4) {
#pragma unroll
                                for (int i = 0; i < 4; ++i) { o1[i] = sigmoidf_(o1[i]); o2[i] = sigmoidf_(o2[i]); }
                            }
                            stg_bf16x8((bf16_t*)(p.ws + OFF_PROJ) + (size_t)(u.pm * 256 + ai * 128 + wr * 64 + m * 16 + fr) * NIN + cb + wc * 32 + 8 * fq, o1, o2);
                        }
                }
            } else {
#pragma unroll
            for (int bj = 0; bj < 2; ++bj) {
                const int cb = u.pn * 256 + bj * 128;
                const int reg = cb < C_V ? 0 : cb < C_RQ ? 1 : cb < C_RV ? 2 : cb < C_RGF ? 1 : cb < C_GA ? 3 : 4;
#pragma unroll
                for (int ai = 0; ai < 2; ++ai)
#pragma unroll
                    for (int m = 0; m < 4; ++m) {
                        const int row = u.pm * 256 + ai * 128 + wr * 64 + m * 16 + fr, pos = isctx ? 0 : (row & (L - 1));
                        f32x4 x1 = acc[ai][bj][m][0], x2 = acc[ai][bj][m][1], o1, o2;
                        if (reg == 0 || reg == 2) {
                            const f32x2* tp = reg == 0 ? ((wc & 1) ? taba + 256 * 16 + (pos & 63) * 16 : taba + (pos >> 6) * 16) + 4 * fq : tabr + pos * 32 + (wc & 1) * 16 + 4 * fq;
                            const f32x4 t0 = *(const f32x4*)tp, t1 = *(const f32x4*)(tp + 2);
                            const f32x4 cs = (f32x4){t0[0], t0[2], t1[0], t1[2]}, sn = (f32x4){t0[1], t0[3], t1[1], t1[3]};
                            o1 = x1 * cs - x2 * sn; o2 = x1 * sn + x2 * cs;
                            if (reg == 0 && cb < C_K) { o1 = o1 * (0.125f * LOG2E); o2 = o2 * (0.125f * LOG2E); }
                            else if (reg == 2 && cb >= C_RK) { o1 = o1 * 0.125f; o2 = o2 * 0.125f; }
                        } else if (reg == 1) { o1 = x1; o2 = x2; }
                        else if (reg == 3) {
#pragma unroll
                            for (int i = 0; i < 4; ++i) { o1[i] = siluf_(x1[i]); o2[i] = siluf_(x2[i]); }
                        } else {
#pragma unroll
                            for (int i = 0; i < 4; ++i) { o1[i] = sigmoidf_(x1[i]); o2[i] = sigmoidf_(x2[i]); }
                        }
                        const int so = ((u.pm * 256 + ai * 128 + m * 16) * NIN + cb) * 2;
                        st_bf16x4(rs, ((wr * 64 + fr) * NIN + wc * 32 + 4 * fq) * 2, so, o1);
                        st_bf16x4(rs, ((wr * 64 + fr) * NIN + wc * 32 + 4 * fq) * 2, so + 32, o2);
                    }
            }
            }
        } else {
            bf16_t* projT = (bf16_t*)(p.ws + OFF_PROJT);
            if (u.pm < 2) {
#pragma unroll
                for (int ai = 0; ai < 2; ++ai) {
                    if (u.pm == 0 && ai == 1) continue;
#pragma unroll
                    for (int m = 0; m < 4; ++m) {
                        const int row = u.pm * 256 + ai * 128 + wr * 64 + m * 16 + fr;
#pragma unroll
                        for (int bj = 0; bj < 2; ++bj)
#pragma unroll
                            for (int n = 0; n < 2; ++n) {
                                const int tok = u.pn * 256 + bj * 128 + wc * 32 + 16 * n + 4 * fq; const f32x4 v = acc[ai][bj][m][n];
                                u32x2 w; w.x = pk2(v[0], v[1]); w.y = pk2(v[2], v[3]);
                                *(u32x2*)(projT + (size_t)row * TA + tok) = w;
                            }
                    }
                }
            } else {
                const float* tcos = (const float*)(p.ws + OFF_TABRT); const float* tsin = tcos + (size_t)32 * L;
                const __amdgpu_buffer_rsrc_t rsT = __builtin_amdgcn_make_buffer_rsrc((void*)projT, (short)0, (int)(TROWS * TA * 2), 0x00020000);
                const int voT = ((wr * 64 + fr) * TA + wc * 32 + 4 * fq) * 2, sbase = u.pn * 256;
#pragma unroll
                for (int bj = 0; bj < 2; ++bj)
#pragma unroll
                    for (int n = 0; n < 2; ++n) {
                        const int tok0 = u.pn * 256 + bj * 128 + wc * 32 + 16 * n + 4 * fq, jj = tok0 & 127; const bool isctx = u.pn * 256 >= TL; const int pos = tok0 & (L - 1);
#pragma unroll
                        for (int ai = 0; ai < 2; ++ai) {
                            const int hh = 2 * ai + wr;
                            const f32x4 wf = *(const f32x4*)((const float*)(p.ws + OFF_TABW) + ((l * 2 + 0) * 4 + hh) * 128 + jj) * 0.125f;
                            const f32x4 wb = *(const f32x4*)((const float*)(p.ws + OFF_TABW) + ((l * 2 + 1) * 4 + hh) * 128 + jj) * 0.125f;
#pragma unroll
                            for (int mp = 0; mp < 2; ++mp) {
                                const int prow = ai * 128 + wr * 64 + mp * 32 + fr, f = mp * 16 + fr;
                                f32x4 cs = (f32x4){1.f, 1.f, 1.f, 1.f}, sn = (f32x4){0.f, 0.f, 0.f, 0.f};
                                if (!isctx) { cs = *(const f32x4*)(tcos + (size_t)f * L + pos); sn = *(const f32x4*)(tsin + (size_t)f * L + pos); }
                                const f32x4 x1 = acc[ai][bj][2 * mp][n], x2 = acc[ai][bj][2 * mp + 1][n];
                                const f32x4 o1 = x1 * cs - x2 * sn, o2 = x1 * sn + x2 * cs;
                                const f32x4 a1 = o1 * wf, a2 = o2 * wf, b1 = o1 * wb, b2 = o2 * wb;
                                u32x2 w; const int so = ((ai * 128 + mp * 32) * TA + sbase + bj * 128 + 16 * n) * 2;
                                w.x = pk2(a1[0], a1[1]); w.y = pk2(a1[2], a1[3]); __builtin_amdgcn_raw_buffer_store_b64(w, rsT, voT, so + (T_RKF * TA) * 2, 0);
                                w.x = pk2(a2[0], a2[1]); w.y = pk2(a2[2], a2[3]); __builtin_amdgcn_raw_buffer_store_b64(w, rsT, voT, so + ((T_RKF + 16) * TA) * 2, 0);
                                w.x = pk2(b1[0], b1[1]); w.y = pk2(b1[2], b1[3]); __builtin_amdgcn_raw_buffer_store_b64(w, rsT, voT, so + (T_RKB * TA) * 2, 0);
                                w.x = pk2(b2[0], b2[1]); w.y = pk2(b2[2], b2[3]); __builtin_amdgcn_raw_buffer_store_b64(w, rsT, voT, so + ((T_RKB + 16) * TA) * 2, 0);
                            }
                        }
                    }
            }
        }
    }
};
template <bool Q>
struct SchedAM {
    const char* hb; const char* wt; const char* wtt; unsigned* ctr; int xcd;
    static constexpr bool GATHER = false, FP8 = Q, DYN = true; static constexpr int PERMC = Q ? 1 : -1;
    static constexpr int DR = Q ? D / 2 : D;
    static constexpr int NM = TA / 256, NN = Q ? 12 : 8, N1 = NM * NN, N2 = Q ? 0 : NM;
    DEV int grab() const { return (int)__hip_atomic_fetch_add(ctr + xcd * 16, 1u, __ATOMIC_RELAXED, __HIP_MEMORY_SCOPE_AGENT); }
    DEV bool decode(int k, pg::Unit& u) const {
        const int Lg = k * 8 + xcd; if (Lg >= N1 + N2) return false;
        u.nt = Q ? 8 : 16;
        if (Lg < N1) { pg::tile_from_L(Lg, NM, NN, u.pm, u.pn); u.kind = 0; u.aMat = hb + (size_t)u.pm * 256 * DR * 2;
            if (Q) { u.bBase = wt + (size_t)u.pn * 256 * DR * 2; u.pn += 9; u.perm = 1; }
            else { if (u.pn >= 6) ++u.pn; u.perm = (u.pn == 3 || u.pn >= 6) ? 1 : 0; u.bBase = wt + (size_t)u.pn * 256 * DR * 2; } }
        else { const int r = Lg - N1; u.pm = 1; u.pn = r; u.kind = 1; u.perm = 0; u.aMat = wtt + (size_t)u.pm * 256 * DR * 2; u.bBase = hb + (size_t)u.pn * 256 * DR * 2; }
        return true;
    }
    DEV bool next(int i, pg::Unit& u) const { return false; }
    DEV void aoff(const pg::Unit& u, const int tid, unsigned (&off)[2][2]) const { off[0][0] = off[0][1] = off[1][0] = off[1][1] = 0u; }
};
struct EpiAQ : EpiA { static constexpr float ACCS = 1.f / QW; };
#ifndef NCONV_
#define NCONV_ 96
#endif
constexpr int NCONV = NCONV_;
DEV void stage_inproj_mixed(const P& p, int l, int bid, int nb, unsigned char* lds, int wvx) {
    unsigned* ctr = (unsigned*)(p.ws + OFF_CTL) + CW_DYN + l * 256;
    if (NCONV > 0 && bid >= nb - NCONV) { stage_prep_experts(p, l, bid - (nb - NCONV), NCONV, lds, wvx); __syncthreads(); }
    { SchedAM<false> S{(const char*)(p.ws + OFF_HBF), (const char*)(p.ws + OFF_WTIN) + (size_t)l * NIN * D * 2, (const char*)(p.ws + OFF_WTT) + (size_t)l * 768 * D * 2, ctr, bid & 7};
      EpiA E{p, l};
      pg::gemm_phase<EpiA, SchedAM<false>>((LAS unsigned char*)lds, S, E, D, wvx); }
    __syncthreads();
    { SchedAM<true> S{(const char*)(p.ws + OFF_HQ), (const char*)(p.ws + OFF_WTINQ) + (size_t)l * (NIN - C_GA) * D, nullptr, ctr + 128, bid & 7};
      EpiAQ E{{p, l}};
      pg::gemm_phase<EpiAQ, SchedAM<true>>((LAS unsigned char*)lds, S, E, D / 2, wvx); }
}
DEV void stage_inproj_fast(const P& p, int l, int bid, int nb, unsigned char* lds, int wvx) {
#if INP_FP8 == 2
    stage_inproj_mixed(p, l, bid, nb, lds, wvx); return;
#endif
    SchedA S{(const char*)(p.ws + OFF_HBF), (const char*)(p.ws + OFF_WTIN) + (size_t)l * NIN * SchedA::DR * 2, (const char*)(p.ws + OFF_WTT) + (size_t)l * 768 * SchedA::DR * 2, nb, bid};
    EpiA E{p, l};
    pg::gemm_phase<EpiA, SchedA>((LAS unsigned char*)lds, S, E, SchedA::DR, wvx);
}

DEV void moe_tiles(const P& p, int l, LAS int* tstart, LAS int* cnt, int wvx) {
    const int tid = TID;
    if (tid < 64) {
        unsigned* cntg = (unsigned*)(p.ws + OFF_CTL) + CW_CNT + l * 32;
        const int c = tid < 32 ? (int)__hip_atomic_load(cntg + (tid & 31), __ATOMIC_RELAXED, __HIP_MEMORY_SCOPE_AGENT) : 0;
        const int nt = (c + 255) >> 8; int incl = nt;
#pragma unroll
        for (int o = 1; o < 32; o <<= 1) { const int t = __shfl_up(incl, o); if ((tid & 63) >= o) incl += t; }
        if (tid < 32) { cnt[tid] = c; tstart[tid] = incl - nt; if (tid == 31) tstart[32] = incl; }
    }
    __syncthreads();
}
template <int NN, bool GATHER_, bool FP8_>
struct SchedMoe {
    static constexpr bool GATHER = GATHER_, FP8 = FP8_; static constexpr int PERMC = GATHER_ ? 0 : 1; static constexpr bool DYN = false;
    static constexpr int DR = FP8_ ? D / 2 : D;
    const char* amat; const char* wt; const int* list_tok; const LAS int* tstart; const LAS int* cnt; int G, c;
    DEV bool next(int i, pg::Unit& u) const {
        const int ntile = __builtin_amdgcn_readfirstlane(tstart[32]); const int Lg = i * G + c; if (Lg >= ntile * NN) return false;
        pg::tile_from_L(Lg, ntile, NN, u.pm, u.pn);
        int e = 0;
        for (int j = 1; j < 32; ++j) e = (u.pm >= __builtin_amdgcn_readfirstlane(tstart[j])) ? j : e;
        u.kind = e; u.nt = FP8_ ? 8 : 16; u.perm = GATHER_ ? 0 : 1; u.aMat = GATHER_ ? amat : amat + (size_t)u.pm * 256 * DR * 2; u.bBase = wt + ((size_t)e * NN * 256 + (size_t)u.pn * 256) * DR * 2;
        return true;
    }
    DEV void aoff(const pg::Unit& u, const int tid, unsigned (&off)[2][2]) const {
        int R[2], C[2];
#pragma unroll
        for (int i = 0; i < 2; ++i) pg::stage_rc(tid * 16 + i * 8192, R[i], C[i]);
#pragma unroll
        for (int h = 0; h < 2; ++h)
#pragma unroll
            for (int i = 0; i < 2; ++i) {
                if (GATHER) { const int e = u.kind, ts = __builtin_amdgcn_readfirstlane(tstart[e]), ce = __builtin_amdgcn_readfirstlane(cnt[e]), pos = (u.pm - ts) * 256 + h * 128 + R[i]; const int tok = list_tok[e * CAP + (pos < ce ? pos : ce - 1)]; off[h][i] = (unsigned)(tok * DR + C[i]) * 2u; }
                else off[h][i] = (unsigned)((u.pm * 256 + h * 128 + R[i]) * DR + C[i]) * 2u;
            }
    }
};
struct EpiM1 {
    static constexpr bool HAS_MID = false, BIASL = true; static constexpr float ACCS = 1.f;
    const P& p; int l; LAS unsigned char* bl;
    DEV const float* bias_src(const pg::Unit& u, int lane) const { return p.b1 + ((size_t)l * NEXP + u.kind) * 2048 + 128 * u.pn + (lane < 32 ? 4 * lane : 1024 + 4 * (lane - 32)); }
    DEV void operator()(const f32x4 (&acc)[2][2][4][2], const pg::Unit& u, int wr, int wc, int fr, int fq) const {
        bf16_t* act = (bf16_t*)(p.ws + OFF_ACT);
        const float* b1 = p.b1 + ((size_t)l * NEXP + u.kind) * 2048;
        const int q = fq == 1 ? 2 : fq == 2 ? 1 : fq;
        f32x4 bgv[2], blv[2];
#pragma unroll
        for (int bj = 0; bj < 2; ++bj) { const LAS float* sl = (const LAS float*)(bl + u.bslot * 1024) + 16 * (4 * bj + wc) + 4 * q; bgv[bj] = *(const LAS f32x4*)sl; blv[bj] = *(const LAS f32x4*)(sl + 128); }
        const int hi = fq >> 1;
        const int ccol = 16 * (8 * u.pn + 4 * hi + wc) + 8 * (fq & 1);
        constexpr float S1 = MOE_FP8 >= 1 ? 1.f / QW : 1.f;
#pragma unroll
        for (int ai = 0; ai < 2; ++ai)
#pragma unroll
            for (int m = 0; m < 4; ++m) {
#if MOE_FP8 >= 2
                unsigned q0 = 0, q1 = 0;
#pragma unroll
                for (int bj = 0; bj < 2; ++bj) {
                    f32x4 o;
#pragma unroll
                    for (int i = 0; i < 4; ++i) {
                        float glu = acc[ai][bj][m][0][i] * S1 + bgv[bj][i], lin = acc[ai][bj][m][1][i] * S1 + blv[bj][i];
                        glu = fminf(glu, 7.f); lin = fminf(fmaxf(lin, -7.f), 7.f);
                        o[i] = QA * glu * sigmoidf_(1.702f * glu) * (lin + 1.f);
                    }
                    if (bj == 0) q0 = pk4q(o[0], o[1], o[2], o[3]); else q1 = pk4q(o[0], o[1], o[2], o[3]);
                }
                { const auto r = __builtin_amdgcn_permlane32_swap(q0, q1, false, false); q0 = r[0]; q1 = r[1]; }
                u32x2 wq; wq.x = q0; wq.y = q1;
                *(u32x2*)((unsigned char*)act + (size_t)(u.pm * 256 + ai * 128 + wr * 64 + m * 16 + fr) * D + ccol) = wq;
            }
#else
                unsigned w0[2], w1[2];
#pragma unroll
                for (int bj = 0; bj < 2; ++bj) {
                    f32x4 o;
#pragma unroll
                    for (int i = 0; i < 4; ++i) {
                        float glu = acc[ai][bj][m][0][i] * S1 + bgv[bj][i], lin = acc[ai][bj][m][1][i] * S1 + blv[bj][i];
                        glu = fminf(glu, 7.f); lin = fminf(fmaxf(lin, -7.f), 7.f);
                        o[i] = glu * sigmoidf_(1.702f * glu) * (lin + 1.f);
                    }
                    if (bj == 0) { w0[0] = pk2(o[0], o[1]); w0[1] = pk2(o[2], o[3]); } else { w1[0] = pk2(o[0], o[1]); w1[1] = pk2(o[2], o[3]); }
                }
#pragma unroll
                for (int k = 0; k < 2; ++k) { const auto r = __builtin_amdgcn_permlane32_swap(w0[k], w1[k], false, false); w0[k] = r[0]; w1[k] = r[1]; }
                u32x4 w; w.x = w0[0]; w.y = w0[1]; w.z = w1[0]; w.w = w1[1];
                *(u32x4*)(act + (size_t)(u.pm * 256 + ai * 128 + wr * 64 + m * 16 + fr) * D + ccol) = w;
            }
#endif
    }
};
struct EpiM2 {
    static constexpr bool HAS_MID = false, BIASL = true; static constexpr float ACCS = 1.f;
    const P& p; int l; LAS unsigned char* bl;
    DEV const float* bias_src(const pg::Unit& u, int lane) const { return p.b2 + ((size_t)l * NEXP + u.kind) * D + 256 * u.pn + 4 * lane; }
    DEV void operator()(const f32x4 (&acc)[2][2][4][2], const pg::Unit& u, int wr, int wc, int fr, int fq) const {
        const __amdgpu_buffer_rsrc_t rs = mk_rsrc(p.ws + OFF_YB, (unsigned)((size_t)PMAX * D * 2));
        const float* b2 = p.b2 + ((size_t)l * NEXP + u.kind) * D;
        const int vo = ((wr * 64 + fr) * D + wc * 32 + 8 * fq) * 2;
        f32x4 bv[2][2];
#pragma unroll
        for (int bj = 0; bj < 2; ++bj)
#pragma unroll
            for (int n = 0; n < 2; ++n) bv[bj][n] = *(const LAS f32x4*)((const LAS float*)(bl + u.bslot * 1024) + bj * 128 + wc * 32 + 8 * fq + 4 * n);
#pragma unroll
        for (int bj = 0; bj < 2; ++bj)
#pragma unroll
            for (int ai = 0; ai < 2; ++ai)
#pragma unroll
                for (int m = 0; m < 4; ++m)
                    { constexpr float S2 = MOE_FP8 >= 2 ? 1.f / (QW * QA) : 1.f; const f32x4 a_ = acc[ai][bj][m][0] * S2 + bv[bj][0], b_ = acc[ai][bj][m][1] * S2 + bv[bj][1]; u32x4 w_; w_.x = pk2(a_[0], a_[1]); w_.y = pk2(a_[2], a_[3]); w_.z = pk2(b_[0], b_[1]); w_.w = pk2(b_[2], b_[3]);
                      *(u32x4*)((bf16_t*)(p.ws + OFF_YB) + (size_t)(u.pm * 256 + ai * 128 + wr * 64 + m * 16 + fr) * D + u.pn * 256 + bj * 128 + wc * 32 + 8 * fq) = w_; }
    }
};
DEV void stage_moe1_fast(const P& p, int l, int bid, int nb, unsigned char* lds, int wvx) {
    LAS int* tstart = (LAS int*)((LAS unsigned char*)lds + 131072); LAS int* cnt = tstart + 40;
    moe_tiles(p, l, tstart, cnt, wvx);
    constexpr bool Q = MOE_FP8 >= 1;
    SchedMoe<8, true, Q> S{(const char*)(p.ws + OFF_HBF), (const char*)(p.ws + OFF_WT1) + (size_t)l * NEXP * 2048 * D * (Q ? 1 : 2), (const int*)(p.ws + OFF_TK + (size_t)l * TK_LAYER) + 3 * TA * 4, tstart, cnt, nb, bid};
    EpiM1 E{p, l, (LAS unsigned char*)lds + 131072 + 4096};
    pg::gemm_phase<EpiM1, SchedMoe<8, true, Q>>((LAS unsigned char*)lds, S, E, Q ? D / 2 : D, wvx);
}
DEV void stage_moe2_fast(const P& p, int l, int bid, int nb, unsigned char* lds, int wvx) {
    LAS int* tstart = (LAS int*)((LAS unsigned char*)lds + 131072); LAS int* cnt = tstart + 40;
    moe_tiles(p, l, tstart, cnt, wvx);
    constexpr bool Q = MOE_FP8 >= 2;
    SchedMoe<4, false, Q> S{(const char*)(p.ws + OFF_ACT), (const char*)(p.ws + OFF_WT2) + (size_t)l * NEXP * D * D * (Q ? 1 : 2), nullptr, tstart, cnt, nb, bid};
    EpiM2 E{p, l, (LAS unsigned char*)lds + 131072 + 4096};
    pg::gemm_phase<EpiM2, SchedMoe<4, false, Q>>((LAS unsigned char*)lds, S, E, Q ? D / 2 : D, wvx);
}

struct SchedMerge {
    const char* mix; const char* wtm; int G, c, NM;
    static constexpr bool GATHER = false, FP8 = false; static constexpr int PERMC = -1; static constexpr bool DYN = false;
    static constexpr int NN = D / 256;
    DEV bool next(int i, pg::Unit& u) const {
        const int Lt = i * G + c; if (Lt >= NM * NN) return false;
        pg::tile_from_L(Lt, NM, NN, u.pm, u.pn);
        u.kind = 0; u.nt = 16; u.perm = 1; u.aMat = mix + (size_t)u.pm * 256 * D * 2; u.bBase = wtm + (size_t)u.pn * 256 * D * 2;
        return true;
    }
    DEV void aoff(const pg::Unit& u, const int tid, unsigned (&off)[2][2]) const {}
};
struct EpiMerge {
    static constexpr bool HAS_MID = true, BIASL = false; static constexpr float ACCS = 1.f;
    const P& p;
    DEV void mid(f32x4 (&acc)[2][2][4][2], const pg::Unit& u, int t, int wr, int wc, int fr, int fq) const {
        const bf16_t* proj = (const bf16_t*)(p.ws + OFF_PROJ);
        const int cnum = C_GA + (t == 8 ? 0 : 1024), cden = cnum + 1024;
#pragma unroll
        for (int ai = 0; ai < 2; ++ai)
#pragma unroll
            for (int m = 0; m < 4; ++m) {
                const bf16_t* rowp = proj + (size_t)(u.pm * 256 + ai * 128 + wr * 64 + m * 16 + fr) * NIN + u.pn * 256 + wc * 32 + 8 * fq;
#pragma unroll
                for (int bj = 0; bj < 2; ++bj) {
                    const u32x4 gnw = *(const u32x4*)(rowp + cnum + bj * 128), gdw = *(const u32x4*)(rowp + cden + bj * 128);
                    const unsigned gn_[4] = {gnw.x, gnw.y, gnw.z, gnw.w}, gd_[4] = {gdw.x, gdw.y, gdw.z, gdw.w};
#pragma unroll
                    for (int n = 0; n < 2; ++n)
#pragma unroll
                        for (int i = 0; i < 4; ++i) {
                            const unsigned wn = gn_[2 * n + (i >> 1)], wd = gd_[2 * n + (i >> 1)];
                            const float gnf = bf2f((bf16_t)((i & 1) ? (wn >> 16) : (wn & 0xffff))), gdf = bf2f((bf16_t)((i & 1) ? (wd >> 16) : (wd & 0xffff)));
                            acc[ai][bj][m][n][i] *= gnf * __builtin_amdgcn_rcpf(fmaxf(gdf, 1e-30f));
                        }
                }
            }
    }
    DEV void operator()(const f32x4 (&acc)[2][2][4][2], const pg::Unit& u, int wr, int wc, int fr, int fq) const {
        const bf16_t* proj = (const bf16_t*)(p.ws + OFF_PROJ);
        bf16_t* mo = (bf16_t*)(p.ws + OFF_M);
        u32x4 gw[2][4][2];
#pragma unroll
        for (int ai = 0; ai < 2; ++ai)
#pragma unroll
            for (int m = 0; m < 4; ++m) {
                const bf16_t* rowp = proj + (size_t)(u.pm * 256 + ai * 128 + wr * 64 + m * 16 + fr) * NIN + C_GA + 2048 + u.pn * 256 + wc * 32 + 8 * fq;
#pragma unroll
                for (int bj = 0; bj < 2; ++bj) gw[ai][m][bj] = *(const u32x4*)(rowp + bj * 128);
            }
#pragma unroll
        for (int ai = 0; ai < 2; ++ai)
#pragma unroll
            for (int m = 0; m < 4; ++m)
#pragma unroll
                for (int bj = 0; bj < 2; ++bj) {
                    const u32x4 w = gw[ai][m][bj];
                    const f32x4 g0 = (f32x4){bf2f((bf16_t)(w.x & 0xffff)), bf2f((bf16_t)(w.x >> 16)), bf2f((bf16_t)(w.y & 0xffff)), bf2f((bf16_t)(w.y >> 16))};
                    const f32x4 g1 = (f32x4){bf2f((bf16_t)(w.z & 0xffff)), bf2f((bf16_t)(w.z >> 16)), bf2f((bf16_t)(w.w & 0xffff)), bf2f((bf16_t)(w.w >> 16))};
#if OUT_FP8
                    { const f32x4 a_ = g0 * acc[ai][bj][m][0] * QM, b_ = g1 * acc[ai][bj][m][1] * QM; u32x2 wq; wq.x = pk4q(a_[0], a_[1], a_[2], a_[3]); wq.y = pk4q(b_[0], b_[1], b_[2], b_[3]);
                      *(u32x2*)((unsigned char*)mo + (size_t)(u.pm * 256 + ai * 128 + wr * 64 + m * 16 + fr) * D + u.pn * 256 + bj * 128 + wc * 32 + 8 * fq) = wq; }
#else
                    stg_bf16x8(mo + (size_t)(u.pm * 256 + ai * 128 + wr * 64 + m * 16 + fr) * D + u.pn * 256 + bj * 128 + wc * 32 + 8 * fq, g0 * acc[ai][bj][m][0], g1 * acc[ai][bj][m][1]);
#endif
                }
    }
};
DEV void stage_merge_fast(const P& p, int l, int bid, int nb, unsigned char* lds, int wvx) {
    SchedMerge S{(const char*)(p.ws + OFF_MIX), (const char*)(p.ws + OFF_WTM) + (size_t)l * D * D * 2, nb, bid, TL / 256};
    EpiMerge E{p};
    pg::gemm_phase<EpiMerge, SchedMerge>((LAS unsigned char*)lds, S, E, D, wvx);
}
struct SchedOut {
    const char* a; const char* wt; int G, c, NM;
    static constexpr bool GATHER = false, FP8 = OUT_FP8 != 0; static constexpr int PERMC = 0; static constexpr bool DYN = false;
    static constexpr int NN = D / 256, DR = FP8 ? D / 2 : D;
    DEV bool next(int i, pg::Unit& u) const {
        const int Lt = i * G + c; if (Lt >= NM * NN) return false;
        pg::tile_from_L(Lt, NM, NN, u.pm, u.pn);
        u.kind = 0; u.nt = FP8 ? 8 : 16; u.perm = 0; u.aMat = a + (size_t)u.pm * 256 * DR * 2; u.bBase = wt + (size_t)u.pn * 256 * DR * 2;
        return true;
    }
    DEV void aoff(const pg::Unit& u, const int tid, unsigned (&off)[2][2]) const {
        int R[2], C[2];
#pragma unroll
        for (int i = 0; i < 2; ++i) pg::stage_rc(tid * 16 + i * 8192, R[i], C[i]);
#pragma unroll
        for (int h = 0; h < 2; ++h)
#pragma unroll
            for (int i = 0; i < 2; ++i) off[h][i] = (unsigned)((u.pm * 256 + h * 128 + R[i]) * D + C[i]) * 2u;
    }
};
struct EpiOut {
    static constexpr bool HAS_MID = false, BIASL = false; static constexpr float ACCS = OUT_FP8 ? 1.f / (QW * QM) : 1.f;
    const P& p; int l;
    DEV void operator()(const f32x4 (&acc)[2][2][4][2], const pg::Unit& u, int wr, int wc, int fr, int fq) const {
        float* xr = (float*)(p.ws + OFF_XR);
        const int row00 = u.pm * 256; const int s = row_mod(row00);
        const float* g1 = modp(p, l, s, 2);
        const float* xbase = l == 0 ? (row00 < TL ? p.x : p.ctx - (size_t)TL * D) : xr;
        float sq[8] = {0.f, 0.f, 0.f, 0.f, 0.f, 0.f, 0.f, 0.f};
#pragma unroll
        for (int bj = 0; bj < 2; ++bj)
#pragma unroll
            for (int n = 0; n < 2; ++n) {
                const int c = u.pn * 256 + bj * 128 + wc * 32 + 16 * n + 4 * fq;
                const f32x4 gvn = *(const f32x4*)(g1 + c);
                f32x4 xin[8];
#pragma unroll
                for (int ai = 0; ai < 2; ++ai)
#pragma unroll
                    for (int m = 0; m < 4; ++m) xin[ai * 4 + m] = *(const f32x4*)(xbase + (size_t)(row00 + ai * 128 + wr * 64 + m * 16 + fr) * D + c);
#pragma unroll
                for (int ai = 0; ai < 2; ++ai)
#pragma unroll
                    for (int m = 0; m < 4; ++m) { const f32x4 xn = xin[ai * 4 + m] + gvn * acc[ai][bj][m][n];
                        *(f32x4*)(xr + (size_t)(row00 + ai * 128 + wr * 64 + m * 16 + fr) * D + c) = xn;
                        sq[ai * 4 + m] += (xn.x * xn.x + xn.y * xn.y) + (xn.z * xn.z + xn.w * xn.w); }
            }
        float* rowsq = (float*)(p.ws + OFF_ROWSQ);
#pragma unroll
        for (int i = 0; i < 8; ++i) { float v = sq[i]; v += __shfl_xor(v, 16); v += __shfl_xor(v, 32);
            if (fq == 0) rowsq[(size_t)(row00 + (i >> 2) * 128 + wr * 64 + (i & 3) * 16 + fr) * 16 + u.pn * 4 + wc] = v; }
    }
};
DEV void stage_out_fast(const P& p, int l, int bid, int nb, unsigned char* lds, int wvx) {
    SchedOut S{(const char*)(p.ws + OFF_M), OUT_FP8 ? (const char*)(p.ws + OFF_WTOQ) + (size_t)l * D * D : (const char*)(p.ws + OFF_WTO) + (size_t)l * D * D * 2, nb, bid, TL / 256};
    EpiOut E{p, l};
    pg::gemm_phase<EpiOut, SchedOut>((LAS unsigned char*)lds, S, E, SchedOut::DR, wvx);
}


DEV void stage_merge_ctx(const P& p, int l, int bid, int nb, int wvx) {
    const int tid_ = TID, lane = tid_ & 63, wave = tid_ >> 6, r16 = lane & 15, q4 = lane >> 4;
    const bf16_t* mix = (const bf16_t*)(p.ws + OFF_MIX); const bf16_t* wt = (const bf16_t*)(p.ws + OFF_WTM) + (size_t)l * D * D;
    const bf16_t* proj = (const bf16_t*)(p.ws + OFF_PROJ); bf16_t* mo = (bf16_t*)(p.ws + OFF_M);
    constexpr int TN = D / 32, TM = TC / 32;
    const int gw = bid * NWAVES + wave; if (gw & 3) return;
    for (int t = gw >> 2; t < TM * TN; t += (nb * NWAVES) >> 2) {
        const int tm = t / TN, tn = t % TN, row0 = TL + tm * 32, col0 = tn * 32;
        f32x4 msum[2][2]; zero_acc(msum);
#pragma unroll
        for (int br = 0; br < 3; ++br) {
            const int k0 = br == 0 ? 0 : (br == 1 ? 512 : 768), kl = br == 0 ? 512 : 256;
            f32x4 acc[2][2]; zero_acc(acc);
            mma_tile32(mix + (size_t)(row0 + r16) * D + k0 + 8 * q4, mix + (size_t)(row0 + 16 + r16) * D + k0 + 8 * q4,
                       wt + (size_t)(col0 + r16) * D + k0 + 8 * q4, wt + (size_t)(col0 + 16 + r16) * D + k0 + 8 * q4, kl, acc);
#pragma unroll
            for (int mt = 0; mt < 2; ++mt)
#pragma unroll
                for (int nt = 0; nt < 2; ++nt)
#pragma unroll
                    for (int j = 0; j < 4; ++j) {
                        const int row = row0 + 16 * mt + 4 * q4 + j, col = col0 + 16 * nt + r16;
                        msum[mt][nt][j] += bf2f(proj[(size_t)row * NIN + C_GA + br * 1024 + col]) * acc[mt][nt][j];
                    }
        }
#pragma unroll
        for (int mt = 0; mt < 2; ++mt)
#pragma unroll
            for (int nt = 0; nt < 2; ++nt)
#pragma unroll
                for (int j = 0; j < 4; ++j) mo[(size_t)(row0 + 16 * mt + 4 * q4 + j) * D + col0 + 16 * nt + r16] = f2bf(msum[mt][nt][j]);
    }
}
DEV void stage_out_ctx(const P& p, int l, int bid, int nb, int wvx) {
    const int tid_ = TID, lane = tid_ & 63, wave = tid_ >> 6, r16 = lane & 15, q4 = lane >> 4;
    const bf16_t* mo = (const bf16_t*)(p.ws + OFF_M); const bf16_t* wt = (const bf16_t*)(p.ws + OFF_WTO) + (size_t)l * D * D;
    float* xr = (float*)(p.ws + OFF_XR);
    constexpr int TN = D / 32, TM = TC / 32;
    const int gw = bid * NWAVES + wave; if (gw & 3) return;
    for (int t = gw >> 2; t < TM * TN; t += (nb * NWAVES) >> 2) {
        const int tm = t / TN, tn = t % TN, row0 = TL + tm * 32, col0 = tn * 32;
        f32x4 acc[2][2]; zero_acc(acc);
        mma_tile32(mo + (size_t)(row0 + r16) * D + 8 * q4, mo + (size_t)(row0 + 16 + r16) * D + 8 * q4,
                   wt + (size_t)(col0 + r16) * D + 8 * q4, wt + (size_t)(col0 + 16 + r16) * D + 8 * q4, D, acc);
#pragma unroll
        for (int mt = 0; mt < 2; ++mt)
#pragma unroll
            for (int nt = 0; nt < 2; ++nt)
#pragma unroll
                for (int j = 0; j < 4; ++j) {
                    const int row = row0 + 16 * mt + 4 * q4 + j, col = col0 + 16 * nt + r16;
                    xr[(size_t)row * D + col] = p.ctx[(size_t)(row - TL) * D + col] + modp(p, l, 2, 2)[col] * acc[mt][nt][j];
                }
    }
}

constexpr size_t OFF_SPREV = OFF_ACT;
DEV void chunk_chain(int cidx, int& b, int& nf, int& nbk) {
    if (cidx < 256) { b = cidx >> 7; const int nl = cidx & 127; nf = 2 + nl; nbk = 2 + (127 - nl); }
    else { const int cc = cidx - 256; b = cc >> 1; const int nc = cc & 1; nf = nc; nbk = 1 - nc; }
}
constexpr int RKV_S = 160, RKV_F = 0, RKV_B = 128 * RKV_S;
DEV void stage_ret_kv(const P& p, int l, int bid, int nb, unsigned char* lds_, int wvx) {
    const int tid_ = TID, lane = tid_ & 63, wave = tid_ >> 6, r16 = lane & 15, q4 = lane >> 4;
    LAS unsigned char* lds = (LAS unsigned char*)lds_;
    const bf16_t* proj = (const bf16_t*)(p.ws + OFF_PROJ); const bf16_t* projT = (const bf16_t*)(p.ws + OFF_PROJT); float* kvbuf = (float*)(p.ws + OFF_KV);
    const float* wtab = (const float*)(p.ws + OFF_TABW) + (size_t)(l * 2) * 4 * 128;
    const int nunits = 260 * 4;
    u32x4 pre[2];
#define RKV_LOAD(unit_) do { const int row0_ = ((unit_) >> 2) * 128, h_ = (unit_) & 3; _Pragma("unroll") for (int i_ = 0; i_ < 2; ++i_) { const int pc = tid_ + 512 * i_; \
        pre[i_] = *(const u32x4*)(proj + (size_t)(row0_ + (pc >> 3)) * NIN + C_RK + h_ * 64 + (pc & 7) * 8); } } while (0)
    if (bid < nunits) RKV_LOAD(bid);
    for (int unit = bid; unit < nunits; unit += nb) {
        const int cidx = unit >> 2, h = unit & 3, row0 = cidx * 128;
        __syncthreads();
#pragma unroll
        for (int i = 0; i < 2; ++i) {
            const int pc = tid_ + 512 * i, j = pc >> 3;
            const float wf = wtab[(0 * 4 + h) * 128 + j], wb = wtab[(1 * 4 + h) * 128 + j];
            const unsigned w4[4] = {pre[i].x, pre[i].y, pre[i].z, pre[i].w};
            u32x4 of, ob; unsigned rf[4], rb[4];
#pragma unroll
            for (int k = 0; k < 4; ++k) { const float lo = bf2f((bf16_t)(w4[k] & 0xffff)), hi = bf2f((bf16_t)(w4[k] >> 16)); rf[k] = pk2(lo * wf, hi * wf); rb[k] = pk2(lo * wb, hi * wb); }
            of.x = rf[0]; of.y = rf[1]; of.z = rf[2]; of.w = rf[3]; ob.x = rb[0]; ob.y = rb[1]; ob.z = rb[2]; ob.w = rb[3];
            *(LAS u32x4*)(lds + RKV_F + j * RKV_S + (pc & 7) * 16) = of;
            *(LAS u32x4*)(lds + RKV_B + j * RKV_S + (pc & 7) * 16) = ob;
        }
        __syncthreads();
        if (unit + nb < nunits) RKV_LOAD(unit + nb);
        const int dir = wave >> 2, quad = wave & 3, e0 = (quad >> 1) * 32, d0 = (quad & 1) * 32;
        int b, nf, nbk; chunk_chain(cidx, b, nf, nbk);
        const bf16_t* va = projT + (size_t)(T_RV + h * 64 + e0 + r16) * TA + row0 + 8 * q4;
        const LAS unsigned char* kimg = lds + (dir ? RKV_B : RKV_F) + (8 * q4 + (r16 >> 2)) * RKV_S + (d0 + 4 * (r16 & 3)) * 2;
        f32x4 acc[2][2]; zero_acc(acc);
#pragma unroll
        for (int ks = 0; ks < 4; ++ks) {
            const bf16x8 fa0 = *(const bf16x8*)(va + 32 * ks), fa1 = *(const bf16x8*)(va + (size_t)16 * TA + 32 * ks);
            bf16x8 fb[2];
#pragma unroll
            for (int nt = 0; nt < 2; ++nt) {
                const u32x2 lo = lds_tr16(kimg + 32 * ks * RKV_S + 32 * nt), hi = lds_tr16(kimg + (32 * ks + 4) * RKV_S + 32 * nt);
                u32x4 w; w.x = lo.x; w.y = lo.y; w.z = hi.x; w.w = hi.y; fb[nt] = __builtin_bit_cast(bf16x8, w);
            }
            acc[0][0] = __builtin_amdgcn_mfma_f32_16x16x32_bf16(fa0, fb[0], acc[0][0], 0, 0, 0);
            acc[0][1] = __builtin_amdgcn_mfma_f32_16x16x32_bf16(fa0, fb[1], acc[0][1], 0, 0, 0);
            acc[1][0] = __builtin_amdgcn_mfma_f32_16x16x32_bf16(fa1, fb[0], acc[1][0], 0, 0, 0);
            acc[1][1] = __builtin_amdgcn_mfma_f32_16x16x32_bf16(fa1, fb[1], acc[1][1], 0, 0, 0);
        }
        float* dst = kvbuf + ((size_t)(((b * 4 + h) * 2 + dir) * 130 + (dir ? nbk : nf))) * 4096;
#pragma unroll
        for (int mt = 0; mt < 2; ++mt)
#pragma unroll
            for (int nt = 0; nt < 2; ++nt)
#pragma unroll
                for (int j = 0; j < 4; ++j) dst[(e0 + 16 * mt + 4 * q4 + j) * 64 + d0 + 16 * nt + r16] = acc[mt][nt][j];
    }
    __syncthreads();
#undef RKV_LOAD
}
DEV void stage_ret_scan(const P& p, int l, int bid, int nb, int wvx) {
    const float* kvbuf = (const float*)(p.ws + OFF_KV); unsigned* sprev = (unsigned*)(p.ws + OFF_SPREV);
    for (int gt = bid * NTHREADS + TID; gt < 16 * 2048; gt += nb * NTHREADS) {
        const int chain = gt >> 11, i2 = gt & 2047, h = (chain >> 1) & 3, dir = chain & 1;
        const float gC = __expf(128.f * log_g(p, l, dir, h));
        const f32x2* src = (const f32x2*)(kvbuf + (size_t)chain * 130 * 4096) + i2; unsigned* dst = sprev + (size_t)chain * 130 * 2048 + i2;
        f32x2 s = (f32x2){0.f, 0.f};
        for (int n0 = 0; n0 < 130; n0 += 10) {
            f32x2 kv[10];
#pragma unroll
            for (int u = 0; u < 10; ++u) kv[u] = src[(size_t)(n0 + u) * 2048];
#pragma unroll
            for (int u = 0; u < 10; ++u) { dst[(size_t)(n0 + u) * 2048] = pk2(s.x, s.y); s = s * gC + kv[u]; }
        }
    }
}
DEV bf16x8 pack_b(const f32x4 a, const f32x4 b) {
    u32x4 w; w.x = pk2(a[0], a[1]); w.y = pk2(a[2], a[3]); w.z = pk2(b[0], b[1]); w.w = pk2(b[2], b[3]);
    return __builtin_bit_cast(bf16x8, w);
}
DEV bf16x8 ldv_frag(const bf16_t* rowp  , int q4) {
    const u32x2 a = *(const u32x2*)(rowp + 4 * q4), b = *(const u32x2*)(rowp + 16 + 4 * q4);
    u32x4 w; w.x = a.x; w.y = a.y; w.z = b.x; w.w = b.y; return __builtin_bit_cast(bf16x8, w);
}
constexpr int RO_K = 0, RO_V = 128 * 144, RO_S = RO_V + 64 * 272, RO_END = RO_S + 2 * 64 * 144;
DEV void stage_ret_out(const P& p, int l, int bid, int nb, unsigned char* lds_, int wvx) {
    const int tid_ = TID, lane = tid_ & 63, wave = tid_ >> 6, r16 = lane & 15, q4 = lane >> 4;
    LAS unsigned char* lds = (LAS unsigned char*)lds_;
    const bf16_t* proj = (const bf16_t*)(p.ws + OFF_PROJ); const bf16_t* projT = (const bf16_t*)(p.ws + OFF_PROJT);
    const bf16_t* sprev = (const bf16_t*)(p.ws + OFF_SPREV); bf16_t* mix = (bf16_t*)(p.ws + OFF_MIX);
    const int nunits = (l == 0 ? 260 : 256) * 4;
    u32x4 pre[6];
#define RO_LOAD(unit_) do { const int cidx_ = (unit_) >> 2, h_ = (unit_) & 3, row0_ = cidx_ * 128; int b_, nf_, nbk_; chunk_chain(cidx_, b_, nf_, nbk_); \
        _Pragma("unroll") for (int i_ = 0; i_ < 2; ++i_) { const int pc = tid_ + 512 * i_; \
            pre[i_] = *(const u32x4*)(proj + (size_t)(row0_ + (pc >> 3)) * NIN + C_RK + h_ * 64 + (pc & 7) * 8); \
            pre[2 + i_] = *(const u32x4*)(projT + (size_t)(T_RV + h_ * 64 + (pc >> 4)) * TA + row0_ + (pc & 15) * 8); \
            const int dir_ = pc >> 9, pp = pc & 511; \
            pre[4 + i_] = *(const u32x4*)(sprev + ((size_t)(((b_ * 4 + h_) * 2 + dir_) * 130 + (dir_ ? nbk_ : nf_))) * 4096 + (pp >> 3) * 64 + (pp & 7) * 8); } } while (0)
#define RO_WRITE() do { _Pragma("unroll") for (int i_ = 0; i_ < 2; ++i_) { const int pc = tid_ + 512 * i_; \
            *(LAS u32x4*)(lds + RO_K + (pc >> 3) * 144 + (pc & 7) * 16) = pre[i_]; \
            *(LAS u32x4*)(lds + RO_V + (pc >> 4) * 272 + (pc & 15) * 16) = pre[2 + i_]; \
            const int dir_ = pc >> 9, pp = pc & 511; \
            *(LAS u32x4*)(lds + RO_S + dir_ * 64 * 144 + (pp >> 3) * 144 + (pp & 7) * 16) = pre[4 + i_]; } } while (0)
    for (int unit = bid; unit < nunits; unit += nb) {
        RO_LOAD(unit);
        __syncthreads();
        RO_WRITE();
        __syncthreads();
        const int cidx = unit >> 2, h = unit & 3, row0 = cidx * 128;
        const int irow = row0 + 16 * wave + r16, ii = 16 * wave + r16;
        const float lgf = log_g(p, l, 0, h), lgb = log_g(p, l, 1, h);
        bf16x8 qf[2];
#pragma unroll
        for (int ks = 0; ks < 2; ++ks) qf[ks] = *(const bf16x8*)(proj + (size_t)irow * NIN + C_RQ + h * 64 + 32 * ks + 8 * q4);
        f32x4 st[8];
#pragma unroll
        for (int mt = 0; mt < 8; ++mt) {
            st[mt] = (f32x4){0.f, 0.f, 0.f, 0.f};
#pragma unroll
            for (int ks = 0; ks < 2; ++ks) {
                const bf16x8 kf = *(const LAS bf16x8*)(lds + RO_K + (16 * mt + r16) * 144 + ks * 64 + q4 * 16);
                st[mt] = __builtin_amdgcn_mfma_f32_16x16x32_bf16(kf, qf[ks], st[mt], 0, 0, 0);
            }
        }
        float outv[4][4];
#pragma unroll
        for (int mt = 0; mt < 4; ++mt)
#pragma unroll
            for (int jj = 0; jj < 4; ++jj) outv[mt][jj] = 0.f;
#pragma nounroll
        for (int dir = 0; dir < 2; ++dir) {
            const float lg = dir ? lgb : lgf;
            f32x4 y[4];
#pragma unroll
            for (int mt = 0; mt < 4; ++mt) {
                y[mt] = (f32x4){0.f, 0.f, 0.f, 0.f};
#pragma unroll
                for (int ks = 0; ks < 2; ++ks) {
                    const bf16x8 sf = *(const LAS bf16x8*)(lds + RO_S + dir * 64 * 144 + (16 * mt + r16) * 144 + ks * 64 + q4 * 16);
                    y[mt] = __builtin_amdgcn_mfma_f32_16x16x32_bf16(sf, qf[ks], y[mt], 0, 0, 0);
                }
            }
            const float cs = __expf(lg * (float)(dir ? 128 - ii : ii + 1));
#pragma unroll
            for (int mt = 0; mt < 4; ++mt) y[mt] = y[mt] * cs;
#pragma unroll
            for (int s = 0; s < 4; ++s) {
                f32x4 pa, pb;
#pragma unroll
                for (int jj = 0; jj < 4; ++jj) {
                    const int ja = 32 * s + 4 * q4 + jj, jb = ja + 16;
                    const int da = dir ? ja - ii : ii - ja, db = dir ? jb - ii : ii - jb;
                    pa[jj] = da >= 0 ? st[2 * s][jj] * __expf(lg * (float)da) : 0.f;
                    pb[jj] = db >= 0 ? st[2 * s + 1][jj] * __expf(lg * (float)db) : 0.f;
                }
                const bf16x8 pf = pack_b(pa, pb);
#pragma unroll
                for (int mt = 0; mt < 4; ++mt) {
                    const LAS unsigned char* vp = lds + RO_V + (16 * mt + r16) * 272 + (32 * s + 4 * q4) * 2;
                    const u32x2 va = *(const LAS u32x2*)vp, vb = *(const LAS u32x2*)(vp + 32);
                    u32x4 vw; vw.x = va.x; vw.y = va.y; vw.z = vb.x; vw.w = vb.y;
                    y[mt] = __builtin_amdgcn_mfma_f32_16x16x32_bf16(__builtin_bit_cast(bf16x8, vw), pf, y[mt], 0, 0, 0);
                }
            }
            float sm = 0.f;
#pragma unroll
            for (int mt = 0; mt < 4; ++mt) sm += (y[mt][0] + y[mt][1]) + (y[mt][2] + y[mt][3]);
            sm += __shfl_xor(sm, 16); sm += __shfl_xor(sm, 32);
            const float mu = sm * (1.f / 64.f); float qv = 0.f;
#pragma unroll
            for (int mt = 0; mt < 4; ++mt) { const f32x4 dd = y[mt] - mu; qv += (dd[0] * dd[0] + dd[1] * dd[1]) + (dd[2] * dd[2] + dd[3] * dd[3]); }
            qv += __shfl_xor(qv, 16); qv += __shfl_xor(qv, 32);
            const float rs = rsqrtf(qv * (1.f / 64.f) + 1e-5f);
#pragma unroll
            for (int mt = 0; mt < 4; ++mt) {
                const f32x4 g = ld_bf16x4(proj + (size_t)irow * NIN + (dir ? C_RGB : C_RGF) + h * 64 + 16 * mt + 4 * q4);
#pragma unroll
                for (int jj = 0; jj < 4; ++jj) outv[mt][jj] += (y[mt][jj] - mu) * rs * g[jj];
            }
        }
#pragma unroll
        for (int mt = 0; mt < 4; ++mt) { u32x2 w; w.x = pk2(outv[mt][0], outv[mt][1]); w.y = pk2(outv[mt][2], outv[mt][3]);
            *(u32x2*)(mix + (size_t)irow * D + MX_RET + h * 64 + 16 * mt + 4 * q4) = w; }
    }
    __syncthreads();
#undef RO_LOAD
#undef RO_WRITE
}

#ifndef ATT_THR
#define ATT_THR 11.5f
#endif
constexpr int AT_K = 0, AT_V = 128 * 144, AT_VS = 160, AT_END = AT_V + 128 * AT_VS;
DEV void stage_attn_fast(const P& p, int l, int bid, int nb, unsigned char* lds_, int wvx) {
    const int tid_ = TID, lane = tid_ & 63, wave = tid_ >> 6, r16 = lane & 15, q4 = lane >> 4;
    LAS unsigned char* lds = (LAS unsigned char*)lds_;
    const bf16_t* proj = (const bf16_t*)(p.ws + OFF_PROJ); const bf16_t* projT = (const bf16_t*)(p.ws + OFF_PROJT); bf16_t* mix = (bf16_t*)(p.ws + OFF_MIX);
    constexpr int BIG = 1 << 20;
    constexpr int NQT = 4;
    for (int it = bid; it < (l == 0 ? 520 : 512); it += nb) {
        const int grp = it, g = wave >> 1, hq = wave & 1;
        int hk, qrow0, cbase, nblk = -1, lbase = 0;
        if (grp < 512) { const int b = grp >> 8; nblk = (grp >> 1) & 127; hk = grp & 1; lbase = b * L; qrow0 = lbase + nblk * 128 + 64 * hq; cbase = TL + b * LC; }
        else { const int gg = grp - 512, cb = gg >> 2, qb = (gg >> 1) & 1; hk = gg & 1; qrow0 = TL + cb * LC + qb * 128 + 64 * hq; cbase = TL + cb * LC; }
        const int h = hk * 4 + g;
        bf16x8 qf[NQT][2];
#pragma unroll
        for (int nt = 0; nt < NQT; ++nt)
#pragma unroll
            for (int ks = 0; ks < 2; ++ks) qf[nt][ks] = *(const bf16x8*)(proj + (size_t)(qrow0 + 16 * nt + r16) * NIN + C_Q + h * 64 + 32 * ks + 8 * q4);
        const float sink = p.sinks[l * 8 + h] * LOG2E;
        float mrun[NQT], lrun[NQT];
#pragma unroll
        for (int nt = 0; nt < NQT; ++nt) { mrun[nt] = sink; lrun[nt] = (q4 == 0) ? 1.f : 0.f; }
        f32x4 o[4][NQT];
#pragma unroll
        for (int mt = 0; mt < 4; ++mt)
#pragma unroll
            for (int nt = 0; nt < NQT; ++nt) o[mt][nt] = (f32x4){0.f, 0.f, 0.f, 0.f};
        u32x4 pre[4];
#define AT_CHUNK_OK(c) ((c) == 0 ? nblk >= 1 : (c) == 1 ? nblk >= 0 : (c) == 2 ? (nblk >= 0 && nblk < 127) : true)
#define AT_CHUNK_ROW(c) ((c) < 3 ? lbase + (nblk - 1 + (c)) * 128 : cbase + ((c) - 3) * 128)
#define AT_LOAD(c) do { const int kr_ = AT_CHUNK_ROW(c); _Pragma("unroll") for (int i_ = 0; i_ < 2; ++i_) { const int pc = tid_ + 512 * i_; \
            pre[i_] = *(const u32x4*)(proj + (size_t)(kr_ + (pc >> 3)) * NIN + C_K + hk * 64 + (pc & 7) * 8); \
            pre[2 + i_] = *(const u32x4*)(proj + (size_t)(kr_ + (pc >> 3)) * NIN + C_V + hk * 64 + (pc & 7) * 8); } } while (0)
#define AT_WRITE() do { _Pragma("unroll") for (int i_ = 0; i_ < 2; ++i_) { const int pc = tid_ + 512 * i_; \
            *(LAS u32x4*)(lds + AT_K + (pc >> 3) * 144 + (pc & 7) * 16) = pre[i_]; \
            *(LAS u32x4*)(lds + AT_V + (pc >> 3) * AT_VS + (pc & 7) * 16) = pre[2 + i_]; } } while (0)
        int c = 0; while (c < 5 && !AT_CHUNK_OK(c)) ++c;
        if (c < 5) AT_LOAD(c);
        while (c < 5) {
            int cn = c + 1; while (cn < 5 && !AT_CHUNK_OK(cn)) ++cn;
            __syncthreads();
            AT_WRITE();
            __syncthreads();
            if (cn < 5) AT_LOAD(cn);
            const int clo = c == 0 ? 0 : -BIG, chi = c == 2 ? 0 : BIG;
            const int sb0 = c == 0 ? 2 * hq : 0, sb1 = c == 2 ? 2 * hq + 1 : 3;
            for (int sb = sb0; sb <= sb1; ++sb) {
                const int dl0 = 32 * sb - 64 * hq;
                f32x4 sa[2][NQT];
#pragma unroll
                for (int mt = 0; mt < 2; ++mt) {
                    bf16x8 kf[2];
#pragma unroll
                    for (int ks = 0; ks < 2; ++ks) kf[ks] = *(const LAS bf16x8*)(lds + AT_K + (32 * sb + 16 * mt + r16) * 144 + ks * 64 + q4 * 16);
#pragma unroll
                    for (int nt = 0; nt < NQT; ++nt) {
                        sa[mt][nt] = (f32x4){0.f, 0.f, 0.f, 0.f};
#pragma unroll
                        for (int ks = 0; ks < 2; ++ks) sa[mt][nt] = __builtin_amdgcn_mfma_f32_16x16x32_bf16(kf[ks], qf[nt][ks], sa[mt][nt], 0, 0, 0);
                    }
                }
                bf16x8 pf[NQT];
                float lmax[NQT];
                if (c == 0 || c == 2) {
#pragma unroll
                    for (int nt = 0; nt < NQT; ++nt) {
                        float bm = -1e30f;
#pragma unroll
                        for (int mt = 0; mt < 2; ++mt)
#pragma unroll
                            for (int jj = 0; jj < 4; ++jj) {
                                const int dl = dl0 + 16 * mt + 4 * q4 + jj - (16 * nt + r16);
                                const float sv = (dl >= clo && dl <= chi) ? sa[mt][nt][jj] : -1e30f;
                                sa[mt][nt][jj] = sv; bm = fmaxf(bm, sv);
                            }
                        lmax[nt] = bm;
                    }
                } else {
#pragma unroll
                    for (int nt = 0; nt < NQT; ++nt)
                        lmax[nt] = fmaxf(fmaxf(fmaxf(sa[0][nt][0], sa[0][nt][1]), fmaxf(sa[0][nt][2], sa[0][nt][3])), fmaxf(fmaxf(sa[1][nt][0], sa[1][nt][1]), fmaxf(sa[1][nt][2], sa[1][nt][3])));
                }
                bool need = false;
#pragma unroll
                for (int nt = 0; nt < NQT; ++nt) need = need || (lmax[nt] > mrun[nt] + ATT_THR);
                if (__any(need)) {
#pragma unroll
                    for (int nt = 0; nt < NQT; ++nt) {
                        float bm = lmax[nt];
                        bm = fmaxf(bm, __shfl_xor(bm, 16)); bm = fmaxf(bm, __shfl_xor(bm, 32));
                        const float mn = fmaxf(mrun[nt], bm), sc = __builtin_amdgcn_exp2f(mrun[nt] - mn);
                        mrun[nt] = mn; lrun[nt] *= sc;
#pragma unroll
                        for (int mt = 0; mt < 4; ++mt) o[mt][nt] = o[mt][nt] * sc;
                    }
                }
#pragma unroll
                for (int nt = 0; nt < NQT; ++nt) {
                    float ps = 0.f;
#pragma unroll
                    for (int mt = 0; mt < 2; ++mt)
#pragma unroll
                        for (int jj = 0; jj < 4; ++jj) { const float pe = __builtin_amdgcn_exp2f(sa[mt][nt][jj] - mrun[nt]); sa[mt][nt][jj] = pe; ps += pe; }
                    lrun[nt] += ps;
                    pf[nt] = pack_b(sa[0][nt], sa[1][nt]);
                }
#pragma unroll
                for (int mt = 0; mt < 4; ++mt) {
                    const LAS unsigned char* vp = lds + AT_V + (32 * sb + 4 * q4 + (r16 >> 2)) * AT_VS + (16 * mt + 4 * (r16 & 3)) * 2;
                    const u32x2 va = lds_tr16(vp), vb = lds_tr16(vp + 16 * AT_VS);
                    u32x4 vw; vw.x = va.x; vw.y = va.y; vw.z = vb.x; vw.w = vb.y;
                    const bf16x8 vf = __builtin_bit_cast(bf16x8, vw);
#pragma unroll
                    for (int nt = 0; nt < NQT; ++nt) o[mt][nt] = __builtin_amdgcn_mfma_f32_16x16x32_bf16(vf, pf[nt], o[mt][nt], 0, 0, 0);
                }
            }
            c = cn;
        }
#undef AT_CHUNK_OK
#undef AT_CHUNK_ROW
#undef AT_LOAD
#undef AT_WRITE
#pragma unroll
        for (int nt = 0; nt < NQT; ++nt) {
            float lt = lrun[nt]; lt += __shfl_xor(lt, 16); lt += __shfl_xor(lt, 32);
            const float inv = 1.f / lt;
#pragma unroll
            for (int mt = 0; mt < 4; ++mt) { const f32x4 v = o[mt][nt] * inv; u32x2 w; w.x = pk2(v[0], v[1]); w.y = pk2(v[2], v[3]);
                *(u32x2*)(mix + (size_t)(qrow0 + 16 * nt + r16) * D + MX_ATTN + h * 64 + 16 * mt + 4 * q4) = w; }
        }
    }
    __syncthreads();
}

#define XB_TMO      128
#define XB_XCNT(j)  (256  + 64 * (j))
#define XB_XSUB(j)  (1280 + 64 * (j))
#define XB_XGEN(j)  (2304 + 64 * (j))
#define XB_TOP      3328
#define XB_TOPGEN   3392
#define XCD_BAR_WORDS 3456
#define XB_SPIN_CAP (1u << 18)
__device__ __forceinline__ unsigned xb_ld(unsigned* p)              { return __hip_atomic_load(p, __ATOMIC_RELAXED, __HIP_MEMORY_SCOPE_AGENT); }
__device__ __forceinline__ unsigned xb_add(unsigned* p, unsigned v) { return __hip_atomic_fetch_add(p, v, __ATOMIC_RELAXED, __HIP_MEMORY_SCOPE_AGENT); }
__device__ __forceinline__ unsigned xb_xcc_id() { return (unsigned)__builtin_amdgcn_s_getreg((3 << 11) | 20) & 0xFu; }
#define XB_SPIN(cond, bar) do { unsigned _sp = 0; while (cond) { __builtin_amdgcn_s_sleep(1); \
    if ((++_sp & 255u) == 0u) { if (xb_ld(&(bar)[XB_TMO])) break; if (_sp > XB_SPIN_CAP) { atomicAdd(&(bar)[XB_TMO], 1u); break; } } } } while (0)
struct XcdBarrier { unsigned* bar; unsigned x; volatile LAS unsigned* st; };
__device__ __forceinline__ XcdBarrier xcd_barrier_post(unsigned* bar, volatile LAS unsigned* st, const int wvx) {
    XcdBarrier b; b.bar = bar; b.x = xb_xcc_id(); b.st = st;
    if (TID == 0) (void)xb_add(&bar[XB_XCNT(b.x)], 1u);
    return b;
}
__device__ __forceinline__ void xcd_barrier_complete(unsigned* bar, unsigned x, unsigned& nloc, unsigned& nx) {
    const unsigned G = gridDim.x * gridDim.y * gridDim.z;
    unsigned sum, cnt, mine, sp = 0u;
    for (;;) {
        sum = 0u; cnt = 0u; mine = 0u;
#pragma unroll
        for (unsigned j = 0; j < 16; ++j) { const unsigned c = xb_ld(&bar[XB_XCNT(j)]); sum += c; cnt += (c > 0u) ? 1u : 0u; mine = (j == x) ? c : mine; }
        if (sum == G) break;
        __builtin_amdgcn_s_sleep(1);
        if ((++sp & 255u) == 0u) { if (xb_ld(&bar[XB_TMO])) break; if (sp > XB_SPIN_CAP) { atomicAdd(&bar[XB_TMO], 1u); break; } }
    }
    nloc = mine > 0u ? mine : 1u; nx = cnt > 0u ? cnt : 1u;
}
__device__ __forceinline__ void xcd_barrier(const XcdBarrier& b, const int wvx) {
    asm volatile("s_waitcnt vmcnt(0)" ::: "memory");
    __syncthreads();
    if (TID == 0) {
        unsigned* bar = b.bar;
        __builtin_amdgcn_s_waitcnt(0);
        unsigned nloc = b.st[0], nx = b.st[1];
        if (nloc == 0u) { xcd_barrier_complete(bar, b.x, nloc, nx); b.st[0] = nloc; b.st[1] = nx; }
        const unsigned old = xb_add(&bar[XB_XSUB(b.x)], 1u);
        const unsigned gen = old / nloc;
        if (old + 1u == (gen + 1u) * nloc) {
            __builtin_amdgcn_fence(__ATOMIC_RELEASE, "agent");
            asm volatile("s_waitcnt vmcnt(0)" ::: "memory");
            const unsigned og = xb_add(&bar[XB_TOP], 1u);
            const unsigned tg = og / nx;
            if (og + 1u == (tg + 1u) * nx) xb_add(&bar[XB_TOPGEN], 1u);
            else XB_SPIN(xb_ld(&bar[XB_TOPGEN]) == tg, bar);
            __builtin_amdgcn_fence(__ATOMIC_ACQUIRE, "agent");
            xb_add(&bar[XB_XGEN(b.x)], 1u);
            asm volatile("s_waitcnt vmcnt(0)" ::: "memory");
        } else {
            XB_SPIN(xb_ld(&bar[XB_XGEN(b.x)]) == gen, bar);
            __builtin_amdgcn_fence(__ATOMIC_ACQUIRE, "agent");
            asm volatile("s_waitcnt vmcnt(0)" ::: "memory");
        }
    }
    __syncthreads();
}

constexpr int NPL = 10;
constexpr int NPHASES = 2 + 2 * NPL;
constexpr int CW_BAR = 4096;
constexpr int LDS_BARW = LDS_BYTES - 16;
__global__ void __launch_bounds__(NTHREADS, 2) mk_fwd(P p) {
    extern __shared__ __attribute__((aligned(16))) unsigned char lds[];
    const int bid = blockIdx.x, nb = gridDim.x;
    const int wvx = __builtin_amdgcn_readfirstlane((int)(threadIdx.x >> 6));
    if (TID == 0) { ((volatile LAS unsigned*)(lds + LDS_BARW))[0] = 0u; ((volatile LAS unsigned*)(lds + LDS_BARW))[1] = 0u; }
    __syncthreads();
    const bool multi = (p.ph_hi - p.ph_lo) > 1;
    XcdBarrier bar; bar.bar = (unsigned*)(p.ws + OFF_CTL) + CW_BAR; bar.x = 0; bar.st = (volatile LAS unsigned*)(lds + LDS_BARW);
    if (multi) bar = xcd_barrier_post((unsigned*)(p.ws + OFF_CTL) + CW_BAR, (volatile LAS unsigned*)(lds + LDS_BARW), wvx);
#define IN(k) (p.ph_lo <= (k) && (k) < p.ph_hi)
#define STAGE(call) do { const P& q = p; const int ll = l; call; } while (0)
#define SEAM(k) do { if (IN(k) && IN((k) + 1)) xcd_barrier(bar, wvx); } while (0)
#ifndef PHMASK
#define PHMASK 0xFFFF
#endif
#define PHON(b) ((PHMASK >> (b)) & 1)
#ifndef DUPMASK
#define DUPMASK 0
#endif
#define DUPN(b) (1 + ((DUPMASK >> (b)) & 1))
    if (PHON(0) && IN(0)) { const int l = 0; for (int r_ = 0; r_ < DUPN(0); ++r_) { STAGE(stage_prep(q, bid, nb, lds, wvx)); __syncthreads(); } } SEAM(0);
    if (PHON(1) && IN(1)) { const int l = 0; STAGE(stage_norm0(q, bid, nb, wvx)); } SEAM(1);
    { constexpr int l = 0; const int pb = 2 + l * NPL;
        if (PHON(2) && IN(pb + 0)) { for (int r_ = 0; r_ < DUPN(2); ++r_) { STAGE(stage_inproj_fast(q, ll, bid, nb, lds, wvx)); __syncthreads(); } } SEAM(pb + 0);
        if (PHON(3) && IN(pb + 1)) { for (int r_ = 0; r_ < DUPN(3); ++r_) { if (l == 0) { if (bid >= 8) STAGE(stage_ret_kv(q, ll, bid - 8, nb - 8, lds, wvx)); } else STAGE(stage_ret_kv(q, ll, bid, nb, lds, wvx));     STAGE(stage_attn_fast(q, ll, bid, nb, lds, wvx)); __syncthreads(); } } SEAM(pb + 1);
        if (PHON(4) && IN(pb + 2)) { for (int r_ = 0; r_ < DUPN(4); ++r_) { if (bid < 64) STAGE(stage_ret_scan(q, ll, bid, 64, wvx)); else STAGE(stage_pool_diff(q, ll, bid - 64, nb - 64, wvx));     __syncthreads(); } } SEAM(pb + 2);
        if (PHON(5) && IN(pb + 3)) { for (int r_ = 0; r_ < DUPN(5); ++r_) { STAGE(stage_ret_out(q, ll, bid, nb, lds, wvx)); __syncthreads(); } } SEAM(pb + 3);
        if (PHON(6) && IN(pb + 4)) { for (int r_ = 0; r_ < DUPN(6); ++r_) { STAGE(stage_merge_fast(q, ll, bid, nb, lds, wvx)); if (l == 0) STAGE(stage_merge_ctx(q, ll, bid, nb, wvx)); __syncthreads(); } } SEAM(pb + 4);
        if (PHON(7) && IN(pb + 5)) { STAGE(stage_out_fast(q, ll, bid, nb, lds, wvx)); if (l == 0) STAGE(stage_out_ctx(q, ll, bid, nb, wvx)); } SEAM(pb + 5);
        if (PHON(8) && IN(pb + 6)) { if (INP_FP8 != 2 || NCONV_ == 0) { STAGE(stage_prep_experts(q, ll, bid, nb, lds, wvx)); __syncthreads(); } if (ROUTE_MFMA) STAGE(stage_route_mfma(q, ll, bid, nb, lds, wvx)); else STAGE(stage_route(q, ll, bid, nb, lds, wvx)); } SEAM(pb + 6);
        if (PHON(9) && IN(pb + 7)) { for (int r_ = 0; r_ < DUPN(9); ++r_) { STAGE(stage_moe1_fast(q, ll, bid, nb, lds, wvx)); __syncthreads(); } } SEAM(pb + 7);
        if (PHON(10) && IN(pb + 8)) { for (int r_ = 0; r_ < DUPN(10); ++r_) { STAGE(stage_moe2_fast(q, ll, bid, nb, lds, wvx)); __syncthreads(); } } SEAM(pb + 8);
        if (PHON(11) && IN(pb + 9)) { STAGE(stage_combine(q, ll, bid, nb, lds, wvx)); } SEAM(pb + 9);
     }
    { constexpr int l = 1; const int pb = 2 + l * NPL;
        if (PHON(2) && IN(pb + 0)) { for (int r_ = 0; r_ < DUPN(2); ++r_) { STAGE(stage_inproj_fast(q, ll, bid, nb, lds, wvx)); __syncthreads(); } } SEAM(pb + 0);
        if (PHON(3) && IN(pb + 1)) { for (int r_ = 0; r_ < DUPN(3); ++r_) { if (l == 0) { if (bid >= 8) STAGE(stage_ret_kv(q, ll, bid - 8, nb - 8, lds, wvx)); } else STAGE(stage_ret_kv(q, ll, bid, nb, lds, wvx));     STAGE(stage_attn_fast(q, ll, bid, nb, lds, wvx)); __syncthreads(); } } SEAM(pb + 1);
        if (PHON(4) && IN(pb + 2)) { for (int r_ = 0; r_ < DUPN(4); ++r_) { if (bid < 64) STAGE(stage_ret_scan(q, ll, bid, 64, wvx)); else STAGE(stage_pool_diff(q, ll, bid - 64, nb - 64, wvx));     __syncthreads(); } } SEAM(pb + 2);
        if (PHON(5) && IN(pb + 3)) { for (int r_ = 0; r_ < DUPN(5); ++r_) { STAGE(stage_ret_out(q, ll, bid, nb, lds, wvx)); __syncthreads(); } } SEAM(pb + 3);
        if (PHON(6) && IN(pb + 4)) { for (int r_ = 0; r_ < DUPN(6); ++r_) { STAGE(stage_merge_fast(q, ll, bid, nb, lds, wvx)); if (l == 0) STAGE(stage_merge_ctx(q, ll, bid, nb, wvx)); __syncthreads(); } } SEAM(pb + 4);
        if (PHON(7) && IN(pb + 5)) { STAGE(stage_out_fast(q, ll, bid, nb, lds, wvx)); if (l == 0) STAGE(stage_out_ctx(q, ll, bid, nb, wvx)); } SEAM(pb + 5);
        if (PHON(8) && IN(pb + 6)) { if (INP_FP8 != 2 || NCONV_ == 0) { STAGE(stage_prep_experts(q, ll, bid, nb, lds, wvx)); __syncthreads(); } if (ROUTE_MFMA) STAGE(stage_route_mfma(q, ll, bid, nb, lds, wvx)); else STAGE(stage_route(q, ll, bid, nb, lds, wvx)); } SEAM(pb + 6);
        if (PHON(9) && IN(pb + 7)) { for (int r_ = 0; r_ < DUPN(9); ++r_) { STAGE(stage_moe1_fast(q, ll, bid, nb, lds, wvx)); __syncthreads(); } } SEAM(pb + 7);
        if (PHON(10) && IN(pb + 8)) { for (int r_ = 0; r_ < DUPN(10); ++r_) { STAGE(stage_moe2_fast(q, ll, bid, nb, lds, wvx)); __syncthreads(); } } SEAM(pb + 8);
        if (PHON(11) && IN(pb + 9)) { STAGE(stage_combine(q, ll, bid, nb, lds, wvx)); } SEAM(pb + 9);
     }
#undef IN
#undef SEAM
}

#ifndef MK_CUTS
#define MK_CUTS 1
#endif
extern "C" void kernel_launch(void* const* d_in, const int* in_sizes, int n_in, void* d_out, int out_size, void* d_ws, size_t ws_size, hipStream_t stream) {
    static int grid = 0;
    if (grid == 0) {
        if (n_in != 24 || out_size != TL * D || ws_size < WS_END) { fprintf(stderr, "kernel_launch: unexpected shapes: n_in %d out %d ws %zu (need %zu)\n", n_in, out_size, ws_size, (size_t)WS_END); grid = -1; return; }
        int dev = 0, cus = 0, per_cu = 0;
        if (hipGetDevice(&dev) != hipSuccess || hipDeviceGetAttribute(&cus, hipDeviceAttributeMultiprocessorCount, dev) != hipSuccess) { grid = -1; return; }
        if (hipFuncSetAttribute((const void*)mk_fwd, hipFuncAttributeMaxDynamicSharedMemorySize, LDS_BYTES) != hipSuccess) { fprintf(stderr, "kernel_launch: hipFuncSetAttribute failed\n"); grid = -1; return; }
        if (hipOccupancyMaxActiveBlocksPerMultiprocessor(&per_cu, (const void*)mk_fwd, NTHREADS, LDS_BYTES) != hipSuccess || per_cu < 1) { fprintf(stderr, "kernel_launch: occupancy query says %d blocks per CU\n", per_cu); (void)hipGetLastError(); }
        grid = cus > 0 ? cus : 256;
    }
    if (grid < 0) return;
    (void)hipMemsetAsync((char*)d_ws + OFF_CTL, 0, CTL_BYTES, stream);
    P p; memset(&p, 0, sizeof(p));
    const float** f = (const float**)&p;
    for (int i = 0; i < 24; ++i) f[i] = (const float*)d_in[i];
    p.out = (float*)d_out; p.ws = (unsigned char*)d_ws;
    for (int i = 0; i < 32; ++i) p.inv_ret[i] = 1.0 / pow(10000.0, (double)((float)i / 31.0f));
    for (int i = 0; i < 16; ++i) p.inv_ax[i] = pow(10000.0, -(double)(2 * i) / 32.0);
#if MK_CUTS
    p.ph_lo = 0; p.ph_hi = NPHASES;
    hipLaunchKernelGGL(mk_fwd, dim3(grid), dim3(NTHREADS), LDS_BYTES, stream, p);
#else
    for (int ph = 0; ph < NPHASES; ++ph) { p.ph_lo = ph; p.ph_hi = ph + 1; hipLaunchKernelGGL(mk_fwd, dim3(grid), dim3(NTHREADS), LDS_BYTES, stream, p); }
#endif
}
```

```cpp
#include <hip/hip_runtime.h>
#include <stdint.h>
#include <stdio.h>
#include <string.h>
#include <math.h>
#include <type_traits>

#define DEV __device__ __forceinline__
#define LAS __attribute__((address_space(3)))
typedef unsigned short bf16_t;
typedef short bf16x8 __attribute__((ext_vector_type(8)));
typedef float f32x4 __attribute__((ext_vector_type(4)));
typedef float f32x2 __attribute__((ext_vector_type(2)));
typedef unsigned u32x4 __attribute__((ext_vector_type(4)));
typedef unsigned u32x2 __attribute__((ext_vector_type(2)));

constexpr int D = 1024, NBATCH = 2, L = 16384, LC = 256, TL = NBATCH * L, TC = NBATCH * LC, TA = TL + TC;
constexpr int NIN = 5376, NEXP = 32, CAP = TA, PMAX = 141312;
constexpr int C_Q = 0, C_K = 512, C_V = 640, C_U = 768, C_RQ = 1024, C_RK = 1280, C_RV = 1536, C_RGF = 1792, C_RGB = 2048, C_GA = 2304;
constexpr int T_V = 0, T_RV = 256, T_RKF = 512, T_RKB = 768, TROWS = 1024;
constexpr int MX_ATTN = 0, MX_POOL = 512, MX_RET = 768;
constexpr int NTHREADS = 512, NWAVES = 8;

constexpr size_t MiB = 1u << 20;
constexpr size_t OFF_CTL = 0, CTL_BYTES = 1 * MiB;
constexpr size_t OFF_MOD = 1 * MiB;
constexpr size_t OFF_TABR = 2 * MiB;
constexpr size_t OFF_TABA = 6 * MiB;
constexpr size_t OFF_TABW = 6 * MiB + 512 * 1024;
constexpr size_t OFF_WTIN = 7 * MiB;
constexpr size_t OFF_WTT = 28 * MiB;
constexpr size_t OFF_WTM = 31 * MiB;
constexpr size_t OFF_WTO = 35 * MiB;
constexpr size_t OFF_WT1 = 40 * MiB;
constexpr size_t OFF_WT2 = 296 * MiB;
constexpr size_t OFF_HBF = 424 * MiB;
constexpr size_t OFF_XR = 489 * MiB;
constexpr size_t OFF_TK = 1840 * MiB;
constexpr size_t OFF_PROJ = 627 * MiB;
constexpr size_t OFF_PROJT = 969 * MiB;
constexpr size_t OFF_MIX = 1034 * MiB;
constexpr size_t OFF_M = 1099 * MiB;
constexpr size_t OFF_HQ = 1164 * MiB;
constexpr size_t OFF_WTOQ = 1212 * MiB;
constexpr size_t OFF_ROWSQ = 1216 * MiB;
constexpr size_t OFF_WTINQ = 1204 * MiB;
constexpr size_t OFF_KV = 1229 * MiB;
constexpr size_t OFF_TABRT = 1272 * MiB;
constexpr size_t OFF_ACT = 1280 * MiB;
constexpr size_t OFF_YB = 1556 * MiB;
constexpr size_t WS_END = 1856 * MiB;
constexpr size_t TK_LAYER = 8 * MiB;
constexpr int CW_CNT = 65536;
constexpr int CW_DYN = 66560;

constexpr int LDS_BYTES = 147456;
constexpr float LOG2E = 1.4426950408889634f;
#ifndef MOE_FP8
#define MOE_FP8 2
#endif
#ifndef INP_FP8
#define INP_FP8 2
#endif
#ifndef OUT_FP8
#define OUT_FP8 0
#endif
constexpr float QW = 32.f, QA = 4.f, QM = 8.f;

struct P {
    const float *x, *c, *ctx, *c_ctx, *w_mod, *b_mod, *norm1, *norm2, *w_in, *sinks, *pool_w, *pool_scale, *ret_decay, *w_o_attn, *w_o_pool, *w_o_ret,
        *w_out, *w_router, *b_router, *w1, *b1, *w2, *b2, *final_norm;
    float* out;
    unsigned char* ws;
    double inv_ret[32];
    double inv_ax[16];
    int ph_lo, ph_hi;
};

DEV float bf2f(bf16_t b) { return __uint_as_float(((unsigned)b) << 16); }
typedef __bf16 bf16x2_t __attribute__((ext_vector_type(2)));
DEV unsigned pk2(float lo, float hi) { f32x2 v = {lo, hi}; bf16x2_t b = __builtin_convertvector(v, bf16x2_t); return __builtin_bit_cast(unsigned, b); }
DEV bf16_t f2bf(float f) { return (bf16_t)(pk2(f, 0.f) & 0xffffu); }
DEV unsigned pk4q(float a, float b, float c, float d) { int w = 0; w = __builtin_amdgcn_cvt_pk_fp8_f32(a, b, w, false); w = __builtin_amdgcn_cvt_pk_fp8_f32(c, d, w, true); return (unsigned)w; }
DEV float sigmoidf_(float x) { return __builtin_amdgcn_rcpf(1.f + __expf(-x)); }
DEV float siluf_(float x) { return x * __builtin_amdgcn_rcpf(1.f + __expf(-x)); }
DEV float rdl(float v, int l) { return __uint_as_float((unsigned)__builtin_amdgcn_readlane((int)__float_as_uint(v), l)); }
DEV int lane_id() { int r; asm volatile("v_mbcnt_lo_u32_b32 %0, -1, 0\n\tv_mbcnt_hi_u32_b32 %0, -1, %0" : "=v"(r)); return r; }
#define TID (wvx * 64 + lane_id())
DEV float wave_sum(float v) {
#pragma unroll
    for (int o = 1; o < 64; o <<= 1) v += __shfl_xor(v, o);
    return v;
}
DEV int row_mod(int r) { return r < TL ? (r >= L ? 1 : 0) : 2; }
DEV const float* in_row(const P& p, int r) { return r < TL ? p.x + (size_t)r * D : p.ctx + (size_t)(r - TL) * D; }
DEV const float* modp(const P& p, int l, int s, int part) { return (const float*)(p.ws + OFF_MOD) + ((size_t)(l * 3 + s) * 6 + part) * D; }

template <class Dst>
DEV void transpose_item(const float* W, int N, int kb, int nb, float* scr  , int lane, Dst dst) {
    const int k0 = 64 * kb + 16 * (lane >> 4), n0 = 64 * nb + 4 * (lane & 15);
    f32x4 v[16];
#pragma unroll
    for (int i = 0; i < 16; ++i) v[i] = *(const f32x4*)(W + (size_t)(k0 + i) * N + n0);
#pragma unroll
    for (int j = 0; j < 4; ++j) {
        u32x4 o0, o1;
        o0.x = pk2(v[0][j], v[1][j]); o0.y = pk2(v[2][j], v[3][j]); o0.z = pk2(v[4][j], v[5][j]); o0.w = pk2(v[6][j], v[7][j]);
        o1.x = pk2(v[8][j], v[9][j]); o1.y = pk2(v[10][j], v[11][j]); o1.z = pk2(v[12][j], v[13][j]); o1.w = pk2(v[14][j], v[15][j]);
        bf16_t* d0 = dst(n0 + j, 0); if (d0) { *(u32x4*)(d0 + k0) = o0; *(u32x4*)(d0 + k0 + 8) = o1; }
        bf16_t* d1 = dst(n0 + j, 1); if (d1) { *(u32x4*)(d1 + k0) = o0; *(u32x4*)(d1 + k0 + 8) = o1; }
    }
}
DEV float log_g(const P& p, int l, int dir, int h) { const float x = p.ret_decay[(l * 2 + dir) * 4 + h]; return -log1pf(__expf(-x)); }
DEV int ret_phys(int d) { return ((d >> 4) & 1) * 32 + (d >> 5) * 16 + (d & 15); }

template <bool NT>
DEV void titem_load(const float* W, int N, int kb, int nb, int lane, f32x4 (&v)[16]) {
    const int k0 = 64 * kb, n0 = 64 * nb;
#pragma unroll
    for (int i = 0; i < 16; ++i) {
        const int kk = 16 * (lane >> 4) + i, c4 = (lane & 15) * 4;
        const f32x4* src = (const f32x4*)(W + (size_t)(k0 + kk) * N + n0 + c4);
        v[i] = NT ? __builtin_nontemporal_load(src) : *src;
    }
}
template <class Dst>
DEV void titem_finish_q(const f32x4 (&v)[16], int kb, int nb, float* scr  , int lane, float sc, Dst dst) {
    const int k0 = 64 * kb + 16 * (lane >> 4), n0 = 64 * nb + 4 * (lane & 15);
#pragma unroll
    for (int j = 0; j < 4; ++j) {
        u32x4 o;
        o.x = pk4q(v[0][j] * sc, v[1][j] * sc, v[2][j] * sc, v[3][j] * sc); o.y = pk4q(v[4][j] * sc, v[5][j] * sc, v[6][j] * sc, v[7][j] * sc);
        o.z = pk4q(v[8][j] * sc, v[9][j] * sc, v[10][j] * sc, v[11][j] * sc); o.w = pk4q(v[12][j] * sc, v[13][j] * sc, v[14][j] * sc, v[15][j] * sc);
        unsigned char* d0 = dst(n0 + j, 0); if (d0) *(u32x4*)(d0 + k0) = o;
        unsigned char* d1 = dst(n0 + j, 1); if (d1) *(u32x4*)(d1 + k0) = o;
    }
}
template <class Dst>
DEV void transpose_item_q(const float* W, int N, int kb, int nb, float* scr, int lane, float sc, Dst dst) {
    f32x4 v[16]; titem_load<false>(W, N, kb, nb, lane, v); titem_finish_q(v, kb, nb, scr, lane, sc, dst);
}

DEV void stage_prep(const P& p, int bid, int nb, unsigned char* lds, int wvx) {
    const int tid = TID, lane = tid & 63, wave = tid >> 6;
    float* scr = (float*)lds + wave * (64 * 65);
    unsigned char* ws = p.ws;
    constexpr int I_IN = 16 * 84, I_OA = 8 * 16, I_OR = 4 * 16, I_OUT = 16 * 16, I_W1 = 16 * 32, I_W2 = 16 * 16;
    constexpr int PER_LAYER = I_IN + I_OA + I_OR + I_OUT;
    const int gw = bid * NWAVES + wave, ngw = nb * NWAVES;
    for (int it = gw; it < 2 * PER_LAYER; it += ngw) {
        const int l = it / PER_LAYER; int r = it % PER_LAYER;
#if INP_FP8 == 2
        if (r < I_IN && (r % 84) >= C_GA / 64) {
            unsigned char* wq = ws + OFF_WTINQ + (size_t)l * (NIN - C_GA) * D;
            transpose_item_q(p.w_in + (size_t)l * D * NIN, NIN, r / 84, r % 84, scr, lane, QW, [&](int n, int which) -> unsigned char* { return which ? (unsigned char*)nullptr : wq + (size_t)(n - C_GA) * D; });
            continue; }
#endif
#if INP_FP8 == 1
        if (r < I_IN) {
            unsigned char* wt = ws + OFF_WTIN + (size_t)l * NIN * D; unsigned char* wtt = ws + OFF_WTT + (size_t)l * 768 * D;
            transpose_item_q(p.w_in + (size_t)l * D * NIN, NIN, r / 84, r % 84, scr, lane, QW, [&](int n, int which) -> unsigned char* {
                int pr = n;
                if (n >= C_RQ && n < C_RV) pr = (n & ~63) + ret_phys(n & 63);
                if (which == 0) return wt + (size_t)pr * D;
                int tr = -1;
                if (n >= C_V && n < C_U) tr = n - C_V;
                else if (n >= C_K && n < C_V) tr = 128 + (n - C_K);
                else if (n >= C_RV && n < C_RGF) tr = 256 + (n - C_RV);
                else if (n >= C_RK && n < C_RV) tr = 512 + (pr - C_RK);
                return tr < 0 ? (unsigned char*)nullptr : wtt + (size_t)tr * D; });
            continue; }
#endif
        if (r < I_IN) {
            bf16_t* wt = (bf16_t*)(ws + OFF_WTIN) + (size_t)l * NIN * D; bf16_t* wtt = (bf16_t*)(ws + OFF_WTT) + (size_t)l * 768 * D;
            transpose_item(p.w_in + (size_t)l * D * NIN, NIN, r / 84, r % 84, scr, lane, [&](int n, int which) -> bf16_t* {
                int pr = n;
                if (n >= C_RQ && n < C_RV) pr = (n & ~63) + ret_phys(n & 63);
                if (which == 0) return wt + (size_t)pr * D;
                int tr = -1;
                if (n >= C_RV && n < C_RGF) tr = 256 + (n - C_RV);
                return tr < 0 ? (bf16_t*)nullptr : wtt + (size_t)tr * D; });
            continue; }
        r -= I_IN;
        if (r < I_OA) { bf16_t* wt = (bf16_t*)(ws + OFF_WTM) + (size_t)l * D * D;
            transpose_item(p.w_o_attn + (size_t)l * 512 * D, D, r / 16, r % 16, scr, lane, [&](int n, int which) -> bf16_t* { return which ? (bf16_t*)nullptr : wt + (size_t)n * D + MX_ATTN; }); continue; }
        r -= I_OA;
        if (r < I_OR) { bf16_t* wt = (bf16_t*)(ws + OFF_WTM) + (size_t)l * D * D;
            transpose_item(p.w_o_ret + (size_t)l * 256 * D, D, r / 16, r % 16, scr, lane, [&](int n, int which) -> bf16_t* { return which ? (bf16_t*)nullptr : wt + (size_t)n * D + MX_RET; }); continue; }
        r -= I_OR;
#if OUT_FP8
        if (r < I_OUT) { unsigned char* wq = ws + OFF_WTOQ + (size_t)l * D * D;
            transpose_item_q(p.w_out + (size_t)l * D * D, D, r / 16, r % 16, scr, lane, QW, [&](int n, int which) -> unsigned char* { return which ? (unsigned char*)nullptr : wq + (size_t)n * D; }); }
#endif
        if (r < I_OUT) { bf16_t* wt = (bf16_t*)(ws + OFF_WTO) + (size_t)l * D * D;
            transpose_item(p.w_out + (size_t)l * D * D, D, r / 16, r % 16, scr, lane, [&](int n, int which) -> bf16_t* { return which ? (bf16_t*)nullptr : wt + (size_t)n * D; }); continue; }
    }
    const int gt = bid * NTHREADS + tid, ngt = nb * NTHREADS;
    for (int it = gt; it < 2 * 256 * D; it += ngt) {
        const int l = it / (256 * D), c = (it / D) % 256, n = it % D, g = c >> 6, cl = c & 63;
        const float* pw = p.pool_w + (((size_t)l * 4 + g) * 64 + cl) * 64; const float* ps = p.pool_scale + l * 256 + g * 64; const float* wo = p.w_o_pool + ((size_t)l * 256 + g * 64) * D + n;
        float s = 0.f;
        for (int e = 0; e < 64; ++e) s += pw[e] * ps[e] * wo[(size_t)e * D];
        ((bf16_t*)(ws + OFF_WTM))[(size_t)l * D * D + (size_t)n * D + MX_POOL + c] = f2bf(s);
    }
    {
        float* sl = (float*)(lds + 8 * 64 * 65 * 4);
        __syncthreads();
        for (int i = tid; i < 3 * D; i += NTHREADS) { const int s = i / D, k = i % D; const float v = s < 2 ? p.c[s * D + k] : p.c_ctx[k]; sl[i] = siluf_(v); }
        __syncthreads();
        float* mod = (float*)(ws + OFF_MOD);
        float* red = (float*)lds;
        for (int blk = bid; blk < 2 * 96; blk += nb) {
            const int l = blk / 96, n = (blk % 96) * 64 + (tid & 63), ks = tid >> 6;
            const float* w = p.w_mod + (size_t)l * D * 6 * D + (size_t)(128 * ks) * 6 * D + n; const float* s0 = sl + 128 * ks; float a0 = 0.f, a1 = 0.f, a2 = 0.f;
#pragma unroll 16
            for (int k = 0; k < 128; ++k) { const float wv = w[(size_t)k * 6 * D]; a0 += s0[k] * wv; a1 += s0[D + k] * wv; a2 += s0[2 * D + k] * wv; }
            red[(ks * 3 + 0) * 64 + (tid & 63)] = a0; red[(ks * 3 + 1) * 64 + (tid & 63)] = a1; red[(ks * 3 + 2) * 64 + (tid & 63)] = a2;
            __syncthreads();
            if (tid < 192) { const int sI = tid >> 6, nn = tid & 63; float a = 0.f;
#pragma unroll
                for (int q = 0; q < 8; ++q) a += red[(q * 3 + sI) * 64 + nn];
                const int nc = (blk % 96) * 64 + nn; mod[(size_t)(l * 3 + sI) * 6 * D + nc] = a + p.b_mod[l * 6 * D + nc]; }
            __syncthreads();
        }
    }
    {
        f32x2* tr = (f32x2*)(ws + OFF_TABR);
        const double TWO_PI = 6.283185307179586476925286766559, INV_2PI = 0.15915494309189533576888376337251;
        for (int it = gt; it < L * 32 + 256 * 16 + 64 * 16; it += ngt) {
            double ang; f32x2* dst;
            if (it < L * 32) { ang = (double)(it >> 5) * p.inv_ret[it & 31]; dst = tr + it; }
            else { const int j = it - L * 32; const int pos = j < 256 * 16 ? (j >> 4) : ((j - 256 * 16) >> 4); ang = (double)pos * p.inv_ax[j & 15]; dst = (f32x2*)(ws + OFF_TABA) + j; }
            const double n = rint(ang * INV_2PI); const float r = (float)(ang - n * TWO_PI);
            const float cv = __cosf(r), sv = __sinf(r);
            *dst = (f32x2){cv, sv};
            if (it < L * 32) { float* tt = (float*)(ws + OFF_TABRT); tt[(size_t)(it & 31) * L + (it >> 5)] = cv; tt[(size_t)(32 + (it & 31)) * L + (it >> 5)] = sv; }
        }
        for (int it = gt; it < 2 * 2 * 4 * 128; it += ngt) {
            const int j = it & 127, h = (it >> 7) & 3, dir = (it >> 9) & 1, l = it >> 10; const float lg = log_g(p, l, dir, h);
            ((float*)(ws + OFF_TABW))[it] = __expf(lg * (float)(dir == 0 ? 127 - j : j));
        }
    }
}


DEV void stage_prep_experts(const P& p, int l, int bid, int nb, unsigned char* lds, int wvx) {
    const int tid = TID, lane = tid & 63, wave = tid >> 6;
    float* scr = (float*)lds + wave * (64 * 65);
    unsigned char* ws = p.ws;
    constexpr int I_W1 = 16 * 32, I_W2 = 16 * 16;
    const int gw = bid * NWAVES + wave, ngw = nb * NWAVES;
#if MOE_FP8 >= 2
    auto src = [&](int it, const float*& W, int& N, int& kb, int& nbk) { const int e = it / (I_W1 + I_W2), r = it % (I_W1 + I_W2);
        if (r < I_W1) { W = p.w1 + ((size_t)l * NEXP + e) * D * 2048; N = 2048; kb = r / 32; nbk = r % 32; }
        else { W = p.w2 + ((size_t)l * NEXP + e) * D * D; N = D; kb = (r - I_W1) / 16; nbk = (r - I_W1) % 16; } };
    f32x4 va[16], vb[16];
    int it = gw;
    if (it < NEXP * (I_W1 + I_W2)) { const float* W; int N, kb, nbk; src(it, W, N, kb, nbk); titem_load<true>(W, N, kb, nbk, lane, va); }
    for (; it < NEXP * (I_W1 + I_W2); it += ngw) {
        const int itn = it + ngw;
        if (itn < NEXP * (I_W1 + I_W2)) { const float* W; int N, kb, nbk; src(itn, W, N, kb, nbk); titem_load<true>(W, N, kb, nbk, lane, vb); }
        const int e = it / (I_W1 + I_W2), r = it % (I_W1 + I_W2);
        if (r < I_W1) {
            unsigned char* wq = ws + OFF_WT1 + ((size_t)l * NEXP + e) * 2048 * D;
            titem_finish_q(va, r / 32, r % 32, scr, lane, QW, [&](int n, int which) -> unsigned char* {
                const int j = n & 1023, jq = (j >> 2) & 3, pq = jq == 1 ? 2 : jq == 2 ? 1 : jq;
                const int pr = 32 * (j >> 4) + (n >= 1024 ? 16 : 0) + 4 * pq + (j & 3);
                return which ? (unsigned char*)nullptr : wq + (size_t)pr * D; });
        } else {
            unsigned char* wq = ws + OFF_WT2 + ((size_t)l * NEXP + e) * D * D;
            titem_finish_q(va, (r - I_W1) / 16, (r - I_W1) % 16, scr, lane, QW, [&](int n, int which) -> unsigned char* { return which ? (unsigned char*)nullptr : wq + (size_t)n * D; });
        }
#pragma unroll
        for (int i = 0; i < 16; ++i) va[i] = vb[i];
    }
#else
    for (int it = gw; it < NEXP * (I_W1 + I_W2); it += ngw) {
        int r = it;
        const int e = r / (I_W1 + I_W2); r %= (I_W1 + I_W2);
        if (r < I_W1) {
#if MOE_FP8 >= 1
            unsigned char* wq = ws + OFF_WT1 + ((size_t)l * NEXP + e) * 2048 * D;
            transpose_item_q(p.w1 + ((size_t)l * NEXP + e) * D * 2048, 2048, r / 32, r % 32, scr, lane, QW, [&](int n, int which) -> unsigned char* {
                const int j = n & 1023, jq = (j >> 2) & 3, pq = jq == 1 ? 2 : jq == 2 ? 1 : jq;
                const int pr = 32 * (j >> 4) + (n >= 1024 ? 16 : 0) + 4 * pq + (j & 3);
                return which ? (unsigned char*)nullptr : wq + (size_t)pr * D; });
#else
            bf16_t* wt = (bf16_t*)(ws + OFF_WT1) + ((size_t)l * NEXP + e) * 2048 * D;
            transpose_item(p.w1 + ((size_t)l * NEXP + e) * D * 2048, 2048, r / 32, r % 32, scr, lane, [&](int n, int which) -> bf16_t* {
                const int j = n & 1023, jq = (j >> 2) & 3, pq = jq == 1 ? 2 : jq == 2 ? 1 : jq;
                const int pr = 32 * (j >> 4) + (n >= 1024 ? 16 : 0) + 4 * pq + (j & 3);
                return which ? (bf16_t*)nullptr : wt + (size_t)pr * D; });
#endif
            continue; }
        r -= I_W1;
#if MOE_FP8 >= 2
        { unsigned char* wq = ws + OFF_WT2 + ((size_t)l * NEXP + e) * D * D;
            transpose_item_q(p.w2 + ((size_t)l * NEXP + e) * D * D, D, r / 16, r % 16, scr, lane, QW, [&](int n, int which) -> unsigned char* { return which ? (unsigned char*)nullptr : wq + (size_t)n * D; }); }
#else
        { bf16_t* wt = (bf16_t*)(ws + OFF_WT2) + ((size_t)l * NEXP + e) * D * D;
            transpose_item(p.w2 + ((size_t)l * NEXP + e) * D * D, D, r / 16, r % 16, scr, lane, [&](int n, int which) -> bf16_t* { return which ? (bf16_t*)nullptr : wt + (size_t)n * D; }); }
#endif
    }
#endif
}

DEV void norm_store(const f32x4 (&v)[4], const float* gamma, const float* sc, const float* sh, bf16_t* orow, unsigned char* qrow, int lane) {
    float s = 0.f;
#pragma unroll
    for (int j = 0; j < 4; ++j) s += (v[j].x * v[j].x + v[j].y * v[j].y) + (v[j].z * v[j].z + v[j].w * v[j].w);
    const float rstd = rsqrtf(wave_sum(s) * (1.f / D) + 1e-6f);
    f32x4 g[4], a[4], b[4];
#pragma unroll
    for (int j = 0; j < 4; ++j) { const int k = 4 * lane + 256 * j; g[j] = *(const f32x4*)(gamma + k); a[j] = *(const f32x4*)(sc + k); b[j] = *(const f32x4*)(sh + k); }
#pragma unroll
    for (int j = 0; j < 4; ++j) {
        const int k = 4 * lane + 256 * j;
        f32x4 y = v[j] * rstd * g[j] * (a[j] + 1.f) + b[j];
#if INP_FP8 == 1
        *(unsigned*)((unsigned char*)orow + k) = pk4q(y.x, y.y, y.z, y.w);
#else
        u32x2 o; o.x = pk2(y.x, y.y); o.y = pk2(y.z, y.w);
        *(u32x2*)(orow + k) = o;
#if INP_FP8 == 2
        *(unsigned*)(qrow + k) = pk4q(y.x, y.y, y.z, y.w);
#endif
#endif
    }
}
constexpr size_t OFF_GM2 = OFF_MOD + 512 * 1024;
DEV void stage_norm0(const P& p, int bid, int nb, int wvx) {
    const int tid_ = TID, lane = tid_ & 63, wave = tid_ >> 6;
    if (bid == nb - 1) { float* gm2 = (float*)(p.ws + OFF_GM2);
        for (int i = tid_; i < 2 * 3 * D; i += NTHREADS) { const int l = i / (3 * D), s = (i / D) % 3, k = i % D; gm2[i] = p.norm2[l * D + k] * (modp(p, l, s, 4)[k] + 1.f); } }
    bf16_t* hbf = (bf16_t*)(p.ws + OFF_HBF);
    int r = bid * NWAVES + wave; f32x4 v[4], vn[4];
    if (r < TA) {
#pragma unroll
        for (int j = 0; j < 4; ++j) v[j] = *(const f32x4*)(in_row(p, r) + 4 * lane + 256 * j);
    }
    for (; r < TA; r += nb * NWAVES) {
        const int rn = r + nb * NWAVES;
        if (rn < TA) {
#pragma unroll
            for (int j = 0; j < 4; ++j) vn[j] = *(const f32x4*)(in_row(p, rn) + 4 * lane + 256 * j);
        }
        const int s = row_mod(r);
        norm_store(v, p.norm1, modp(p, 0, s, 1), modp(p, 0, s, 0), hbf + (size_t)r * (INP_FP8 == 1 ? D / 2 : D), p.ws + OFF_HQ + (size_t)r * D, lane);
#pragma unroll
        for (int j = 0; j < 4; ++j) v[j] = vn[j];
    }
}

typedef short s16x4 __attribute__((ext_vector_type(4)));
DEV u32x2 lds_tr16(const LAS unsigned char* a) { const s16x4 v = __builtin_amdgcn_ds_read_tr16_b64_v4i16((LAS s16x4*)a); return __builtin_bit_cast(u32x2, v); }
DEV void mma_tile32(const bf16_t* a0, const bf16_t* a1, const bf16_t* b0, const bf16_t* b1, int K, f32x4 (&acc)[2][2]) {
#pragma unroll 4
    for (int k = 0; k < K; k += 32) {
        const bf16x8 fa0 = *(const bf16x8*)(a0 + k), fa1 = *(const bf16x8*)(a1 + k), fb0 = *(const bf16x8*)(b0 + k), fb1 = *(const bf16x8*)(b1 + k);
        acc[0][0] = __builtin_amdgcn_mfma_f32_16x16x32_bf16(fa0, fb0, acc[0][0], 0, 0, 0);
        acc[0][1] = __builtin_amdgcn_mfma_f32_16x16x32_bf16(fa0, fb1, acc[0][1], 0, 0, 0);
        acc[1][0] = __builtin_amdgcn_mfma_f32_16x16x32_bf16(fa1, fb0, acc[1][0], 0, 0, 0);
        acc[1][1] = __builtin_amdgcn_mfma_f32_16x16x32_bf16(fa1, fb1, acc[1][1], 0, 0, 0);
    }
}
DEV void zero_acc(f32x4 (&acc)[2][2]) {
#pragma unroll
    for (int a = 0; a < 2; ++a)
#pragma unroll
        for (int b = 0; b < 2; ++b) acc[a][b] = (f32x4){0.f, 0.f, 0.f, 0.f};
}

DEV f32x2 ax_cs(const P& p, int row, int sub, int f) {
    if (row >= TL) return (f32x2){1.f, 0.f};
    const int l = row & (L - 1); const f32x2* ta = (const f32x2*)(p.ws + OFF_TABA);
    return sub == 0 ? ta[(l >> 6) * 16 + f] : ta[256 * 16 + (l & 63) * 16 + f];
}
DEV f32x2 ret_cs(const P& p, int row, int f) {
    if (row >= TL) return (f32x2){1.f, 0.f};
    return ((const f32x2*)(p.ws + OFF_TABR))[(row & (L - 1)) * 32 + f];
}

DEV void inproj_pair(const P& p, int row, int c1, float x1, float x2, float& o1, float& o2) {
    const int f16 = c1 & 15;
    if (c1 < C_V) {
        const f32x2 cs = ax_cs(p, row, (c1 >> 5) & 1, f16);
        o1 = x1 * cs.x - x2 * cs.y; o2 = x1 * cs.y + x2 * cs.x;
        if (c1 < C_K) { o1 *= 0.125f; o2 *= 0.125f; }
    } else if (c1 < C_RQ) { o1 = x1; o2 = x2; }
    else if (c1 < C_RV) {
        const f32x2 cs = ret_cs(p, row, ((c1 >> 5) & 1) * 16 + f16);
        o1 = x1 * cs.x - x2 * cs.y; o2 = x1 * cs.y + x2 * cs.x;
        if (c1 >= C_RK) { o1 *= 0.125f; o2 *= 0.125f; }
    } else if (c1 < C_RGF) { o1 = x1; o2 = x2; }
    else if (c1 < C_GA) { o1 = siluf_(x1); o2 = siluf_(x2); }
    else { o1 = sigmoidf_(x1); o2 = sigmoidf_(x2); }
}


DEV void stage_pool_diff(const P& p, int l, int bid, int nb, int wvx) {
    const int NR = l == 0 ? TA : TL;
    const bf16_t* proj = (const bf16_t*)(p.ws + OFF_PROJ); bf16_t* mix = (bf16_t*)(p.ws + OFF_MIX);
    for (int it = bid * NTHREADS + TID; it < 4 * NR * 8; it += nb * NTHREADS) {
        const int g = it / (NR * 8), rem = it % (NR * 8), row = rem >> 3, c = g * 64 + (rem & 7) * 8, w = __builtin_amdgcn_readfirstlane(2 << g);
        int s0, len; if (row < TL) { s0 = row & ~(L - 1); len = L; } else { s0 = TL + (((row - TL) >> 8) << 8); len = LC; }
        const int t = row - s0, lo0 = t - w / 2;
        float acc[8];
#pragma unroll
        for (int j = 0; j < 8; ++j) acc[j] = 0.f;
        bf16x8 own = *(const bf16x8*)(proj + (size_t)row * NIN + C_U + c);
#pragma unroll
        for (int i = 0; i < 16; ++i) {
            {
                const int pos = lo0 + i; const bool ok = i < w && pos >= 0 && pos < len;
                const bf16x8 v = *(const bf16x8*)(proj + (size_t)(s0 + (ok ? pos : t)) * NIN + C_U + c);
                const float mk = ok ? 1.f : 0.f;
#pragma unroll
                for (int j = 0; j < 8; ++j) acc[j] += mk * bf2f((bf16_t)v[j]);
            }
        }
        int lo = lo0 < 0 ? 0 : lo0, hi = lo0 + w > len ? len : lo0 + w;
        const float inv = 1.f / (float)(hi - lo);
        float d[8];
#pragma unroll
        for (int j = 0; j < 8; ++j) d[j] = acc[j] * inv - bf2f((bf16_t)own[j]);
        u32x4 o; o.x = pk2(d[0], d[1]); o.y = pk2(d[2], d[3]); o.z = pk2(d[4], d[5]); o.w = pk2(d[6], d[7]);
        *(u32x4*)(mix + (size_t)row * D + MX_POOL + c) = o;
    }
}


constexpr int MAXENT = 640;
DEV void stage_route(const P& p, int l, int bid, int nb, unsigned char* lds, int wvx) {
    const int tid = TID, lane = tid & 63, wave = tid >> 6;
    float* wl = (float*)lds;
    int* lcnt = (int*)(lds + 131072); int* lbase = lcnt + 32; int* ent = lbase + 32;
    const float* wr = p.w_router + (size_t)l * D * NEXP;
    for (int k = tid; k < D; k += NTHREADS) {
#pragma unroll
        for (int e4 = 0; e4 < 8; ++e4) { const f32x4 w = *(const f32x4*)(wr + (size_t)k * NEXP + 4 * e4);
            wl[(4 * e4 + 0) * D + k] = w.x; wl[(4 * e4 + 1) * D + k] = w.y; wl[(4 * e4 + 2) * D + k] = w.z; wl[(4 * e4 + 3) * D + k] = w.w; }
    }
    for (int i = tid; i < 32; i += NTHREADS) lcnt[i] = 0;
    for (int i = tid; i < MAXENT; i += NTHREADS) ent[i] = -1;
    __syncthreads();
    const float* xr = (const float*)(p.ws + OFF_XR); bf16_t* hbf = (bf16_t*)(p.ws + OFF_HBF);
    int* tk_e = (int*)(p.ws + OFF_TK + (size_t)l * TK_LAYER); float* tk_w = (float*)(tk_e + TA * 4); int* tk_pos = (int*)(tk_w + TA * 4); int* list_tok = tk_pos + TA * 4;
    unsigned* cntg = (unsigned*)(p.ws + OFF_CTL) + CW_CNT + l * 32;
    const int NR = l == 0 ? TA : TL, ngw = nb * NWAVES, gw = bid * NWAVES + wave;
    const int t_begin = (int)(((long long)gw * NR) / ngw), t_end = (int)(((long long)(gw + 1) * NR) / ngw);
    const float* gamma = p.norm2 + l * D;
    f32x4 gam[4];
#pragma unroll
    for (int j = 0; j < 4; ++j) gam[j] = *(const f32x4*)(gamma + 4 * lane + 256 * j);
    for (int t0 = t_begin; t0 < t_end; t0 += 4) {
        f32x4 v[4][4]; int tok[4]; float ss[4];
#pragma unroll
        for (int u = 0; u < 4; ++u) { tok[u] = t0 + u < t_end ? t0 + u : t_end - 1; ss[u] = 0.f;
#pragma unroll
            for (int j = 0; j < 4; ++j) { v[u][j] = *(const f32x4*)(xr + (size_t)tok[u] * D + 4 * lane + 256 * j); ss[u] += (v[u][j].x * v[u][j].x + v[u][j].y * v[u][j].y) + (v[u][j].z * v[u][j].z + v[u][j].w * v[u][j].w); } }
        const int s0 = row_mod(tok[0]);
        f32x4 scv[4], shv[4];
#pragma unroll
        for (int j = 0; j < 4; ++j) { scv[j] = *(const f32x4*)(modp(p, l, s0, 4) + 4 * lane + 256 * j); shv[j] = *(const f32x4*)(modp(p, l, s0, 3) + 4 * lane + 256 * j); }
#pragma unroll
        for (int o = 1; o < 64; o <<= 1) {
#pragma unroll
            for (int u = 0; u < 4; ++u) ss[u] += __shfl_xor(ss[u], o); }
#pragma unroll
        for (int u = 0; u < 4; ++u) {
            const float rstd = rsqrtf(ss[u] * (1.f / D) + 1e-6f); const int sm = row_mod(tok[u]);
            f32x4 av[4], bv[4];
            if (sm != s0) {
                const float* sc = modp(p, l, sm, 4); const float* sh = modp(p, l, sm, 3);
#pragma unroll
                for (int j = 0; j < 4; ++j) { av[j] = *(const f32x4*)(sc + 4 * lane + 256 * j); bv[j] = *(const f32x4*)(sh + 4 * lane + 256 * j); }
            } else {
#pragma unroll
                for (int j = 0; j < 4; ++j) { av[j] = scv[j]; bv[j] = shv[j]; }
            }
#pragma unroll
            for (int j = 0; j < 4; ++j) { const int k = 4 * lane + 256 * j;
                const f32x4 g = gam[j], a = av[j], b = bv[j];
                v[u][j] = v[u][j] * rstd * g * (a + 1.f) + b;
#if MOE_FP8 >= 1
                if (t0 + u < t_end) *(unsigned*)((unsigned char*)hbf + (size_t)tok[u] * D + k) = pk4q(v[u][j].x, v[u][j].y, v[u][j].z, v[u][j].w); }
#else
                u32x2 o; o.x = pk2(v[u][j].x, v[u][j].y); o.y = pk2(v[u][j].z, v[u][j].w);
                if (t0 + u < t_end) *(u32x2*)(hbf + (size_t)tok[u] * D + k) = o; }
#endif
        }
        float lgc[4] = {0.f, 0.f, 0.f, 0.f};
        const int e8 = lane & 7, ut = (lane >> 3) & 3;
#pragma nounroll
        for (int c = 0; c < 4; ++c) {
            float val[32];
#pragma unroll
            for (int x = 0; x < 8; ++x) {
                f32x4 w[4];
#pragma unroll
                for (int j = 0; j < 4; ++j) w[j] = *(const f32x4*)(wl + (8 * c + x) * D + 4 * lane + 256 * j);
#pragma unroll
                for (int u = 0; u < 4; ++u) { float a = 0.f;
#pragma unroll
                    for (int j = 0; j < 4; ++j) a += (v[u][j].x * w[j].x + v[u][j].y * w[j].y) + (v[u][j].z * w[j].z + v[u][j].w * w[j].w);
                    val[u * 8 + x] = a; }
            }
            float v16[16], v8[8], v4[4], v2[2];
#define RT_STAGE(dst, src, n, b) do { const bool hi_ = (lane >> (b)) & 1; _Pragma("unroll") for (int i_ = 0; i_ < (n); ++i_) { const float lo_v = (src)[2 * i_], hi_v = (src)[2 * i_ + 1]; \
                const float keep = hi_ ? hi_v : lo_v, send = hi_ ? lo_v : hi_v; (dst)[i_] = keep + __shfl_xor(send, 1 << (b)); } } while (0)
            RT_STAGE(v16, val, 16, 0); RT_STAGE(v8, v16, 8, 1); RT_STAGE(v4, v8, 4, 2); RT_STAGE(v2, v4, 2, 3);
            float v1; { const bool hi_ = (lane >> 4) & 1; const float keep = hi_ ? v2[1] : v2[0], send = hi_ ? v2[0] : v2[1]; v1 = keep + __shfl_xor(send, 16); }
#undef RT_STAGE
            { const float lv = v1 + __shfl_xor(v1, 32) + p.b_router[l * NEXP + 8 * c + e8];
#pragma unroll
              for (int cc = 0; cc < 4; ++cc) lgc[cc] = (cc == c) ? lv : lgc[cc]; }
        }
        int te[4]; float tv[4];
#pragma unroll
        for (int k = 0; k < 4; ++k) {
            float bv = lgc[0]; int be = e8;
#pragma unroll
            for (int c = 1; c < 4; ++c) { const bool t = lgc[c] > bv; bv = t ? lgc[c] : bv; be = t ? 8 * c + e8 : be; }
#pragma unroll
            for (int d = 1; d < 8; d <<= 1) { const float ov = __shfl_xor(bv, d); const int oe = __shfl_xor(be, d); const bool t = (ov > bv) || (ov == bv && oe < be); bv = t ? ov : bv; be = t ? oe : be; }
            te[k] = be; tv[k] = bv;
#pragma unroll
            for (int c = 0; c < 4; ++c) lgc[c] = (be == 8 * c + e8) ? -INFINITY : lgc[c];
        }
        float ex[4], es = 0.f;
#pragma unroll
        for (int k = 0; k < 4; ++k) { ex[k] = __expf(tv[k] - tv[0]); es += ex[k]; }
        if (lane < 32 && e8 < 4 && t0 + ut < t_end) {
            const int e = e8 == 0 ? te[0] : e8 == 1 ? te[1] : e8 == 2 ? te[2] : te[3];
            const float wgt = (e8 == 0 ? ex[0] : e8 == 1 ? ex[1] : e8 == 2 ? ex[2] : ex[3]) / es;
            const int rank = atomicAdd(&lcnt[e], 1);
            const int tk = t0 + ut, lid = wave * 72 + (tk - t_begin) * 4 + e8;
            ent[lid] = e | (rank << 8);
            tk_e[tk * 4 + e8] = e; tk_w[tk * 4 + e8] = wgt;
        }
    }
    __syncthreads();
    if (tid < 32) lbase[tid] = (int)atomicAdd(&cntg[tid], (unsigned)lcnt[tid]);
    __syncthreads();
    for (int lid = tid; lid < 8 * 72; lid += NTHREADS) {
        const int en = ent[lid]; if (en < 0) continue;
        const int e = en & 255, rank = en >> 8, wv = lid / 72, rem = lid % 72, k = rem & 3;
        const int tb = (int)(((long long)(bid * NWAVES + wv) * NR) / ngw);
        const int tokk = tb + (rem >> 2), pos = lbase[e] + rank;
        tk_pos[tokk * 4 + k] = pos; list_tok[e * CAP + pos] = tokk;
    }
}

DEV void moe_prefix(const P& p, int l, int* pstart, int* cnt, int wvx) {
    const int tid = TID;
    if (tid < 64) {
        unsigned* cntg = (unsigned*)(p.ws + OFF_CTL) + CW_CNT + l * 32;
        const int c = tid < 32 ? (int)__hip_atomic_load(cntg + (tid & 31), __ATOMIC_RELAXED, __HIP_MEMORY_SCOPE_AGENT) : 0;
        const int pad = (c + 255) & ~255; int incl = pad;
#pragma unroll
        for (int o = 1; o < 32; o <<= 1) { const int t = __shfl_up(incl, o); if ((tid & 63) >= o) incl += t; }
        if (tid < 32) { cnt[tid] = c; pstart[tid] = incl - pad; if (tid == 31) pstart[32] = incl; }
    }
    __syncthreads();
}
#ifndef ROUTE_MFMA
#define ROUTE_MFMA 1
#endif
constexpr int RW_STRIDE = 2064, RW_LO = 32 * RW_STRIDE, RT_TAB = 2 * RW_LO, RT_MAXENT = 1024;
DEV void stage_route_mfma(const P& p, int l, int bid, int nb, unsigned char* lds_, int wvx) {
    const int tid = TID, lane = tid & 63, wave = tid >> 6, fr = lane & 15, fq = lane >> 4;
    LAS unsigned char* lds = (LAS unsigned char*)lds_;
    int* lcnt = (int*)(lds_ + RT_TAB); int* lbase = lcnt + 32; int* ent = lbase + 32; int* enttok = ent + RT_MAXENT;
    const float* wr = p.w_router + (size_t)l * D * NEXP;
    for (int k = tid; k < D; k += NTHREADS) {
#pragma unroll
        for (int e4 = 0; e4 < 8; ++e4) { const f32x4 w = *(const f32x4*)(wr + (size_t)k * NEXP + 4 * e4);
#pragma unroll
            for (int j = 0; j < 4; ++j) { const float wv = w[j]; const bf16_t h = f2bf(wv); const bf16_t lo = f2bf(wv - bf2f(h));
                *(LAS bf16_t*)(lds + (4 * e4 + j) * RW_STRIDE + 2 * k) = h; *(LAS bf16_t*)(lds + RW_LO + (4 * e4 + j) * RW_STRIDE + 2 * k) = lo; } }
    }
    for (int i = tid; i < 32; i += NTHREADS) lcnt[i] = 0;
    for (int i = tid; i < RT_MAXENT; i += NTHREADS) ent[i] = -1;
    __syncthreads();
    const float* xr = (const float*)(p.ws + OFF_XR); unsigned char* h2q = p.ws + OFF_HBF;
    int* tk_e = (int*)(p.ws + OFF_TK + (size_t)l * TK_LAYER); float* tk_w = (float*)(tk_e + TA * 4); int* tk_pos = (int*)(tk_w + TA * 4); int* list_tok = tk_pos + TA * 4;
    unsigned* cntg = (unsigned*)(p.ws + OFF_CTL) + CW_CNT + l * 32;
    const int NR = l == 0 ? TA : TL, ntile = NR / 16, ngw = nb * NWAVES, gw = bid * NWAVES + wave;
    auto body = [&](auto ntc) {
        constexpr int NT = decltype(ntc)::value;
        int tk[NT]; const float* xrow[NT]; const float* gmp[NT]; const float* shp[NT]; float rstd[NT]; unsigned char* hq[NT]; f32x4 acc[NT][2];
#pragma unroll
        for (int u = 0; u < NT; ++u) {
            const int tile = gw + u * ngw, sm = row_mod(tile * 16);
            tk[u] = tile * 16 + fr; xrow[u] = xr + (size_t)tk[u] * D + 8 * fq; hq[u] = h2q + (size_t)tk[u] * D + 8 * fq;
            gmp[u] = (const float*)(p.ws + OFF_GM2) + (size_t)(l * 3 + sm) * D + 8 * fq; shp[u] = modp(p, l, sm, 3) + 8 * fq;
            float ss = 0.f;
            if (tile * 16 < TL) { const f32x4 q = *(const f32x4*)((const float*)(p.ws + OFF_ROWSQ) + (size_t)tk[u] * 16 + 4 * fq); ss = (q.x + q.y) + (q.z + q.w); }
            else {
#pragma unroll 8
                for (int s = 0; s < 32; ++s) { const f32x4 a = *(const f32x4*)(xrow[u] + 32 * s), b = *(const f32x4*)(xrow[u] + 32 * s + 4);
                    ss += (a.x * a.x + a.y * a.y) + (a.z * a.z + a.w * a.w) + (b.x * b.x + b.y * b.y) + (b.z * b.z + b.w * b.w); }
            }
            ss += __shfl_xor(ss, 16); ss += __shfl_xor(ss, 32);
            rstd[u] = rsqrtf(ss * (1.f / D) + 1e-6f);
            acc[u][0] = (f32x4){0.f, 0.f, 0.f, 0.f}; acc[u][1] = acc[u][0];
        }
#pragma unroll 4
        for (int s = 0; s < 32; ++s) {
            bf16x8 yh[NT], yl[NT];
#pragma unroll
            for (int u = 0; u < NT; ++u) {
                f32x4 y[2];
#pragma unroll
                for (int c = 0; c < 2; ++c) { const int k = 32 * s + 4 * c; y[c] = *(const f32x4*)(xrow[u] + k) * rstd[u] * *(const f32x4*)(gmp[u] + k) + *(const f32x4*)(shp[u] + k); }
                u32x2 q8; q8.x = pk4q(y[0].x, y[0].y, y[0].z, y[0].w); q8.y = pk4q(y[1].x, y[1].y, y[1].z, y[1].w);
                *(u32x2*)(hq[u] + 32 * s) = q8;
                u32x4 hw, lw;
                hw.x = pk2(y[0].x, y[0].y); hw.y = pk2(y[0].z, y[0].w); hw.z = pk2(y[1].x, y[1].y); hw.w = pk2(y[1].z, y[1].w);
                lw.x = pk2(y[0].x - bf2f((bf16_t)(hw.x & 0xffff)), y[0].y - bf2f((bf16_t)(hw.x >> 16))); lw.y = pk2(y[0].z - bf2f((bf16_t)(hw.y & 0xffff)), y[0].w - bf2f((bf16_t)(hw.y >> 16)));
                lw.z = pk2(y[1].x - bf2f((bf16_t)(hw.z & 0xffff)), y[1].y - bf2f((bf16_t)(hw.z >> 16))); lw.w = pk2(y[1].z - bf2f((bf16_t)(hw.w & 0xffff)), y[1].w - bf2f((bf16_t)(hw.w >> 16)));
                yh[u] = __builtin_bit_cast(bf16x8, hw); yl[u] = __builtin_bit_cast(bf16x8, lw);
            }
#pragma unroll
            for (int et = 0; et < 2; ++et) {
                const bf16x8 ah = *(const LAS bf16x8*)(lds + (16 * et + fr) * RW_STRIDE + (4 * s + fq) * 16), al = *(const LAS bf16x8*)(lds + RW_LO + (16 * et + fr) * RW_STRIDE + (4 * s + fq) * 16);
#pragma unroll
                for (int u = 0; u < NT; ++u) {
                    acc[u][et] = __builtin_amdgcn_mfma_f32_16x16x32_bf16(ah, yh[u], acc[u][et], 0, 0, 0);
                    acc[u][et] = __builtin_amdgcn_mfma_f32_16x16x32_bf16(ah, yl[u], acc[u][et], 0, 0, 0);
                    acc[u][et] = __builtin_amdgcn_mfma_f32_16x16x32_bf16(al, yh[u], acc[u][et], 0, 0, 0);
                }
            }
        }
#pragma unroll
        for (int u = 0; u < NT; ++u) {
            float lg[8];
#pragma unroll
            for (int et = 0; et < 2; ++et) { const f32x4 bb = *(const f32x4*)(p.b_router + l * NEXP + 16 * et + 4 * fq);
#pragma unroll
                for (int j = 0; j < 4; ++j) lg[4 * et + j] = acc[u][et][j] + bb[j]; }
            int te[4]; float tv[4];
#pragma unroll
            for (int k = 0; k < 4; ++k) {
                float bv = lg[0]; int be = 4 * fq;
#pragma unroll
                for (int i = 1; i < 8; ++i) { const int ei = 16 * (i >> 2) + 4 * fq + (i & 3); const bool t = lg[i] > bv; bv = t ? lg[i] : bv; be = t ? ei : be; }
#pragma unroll
                for (int d = 16; d < 64; d <<= 1) { const float ov = __shfl_xor(bv, d); const int oe = __shfl_xor(be, d); const bool t = (ov > bv) || (ov == bv && oe < be); bv = t ? ov : bv; be = t ? oe : be; }
                te[k] = be; tv[k] = bv;
#pragma unroll
                for (int i = 0; i < 8; ++i) { const int ei = 16 * (i >> 2) + 4 * fq + (i & 3); lg[i] = (be == ei) ? -INFINITY : lg[i]; }
            }
            float ex[4], es = 0.f;
#pragma unroll
            for (int k = 0; k < 4; ++k) { ex[k] = __expf(tv[k] - tv[0]); es += ex[k]; }
            {
                const int e = fq == 0 ? te[0] : fq == 1 ? te[1] : fq == 2 ? te[2] : te[3];
                const float wgt = (fq == 0 ? ex[0] : fq == 1 ? ex[1] : fq == 2 ? ex[2] : ex[3]) / es;
                const int rank = atomicAdd(&lcnt[e], 1);
                const int lid = wave * 128 + u * 64 + fr * 4 + fq;
                ent[lid] = e | (rank << 8); enttok[lid] = tk[u];
                tk_e[tk[u] * 4 + fq] = e; tk_w[tk[u] * 4 + fq] = wgt;
            }
        }
    };
    if (gw + ngw < ntile) body(std::integral_constant<int, 2>{}); else if (gw < ntile) body(std::integral_constant<int, 1>{});
    __syncthreads();
    if (tid < 32) lbase[tid] = (int)atomicAdd(&cntg[tid], (unsigned)lcnt[tid]);
    __syncthreads();
    for (int lid = tid; lid < RT_MAXENT; lid += NTHREADS) {
        const int en = ent[lid]; if (en < 0) continue;
        const int e = en & 255, rank = en >> 8, tokk = enttok[lid], k = lid & 3, pos = lbase[e] + rank;
        tk_pos[tokk * 4 + k] = pos; list_tok[e * CAP + pos] = tokk;
    }
}

DEV void stage_combine(const P& p, int l, int bid, int nb, unsigned char* lds, int wvx) {
    const int tid_ = TID, lane = tid_ & 63, wave = tid_ >> 6;
    int* pstart = (int*)lds; int* cnt = pstart + 40;
    moe_prefix(p, l, pstart, cnt, wvx);
    float* xr = (float*)(p.ws + OFF_XR); const bf16_t* yb = (const bf16_t*)(p.ws + OFF_YB); bf16_t* hbf = (bf16_t*)(p.ws + OFF_HBF);
    const int* tk_e = (const int*)(p.ws + OFF_TK + (size_t)l * TK_LAYER); const float* tk_w = (const float*)(tk_e + TA * 4); const int* tk_pos = (const int*)(tk_w + TA * 4);
    const int NR = l == 0 ? TA : TL;
    int row = bid * NWAVES + wave;
    int ce[4], cp[4]; float cw[4]; f32x4 xv[4];
    if (row < NR) {
#pragma unroll
        for (int k = 0; k < 4; ++k) { ce[k] = tk_e[row * 4 + k]; cw[k] = tk_w[row * 4 + k]; cp[k] = tk_pos[row * 4 + k]; }
#pragma unroll
        for (int j = 0; j < 4; ++j) xv[j] = *(const f32x4*)(xr + (size_t)row * D + 4 * lane + 256 * j);
    }
    for (; row < NR; row += nb * NWAVES) {
        const int s = row_mod(row); const float* g2 = modp(p, l, s, 5);
        size_t slot[4];
#pragma unroll
        for (int k = 0; k < 4; ++k) slot[k] = (size_t)(pstart[ce[k]] + cp[k]);
        u32x2 yv[4][4];
#pragma unroll
        for (int k = 0; k < 4; ++k)
#pragma unroll
            for (int j = 0; j < 4; ++j) yv[k][j] = *(const u32x2*)(yb + slot[k] * D + 4 * lane + 256 * j);
        float w4[4]; f32x4 xc[4];
#pragma unroll
        for (int k = 0; k < 4; ++k) w4[k] = cw[k];
#pragma unroll
        for (int j = 0; j < 4; ++j) xc[j] = xv[j];
        const int rown = row + nb * NWAVES;
        if (rown < NR) {
#pragma unroll
            for (int k = 0; k < 4; ++k) { ce[k] = tk_e[rown * 4 + k]; cw[k] = tk_w[rown * 4 + k]; cp[k] = tk_pos[rown * 4 + k]; }
#pragma unroll
            for (int j = 0; j < 4; ++j) xv[j] = *(const f32x4*)(xr + (size_t)rown * D + 4 * lane + 256 * j);
        }
        f32x4 a[4];
#pragma unroll
        for (int j = 0; j < 4; ++j) a[j] = (f32x4){0.f, 0.f, 0.f, 0.f};
#pragma unroll
        for (int k = 0; k < 4; ++k) {
            const float w = w4[k];
#pragma unroll
            for (int j = 0; j < 4; ++j) { const u32x2 y = yv[k][j];
                a[j].x += w * bf2f((bf16_t)(y.x & 0xffff)); a[j].y += w * bf2f((bf16_t)(y.x >> 16)); a[j].z += w * bf2f((bf16_t)(y.y & 0xffff)); a[j].w += w * bf2f((bf16_t)(y.y >> 16)); }
        }
        f32x4 v[4];
#pragma unroll
        for (int j = 0; j < 4; ++j) { const int k = 4 * lane + 256 * j; v[j] = xc[j] + *(const f32x4*)(g2 + k) * a[j]; }
        if (l == 0) {
#pragma unroll
            for (int j = 0; j < 4; ++j) *(f32x4*)(xr + (size_t)row * D + 4 * lane + 256 * j) = v[j];
            norm_store(v, p.norm1 + D, modp(p, 1, s, 1), modp(p, 1, s, 0), hbf + (size_t)row * (INP_FP8 == 1 ? D / 2 : D), p.ws + OFF_HQ + (size_t)row * D, lane);
        } else if (row < TL) {
            float ss = 0.f;
#pragma unroll
            for (int j = 0; j < 4; ++j) ss += (v[j].x * v[j].x + v[j].y * v[j].y) + (v[j].z * v[j].z + v[j].w * v[j].w);
            const float rstd = rsqrtf(wave_sum(ss) * (1.f / D) + 1e-6f);
#pragma unroll
            for (int j = 0; j < 4; ++j) { const int k = 4 * lane + 256 * j; *(f32x4*)(p.out + (size_t)row * D + k) = v[j] * rstd * *(const f32x4*)(p.final_norm + k); }
        }
    }
}

namespace pg {
#define LAS __attribute__((address_space(3)))
constexpr int BM = 256, BK = 64, HALF = 128, HTB = HALF * BK * 2, STAGE_BYTES = 8 * HTB, NXCD = 8, WGM = 4;
DEV int lds_byte(int r, int c) { const int st = (r >> 4) * 2 + (c >> 5), rr = r & 15, cc = c & 31, ob = rr * 64 + cc * 2; return st * 1024 + (ob ^ (((ob >> 9) & 1) << 5)); }
DEV int perm32(int rho) { const int n = rho >> 4, i = rho & 15; return 8 * (i >> 2) + 4 * n + (i & 3); }
DEV void stage_rc(int b, int& R, int& C) { const int st = b / 1024, sb = b % 1024, swz = sb ^ (((sb >> 9) & 1) << 5); R = (st >> 1) * 16 + swz / 64; C = (st & 1) * 32 + (swz % 64) / 2; }
typedef int i32x8 __attribute__((ext_vector_type(8)));
typedef int i32x4v __attribute__((ext_vector_type(4)));
DEV i32x8 cat8(const bf16x8 a, const bf16x8 b) { const i32x4v x = __builtin_bit_cast(i32x4v, a), y = __builtin_bit_cast(i32x4v, b); return __builtin_shufflevector(x, y, 0, 1, 2, 3, 4, 5, 6, 7); }
DEV void mfma_q(f32x4& acc, const i32x8 b, const i32x8 a, const int one) {
    asm volatile("v_mfma_scale_f32_16x16x128_f8f6f4 %0, %1, %2, %0, %3, %3 op_sel_hi:[0,0,0]" : "+v"(acc) : "v"(b), "v"(a), "v"(one));
}
struct Unit { const char* aMat; const char* bBase; int pm, pn, kind, nt, perm, bslot; };
DEV void tile_from_L(int Lg, int nM, int nN, int& pm, int& pn) {
    const int nwg = nM * nN; int wgid = Lg; { const int q = nwg / NXCD, r = nwg % NXCD, xcd = wgid % NXCD, off = wgid / NXCD; wgid = (xcd < r ? xcd * (q + 1) : r * (q + 1) + (xcd - r) * q) + off; }
    const int nig = WGM * nN, gid = wgid / nig, fm = gid * WGM, gsz = (nM - fm) < WGM ? (nM - fm) : WGM;
    pm = fm + ((wgid % nig) % gsz); pn = (wgid % nig) / gsz;
}
template <class Epi, class Sched>
DEV void gemm_phase(LAS unsigned char* lds, const Sched& S, const Epi& E, const int ldb, const int wvx) {
    constexpr bool FP8 = Sched::FP8;
    constexpr int PERMC = Sched::PERMC;
    constexpr bool GATHER = Sched::GATHER;
    const int tid = TID, wid = __builtin_amdgcn_readfirstlane(tid >> 6), lane = tid & 63, wr = wid >> 2, wc = wid & 3, fr = lane & 15, fq = lane >> 4;
    unsigned voffB[2], voffBp[2], voffA[2];
#pragma unroll
    for (int i = 0; i < 2; ++i) { int R_, C_; stage_rc(tid * 16 + i * 8192, R_, C_); voffB[i] = (unsigned)(R_ * ldb + C_) * 2u; voffA[i] = (unsigned)(R_ * ldb + C_) * 2u;
        voffBp[i] = (unsigned)(((R_ & ~31) + perm32(R_ & 31)) * ldb + C_) * 2u; }
    const size_t kstep = (size_t)(BK * 2);
    const size_t hstepB = (size_t)HALF * ldb * 2;
    const unsigned ldsw = (unsigned)wid * 1024u;
    const int aoff = lds_byte(wr * 64 + fr, fq * 8), boff = lds_byte(wc * 32 + fr, fq * 8);
#define PG_SA(b, h) (((b) * 2 + (h)) * HTB)
#define PG_SB(b, h) ((4 + (b) * 2 + (h)) * HTB)
#define PG_STAGE(bufoff, gbase, voff) do { const char* gb_ = (const char*)(gbase); asm("" : "+s"(gb_));   _Pragma("unroll") for (int _i = 0; _i < 2; ++_i) { \
        unsigned vo_ = (voff)[_i]; asm volatile("" : "+v"(vo_)); __builtin_amdgcn_global_load_lds((const unsigned*)(gb_ + vo_), (LAS unsigned*)(lds + (bufoff) + ldsw + _i * 8192), 16, 0, 0); } } while (0)
#define PG_STAGE_A(bufoff, gbase, h, og) do { if constexpr (GATHER) PG_STAGE(bufoff, gbase, (og)[h]); else PG_STAGE(bufoff, (gbase) + (h) * hstepB, voffA); } while (0)
#define PG_LDA(dst, b, h) do { _Pragma("unroll") for (int m = 0; m < 4; ++m) _Pragma("unroll") for (int k = 0; k < 2; ++k) dst[m][k] = *(const LAS bf16x8*)(lds + PG_SA(b, h) + aoff + m * 2048 + k * 1024); } while (0)
#define PG_LDB(dst, b, h) do { _Pragma("unroll") for (int n = 0; n < 2; ++n) _Pragma("unroll") for (int k = 0; k < 2; ++k) dst[n][k] = *(const LAS bf16x8*)(lds + PG_SB(b, h) + boff + n * 2048 + k * 1024); } while (0)
#define PG_MMA(ai, bj, At, Bt) do { __builtin_amdgcn_s_setprio(1); if constexpr (FP8) { _Pragma("unroll") for (int m = 0; m < 4; ++m) _Pragma("unroll") for (int n = 0; n < 2; ++n) \
        mfma_q(acc[ai][bj][m][n], cat8(Bt[n][0], Bt[n][1]), cat8(At[m][0], At[m][1]), qone); } \
        else { _Pragma("unroll") for (int m = 0; m < 4; ++m) _Pragma("unroll") for (int n = 0; n < 2; ++n) _Pragma("unroll") for (int k = 0; k < 2; ++k) \
        acc[ai][bj][m][n] = __builtin_amdgcn_mfma_f32_16x16x32_bf16(Bt[n][k], At[m][k], acc[ai][bj][m][n], 0, 0, 0); } __builtin_amdgcn_s_setprio(0); } while (0)
#define PG_WAIT_V(n) asm volatile("s_waitcnt vmcnt(" #n ")" ::: "memory")
#define PG_WAIT_L(n) asm volatile("s_waitcnt lgkmcnt(" #n ")" ::: "memory")
#define PG_BAR __builtin_amdgcn_s_barrier()
#define PG_SCHED __builtin_amdgcn_sched_barrier(0)
    Unit cur, nxt; int ui = 0;
    constexpr bool DYN = Sched::DYN;
    volatile LAS int* dslot = (volatile LAS int*)(lds + 131072 + 1024);
    if constexpr (DYN) {
        if (tid == 0) dslot[0] = S.grab();
        __syncthreads();
        const int L0 = __builtin_amdgcn_readfirstlane(dslot[0]);
        __syncthreads();
        if (!S.decode(L0, cur)) return;
    } else { if (!S.next(0, cur)) return; }
    int qone = 0x7F7F7F7F; if constexpr (FP8) asm volatile("" : "+v"(qone));
    LAS unsigned char* bslots = lds + 131072 + 4096;
    cur.bslot = 0;
    if constexpr (Epi::BIASL) { if (wid == 0) __builtin_amdgcn_global_load_lds((const unsigned*)E.bias_src(cur, lane), (LAS unsigned*)(bslots), 16, 0, 0); }
    f32x4 acc[2][2][4][2];
#pragma unroll
    for (int a = 0; a < 2; ++a)
#pragma unroll
        for (int b = 0; b < 2; ++b)
#pragma unroll
            for (int m = 0; m < 4; ++m)
#pragma unroll
                for (int n = 0; n < 2; ++n) acc[a][b][m][n] = (f32x4){0.f, 0.f, 0.f, 0.f};
    bf16x8 At[4][2], B0[2][2], B1[2][2];
    unsigned offC[2][2], offK[2][2];
    constexpr bool KEEPK = GATHER && !FP8;
    if constexpr (GATHER) { S.aoff(cur, tid, offC);
        if constexpr (KEEPK) {
#pragma unroll
        for (int h = 0; h < 2; ++h)
#pragma unroll
            for (int i = 0; i < 2; ++i) offK[h][i] = offC[h][i]; } }
    const char* cA = cur.aMat; const char* cB = cur.bBase;
    unsigned vbc[2];
#pragma unroll
    for (int i = 0; i < 2; ++i) vbc[i] = PERMC == 0 ? voffB[i] : PERMC == 1 ? voffBp[i] : cur.perm ? voffBp[i] : voffB[i];
    PG_STAGE(PG_SB(0, 0), cB, vbc); PG_STAGE(PG_SB(0, 1), cB + hstepB, vbc); PG_STAGE_A(PG_SA(0, 0), cA, 0, offC); PG_STAGE_A(PG_SA(0, 1), cA, 1, offC);
    if (wr == 1) PG_BAR;
    PG_WAIT_V(2); PG_BAR;
    PG_STAGE(PG_SB(1, 0), cB + kstep, vbc); PG_STAGE_A(PG_SA(1, 0), cA + kstep, 0, offC); PG_STAGE(PG_SB(1, 1), cB + hstepB + kstep, vbc);
    PG_WAIT_V(6); PG_BAR;
    for (;;) {
        bool has_next = false; const char* nA = cA; const char* nB = cB; int tk_ = 0;
        if constexpr (DYN) { if (tid == 0) tk_ = S.grab(); }
        else { has_next = S.next(ui + 1, nxt); nA = has_next ? nxt.aMat : cA; nB = has_next ? nxt.bBase : cB; }
        nxt.bslot = cur.bslot == 2 ? 0 : cur.bslot + 1;
        if constexpr (Epi::BIASL && !DYN) { if (has_next && wid == 0) __builtin_amdgcn_global_load_lds((const unsigned*)E.bias_src(nxt, lane), (LAS unsigned*)(bslots + nxt.bslot * 1024), 16, 0, 0); }
        const int nt = cur.nt;
        for (int t = 0; t < nt; t += 2) {
            const bool last = (t == nt - 2);
            if constexpr (DYN) {
                if (t == 2) { if (tid == 0) dslot[(ui + 1) & 1] = tk_; }
                if (t == 4) { const int Ln = __builtin_amdgcn_readfirstlane(dslot[(ui + 1) & 1]); has_next = S.decode(Ln, nxt); nA = has_next ? nxt.aMat : cA; nB = has_next ? nxt.bBase : cB; }
            }
            if constexpr (Epi::HAS_MID) { if (t == 8 || t == 12) E.mid(acc, cur, t, wr, wc, fr, fq); }
            const char* a1 = cA + (size_t)(t + 1) * kstep;
            const char* a2 = last ? nA : cA + (size_t)(t + 2) * kstep; const char* b2 = last ? nB : cB + (size_t)(t + 2) * kstep;
            const char* a3 = a2 + kstep; const char* b3 = b2 + kstep;
            unsigned vb2[2];
            { const int pf_ = (last && has_next) ? nxt.perm : cur.perm;
#pragma unroll
              for (int i = 0; i < 2; ++i) vb2[i] = PERMC == 0 ? voffB[i] : PERMC == 1 ? voffBp[i] : pf_ ? voffBp[i] : voffB[i]; }
            unsigned o2[2][2];
            if constexpr (GATHER) {
                if (last && has_next) { S.aoff(nxt, tid, o2);
                    if constexpr (KEEPK) {
#pragma unroll
                    for (int h = 0; h < 2; ++h)
#pragma unroll
                        for (int i = 0; i < 2; ++i) offK[h][i] = o2[h][i]; } }
                else {
#pragma unroll
                    for (int h = 0; h < 2; ++h)
#pragma unroll
                        for (int i = 0; i < 2; ++i) o2[h][i] = offC[h][i];
                }
            }
            PG_LDB(B0, 0, 0); PG_LDB(B1, 0, 1); PG_SCHED; PG_LDA(At, 0, 0); PG_STAGE_A(PG_SA(1, 1), a1, 1, offC);
            PG_WAIT_V(8); PG_WAIT_L(0); PG_BAR; PG_MMA(0, 0, At, B0); PG_MMA(0, 1, At, B1); PG_BAR; PG_SCHED;
            PG_LDA(At, 0, 1); PG_STAGE(PG_SB(0, 0), b2, vb2); PG_STAGE(PG_SB(0, 1), b2 + hstepB, vb2); PG_STAGE_A(PG_SA(0, 0), a2, 0, o2);
            PG_WAIT_V(8); PG_WAIT_L(0); PG_BAR; PG_MMA(1, 0, At, B0); PG_MMA(1, 1, At, B1); PG_BAR; PG_SCHED;
            PG_LDB(B0, 1, 0); PG_LDB(B1, 1, 1); PG_SCHED; PG_LDA(At, 1, 0); PG_STAGE_A(PG_SA(0, 1), a2, 1, o2);
            PG_WAIT_V(8); PG_WAIT_L(0); PG_BAR; PG_MMA(0, 0, At, B0); PG_MMA(0, 1, At, B1); PG_BAR; PG_SCHED;
            PG_LDA(At, 1, 1); PG_STAGE(PG_SB(1, 0), b3, vb2); PG_STAGE(PG_SB(1, 1), b3 + hstepB, vb2); PG_STAGE_A(PG_SA(1, 0), a3, 0, o2);
            PG_WAIT_V(8); PG_WAIT_L(0); PG_BAR; PG_MMA(1, 0, At, B0); PG_MMA(1, 1, At, B1); PG_BAR; PG_SCHED;
        }
        if (wr == 0) PG_BAR;
        if constexpr (FP8) asm volatile("s_nop 15\n\ts_nop 7" ::: "memory");
        if constexpr (Epi::ACCS != 1.f) {
#pragma unroll
            for (int a = 0; a < 2; ++a)
#pragma unroll
                for (int b = 0; b < 2; ++b)
#pragma unroll
                    for (int m = 0; m < 4; ++m)
#pragma unroll
                        for (int n = 0; n < 2; ++n) acc[a][b][m][n] *= Epi::ACCS; }
        E(acc, cur, wr, wc, fr, fq);
        if (!has_next) break;
#pragma unroll
        for (int a = 0; a < 2; ++a)
#pragma unroll
            for (int b = 0; b < 2; ++b)
#pragma unroll
                for (int m = 0; m < 4; ++m)
#pragma unroll
                    for (int n = 0; n < 2; ++n) acc[a][b][m][n] = (f32x4){0.f, 0.f, 0.f, 0.f};
        cur = nxt; cA = nA; cB = nB; ++ui;
        if constexpr (KEEPK) {
#pragma unroll
            for (int h = 0; h < 2; ++h)
#pragma unroll
                for (int i = 0; i < 2; ++i) offC[h][i] = offK[h][i]; }
        else if constexpr (GATHER) S.aoff(cur, tid, offC);
        if (wr == 1) PG_BAR;
    }
    PG_WAIT_V(0);
    PG_BAR;
#undef PG_SA
#undef PG_SB
#undef PG_STAGE
#undef PG_STAGE_A
#undef PG_LDA
#undef PG_LDB
#undef PG_MMA
#undef PG_WAIT_V
#undef PG_WAIT_L
#undef PG_BAR
#undef PG_SCHED
}
}

DEV __amdgpu_buffer_rsrc_t mk_rsrc(const void* ptr, unsigned bytes) { return __builtin_amdgcn_make_buffer_rsrc((void*)ptr, (short)0, (int)bytes, 0x00020000); }
DEV void st_bf16x4(__amdgpu_buffer_rsrc_t rs, int voff, int soff, const f32x4 v) { u32x2 w; w.x = pk2(v[0], v[1]); w.y = pk2(v[2], v[3]); __builtin_amdgcn_raw_buffer_store_b64(w, rs, voff, soff, 0); }
DEV void stg_bf16x8(bf16_t* ptr, const f32x4 a, const f32x4 b) { u32x4 w; w.x = pk2(a[0], a[1]); w.y = pk2(a[2], a[3]); w.z = pk2(b[0], b[1]); w.w = pk2(b[2], b[3]); *(u32x4*)ptr = w; }
DEV f32x4 ld_bf16x4(const bf16_t* ptr) { const u32x2 w = *(const u32x2*)ptr; return (f32x4){bf2f((bf16_t)(w.x & 0xffff)), bf2f((bf16_t)(w.x >> 16)), bf2f((bf16_t)(w.y & 0xffff)), bf2f((bf16_t)(w.y >> 16))}; }

struct SchedA {
    const char* hbf; const char* wtin; const char* wtt; int G, c;
    static constexpr bool GATHER = false, FP8 = INP_FP8 == 1; static constexpr int PERMC = -1; static constexpr bool DYN = false;
    static constexpr int DR = FP8 ? D / 2 : D;
    static constexpr int NM = TA / 256, NN = NIN / 256 - 1, N1 = NM * NN, N2 = 3 * NM;
    DEV bool next(int i, pg::Unit& u) const {
        const int Lg = i * G + c; if (Lg >= N1 + N2) return false;
        u.nt = FP8 ? 8 : 16;
        if (Lg < N1) { pg::tile_from_L(Lg, NM, NN, u.pm, u.pn); if (u.pn >= 6) ++u.pn; u.kind = 0; u.perm = (u.pn == 3 || u.pn >= 6) ? 1 : 0; u.aMat = hbf + (size_t)u.pm * 256 * DR * 2; u.bBase = wtin + (size_t)u.pn * 256 * DR * 2; }
        else { const int r = Lg - N1; u.pm = r % 3; u.pn = r / 3; u.kind = 1; u.perm = 0; u.aMat = wtt + (size_t)u.pm * 256 * DR * 2; u.bBase = hbf + (size_t)u.pn * 256 * DR * 2; }
        return true;
    }
    DEV void aoff(const pg::Unit& u, const int tid, unsigned (&off)[2][2]) const {
        int R[2], C[2];
#pragma unroll
        for (int i = 0; i < 2; ++i) pg::stage_rc(tid * 16 + i * 8192, R[i], C[i]);
#pragma unroll
        for (int h = 0; h < 2; ++h)
#pragma unroll
            for (int i = 0; i < 2; ++i) off[h][i] = (unsigned)((u.pm * 256 + h * 128 + R[i]) * D + C[i]) * 2u;
    }
};
struct EpiA {
    static constexpr bool HAS_MID = false, BIASL = false; static constexpr float ACCS = INP_FP8 == 1 ? 1.f / QW : 1.f;
    const P& p; int l;
    DEV void operator()(const f32x4 (&acc)[2][2][4][2], const pg::Unit& u, int wr, int wc, int fr, int fq) const {
        if (u.kind == 0) {
            const __amdgpu_buffer_rsrc_t rs = mk_rsrc(p.ws + OFF_PROJ, (unsigned)((size_t)TA * NIN * 2));
            const bool isctx = u.pm * 256 >= TL;
            const f32x2* taba = (const f32x2*)(p.ws + OFF_TABA); const f32x2* tabr = (const f32x2*)(p.ws + OFF_TABR);
            if (u.perm) {
#pragma unroll
                for (int bj = 0; bj < 2; ++bj) {
                    const int cb = u.pn * 256 + bj * 128;
                    const int reg = cb < C_RGF ? 1 : cb < C_GA ? 3 : 4;
#pragma unroll
                    for (int ai = 0; ai < 2; ++ai)
#pragma unroll
                        for (int m = 0; m < 4; ++m) {
                            f32x4 o1 = acc[ai][bj][m][0], o2 = acc[ai][bj][m][1];
                            if (reg == 3) {
#pragma unroll
                                for (int i = 0; i < 4; ++i) { o1[i] = siluf_(o1[i]); o2[i] = siluf_(o2[i]); }
                            } else if (reg == 4) {
#pragma unroll
                                for (int i = 0; i < 4; ++i) { o1[i] = sigmoidf_(o1[i]); o2[i] = sigmoidf_(o2[i]); }
                            }
                            stg_bf16x8((bf16_t*)(p.ws + OFF_PROJ) + (size_t)(u.pm * 256 + ai * 128 + wr * 64 + m * 16 + fr) * NIN + cb + wc * 32 + 8 * fq, o1, o2);
                        }
                }
            } else {
#pragma unroll
            for (int bj = 0; bj < 2; ++bj) {
                const int cb = u.pn * 256 + bj * 128;
                const int reg = cb < C_V ? 0 : cb < C_RQ ? 1 : cb < C_RV ? 2 : cb < C_RGF ? 1 : cb < C_GA ? 3 : 4;
#pragma unroll
                for (int ai = 0; ai < 2; ++ai)
#pragma unroll
                    for (int m = 0; m < 4; ++m) {
                        const int row = u.pm * 256 + ai * 128 + wr * 64 + m * 16 + fr, pos = isctx ? 0 : (row & (L - 1));
                        f32x4 x1 = acc[ai][bj][m][0], x2 = acc[ai][bj][m][1], o1, o2;
                        if (reg == 0 || reg == 2) {
                            const f32x2* tp = reg == 0 ? ((wc & 1) ? taba + 256 * 16 + (pos & 63) * 16 : taba + (pos >> 6) * 16) + 4 * fq : tabr + pos * 32 + (wc & 1) * 16 + 4 * fq;
                            const f32x4 t0 = *(const f32x4*)tp, t1 = *(const f32x4*)(tp + 2);
                            const f32x4 cs = (f32x4){t0[0], t0[2], t1[0], t1[2]}, sn = (f32x4){t0[1], t0[3], t1[1], t1[3]};
                            o1 = x1 * cs - x2 * sn; o2 = x1 * sn + x2 * cs;
                            if (reg == 0 && cb < C_K) { o1 = o1 * (0.125f * LOG2E); o2 = o2 * (0.125f * LOG2E); }
                            else if (reg == 2 && cb >= C_RK) { o1 = o1 * 0.125f; o2 = o2 * 0.125f; }
                        } else if (reg == 1) { o1 = x1; o2 = x2; }
                        else if (reg == 3) {
#pragma unroll
                            for (int i = 0; i < 4; ++i) { o1[i] = siluf_(x1[i]); o2[i] = siluf_(x2[i]); }
                        } else {
#pragma unroll
                            for (int i = 0; i < 4; ++i) { o1[i] = sigmoidf_(x1[i]); o2[i] = sigmoidf_(x2[i]); }
                        }
                        const int so = ((u.pm * 256 + ai * 128 + m * 16) * NIN + cb) * 2;
                        st_bf16x4(rs, ((wr * 64 + fr) * NIN + wc * 32 + 4 * fq) * 2, so, o1);
                        st_bf16x4(rs, ((wr * 64 + fr) * NIN + wc * 32 + 4 * fq) * 2, so + 32, o2);
                    }
            }
            }
        } else {
            bf16_t* projT = (bf16_t*)(p.ws + OFF_PROJT);
            if (u.pm < 2) {
#pragma unroll
                for (int ai = 0; ai < 2; ++ai) {
                    if (u.pm == 0 && ai == 1) continue;
#pragma unroll
                    for (int m = 0; m < 4; ++m) {
                        const int row = u.pm * 256 + ai * 128 + wr * 64 + m * 16 + fr;
#pragma unroll
                        for (int bj = 0; bj < 2; ++bj)
#pragma unroll
                            for (int n = 0; n < 2; ++n) {
                                const int tok = u.pn * 256 + bj * 128 + wc * 32 + 16 * n + 4 * fq; const f32x4 v = acc[ai][bj][m][n];
                                u32x2 w; w.x = pk2(v[0], v[1]); w.y = pk2(v[2], v[3]);
                                *(u32x2*)(projT + (size_t)row * TA + tok) = w;
                            }
                    }
                }
            } else {
                const float* tcos = (const float*)(p.ws + OFF_TABRT); const float* tsin = tcos + (size_t)32 * L;
                const __amdgpu_buffer_rsrc_t rsT = __builtin_amdgcn_make_buffer_rsrc((void*)projT, (short)0, (int)(TROWS * TA * 2), 0x00020000);
                const int voT = ((wr * 64 + fr) * TA + wc * 32 + 4 * fq) * 2, sbase = u.pn * 256;
#pragma unroll
                for (int bj = 0; bj < 2; ++bj)
#pragma unroll
                    for (int n = 0; n < 2; ++n) {
                        const int tok0 = u.pn * 256 + bj * 128 + wc * 32 + 16 * n + 4 * fq, jj = tok0 & 127; const bool isctx = u.pn * 256 >= TL; const int pos = tok0 & (L - 1);
#pragma unroll
                        for (int ai = 0; ai < 2; ++ai) {
                            const int hh = 2 * ai + wr;
                            const f32x4 wf = *(const f32x4*)((const float*)(p.ws + OFF_TABW) + ((l * 2 + 0) * 4 + hh) * 128 + jj) * 0.125f;
                            const f32x4 wb = *(const f32x4*)((const float*)(p.ws + OFF_TABW) + ((l * 2 + 1) * 4 + hh) * 128 + jj) * 0.125f;
#pragma unroll
                            for (int mp = 0; mp < 2; ++mp) {
                                const int prow = ai * 128 + wr * 64 + mp * 32 + fr, f = mp * 16 + fr;
                                f32x4 cs = (f32x4){1.f, 1.f, 1.f, 1.f}, sn = (f32x4){0.f, 0.f, 0.f, 0.f};
                                if (!isctx) { cs = *(const f32x4*)(tcos + (size_t)f * L + pos); sn = *(const f32x4*)(tsin + (size_t)f * L + pos); }
                                const f32x4 x1 = acc[ai][bj][2 * mp][n], x2 = acc[ai][bj][2 * mp + 1][n];
                                const f32x4 o1 = x1 * cs - x2 * sn, o2 = x1 * sn + x2 * cs;
                                const f32x4 a1 = o1 * wf, a2 = o2 * wf, b1 = o1 * wb, b2 = o2 * wb;
                                u32x2 w; const int so = ((ai * 128 + mp * 32) * TA + sbase + bj * 128 + 16 * n) * 2;
                                w.x = pk2(a1[0], a1[1]); w.y = pk2(a1[2], a1[3]); __builtin_amdgcn_raw_buffer_store_b64(w, rsT, voT, so + (T_RKF * TA) * 2, 0);
                                w.x = pk2(a2[0], a2[1]); w.y = pk2(a2[2], a2[3]); __builtin_amdgcn_raw_buffer_store_b64(w, rsT, voT, so + ((T_RKF + 16) * TA) * 2, 0);
                                w.x = pk2(b1[0], b1[1]); w.y = pk2(b1[2], b1[3]); __builtin_amdgcn_raw_buffer_store_b64(w, rsT, voT, so + (T_RKB * TA) * 2, 0);
                                w.x = pk2(b2[0], b2[1]); w.y = pk2(b2[2], b2[3]); __builtin_amdgcn_raw_buffer_store_b64(w, rsT, voT, so + ((T_RKB + 16) * TA) * 2, 0);
                            }
                        }
                    }
            }
        }
    }
};
template <bool Q>
struct SchedAM {
    const char* hb; const char* wt; const char* wtt; unsigned* ctr; int xcd;
    static constexpr bool GATHER = false, FP8 = Q, DYN = true; static constexpr int PERMC = Q ? 1 : -1;
    static constexpr int DR = Q ? D / 2 : D;
    static constexpr int NM = TA / 256, NN = Q ? 12 : 8, N1 = NM * NN, N2 = Q ? 0 : NM;
    DEV int grab() const { return (int)__hip_atomic_fetch_add(ctr + xcd * 16, 1u, __ATOMIC_RELAXED, __HIP_MEMORY_SCOPE_AGENT); }
    DEV bool decode(int k, pg::Unit& u) const {
        const int Lg = k * 8 + xcd; if (Lg >= N1 + N2) return false;
        u.nt = Q ? 8 : 16;
        if (Lg < N1) { pg::tile_from_L(Lg, NM, NN, u.pm, u.pn); u.kind = 0; u.aMat = hb + (size_t)u.pm * 256 * DR * 2;
            if (Q) { u.bBase = wt + (size_t)u.pn * 256 * DR * 2; u.pn += 9; u.perm = 1; }
            else { if (u.pn >= 6) ++u.pn; u.perm = (u.pn == 3 || u.pn >= 6) ? 1 : 0; u.bBase = wt + (size_t)u.pn * 256 * DR * 2; } }
        else { const int r = Lg - N1; u.pm = 1; u.pn = r; u.kind = 1; u.perm = 0; u.aMat = wtt + (size_t)u.pm * 256 * DR * 2; u.bBase = hb + (size_t)u.pn * 256 * DR * 2; }
        return true;
    }
    DEV bool next(int i, pg::Unit& u) const { return false; }
    DEV void aoff(const pg::Unit& u, const int tid, unsigned (&off)[2][2]) const { off[0][0] = off[0][1] = off[1][0] = off[1][1] = 0u; }
};
struct EpiAQ : EpiA { static constexpr float ACCS = 1.f / QW; };
#ifndef NCONV_
#define NCONV_ 96
#endif
constexpr int NCONV = NCONV_;
DEV void stage_inproj_mixed(const P& p, int l, int bid, int nb, unsigned char* lds, int wvx) {
    unsigned* ctr = (unsigned*)(p.ws + OFF_CTL) + CW_DYN + l * 256;
    if (NCONV > 0 && bid >= nb - NCONV) { stage_prep_experts(p, l, bid - (nb - NCONV), NCONV, lds, wvx); __syncthreads(); }
    { SchedAM<false> S{(const char*)(p.ws + OFF_HBF), (const char*)(p.ws + OFF_WTIN) + (size_t)l * NIN * D * 2, (const char*)(p.ws + OFF_WTT) + (size_t)l * 768 * D * 2, ctr, bid & 7};
      EpiA E{p, l};
      pg::gemm_phase<EpiA, SchedAM<false>>((LAS unsigned char*)lds, S, E, D, wvx); }
    __syncthreads();
    { SchedAM<true> S{(const char*)(p.ws + OFF_HQ), (const char*)(p.ws + OFF_WTINQ) + (size_t)l * (NIN - C_GA) * D, nullptr, ctr + 128, bid & 7};
      EpiAQ E{{p, l}};
      pg::gemm_phase<EpiAQ, SchedAM<true>>((LAS unsigned char*)lds, S, E, D / 2, wvx); }
}
DEV void stage_inproj_fast(const P& p, int l, int bid, int nb, unsigned char* lds, int wvx) {
#if INP_FP8 == 2
    stage_inproj_mixed(p, l, bid, nb, lds, wvx); return;
#endif
    SchedA S{(const char*)(p.ws + OFF_HBF), (const char*)(p.ws + OFF_WTIN) + (size_t)l * NIN * SchedA::DR * 2, (const char*)(p.ws + OFF_WTT) + (size_t)l * 768 * SchedA::DR * 2, nb, bid};
    EpiA E{p, l};
    pg::gemm_phase<EpiA, SchedA>((LAS unsigned char*)lds, S, E, SchedA::DR, wvx);
}

DEV void moe_tiles(const P& p, int l, LAS int* tstart, LAS int* cnt, int wvx) {
    const int tid = TID;
    if (tid < 64) {
        unsigned* cntg = (unsigned*)(p.ws + OFF_CTL) + CW_CNT + l * 32;
        const int c = tid < 32 ? (int)__hip_atomic_load(cntg + (tid & 31), __ATOMIC_RELAXED, __HIP_MEMORY_SCOPE_AGENT) : 0;
        const int nt = (c + 255) >> 8; int incl = nt;
#pragma unroll
        for (int o = 1; o < 32; o <<= 1) { const int t = __shfl_up(incl, o); if ((tid & 63) >= o) incl += t; }
        if (tid < 32) { cnt[tid] = c; tstart[tid] = incl - nt; if (tid == 31) tstart[32] = incl; }
    }
    __syncthreads();
}
template <int NN, bool GATHER_, bool FP8_>
struct SchedMoe {
    static constexpr bool GATHER = GATHER_, FP8 = FP8_; static constexpr int PERMC = GATHER_ ? 0 : 1; static constexpr bool DYN = false;
    static constexpr int DR = FP8_ ? D / 2 : D;
    const char* amat; const char* wt; const int* list_tok; const LAS int* tstart; const LAS int* cnt; int G, c;
    DEV bool next(int i, pg::Unit& u) const {
        const int ntile = __builtin_amdgcn_readfirstlane(tstart[32]); const int Lg = i * G + c; if (Lg >= ntile * NN) return false;
        pg::tile_from_L(Lg, ntile, NN, u.pm, u.pn);
        int e = 0;
        for (int j = 1; j < 32; ++j) e = (u.pm >= __builtin_amdgcn_readfirstlane(tstart[j])) ? j : e;
        u.kind = e; u.nt = FP8_ ? 8 : 16; u.perm = GATHER_ ? 0 : 1; u.aMat = GATHER_ ? amat : amat + (size_t)u.pm * 256 * DR * 2; u.bBase = wt + ((size_t)e * NN * 256 + (size_t)u.pn * 256) * DR * 2;
        return true;
    }
    DEV void aoff(const pg::Unit& u, const int tid, unsigned (&off)[2][2]) const {
        int R[2], C[2];
#pragma unroll
        for (int i = 0; i < 2; ++i) pg::stage_rc(tid * 16 + i * 8192, R[i], C[i]);
#pragma unroll
        for (int h = 0; h < 2; ++h)
#pragma unroll
            for (int i = 0; i < 2; ++i) {
                if (GATHER) { const int e = u.kind, ts = __builtin_amdgcn_readfirstlane(tstart[e]), ce = __builtin_amdgcn_readfirstlane(cnt[e]), pos = (u.pm - ts) * 256 + h * 128 + R[i]; const int tok = list_tok[e * CAP + (pos < ce ? pos : ce - 1)]; off[h][i] = (unsigned)(tok * DR + C[i]) * 2u; }
                else off[h][i] = (unsigned)((u.pm * 256 + h * 128 + R[i]) * DR + C[i]) * 2u;
            }
    }
};
struct EpiM1 {
    static constexpr bool HAS_MID = false, BIASL = true; static constexpr float ACCS = 1.f;
    const P& p; int l; LAS unsigned char* bl;
    DEV const float* bias_src(const pg::Unit& u, int lane) const { return p.b1 + ((size_t)l * NEXP + u.kind) * 2048 + 128 * u.pn + (lane < 32 ? 4 * lane : 1024 + 4 * (lane - 32)); }
    DEV void operator()(const f32x4 (&acc)[2][2][4][2], const pg::Unit& u, int wr, int wc, int fr, int fq) const {
        bf16_t* act = (bf16_t*)(p.ws + OFF_ACT);
        const float* b1 = p.b1 + ((size_t)l * NEXP + u.kind) * 2048;
        const int q = fq == 1 ? 2 : fq == 2 ? 1 : fq;
        f32x4 bgv[2], blv[2];
#pragma unroll
        for (int bj = 0; bj < 2; ++bj) { const LAS float* sl = (const LAS float*)(bl + u.bslot * 1024) + 16 * (4 * bj + wc) + 4 * q; bgv[bj] = *(const LAS f32x4*)sl; blv[bj] = *(const LAS f32x4*)(sl + 128); }
        const int hi = fq >> 1;
        const int ccol = 16 * (8 * u.pn + 4 * hi + wc) + 8 * (fq & 1);
        constexpr float S1 = MOE_FP8 >= 1 ? 1.f / QW : 1.f;
#pragma unroll
        for (int ai = 0; ai < 2; ++ai)
#pragma unroll
            for (int m = 0; m < 4; ++m) {
#if MOE_FP8 >= 2
                unsigned q0 = 0, q1 = 0;
#pragma unroll
                for (int bj = 0; bj < 2; ++bj) {
                    f32x4 o;
#pragma unroll
                    for (int i = 0; i < 4; ++i) {
                        float glu = acc[ai][bj][m][0][i] * S1 + bgv[bj][i], lin = acc[ai][bj][m][1][i] * S1 + blv[bj][i];
                        glu = fminf(glu, 7.f); lin = fminf(fmaxf(lin, -7.f), 7.f);
                        o[i] = QA * glu * sigmoidf_(1.702f * glu) * (lin + 1.f);
                    }
                    if (bj == 0) q0 = pk4q(o[0], o[1], o[2], o[3]); else q1 = pk4q(o[0], o[1], o[2], o[3]);
                }
                { const auto r = __builtin_amdgcn_permlane32_swap(q0, q1, false, false); q0 = r[0]; q1 = r[1]; }
                u32x2 wq; wq.x = q0; wq.y = q1;
                *(u32x2*)((unsigned char*)act + (size_t)(u.pm * 256 + ai * 128 + wr * 64 + m * 16 + fr) * D + ccol) = wq;
            }
#else
                unsigned w0[2], w1[2];
#pragma unroll
                for (int bj = 0; bj < 2; ++bj) {
                    f32x4 o;
#pragma unroll
                    for (int i = 0; i < 4; ++i) {
                        float glu = acc[ai][bj][m][0][i] * S1 + bgv[bj][i], lin = acc[ai][bj][m][1][i] * S1 + blv[bj][i];
                        glu = fminf(glu, 7.f); lin = fminf(fmaxf(lin, -7.f), 7.f);
                        o[i] = glu * sigmoidf_(1.702f * glu) * (lin + 1.f);
                    }
                    if (bj == 0) { w0[0] = pk2(o[0], o[1]); w0[1] = pk2(o[2], o[3]); } else { w1[0] = pk2(o[0], o[1]); w1[1] = pk2(o[2], o[3]); }
                }
#pragma unroll
                for (int k = 0; k < 2; ++k) { const auto r = __builtin_amdgcn_permlane32_swap(w0[k], w1[k], false, false); w0[k] = r[0]; w1[k] = r[1]; }
                u32x4 w; w.x = w0[0]; w.y = w0[1]; w.z = w1[0]; w.w = w1[1];
                *(u32x4*)(act + (size_t)(u.pm * 256 + ai * 128 + wr * 64 + m * 16 + fr) * D + ccol) = w;
            }
#endif
    }
};
struct EpiM2 {
    static constexpr bool HAS_MID = false, BIASL = true; static constexpr float ACCS = 1.f;
    const P& p; int l; LAS unsigned char* bl;
    DEV const float* bias_src(const pg::Unit& u, int lane) const { return p.b2 + ((size_t)l * NEXP + u.kind) * D + 256 * u.pn + 4 * lane; }
    DEV void operator()(const f32x4 (&acc)[2][2][4][2], const pg::Unit& u, int wr, int wc, int fr, int fq) const {
        const __amdgpu_buffer_rsrc_t rs = mk_rsrc(p.ws + OFF_YB, (unsigned)((size_t)PMAX * D * 2));
        const float* b2 = p.b2 + ((size_t)l * NEXP + u.kind) * D;
        const int vo = ((wr * 64 + fr) * D + wc * 32 + 8 * fq) * 2;
        f32x4 bv[2][2];
#pragma unroll
        for (int bj = 0; bj < 2; ++bj)
#pragma unroll
            for (int n = 0; n < 2; ++n) bv[bj][n] = *(const LAS f32x4*)((const LAS float*)(bl + u.bslot * 1024) + bj * 128 + wc * 32 + 8 * fq + 4 * n);
#pragma unroll
        for (int bj = 0; bj < 2; ++bj)
#pragma unroll
            for (int ai = 0; ai < 2; ++ai)
#pragma unroll
                for (int m = 0; m < 4; ++m)
                    { constexpr float S2 = MOE_FP8 >= 2 ? 1.f / (QW * QA) : 1.f; const f32x4 a_ = acc[ai][bj][m][0] * S2 + bv[bj][0], b_ = acc[ai][bj][m][1] * S2 + bv[bj][1]; u32x4 w_; w_.x = pk2(a_[0], a_[1]); w_.y = pk2(a_[2], a_[3]); w_.z = pk2(b_[0], b_[1]); w_.w = pk2(b_[2], b_[3]);
                      *(u32x4*)((bf16_t*)(p.ws + OFF_YB) + (size_t)(u.pm * 256 + ai * 128 + wr * 64 + m * 16 + fr) * D + u.pn * 256 + bj * 128 + wc * 32 + 8 * fq) = w_; }
    }
};
DEV void stage_moe1_fast(const P& p, int l, int bid, int nb, unsigned char* lds, int wvx) {
    LAS int* tstart = (LAS int*)((LAS unsigned char*)lds + 131072); LAS int* cnt = tstart + 40;
    moe_tiles(p, l, tstart, cnt, wvx);
    constexpr bool Q = MOE_FP8 >= 1;
    SchedMoe<8, true, Q> S{(const char*)(p.ws + OFF_HBF), (const char*)(p.ws + OFF_WT1) + (size_t)l * NEXP * 2048 * D * (Q ? 1 : 2), (const int*)(p.ws + OFF_TK + (size_t)l * TK_LAYER) + 3 * TA * 4, tstart, cnt, nb, bid};
    EpiM1 E{p, l, (LAS unsigned char*)lds + 131072 + 4096};
    pg::gemm_phase<EpiM1, SchedMoe<8, true, Q>>((LAS unsigned char*)lds, S, E, Q ? D / 2 : D, wvx);
}
DEV void stage_moe2_fast(const P& p, int l, int bid, int nb, unsigned char* lds, int wvx) {
    LAS int* tstart = (LAS int*)((LAS unsigned char*)lds + 131072); LAS int* cnt = tstart + 40;
    moe_tiles(p, l, tstart, cnt, wvx);
    constexpr bool Q = MOE_FP8 >= 2;
    SchedMoe<4, false, Q> S{(const char*)(p.ws + OFF_ACT), (const char*)(p.ws + OFF_WT2) + (size_t)l * NEXP * D * D * (Q ? 1 : 2), nullptr, tstart, cnt, nb, bid};
    EpiM2 E{p, l, (LAS unsigned char*)lds + 131072 + 4096};
    pg::gemm_phase<EpiM2, SchedMoe<4, false, Q>>((LAS unsigned char*)lds, S, E, Q ? D / 2 : D, wvx);
}

struct SchedMerge {
    const char* mix; const char* wtm; int G, c, NM;
    static constexpr bool GATHER = false, FP8 = false; static constexpr int PERMC = -1; static constexpr bool DYN = false;
    static constexpr int NN = D / 256;
    DEV bool next(int i, pg::Unit& u) const {
        const int Lt = i * G + c; if (Lt >= NM * NN) return false;
        pg::tile_from_L(Lt, NM, NN, u.pm, u.pn);
        u.kind = 0; u.nt = 16; u.perm = 1; u.aMat = mix + (size_t)u.pm * 256 * D * 2; u.bBase = wtm + (size_t)u.pn * 256 * D * 2;
        return true;
    }
    DEV void aoff(const pg::Unit& u, const int tid, unsigned (&off)[2][2]) const {}
};
struct EpiMerge {
    static constexpr bool HAS_MID = true, BIASL = false; static constexpr float ACCS = 1.f;
    const P& p;
    DEV void mid(f32x4 (&acc)[2][2][4][2], const pg::Unit& u, int t, int wr, int wc, int fr, int fq) const {
        const bf16_t* proj = (const bf16_t*)(p.ws + OFF_PROJ);
        const int cnum = C_GA + (t == 8 ? 0 : 1024), cden = cnum + 1024;
#pragma unroll
        for (int ai = 0; ai < 2; ++ai)
#pragma unroll
            for (int m = 0; m < 4; ++m) {
                const bf16_t* rowp = proj + (size_t)(u.pm * 256 + ai * 128 + wr * 64 + m * 16 + fr) * NIN + u.pn * 256 + wc * 32 + 8 * fq;
#pragma unroll
                for (int bj = 0; bj < 2; ++bj) {
                    const u32x4 gnw = *(const u32x4*)(rowp + cnum + bj * 128), gdw = *(const u32x4*)(rowp + cden + bj * 128);
                    const unsigned gn_[4] = {gnw.x, gnw.y, gnw.z, gnw.w}, gd_[4] = {gdw.x, gdw.y, gdw.z, gdw.w};
#pragma unroll
                    for (int n = 0; n < 2; ++n)
#pragma unroll
                        for (int i = 0; i < 4; ++i) {
                            const unsigned wn = gn_[2 * n + (i >> 1)], wd = gd_[2 * n + (i >> 1)];
                            const float gnf = bf2f((bf16_t)((i & 1) ? (wn >> 16) : (wn & 0xffff))), gdf = bf2f((bf16_t)((i & 1) ? (wd >> 16) : (wd & 0xffff)));
                            acc[ai][bj][m][n][i] *= gnf * __builtin_amdgcn_rcpf(fmaxf(gdf, 1e-30f));
                        }
                }
            }
    }
    DEV void operator()(const f32x4 (&acc)[2][2][4][2], const pg::Unit& u, int wr, int wc, int fr, int fq) const {
        const bf16_t* proj = (const bf16_t*)(p.ws + OFF_PROJ);
        bf16_t* mo = (bf16_t*)(p.ws + OFF_M);
        u32x4 gw[2][4][2];
#pragma unroll
        for (int ai = 0; ai < 2; ++ai)
#pragma unroll
            for (int m = 0; m < 4; ++m) {
                const bf16_t* rowp = proj + (size_t)(u.pm * 256 + ai * 128 + wr * 64 + m * 16 + fr) * NIN + C_GA + 2048 + u.pn * 256 + wc * 32 + 8 * fq;
#pragma unroll
                for (int bj = 0; bj < 2; ++bj) gw[ai][m][bj] = *(const u32x4*)(rowp + bj * 128);
            }
#pragma unroll
        for (int ai = 0; ai < 2; ++ai)
#pragma unroll
            for (int m = 0; m < 4; ++m)
#pragma unroll
                for (int bj = 0; bj < 2; ++bj) {
                    const u32x4 w = gw[ai][m][bj];
                    const f32x4 g0 = (f32x4){bf2f((bf16_t)(w.x & 0xffff)), bf2f((bf16_t)(w.x >> 16)), bf2f((bf16_t)(w.y & 0xffff)), bf2f((bf16_t)(w.y >> 16))};
                    const f32x4 g1 = (f32x4){bf2f((bf16_t)(w.z & 0xffff)), bf2f((bf16_t)(w.z >> 16)), bf2f((bf16_t)(w.w & 0xffff)), bf2f((bf16_t)(w.w >> 16))};
#if OUT_FP8
                    { const f32x4 a_ = g0 * acc[ai][bj][m][0] * QM, b_ = g1 * acc[ai][bj][m][1] * QM; u32x2 wq; wq.x = pk4q(a_[0], a_[1], a_[2], a_[3]); wq.y = pk4q(b_[0], b_[1], b_[2], b_[3]);
                      *(u32x2*)((unsigned char*)mo + (size_t)(u.pm * 256 + ai * 128 + wr * 64 + m * 16 + fr) * D + u.pn * 256 + bj * 128 + wc * 32 + 8 * fq) = wq; }
#else
                    stg_bf16x8(mo + (size_t)(u.pm * 256 + ai * 128 + wr * 64 + m * 16 + fr) * D + u.pn * 256 + bj * 128 + wc * 32 + 8 * fq, g0 * acc[ai][bj][m][0], g1 * acc[ai][bj][m][1]);
#endif
                }
    }
};
DEV void stage_merge_fast(const P& p, int l, int bid, int nb, unsigned char* lds, int wvx) {
    SchedMerge S{(const char*)(p.ws + OFF_MIX), (const char*)(p.ws + OFF_WTM) + (size_t)l * D * D * 2, nb, bid, TL / 256};
    EpiMerge E{p};
    pg::gemm_phase<EpiMerge, SchedMerge>((LAS unsigned char*)lds, S, E, D, wvx);
}
struct SchedOut {
    const char* a; const char* wt; int G, c, NM;
    static constexpr bool GATHER = false, FP8 = OUT_FP8 != 0; static constexpr int PERMC = 0; static constexpr bool DYN = false;
    static constexpr int NN = D / 256, DR = FP8 ? D / 2 : D;
    DEV bool next(int i, pg::Unit& u) const {
        const int Lt = i * G + c; if (Lt >= NM * NN) return false;
        pg::tile_from_L(Lt, NM, NN, u.pm, u.pn);
        u.kind = 0; u.nt = FP8 ? 8 : 16; u.perm = 0; u.aMat = a + (size_t)u.pm * 256 * DR * 2; u.bBase = wt + (size_t)u.pn * 256 * DR * 2;
        return true;
    }
    DEV void aoff(const pg::Unit& u, const int tid, unsigned (&off)[2][2]) const {
        int R[2], C[2];
#pragma unroll
        for (int i = 0; i < 2; ++i) pg::stage_rc(tid * 16 + i * 8192, R[i], C[i]);
#pragma unroll
        for (int h = 0; h < 2; ++h)
#pragma unroll
            for (int i = 0; i < 2; ++i) off[h][i] = (unsigned)((u.pm * 256 + h * 128 + R[i]) * D + C[i]) * 2u;
    }
};
struct EpiOut {
    static constexpr bool HAS_MID = false, BIASL = false; static constexpr float ACCS = OUT_FP8 ? 1.f / (QW * QM) : 1.f;
    const P& p; int l;
    DEV void operator()(const f32x4 (&acc)[2][2][4][2], const pg::Unit& u, int wr, int wc, int fr, int fq) const {
        float* xr = (float*)(p.ws + OFF_XR);
        const int row00 = u.pm * 256; const int s = row_mod(row00);
        const float* g1 = modp(p, l, s, 2);
        const float* xbase = l == 0 ? (row00 < TL ? p.x : p.ctx - (size_t)TL * D) : xr;
        float sq[8] = {0.f, 0.f, 0.f, 0.f, 0.f, 0.f, 0.f, 0.f};
#pragma unroll
        for (int bj = 0; bj < 2; ++bj)
#pragma unroll
            for (int n = 0; n < 2; ++n) {
                const int c = u.pn * 256 + bj * 128 + wc * 32 + 16 * n + 4 * fq;
                const f32x4 gvn = *(const f32x4*)(g1 + c);
                f32x4 xin[8];
#pragma unroll
                for (int ai = 0; ai < 2; ++ai)
#pragma unroll
                    for (int m = 0; m < 4; ++m) xin[ai * 4 + m] = *(const f32x4*)(xbase + (size_t)(row00 + ai * 128 + wr * 64 + m * 16 + fr) * D + c);
#pragma unroll
                for (int ai = 0; ai < 2; ++ai)
#pragma unroll
                    for (int m = 0; m < 4; ++m) { const f32x4 xn = xin[ai * 4 + m] + gvn * acc[ai][bj][m][n];
                        *(f32x4*)(xr + (size_t)(row00 + ai * 128 + wr * 64 + m * 16 + fr) * D + c) = xn;
                        sq[ai * 4 + m] += (xn.x * xn.x + xn.y * xn.y) + (xn.z * xn.z + xn.w * xn.w); }
            }
        float* rowsq = (float*)(p.ws + OFF_ROWSQ);
#pragma unroll
        for (int i = 0; i < 8; ++i) { float v = sq[i]; v += __shfl_xor(v, 16); v += __shfl_xor(v, 32);
            if (fq == 0) rowsq[(size_t)(row00 + (i >> 2) * 128 + wr * 64 + (i & 3) * 16 + fr) * 16 + u.pn * 4 + wc] = v; }
    }
};
DEV void stage_out_fast(const P& p, int l, int bid, int nb, unsigned char* lds, int wvx) {
    SchedOut S{(const char*)(p.ws + OFF_M), OUT_FP8 ? (const char*)(p.ws + OFF_WTOQ) + (size_t)l * D * D : (const char*)(p.ws + OFF_WTO) + (size_t)l * D * D * 2, nb, bid, TL / 256};
    EpiOut E{p, l};
    pg::gemm_phase<EpiOut, SchedOut>((LAS unsigned char*)lds, S, E, SchedOut::DR, wvx);
}


DEV void stage_merge_ctx(const P& p, int l, int bid, int nb, int wvx) {
    const int tid_ = TID, lane = tid_ & 63, wave = tid_ >> 6, r16 = lane & 15, q4 = lane >> 4;
    const bf16_t* mix = (const bf16_t*)(p.ws + OFF_MIX); const bf16_t* wt = (const bf16_t*)(p.ws + OFF_WTM) + (size_t)l * D * D;
    const bf16_t* proj = (const bf16_t*)(p.ws + OFF_PROJ); bf16_t* mo = (bf16_t*)(p.ws + OFF_M);
    constexpr int TN = D / 32, TM = TC / 32;
    const int gw = bid * NWAVES + wave; if (gw & 3) return;
    for (int t = gw >> 2; t < TM * TN; t += (nb * NWAVES) >> 2) {
        const int tm = t / TN, tn = t % TN, row0 = TL + tm * 32, col0 = tn * 32;
        f32x4 msum[2][2]; zero_acc(msum);
#pragma unroll
        for (int br = 0; br < 3; ++br) {
            const int k0 = br == 0 ? 0 : (br == 1 ? 512 : 768), kl = br == 0 ? 512 : 256;
            f32x4 acc[2][2]; zero_acc(acc);
            mma_tile32(mix + (size_t)(row0 + r16) * D + k0 + 8 * q4, mix + (size_t)(row0 + 16 + r16) * D + k0 + 8 * q4,
                       wt + (size_t)(col0 + r16) * D + k0 + 8 * q4, wt + (size_t)(col0 + 16 + r16) * D + k0 + 8 * q4, kl, acc);
#pragma unroll
            for (int mt = 0; mt < 2; ++mt)
#pragma unroll
                for (int nt = 0; nt < 2; ++nt)
#pragma unroll
                    for (int j = 0; j < 4; ++j) {
                        const int row = row0 + 16 * mt + 4 * q4 + j, col = col0 + 16 * nt + r16;
                        msum[mt][nt][j] += bf2f(proj[(size_t)row * NIN + C_GA + br * 1024 + col]) * acc[mt][nt][j];
                    }
        }
#pragma unroll
        for (int mt = 0; mt < 2; ++mt)
#pragma unroll
            for (int nt = 0; nt < 2; ++nt)
#pragma unroll
                for (int j = 0; j < 4; ++j) mo[(size_t)(row0 + 16 * mt + 4 * q4 + j) * D + col0 + 16 * nt + r16] = f2bf(msum[mt][nt][j]);
    }
}
DEV void stage_out_ctx(const P& p, int l, int bid, int nb, int wvx) {
    const int tid_ = TID, lane = tid_ & 63, wave = tid_ >> 6, r16 = lane & 15, q4 = lane >> 4;
    const bf16_t* mo = (const bf16_t*)(p.ws + OFF_M); const bf16_t* wt = (const bf16_t*)(p.ws + OFF_WTO) + (size_t)l * D * D;
    float* xr = (float*)(p.ws + OFF_XR);
    constexpr int TN = D / 32, TM = TC / 32;
    const int gw = bid * NWAVES + wave; if (gw & 3) return;
    for (int t = gw >> 2; t < TM * TN; t += (nb * NWAVES) >> 2) {
        const int tm = t / TN, tn = t % TN, row0 = TL + tm * 32, col0 = tn * 32;
        f32x4 acc[2][2]; zero_acc(acc);
        mma_tile32(mo + (size_t)(row0 + r16) * D + 8 * q4, mo + (size_t)(row0 + 16 + r16) * D + 8 * q4,
                   wt + (size_t)(col0 + r16) * D + 8 * q4, wt + (size_t)(col0 + 16 + r16) * D + 8 * q4, D, acc);
#pragma unroll
        for (int mt = 0; mt < 2; ++mt)
#pragma unroll
            for (int nt = 0; nt < 2; ++nt)
#pragma unroll
                for (int j = 0; j < 4; ++j) {
                    const int row = row0 + 16 * mt + 4 * q4 + j, col = col0 + 16 * nt + r16;
                    xr[(size_t)row * D + col] = p.ctx[(size_t)(row - TL) * D + col] + modp(p, l, 2, 2)[col] * acc[mt][nt][j];
                }
    }
}

constexpr size_t OFF_SPREV = OFF_ACT;
DEV void chunk_chain(int cidx, int& b, int& nf, int& nbk) {
    if (cidx < 256) { b = cidx >> 7; const int nl = cidx & 127; nf = 2 + nl; nbk = 2 + (127 - nl); }
    else { const int cc = cidx - 256; b = cc >> 1; const int nc = cc & 1; nf = nc; nbk = 1 - nc; }
}
constexpr int RKV_S = 160, RKV_F = 0, RKV_B = 128 * RKV_S;
DEV void stage_ret_kv(const P& p, int l, int bid, int nb, unsigned char* lds_, int wvx) {
    const int tid_ = TID, lane = tid_ & 63, wave = tid_ >> 6, r16 = lane & 15, q4 = lane >> 4;
    LAS unsigned char* lds = (LAS unsigned char*)lds_;
    const bf16_t* proj = (const bf16_t*)(p.ws + OFF_PROJ); const bf16_t* projT = (const bf16_t*)(p.ws + OFF_PROJT); float* kvbuf = (float*)(p.ws + OFF_KV);
    const float* wtab = (const float*)(p.ws + OFF_TABW) + (size_t)(l * 2) * 4 * 128;
    const int nunits = 260 * 4;
    u32x4 pre[2];
#define RKV_LOAD(unit_) do { const int row0_ = ((unit_) >> 2) * 128, h_ = (unit_) & 3; _Pragma("unroll") for (int i_ = 0; i_ < 2; ++i_) { const int pc = tid_ + 512 * i_; \
        pre[i_] = *(const u32x4*)(proj + (size_t)(row0_ + (pc >> 3)) * NIN + C_RK + h_ * 64 + (pc & 7) * 8); } } while (0)
    if (bid < nunits) RKV_LOAD(bid);
    for (int unit = bid; unit < nunits; unit += nb) {
        const int cidx = unit >> 2, h = unit & 3, row0 = cidx * 128;
        __syncthreads();
#pragma unroll
        for (int i = 0; i < 2; ++i) {
            const int pc = tid_ + 512 * i, j = pc >> 3;
            const float wf = wtab[(0 * 4 + h) * 128 + j], wb = wtab[(1 * 4 + h) * 128 + j];
            const unsigned w4[4] = {pre[i].x, pre[i].y, pre[i].z, pre[i].w};
            u32x4 of, ob; unsigned rf[4], rb[4];
#pragma unroll
            for (int k = 0; k < 4; ++k) { const float lo = bf2f((bf16_t)(w4[k] & 0xffff)), hi = bf2f((bf16_t)(w4[k] >> 16)); rf[k] = pk2(lo * wf, hi * wf); rb[k] = pk2(lo * wb, hi * wb); }
            of.x = rf[0]; of.y = rf[1]; of.z = rf[2]; of.w = rf[3]; ob.x = rb[0]; ob.y = rb[1]; ob.z = rb[2]; ob.w = rb[3];
            *(LAS u32x4*)(lds + RKV_F + j * RKV_S + (pc & 7) * 16) = of;
            *(LAS u32x4*)(lds + RKV_B + j * RKV_S + (pc & 7) * 16) = ob;
        }
        __syncthreads();
        if (unit + nb < nunits) RKV_LOAD(unit + nb);
        const int dir = wave >> 2, quad = wave & 3, e0 = (quad >> 1) * 32, d0 = (quad & 1) * 32;
        int b, nf, nbk; chunk_chain(cidx, b, nf, nbk);
        const bf16_t* va = projT + (size_t)(T_RV + h * 64 + e0 + r16) * TA + row0 + 8 * q4;
        const LAS unsigned char* kimg = lds + (dir ? RKV_B : RKV_F) + (8 * q4 + (r16 >> 2)) * RKV_S + (d0 + 4 * (r16 & 3)) * 2;
        f32x4 acc[2][2]; zero_acc(acc);
#pragma unroll
        for (int ks = 0; ks < 4; ++ks) {
            const bf16x8 fa0 = *(const bf16x8*)(va + 32 * ks), fa1 = *(const bf16x8*)(va + (size_t)16 * TA + 32 * ks);
            bf16x8 fb[2];
#pragma unroll
            for (int nt = 0; nt < 2; ++nt) {
                const u32x2 lo = lds_tr16(kimg + 32 * ks * RKV_S + 32 * nt), hi = lds_tr16(kimg + (32 * ks + 4) * RKV_S + 32 * nt);
                u32x4 w; w.x = lo.x; w.y = lo.y; w.z = hi.x; w.w = hi.y; fb[nt] = __builtin_bit_cast(bf16x8, w);
            }
            acc[0][0] = __builtin_amdgcn_mfma_f32_16x16x32_bf16(fa0, fb[0], acc[0][0], 0, 0, 0);
            acc[0][1] = __builtin_amdgcn_mfma_f32_16x16x32_bf16(fa0, fb[1], acc[0][1], 0, 0, 0);
            acc[1][0] = __builtin_amdgcn_mfma_f32_16x16x32_bf16(fa1, fb[0], acc[1][0], 0, 0, 0);
            acc[1][1] = __builtin_amdgcn_mfma_f32_16x16x32_bf16(fa1, fb[1], acc[1][1], 0, 0, 0);
        }
        float* dst = kvbuf + ((size_t)(((b * 4 + h) * 2 + dir) * 130 + (dir ? nbk : nf))) * 4096;
#pragma unroll
        for (int mt = 0; mt < 2; ++mt)
#pragma unroll
            for (int nt = 0; nt < 2; ++nt)
#pragma unroll
                for (int j = 0; j < 4; ++j) dst[(e0 + 16 * mt + 4 * q4 + j) * 64 + d0 + 16 * nt + r16] = acc[mt][nt][j];
    }
    __syncthreads();
#undef RKV_LOAD
}
DEV void stage_ret_scan(const P& p, int l, int bid, int nb, int wvx) {
    const float* kvbuf = (const float*)(p.ws + OFF_KV); unsigned* sprev = (unsigned*)(p.ws + OFF_SPREV);
    for (int gt = bid * NTHREADS + TID; gt < 16 * 2048; gt += nb * NTHREADS) {
        const int chain = gt >> 11, i2 = gt & 2047, h = (chain >> 1) & 3, dir = chain & 1;
        const float gC = __expf(128.f * log_g(p, l, dir, h));
        const f32x2* src = (const f32x2*)(kvbuf + (size_t)chain * 130 * 4096) + i2; unsigned* dst = sprev + (size_t)chain * 130 * 2048 + i2;
        f32x2 s = (f32x2){0.f, 0.f};
        for (int n0 = 0; n0 < 130; n0 += 10) {
            f32x2 kv[10];
#pragma unroll
            for (int u = 0; u < 10; ++u) kv[u] = src[(size_t)(n0 + u) * 2048];
#pragma unroll
            for (int u = 0; u < 10; ++u) { dst[(size_t)(n0 + u) * 2048] = pk2(s.x, s.y); s = s * gC + kv[u]; }
        }
    }
}
DEV bf16x8 pack_b(const f32x4 a, const f32x4 b) {
    u32x4 w; w.x = pk2(a[0], a[1]); w.y = pk2(a[2], a[3]); w.z = pk2(b[0], b[1]); w.w = pk2(b[2], b[3]);
    return __builtin_bit_cast(bf16x8, w);
}
DEV bf16x8 ldv_frag(const bf16_t* rowp  , int q4) {
    const u32x2 a = *(const u32x2*)(rowp + 4 * q4), b = *(const u32x2*)(rowp + 16 + 4 * q4);
    u32x4 w; w.x = a.x; w.y = a.y; w.z = b.x; w.w = b.y; return __builtin_bit_cast(bf16x8, w);
}
constexpr int RO_K = 0, RO_V = 128 * 144, RO_S = RO_V + 64 * 272, RO_END = RO_S + 2 * 64 * 144;
DEV void stage_ret_out(const P& p, int l, int bid, int nb, unsigned char* lds_, int wvx) {
    const int tid_ = TID, lane = tid_ & 63, wave = tid_ >> 6, r16 = lane & 15, q4 = lane >> 4;
    LAS unsigned char* lds = (LAS unsigned char*)lds_;
    const bf16_t* proj = (const bf16_t*)(p.ws + OFF_PROJ); const bf16_t* projT = (const bf16_t*)(p.ws + OFF_PROJT);
    const bf16_t* sprev = (const bf16_t*)(p.ws + OFF_SPREV); bf16_t* mix = (bf16_t*)(p.ws + OFF_MIX);
    const int nunits = (l == 0 ? 260 : 256) * 4;
    u32x4 pre[6];
#define RO_LOAD(unit_) do { const int cidx_ = (unit_) >> 2, h_ = (unit_) & 3, row0_ = cidx_ * 128; int b_, nf_, nbk_; chunk_chain(cidx_, b_, nf_, nbk_); \
        _Pragma("unroll") for (int i_ = 0; i_ < 2; ++i_) { const int pc = tid_ + 512 * i_; \
            pre[i_] = *(const u32x4*)(proj + (size_t)(row0_ + (pc >> 3)) * NIN + C_RK + h_ * 64 + (pc & 7) * 8); \
            pre[2 + i_] = *(const u32x4*)(projT + (size_t)(T_RV + h_ * 64 + (pc >> 4)) * TA + row0_ + (pc & 15) * 8); \
            const int dir_ = pc >> 9, pp = pc & 511; \
            pre[4 + i_] = *(const u32x4*)(sprev + ((size_t)(((b_ * 4 + h_) * 2 + dir_) * 130 + (dir_ ? nbk_ : nf_))) * 4096 + (pp >> 3) * 64 + (pp & 7) * 8); } } while (0)
#define RO_WRITE() do { _Pragma("unroll") for (int i_ = 0; i_ < 2; ++i_) { const int pc = tid_ + 512 * i_; \
            *(LAS u32x4*)(lds + RO_K + (pc >> 3) * 144 + (pc & 7) * 16) = pre[i_]; \
            *(LAS u32x4*)(lds + RO_V + (pc >> 4) * 272 + (pc & 15) * 16) = pre[2 + i_]; \
            const int dir_ = pc >> 9, pp = pc & 511; \
            *(LAS u32x4*)(lds + RO_S + dir_ * 64 * 144 + (pp >> 3) * 144 + (pp & 7) * 16) = pre[4 + i_]; } } while (0)
    for (int unit = bid; unit < nunits; unit += nb) {
        RO_LOAD(unit);
        __syncthreads();
        RO_WRITE();
        __syncthreads();
        const int cidx = unit >> 2, h = unit & 3, row0 = cidx * 128;
        const int irow = row0 + 16 * wave + r16, ii = 16 * wave + r16;
        const float lgf = log_g(p, l, 0, h), lgb = log_g(p, l, 1, h);
        bf16x8 qf[2];
#pragma unroll
        for (int ks = 0; ks < 2; ++ks) qf[ks] = *(const bf16x8*)(proj + (size_t)irow * NIN + C_RQ + h * 64 + 32 * ks + 8 * q4);
        f32x4 st[8];
#pragma unroll
        for (int mt = 0; mt < 8; ++mt) {
            st[mt] = (f32x4){0.f, 0.f, 0.f, 0.f};
#pragma unroll
            for (int ks = 0; ks < 2; ++ks) {
                const bf16x8 kf = *(const LAS bf16x8*)(lds + RO_K + (16 * mt + r16) * 144 + ks * 64 + q4 * 16);
                st[mt] = __builtin_amdgcn_mfma_f32_16x16x32_bf16(kf, qf[ks], st[mt], 0, 0, 0);
            }
        }
        float outv[4][4];
#pragma unroll
        for (int mt = 0; mt < 4; ++mt)
#pragma unroll
            for (int jj = 0; jj < 4; ++jj) outv[mt][jj] = 0.f;
#pragma nounroll
        for (int dir = 0; dir < 2; ++dir) {
            const float lg = dir ? lgb : lgf;
            f32x4 y[4];
#pragma unroll
            for (int mt = 0; mt < 4; ++mt) {
                y[mt] = (f32x4){0.f, 0.f, 0.f, 0.f};
#pragma unroll
                for (int ks = 0; ks < 2; ++ks) {
                    const bf16x8 sf = *(const LAS bf16x8*)(lds + RO_S + dir * 64 * 144 + (16 * mt + r16) * 144 + ks * 64 + q4 * 16);
                    y[mt] = __builtin_amdgcn_mfma_f32_16x16x32_bf16(sf, qf[ks], y[mt], 0, 0, 0);
                }
            }
            const float cs = __expf(lg * (float)(dir ? 128 - ii : ii + 1));
#pragma unroll
            for (int mt = 0; mt < 4; ++mt) y[mt] = y[mt] * cs;
#pragma unroll
            for (int s = 0; s < 4; ++s) {
                f32x4 pa, pb;
#pragma unroll
                for (int jj = 0; jj < 4; ++jj) {
                    const int ja = 32 * s + 4 * q4 + jj, jb = ja + 16;
                    const int da = dir ? ja - ii : ii - ja, db = dir ? jb - ii : ii - jb;
                    pa[jj] = da >= 0 ? st[2 * s][jj] * __expf(lg * (float)da) : 0.f;
                    pb[jj] = db >= 0 ? st[2 * s + 1][jj] * __expf(lg * (float)db) : 0.f;
                }
                const bf16x8 pf = pack_b(pa, pb);
#pragma unroll
                for (int mt = 0; mt < 4; ++mt) {
                    const LAS unsigned char* vp = lds + RO_V + (16 * mt + r16) * 272 + (32 * s + 4 * q4) * 2;
                    const u32x2 va = *(const LAS u32x2*)vp, vb = *(const LAS u32x2*)(vp + 32);
                    u32x4 vw; vw.x = va.x; vw.y = va.y; vw.z = vb.x; vw.w = vb.y;
                    y[mt] = __builtin_amdgcn_mfma_f32_16x16x32_bf16(__builtin_bit_cast(bf16x8, vw), pf, y[mt], 0, 0, 0);
                }
            }
            float sm = 0.f;
#pragma unroll
            for (int mt = 0; mt < 4; ++mt) sm += (y[mt][0] + y[mt][1]) + (y[mt][2] + y[mt][3]);
            sm += __shfl_xor(sm, 16); sm += __shfl_xor(sm, 32);
            const float mu = sm * (1.f / 64.f); float qv = 0.f;
#pragma unroll
            for (int mt = 0; mt < 4; ++mt) { const f32x4 dd = y[mt] - mu; qv += (dd[0] * dd[0] + dd[1] * dd[1]) + (dd[2] * dd[2] + dd[3] * dd[3]); }
            qv += __shfl_xor(qv, 16); qv += __shfl_xor(qv, 32);
            const float rs = rsqrtf(qv * (1.f / 64.f) + 1e-5f);
#pragma unroll
            for (int mt = 0; mt < 4; ++mt) {
                const f32x4 g = ld_bf16x4(proj + (size_t)irow * NIN + (dir ? C_RGB : C_RGF) + h * 64 + 16 * mt + 4 * q4);
#pragma unroll
                for (int jj = 0; jj < 4; ++jj) outv[mt][jj] += (y[mt][jj] - mu) * rs * g[jj];
            }
        }
#pragma unroll
        for (int mt = 0; mt < 4; ++mt) { u32x2 w; w.x = pk2(outv[mt][0], outv[mt][1]); w.y = pk2(outv[mt][2], outv[mt][3]);
            *(u32x2*)(mix + (size_t)irow * D + MX_RET + h * 64 + 16 * mt + 4 * q4) = w; }
    }
    __syncthreads();
#undef RO_LOAD
#undef RO_WRITE
}

#ifndef ATT_THR
#define ATT_THR 11.5f
#endif
constexpr int AT_K = 0, AT_V = 128 * 144, AT_VS = 160, AT_END = AT_V + 128 * AT_VS;
DEV void stage_attn_fast(const P& p, int l, int bid, int nb, unsigned char* lds_, int wvx) {
    const int tid_ = TID, lane = tid_ & 63, wave = tid_ >> 6, r16 = lane & 15, q4 = lane >> 4;
    LAS unsigned char* lds = (LAS unsigned char*)lds_;
    const bf16_t* proj = (const bf16_t*)(p.ws + OFF_PROJ); const bf16_t* projT = (const bf16_t*)(p.ws + OFF_PROJT); bf16_t* mix = (bf16_t*)(p.ws + OFF_MIX);
    constexpr int BIG = 1 << 20;
    constexpr int NQT = 4;
    for (int it = bid; it < (l == 0 ? 520 : 512); it += nb) {
        const int grp = it, g = wave >> 1, hq = wave & 1;
        int hk, qrow0, cbase, nblk = -1, lbase = 0;
        if (grp < 512) { const int b = grp >> 8; nblk = (grp >> 1) & 127; hk = grp & 1; lbase = b * L; qrow0 = lbase + nblk * 128 + 64 * hq; cbase = TL + b * LC; }
        else { const int gg = grp - 512, cb = gg >> 2, qb = (gg >> 1) & 1; hk = gg & 1; qrow0 = TL + cb * LC + qb * 128 + 64 * hq; cbase = TL + cb * LC; }
        const int h = hk * 4 + g;
        bf16x8 qf[NQT][2];
#pragma unroll
        for (int nt = 0; nt < NQT; ++nt)
#pragma unroll
            for (int ks = 0; ks < 2; ++ks) qf[nt][ks] = *(const bf16x8*)(proj + (size_t)(qrow0 + 16 * nt + r16) * NIN + C_Q + h * 64 + 32 * ks + 8 * q4);
        const float sink = p.sinks[l * 8 + h] * LOG2E;
        float mrun[NQT], lrun[NQT];
#pragma unroll
        for (int nt = 0; nt < NQT; ++nt) { mrun[nt] = sink; lrun[nt] = (q4 == 0) ? 1.f : 0.f; }
        f32x4 o[4][NQT];
#pragma unroll
        for (int mt = 0; mt < 4; ++mt)
#pragma unroll
            for (int nt = 0; nt < NQT; ++nt) o[mt][nt] = (f32x4){0.f, 0.f, 0.f, 0.f};
        u32x4 pre[4];
#define AT_CHUNK_OK(c) ((c) == 0 ? nblk >= 1 : (c) == 1 ? nblk >= 0 : (c) == 2 ? (nblk >= 0 && nblk < 127) : true)
#define AT_CHUNK_ROW(c) ((c) < 3 ? lbase + (nblk - 1 + (c)) * 128 : cbase + ((c) - 3) * 128)
#define AT_LOAD(c) do { const int kr_ = AT_CHUNK_ROW(c); _Pragma("unroll") for (int i_ = 0; i_ < 2; ++i_) { const int pc = tid_ + 512 * i_; \
            pre[i_] = *(const u32x4*)(proj + (size_t)(kr_ + (pc >> 3)) * NIN + C_K + hk * 64 + (pc & 7) * 8); \
            pre[2 + i_] = *(const u32x4*)(proj + (size_t)(kr_ + (pc >> 3)) * NIN + C_V + hk * 64 + (pc & 7) * 8); } } while (0)
#define AT_WRITE() do { _Pragma("unroll") for (int i_ = 0; i_ < 2; ++i_) { const int pc = tid_ + 512 * i_; \
            *(LAS u32x4*)(lds + AT_K + (pc >> 3) * 144 + (pc & 7) * 16) = pre[i_]; \
            *(LAS u32x4*)(lds + AT_V + (pc >> 3) * AT_VS + (pc & 7) * 16) = pre[2 + i_]; } } while (0)
        int c = 0; while (c < 5 && !AT_CHUNK_OK(c)) ++c;
        if (c < 5) AT_LOAD(c);
        while (c < 5) {
            int cn = c + 1; while (cn < 5 && !AT_CHUNK_OK(cn)) ++cn;
            __syncthreads();
            AT_WRITE();
            __syncthreads();
            if (cn < 5) AT_LOAD(cn);
            const int clo = c == 0 ? 0 : -BIG, chi = c == 2 ? 0 : BIG;
            const int sb0 = c == 0 ? 2 * hq : 0, sb1 = c == 2 ? 2 * hq + 1 : 3;
            for (int sb = sb0; sb <= sb1; ++sb) {
                const int dl0 = 32 * sb - 64 * hq;
                f32x4 sa[2][NQT];
#pragma unroll
                for (int mt = 0; mt < 2; ++mt) {
                    bf16x8 kf[2];
#pragma unroll
                    for (int ks = 0; ks < 2; ++ks) kf[ks] = *(const LAS bf16x8*)(lds + AT_K + (32 * sb + 16 * mt + r16) * 144 + ks * 64 + q4 * 16);
#pragma unroll
                    for (int nt = 0; nt < NQT; ++nt) {
                        sa[mt][nt] = (f32x4){0.f, 0.f, 0.f, 0.f};
#pragma unroll
                        for (int ks = 0; ks < 2; ++ks) sa[mt][nt] = __builtin_amdgcn_mfma_f32_16x16x32_bf16(kf[ks], qf[nt][ks], sa[mt][nt], 0, 0, 0);
                    }
                }
                bf16x8 pf[NQT];
                float lmax[NQT];
                if (c == 0 || c == 2) {
#pragma unroll
                    for (int nt = 0; nt < NQT; ++nt) {
                        float bm = -1e30f;
#pragma unroll
                        for (int mt = 0; mt < 2; ++mt)
#pragma unroll
                            for (int jj = 0; jj < 4; ++jj) {
                                const int dl = dl0 + 16 * mt + 4 * q4 + jj - (16 * nt + r16);
                                const float sv = (dl >= clo && dl <= chi) ? sa[mt][nt][jj] : -1e30f;
                                sa[mt][nt][jj] = sv; bm = fmaxf(bm, sv);
                            }
                        lmax[nt] = bm;
                    }
                } else {
#pragma unroll
                    for (int nt = 0; nt < NQT; ++nt)
                        lmax[nt] = fmaxf(fmaxf(fmaxf(sa[0][nt][0], sa[0][nt][1]), fmaxf(sa[0][nt][2], sa[0][nt][3])), fmaxf(fmaxf(sa[1][nt][0], sa[1][nt][1]), fmaxf(sa[1][nt][2], sa[1][nt][3])));
                }
                bool need = false;
#pragma unroll
                for (int nt = 0; nt < NQT; ++nt) need = need || (lmax[nt] > mrun[nt] + ATT_THR);
                if (__any(need)) {
#pragma unroll
                    for (int nt = 0; nt < NQT; ++nt) {
                        float bm = lmax[nt];
                        bm = fmaxf(bm, __shfl_xor(bm, 16)); bm = fmaxf(bm, __shfl_xor(bm, 32));
                        const float mn = fmaxf(mrun[nt], bm), sc = __builtin_amdgcn_exp2f(mrun[nt] - mn);
                        mrun[nt] = mn; lrun[nt] *= sc;
#pragma unroll
                        for (int mt = 0; mt < 4; ++mt) o[mt][nt] = o[mt][nt] * sc;
                    }
                }
#pragma unroll
                for (int nt = 0; nt < NQT; ++nt) {
                    float ps = 0.f;
#pragma unroll
                    for (int mt = 0; mt < 2; ++mt)
#pragma unroll
                        for (int jj = 0; jj < 4; ++jj) { const float pe = __builtin_amdgcn_exp2f(sa[mt][nt][jj] - mrun[nt]); sa[mt][nt][jj] = pe; ps += pe; }
                    lrun[nt] += ps;
                    pf[nt] = pack_b(sa[0][nt], sa[1][nt]);
                }
#pragma unroll
                for (int mt = 0; mt < 4; ++mt) {
                    const LAS unsigned char* vp = lds + AT_V + (32 * sb + 4 * q4 + (r16 >> 2)) * AT_VS + (16 * mt + 4 * (r16 & 3)) * 2;
                    const u32x2 va = lds_tr16(vp), vb = lds_tr16(vp + 16 * AT_VS);
                    u32x4 vw; vw.x = va.x; vw.y = va.y; vw.z = vb.x; vw.w = vb.y;
                    const bf16x8 vf = __builtin_bit_cast(bf16x8, vw);
#pragma unroll
                    for (int nt = 0; nt < NQT; ++nt) o[mt][nt] = __builtin_amdgcn_mfma_f32_16x16x32_bf16(vf, pf[nt], o[mt][nt], 0, 0, 0);
                }
            }
            c = cn;
        }
#undef AT_CHUNK_OK
#undef AT_CHUNK_ROW
#undef AT_LOAD
#undef AT_WRITE
#pragma unroll
        for (int nt = 0; nt < NQT; ++nt) {
            float lt = lrun[nt]; lt += __shfl_xor(lt, 16); lt += __shfl_xor(lt, 32);
            const float inv = 1.f / lt;
#pragma unroll
            for (int mt = 0; mt < 4; ++mt) { const f32x4 v = o[mt][nt] * inv; u32x2 w; w.x = pk2(v[0], v[1]); w.y = pk2(v[2], v[3]);
                *(u32x2*)(mix + (size_t)(qrow0 + 16 * nt + r16) * D + MX_ATTN + h * 64 + 16 * mt + 4 * q4) = w; }
        }
    }
    __syncthreads();
}

#define XB_TMO      128
#define XB_XCNT(j)  (256  + 64 * (j))
#define XB_XSUB(j)  (1280 + 64 * (j))
#define XB_XGEN(j)  (2304 + 64 * (j))
#define XB_TOP      3328
#define XB_TOPGEN   3392
#define XCD_BAR_WORDS 3456
#define XB_SPIN_CAP (1u << 18)
__device__ __forceinline__ unsigned xb_ld(unsigned* p)              { return __hip_atomic_load(p, __ATOMIC_RELAXED, __HIP_MEMORY_SCOPE_AGENT); }
__device__ __forceinline__ unsigned xb_add(unsigned* p, unsigned v) { return __hip_atomic_fetch_add(p, v, __ATOMIC_RELAXED, __HIP_MEMORY_SCOPE_AGENT); }
__device__ __forceinline__ unsigned xb_xcc_id() { return (unsigned)__builtin_amdgcn_s_getreg((3 << 11) | 20) & 0xFu; }
#define XB_SPIN(cond, bar) do { unsigned _sp = 0; while (cond) { __builtin_amdgcn_s_sleep(1); \
    if ((++_sp & 255u) == 0u) { if (xb_ld(&(bar)[XB_TMO])) break; if (_sp > XB_SPIN_CAP) { atomicAdd(&(bar)[XB_TMO], 1u); break; } } } } while (0)
struct XcdBarrier { unsigned* bar; unsigned x; volatile LAS unsigned* st; };
__device__ __forceinline__ XcdBarrier xcd_barrier_post(unsigned* bar, volatile LAS unsigned* st, const int wvx) {
    XcdBarrier b; b.bar = bar; b.x = xb_xcc_id(); b.st = st;
    if (TID == 0) (void)xb_add(&bar[XB_XCNT(b.x)], 1u);
    return b;
}
__device__ __forceinline__ void xcd_barrier_complete(unsigned* bar, unsigned x, unsigned& nloc, unsigned& nx) {
    const unsigned G = gridDim.x * gridDim.y * gridDim.z;
    unsigned sum, cnt, mine, sp = 0u;
    for (;;) {
        sum = 0u; cnt = 0u; mine = 0u;
#pragma unroll
        for (unsigned j = 0; j < 16; ++j) { const unsigned c = xb_ld(&bar[XB_XCNT(j)]); sum += c; cnt += (c > 0u) ? 1u : 0u; mine = (j == x) ? c : mine; }
        if (sum == G) break;
        __builtin_amdgcn_s_sleep(1);
        if ((++sp & 255u) == 0u) { if (xb_ld(&bar[XB_TMO])) break; if (sp > XB_SPIN_CAP) { atomicAdd(&bar[XB_TMO], 1u); break; } }
    }
    nloc = mine > 0u ? mine : 1u; nx = cnt > 0u ? cnt : 1u;
}
__device__ __forceinline__ void xcd_barrier(const XcdBarrier& b, const int wvx) {
    asm volatile("s_waitcnt vmcnt(0)" ::: "memory");
    __syncthreads();
    if (TID == 0) {
        unsigned* bar = b.bar;
        __builtin_amdgcn_s_waitcnt(0);
        unsigned nloc = b.st[0], nx = b.st[1];
        if (nloc == 0u) { xcd_barrier_complete(bar, b.x, nloc, nx); b.st[0] = nloc; b.st[1] = nx; }
        const unsigned old = xb_add(&bar[XB_XSUB(b.x)], 1u);
        const unsigned gen = old / nloc;
        if (old + 1u == (gen + 1u) * nloc) {
            __builtin_amdgcn_fence(__ATOMIC_RELEASE, "agent");
            asm volatile("s_waitcnt vmcnt(0)" ::: "memory");
            const unsigned og = xb_add(&bar[XB_TOP], 1u);
            const unsigned tg = og / nx;
            if (og + 1u == (tg + 1u) * nx) xb_add(&bar[XB_TOPGEN], 1u);
            else XB_SPIN(xb_ld(&bar[XB_TOPGEN]) == tg, bar);
            __builtin_amdgcn_fence(__ATOMIC_ACQUIRE, "agent");
            xb_add(&bar[XB_XGEN(b.x)], 1u);
            asm volatile("s_waitcnt vmcnt(0)" ::: "memory");
        } else {
            XB_SPIN(xb_ld(&bar[XB_XGEN(b.x)]) == gen, bar);
            __builtin_amdgcn_fence(__ATOMIC_ACQUIRE, "agent");
            asm volatile("s_waitcnt vmcnt(0)" ::: "memory");
        }
    }
    __syncthreads();
}

constexpr int NPL = 10;
constexpr int NPHASES = 2 + 2 * NPL;
constexpr int CW_BAR = 4096;
constexpr int LDS_BARW = LDS_BYTES - 16;
__global__ void __launch_bounds__(NTHREADS, 2) mk_fwd(P p) {
    extern __shared__ __attribute__((aligned(16))) unsigned char lds[];
    const int bid = blockIdx.x, nb = gridDim.x;
    const int wvx = __builtin_amdgcn_readfirstlane((int)(threadIdx.x >> 6));
    if (TID == 0) { ((volatile LAS unsigned*)(lds + LDS_BARW))[0] = 0u; ((volatile LAS unsigned*)(lds + LDS_BARW))[1] = 0u; }
    __syncthreads();
    const bool multi = (p.ph_hi - p.ph_lo) > 1;
    XcdBarrier bar; bar.bar = (unsigned*)(p.ws + OFF_CTL) + CW_BAR; bar.x = 0; bar.st = (volatile LAS unsigned*)(lds + LDS_BARW);
    if (multi) bar = xcd_barrier_post((unsigned*)(p.ws + OFF_CTL) + CW_BAR, (volatile LAS unsigned*)(lds + LDS_BARW), wvx);
#define IN(k) (p.ph_lo <= (k) && (k) < p.ph_hi)
#define STAGE(call) do { const P& q = p; const int ll = l; call; } while (0)
#define SEAM(k) do { if (IN(k) && IN((k) + 1)) xcd_barrier(bar, wvx); } while (0)
#ifndef PHMASK
#define PHMASK 0xFFFF
#endif
#define PHON(b) ((PHMASK >> (b)) & 1)
#ifndef DUPMASK
#define DUPMASK 0
#endif
#define DUPN(b) (1 + ((DUPMASK >> (b)) & 1))
    if (PHON(0) && IN(0)) { const int l = 0; for (int r_ = 0; r_ < DUPN(0); ++r_) { STAGE(stage_prep(q, bid, nb, lds, wvx)); __syncthreads(); } } SEAM(0);
    if (PHON(1) && IN(1)) { const int l = 0; STAGE(stage_norm0(q, bid, nb, wvx)); } SEAM(1);
    { constexpr int l = 0; const int pb = 2 + l * NPL;
        if (PHON(2) && IN(pb + 0)) { for (int r_ = 0; r_ < DUPN(2); ++r_) { STAGE(stage_inproj_fast(q, ll, bid, nb, lds, wvx)); __syncthreads(); } } SEAM(pb + 0);
        if (PHON(3) && IN(pb + 1)) { for (int r_ = 0; r_ < DUPN(3); ++r_) { if (l == 0) { if (bid >= 8) STAGE(stage_ret_kv(q, ll, bid - 8, nb - 8, lds, wvx)); } else STAGE(stage_ret_kv(q, ll, bid, nb, lds, wvx));     STAGE(stage_attn_fast(q, ll, bid, nb, lds, wvx)); __syncthreads(); } } SEAM(pb + 1);
        if (PHON(4) && IN(pb + 2)) { for (int r_ = 0; r_ < DUPN(4); ++r_) { if (bid < 64) STAGE(stage_ret_scan(q, ll, bid, 64, wvx)); else STAGE(stage_pool_diff(q, ll, bid - 64, nb - 64, wvx));     __syncthreads(); } } SEAM(pb + 2);
        if (PHON(5) && IN(pb + 3)) { for (int r_ = 0; r_ < DUPN(5); ++r_) { STAGE(stage_ret_out(q, ll, bid, nb, lds, wvx)); __syncthreads(); } } SEAM(pb + 3);
        if (PHON(6) && IN(pb + 4)) { for (int r_ = 0; r_ < DUPN(6); ++r_) { STAGE(stage_merge_fast(q, ll, bid, nb, lds, wvx)); if (l == 0) STAGE(stage_merge_ctx(q, ll, bid, nb, wvx)); __syncthreads(); } } SEAM(pb + 4);
        if (PHON(7) && IN(pb + 5)) { STAGE(stage_out_fast(q, ll, bid, nb, lds, wvx)); if (l == 0) STAGE(stage_out_ctx(q, ll, bid, nb, wvx)); } SEAM(pb + 5);
        if (PHON(8) && IN(pb + 6)) { if (INP_FP8 != 2 || NCONV_ == 0) { STAGE(stage_prep_experts(q, ll, bid, nb, lds, wvx)); __syncthreads(); } if (ROUTE_MFMA) STAGE(stage_route_mfma(q, ll, bid, nb, lds, wvx)); else STAGE(stage_route(q, ll, bid, nb, lds, wvx)); } SEAM(pb + 6);
        if (PHON(9) && IN(pb + 7)) { for (int r_ = 0; r_ < DUPN(9); ++r_) { STAGE(stage_moe1_fast(q, ll, bid, nb, lds, wvx)); __syncthreads(); } } SEAM(pb + 7);
        if (PHON(10) && IN(pb + 8)) { for (int r_ = 0; r_ < DUPN(10); ++r_) { STAGE(stage_moe2_fast(q, ll, bid, nb, lds, wvx)); __syncthreads(); } } SEAM(pb + 8);
        if (PHON(11) && IN(pb + 9)) { STAGE(stage_combine(q, ll, bid, nb, lds, wvx)); } SEAM(pb + 9);
     }
    { constexpr int l = 1; const int pb = 2 + l * NPL;
        if (PHON(2) && IN(pb + 0)) { for (int r_ = 0; r_ < DUPN(2); ++r_) { STAGE(stage_inproj_fast(q, ll, bid, nb, lds, wvx)); __syncthreads(); } } SEAM(pb + 0);
        if (PHON(3) && IN(pb + 1)) { for (int r_ = 0; r_ < DUPN(3); ++r_) { if (l == 0) { if (bid >= 8) STAGE(stage_ret_kv(q, ll, bid - 8, nb - 8, lds, wvx)); } else STAGE(stage_ret_kv(q, ll, bid, nb, lds, wvx));     STAGE(stage_attn_fast(q, ll, bid, nb, lds, wvx)); __syncthreads(); } } SEAM(pb + 1);
        if (PHON(4) && IN(pb + 2)) { for (int r_ = 0; r_ < DUPN(4); ++r_) { if (bid < 64) STAGE(stage_ret_scan(q, ll, bid, 64, wvx)); else STAGE(stage_pool_diff(q, ll, bid - 64, nb - 64, wvx));     __syncthreads(); } } SEAM(pb + 2);
        if (PHON(5) && IN(pb + 3)) { for (int r_ = 0; r_ < DUPN(5); ++r_) { STAGE(stage_ret_out(q, ll, bid, nb, lds, wvx)); __syncthreads(); } } SEAM(pb + 3);
        if (PHON(6) && IN(pb + 4)) { for (int r_ = 0; r_ < DUPN(6); ++r_) { STAGE(stage_merge_fast(q, ll, bid, nb, lds, wvx)); if (l == 0) STAGE(stage_merge_ctx(q, ll, bid, nb, wvx)); __syncthreads(); } } SEAM(pb + 4);
        if (PHON(7) && IN(pb + 5)) { STAGE(stage_out_fast(q, ll, bid, nb, lds, wvx)); if (l == 0) STAGE(stage_out_ctx(q, ll, bid, nb, wvx)); } SEAM(pb + 5);
        if (PHON(8) && IN(pb + 6)) { if (INP_FP8 != 2 || NCONV_ == 0) { STAGE(stage_prep_experts(q, ll, bid, nb, lds, wvx)); __syncthreads(); } if (ROUTE_MFMA) STAGE(stage_route_mfma(q, ll, bid, nb, lds, wvx)); else STAGE(stage_route(q, ll, bid, nb, lds, wvx)); } SEAM(pb + 6);
        if (PHON(9) && IN(pb + 7)) { for (int r_ = 0; r_ < DUPN(9); ++r_) { STAGE(stage_moe1_fast(q, ll, bid, nb, lds, wvx)); __syncthreads(); } } SEAM(pb + 7);
        if (PHON(10) && IN(pb + 8)) { for (int r_ = 0; r_ < DUPN(10); ++r_) { STAGE(stage_moe2_fast(q, ll, bid, nb, lds, wvx)); __syncthreads(); } } SEAM(pb + 8);
        if (PHON(11) && IN(pb + 9)) { STAGE(stage_combine(q, ll, bid, nb, lds, wvx)); } SEAM(pb + 9);
     }
#undef IN
#undef SEAM
}

#ifndef MK_CUTS
#define MK_CUTS 1
#endif
extern "C" void kernel_launch(void* const* d_in, const int* in_sizes, int n_in, void* d_out, int out_size, void* d_ws, size_t ws_size, hipStream_t stream) {
    static int grid = 0;
    if (grid == 0) {
        if (n_in != 24 || out_size != TL * D || ws_size < WS_END) { fprintf(stderr, "kernel_launch: unexpected shapes: n_in %d out %d ws %zu (need %zu)\n", n_in, out_size, ws_size, (size_t)WS_END); grid = -1; return; }
        int dev = 0, cus = 0, per_cu = 0;
        if (hipGetDevice(&dev) != hipSuccess || hipDeviceGetAttribute(&cus, hipDeviceAttributeMultiprocessorCount, dev) != hipSuccess) { grid = -1; return; }
        if (hipFuncSetAttribute((const void*)mk_fwd, hipFuncAttributeMaxDynamicSharedMemorySize, LDS_BYTES) != hipSuccess) { fprintf(stderr, "kernel_launch: hipFuncSetAttribute failed\n"); grid = -1; return; }
        if (hipOccupancyMaxActiveBlocksPerMultiprocessor(&per_cu, (const void*)mk_fwd, NTHREADS, LDS_BYTES) != hipSuccess || per_cu < 1) { fprintf(stderr, "kernel_launch: occupancy query says %d blocks per CU\n", per_cu); (void)hipGetLastError(); }
        grid = cus > 0 ? cus : 256;
    }
    if (grid < 0) return;
    (void)hipMemsetAsync((char*)d_ws + OFF_CTL, 0, CTL_BYTES, stream);
    P p; memset(&p, 0, sizeof(p));
    const float** f = (const float**)&p;
    for (int i = 0; i < 24; ++i) f[i] = (const float*)d_in[i];
    p.out = (float*)d_out; p.ws = (unsigned char*)d_ws;
    for (int i = 0; i < 32; ++i) p.inv_ret[i] = 1.0 / pow(10000.0, (double)((float)i / 31.0f));
    for (int i = 0; i < 16; ++i) p.inv_ax[i] = pow(10000.0, -(double)(2 * i) / 32.0);
#if MK_CUTS
    p.ph_lo = 0; p.ph_hi = NPHASES;
    hipLaunchKernelGGL(mk_fwd, dim3(grid), dim3(NTHREADS), LDS_BYTES, stream, p);
#else
    for (int ph = 0; ph < NPHASES; ++ph) { p.ph_lo = ph; p.ph_hi = ph + 1; hipLaunchKernelGGL(mk_fwd, dim3(grid), dim3(NTHREADS), LDS_BYTES, stream, p); }
#endif
}
```

```cpp
#include <hip/hip_runtime.h>
#include <stdint.h>
#include <stdio.h>
#include <string.h>
#include <math.h>
#include <type_traits>

#define DEV __device__ __forceinline__
#define LAS __attribute__((address_space(3)))
typedef unsigned short bf16_t;
typedef short bf16x8 __attribute__((ext_vector_type(8)));
typedef float f32x4 __attribute__((ext_vector_type(4)));
typedef float f32x2 __attribute__((ext_vector_type(2)));
typedef unsigned u32x4 __attribute__((ext_vector_type(4)));
typedef unsigned u32x2 __attribute__((ext_vector_type(2)));

constexpr int D = 1024, NBATCH = 2, L = 16384, LC = 256, TL = NBATCH * L, TC = NBATCH * LC, TA = TL + TC;
constexpr int NIN = 5376, NEXP = 32, CAP = TA, PMAX = 141312;
constexpr int C_Q = 0, C_K = 512, C_V = 640, C_U = 768, C_RQ = 1024, C_RK = 1280, C_RV = 1536, C_RGF = 1792, C_RGB = 2048, C_GA = 2304;
constexpr int T_V = 0, T_RV = 256, T_RKF = 512, T_RKB = 768, TROWS = 1024;
constexpr int MX_ATTN = 0, MX_POOL = 512, MX_RET = 768;
constexpr int NTHREADS = 512, NWAVES = 8;

constexpr size_t MiB = 1u << 20;
constexpr size_t OFF_CTL = 0, CTL_BYTES = 1 * MiB;
constexpr size_t OFF_MOD = 1 * MiB;
constexpr size_t OFF_TABR = 2 * MiB;
constexpr size_t OFF_TABA = 6 * MiB;
constexpr size_t OFF_TABW = 6 * MiB + 512 * 1024;
constexpr size_t OFF_WTIN = 7 * MiB;
constexpr size_t OFF_WTT = 28 * MiB;
constexpr size_t OFF_WTM = 31 * MiB;
constexpr size_t OFF_WTO = 35 * MiB;
constexpr size_t OFF_WT1 = 40 * MiB;
constexpr size_t OFF_WT2 = 296 * MiB;
constexpr size_t OFF_HBF = 424 * MiB;
constexpr size_t OFF_XR = 489 * MiB;
constexpr size_t OFF_TK = 1840 * MiB;
constexpr size_t OFF_PROJ = 627 * MiB;
constexpr size_t OFF_PROJT = 969 * MiB;
constexpr size_t OFF_MIX = 1034 * MiB;
constexpr size_t OFF_M = 1099 * MiB;
constexpr size_t OFF_HQ = 1164 * MiB;
constexpr size_t OFF_WTOQ = 1212 * MiB;
constexpr size_t OFF_ROWSQ = 1216 * MiB;
constexpr size_t OFF_WTINQ = 1204 * MiB;
constexpr size_t OFF_KV = 1229 * MiB;
constexpr size_t OFF_TABRT = 1272 * MiB;
constexpr size_t OFF_ACT = 1280 * MiB;
constexpr size_t OFF_G8 = 1716 * MiB;
constexpr size_t OFF_YB = 1556 * MiB;
constexpr size_t WS_END = 1856 * MiB;
constexpr size_t TK_LAYER = 8 * MiB;
constexpr int CW_CNT = 65536;
constexpr int CW_DYN = 66560;

constexpr int LDS_BYTES = 147456;
constexpr float LOG2E = 1.4426950408889634f;
#ifndef MOE_FP8
#define MOE_FP8 2
#endif
#ifndef INP_FP8
#define INP_FP8 2
#endif
#ifndef OUT_FP8
#define OUT_FP8 0
#endif
#ifndef G8
#define G8 1
#endif
#ifndef XBF16
#define XBF16 1
#endif
#ifndef YB_FP8
#define YB_FP8 1
#endif
constexpr float QW = 32.f, QA = 4.f, QM = 8.f, QY = 8.f;

struct P {
    const float *x, *c, *ctx, *c_ctx, *w_mod, *b_mod, *norm1, *norm2, *w_in, *sinks, *pool_w, *pool_scale, *ret_decay, *w_o_attn, *w_o_pool, *w_o_ret,
        *w_out, *w_router, *b_router, *w1, *b1, *w2, *b2, *final_norm;
    float* out;
    unsigned char* ws;
    double inv_ret[32];
    double inv_ax[16];
    int ph_lo, ph_hi;
};

DEV float bf2f(bf16_t b) { return __uint_as_float(((unsigned)b) << 16); }
typedef __bf16 bf16x2_t __attribute__((ext_vector_type(2)));
DEV unsigned pk2(float lo, float hi) { f32x2 v = {lo, hi}; bf16x2_t b = __builtin_convertvector(v, bf16x2_t); return __builtin_bit_cast(unsigned, b); }
DEV bf16_t f2bf(float f) { return (bf16_t)(pk2(f, 0.f) & 0xffffu); }
DEV f32x4 bf4_to_f32(const u32x2 w) { return (f32x4){bf2f((bf16_t)(w.x & 0xffff)), bf2f((bf16_t)(w.x >> 16)), bf2f((bf16_t)(w.y & 0xffff)), bf2f((bf16_t)(w.y >> 16))}; }
DEV unsigned pk4q(float a, float b, float c, float d) { int w = 0; w = __builtin_amdgcn_cvt_pk_fp8_f32(a, b, w, false); w = __builtin_amdgcn_cvt_pk_fp8_f32(c, d, w, true); return (unsigned)w; }
DEV float sigmoidf_(float x) { return __builtin_amdgcn_rcpf(1.f + __expf(-x)); }
DEV float siluf_(float x) { return x * __builtin_amdgcn_rcpf(1.f + __expf(-x)); }
DEV float rdl(float v, int l) { return __uint_as_float((unsigned)__builtin_amdgcn_readlane((int)__float_as_uint(v), l)); }
DEV int lane_id() { int r; asm volatile("v_mbcnt_lo_u32_b32 %0, -1, 0\n\tv_mbcnt_hi_u32_b32 %0, -1, %0" : "=v"(r)); return r; }
#define TID (wvx * 64 + lane_id())
DEV float wave_sum(float v) {
#pragma unroll
    for (int o = 1; o < 64; o <<= 1) v += __shfl_xor(v, o);
    return v;
}
DEV int row_mod(int r) { return r < TL ? (r >= L ? 1 : 0) : 2; }
DEV const float* in_row(const P& p, int r) { return r < TL ? p.x + (size_t)r * D : p.ctx + (size_t)(r - TL) * D; }
DEV const float* modp(const P& p, int l, int s, int part) { return (const float*)(p.ws + OFF_MOD) + ((size_t)(l * 3 + s) * 6 + part) * D; }

template <class Dst>
DEV void transpose_item(const float* W, int N, int kb, int nb, float* scr  , int lane, Dst dst) {
    const int k0 = 64 * kb + 16 * (lane >> 4), n0 = 64 * nb + 4 * (lane & 15);
    f32x4 v[16];
#pragma unroll
    for (int i = 0; i < 16; ++i) v[i] = *(const f32x4*)(W + (size_t)(k0 + i) * N + n0);
#pragma unroll
    for (int j = 0; j < 4; ++j) {
        u32x4 o0, o1;
        o0.x = pk2(v[0][j], v[1][j]); o0.y = pk2(v[2][j], v[3][j]); o0.z = pk2(v[4][j], v[5][j]); o0.w = pk2(v[6][j], v[7][j]);
        o1.x = pk2(v[8][j], v[9][j]); o1.y = pk2(v[10][j], v[11][j]); o1.z = pk2(v[12][j], v[13][j]); o1.w = pk2(v[14][j], v[15][j]);
        bf16_t* d0 = dst(n0 + j, 0); if (d0) { *(u32x4*)(d0 + k0) = o0; *(u32x4*)(d0 + k0 + 8) = o1; }
        bf16_t* d1 = dst(n0 + j, 1); if (d1) { *(u32x4*)(d1 + k0) = o0; *(u32x4*)(d1 + k0 + 8) = o1; }
    }
}
DEV float log_g(const P& p, int l, int dir, int h) { const float x = p.ret_decay[(l * 2 + dir) * 4 + h]; return -log1pf(__expf(-x)); }
DEV int ret_phys(int d) { return ((d >> 4) & 1) * 32 + (d >> 5) * 16 + (d & 15); }

template <bool NT>
DEV void titem_load(const float* W, int N, int kb, int nb, int lane, f32x4 (&v)[16]) {
    const int k0 = 64 * kb, n0 = 64 * nb;
#pragma unroll
    for (int i = 0; i < 16; ++i) {
        const int kk = 16 * (lane >> 4) + i, c4 = (lane & 15) * 4;
        const f32x4* src = (const f32x4*)(W + (size_t)(k0 + kk) * N + n0 + c4);
        v[i] = NT ? __builtin_nontemporal_load(src) : *src;
    }
}
template <class Dst>
DEV void titem_finish_q(const f32x4 (&v)[16], int kb, int nb, float* scr  , int lane, float sc, Dst dst) {
    const int k0 = 64 * kb + 16 * (lane >> 4), n0 = 64 * nb + 4 * (lane & 15);
#pragma unroll
    for (int j = 0; j < 4; ++j) {
        u32x4 o;
        o.x = pk4q(v[0][j] * sc, v[1][j] * sc, v[2][j] * sc, v[3][j] * sc); o.y = pk4q(v[4][j] * sc, v[5][j] * sc, v[6][j] * sc, v[7][j] * sc);
        o.z = pk4q(v[8][j] * sc, v[9][j] * sc, v[10][j] * sc, v[11][j] * sc); o.w = pk4q(v[12][j] * sc, v[13][j] * sc, v[14][j] * sc, v[15][j] * sc);
        unsigned char* d0 = dst(n0 + j, 0); if (d0) *(u32x4*)(d0 + k0) = o;
        unsigned char* d1 = dst(n0 + j, 1); if (d1) *(u32x4*)(d1 + k0) = o;
    }
}
template <class Dst>
DEV void transpose_item_q(const float* W, int N, int kb, int nb, float* scr, int lane, float sc, Dst dst) {
    f32x4 v[16]; titem_load<false>(W, N, kb, nb, lane, v); titem_finish_q(v, kb, nb, scr, lane, sc, dst);
}

DEV void stage_prep(const P& p, int bid, int nb, unsigned char* lds, int wvx) {
    const int tid = TID, lane = tid & 63, wave = tid >> 6;
    float* scr = (float*)lds + wave * (64 * 65);
    unsigned char* ws = p.ws;
    constexpr int I_IN = 16 * 84, I_OA = 8 * 16, I_OR = 4 * 16, I_OUT = 16 * 16, I_W1 = 16 * 32, I_W2 = 16 * 16;
    constexpr int PER_LAYER = I_IN + I_OA + I_OR + I_OUT;
    const int gw = bid * NWAVES + wave, ngw = nb * NWAVES;
    for (int it = gw; it < 2 * PER_LAYER; it += ngw) {
        const int l = it / PER_LAYER; int r = it % PER_LAYER;
#if INP_FP8 == 2
        if (r < I_IN && (r % 84) >= C_GA / 64) {
            unsigned char* wq = ws + OFF_WTINQ + (size_t)l * (NIN - C_GA) * D;
            transpose_item_q(p.w_in + (size_t)l * D * NIN, NIN, r / 84, r % 84, scr, lane, QW, [&](int n, int which) -> unsigned char* { return which ? (unsigned char*)nullptr : wq + (size_t)(n - C_GA) * D; });
            continue; }
#endif
#if INP_FP8 == 1
        if (r < I_IN) {
            unsigned char* wt = ws + OFF_WTIN + (size_t)l * NIN * D; unsigned char* wtt = ws + OFF_WTT + (size_t)l * 768 * D;
            transpose_item_q(p.w_in + (size_t)l * D * NIN, NIN, r / 84, r % 84, scr, lane, QW, [&](int n, int which) -> unsigned char* {
                int pr = n;
                if (n >= C_RQ && n < C_RV) pr = (n & ~63) + ret_phys(n & 63);
                if (which == 0) return wt + (size_t)pr * D;
                int tr = -1;
                if (n >= C_V && n < C_U) tr = n - C_V;
                else if (n >= C_K && n < C_V) tr = 128 + (n - C_K);
                else if (n >= C_RV && n < C_RGF) tr = 256 + (n - C_RV);
                else if (n >= C_RK && n < C_RV) tr = 512 + (pr - C_RK);
                return tr < 0 ? (unsigned char*)nullptr : wtt + (size_t)tr * D; });
            continue; }
#endif
        if (r < I_IN) {
            bf16_t* wt = (bf16_t*)(ws + OFF_WTIN) + (size_t)l * NIN * D; bf16_t* wtt = (bf16_t*)(ws + OFF_WTT) + (size_t)l * 768 * D;
            transpose_item(p.w_in + (size_t)l * D * NIN, NIN, r / 84, r % 84, scr, lane, [&](int n, int which) -> bf16_t* {
                int pr = n;
                if (n >= C_RQ && n < C_RV) pr = (n & ~63) + ret_phys(n & 63);
                if (which == 0) return wt + (size_t)pr * D;
                int tr = -1;
                if (n >= C_RV && n < C_RGF) tr = 256 + (n - C_RV);
                return tr < 0 ? (bf16_t*)nullptr : wtt + (size_t)tr * D; });
            continue; }
        r -= I_IN;
        if (r < I_OA) { bf16_t* wt = (bf16_t*)(ws + OFF_WTM) + (size_t)l * D * D;
            transpose_item(p.w_o_attn + (size_t)l * 512 * D, D, r / 16, r % 16, scr, lane, [&](int n, int which) -> bf16_t* { return which ? (bf16_t*)nullptr : wt + (size_t)n * D + MX_ATTN; }); continue; }
        r -= I_OA;
        if (r < I_OR) { bf16_t* wt = (bf16_t*)(ws + OFF_WTM) + (size_t)l * D * D;
            transpose_item(p.w_o_ret + (size_t)l * 256 * D, D, r / 16, r % 16, scr, lane, [&](int n, int which) -> bf16_t* { return which ? (bf16_t*)nullptr : wt + (size_t)n * D + MX_RET; }); continue; }
        r -= I_OR;
#if OUT_FP8
        if (r < I_OUT) { unsigned char* wq = ws + OFF_WTOQ + (size_t)l * D * D;
            transpose_item_q(p.w_out + (size_t)l * D * D, D, r / 16, r % 16, scr, lane, QW, [&](int n, int which) -> unsigned char* { return which ? (unsigned char*)nullptr : wq + (size_t)n * D; }); }
#endif
        if (r < I_OUT) { bf16_t* wt = (bf16_t*)(ws + OFF_WTO) + (size_t)l * D * D;
            transpose_item(p.w_out + (size_t)l * D * D, D, r / 16, r % 16, scr, lane, [&](int n, int which) -> bf16_t* { return which ? (bf16_t*)nullptr : wt + (size_t)n * D; }); continue; }
    }
    const int gt = bid * NTHREADS + tid, ngt = nb * NTHREADS;
    for (int it = gt; it < 2 * 256 * D; it += ngt) {
        const int l = it / (256 * D), c = (it / D) % 256, n = it % D, g = c >> 6, cl = c & 63;
        const float* pw = p.pool_w + (((size_t)l * 4 + g) * 64 + cl) * 64; const float* ps = p.pool_scale + l * 256 + g * 64; const float* wo = p.w_o_pool + ((size_t)l * 256 + g * 64) * D + n;
        float s = 0.f;
        for (int e = 0; e < 64; ++e) s += pw[e] * ps[e] * wo[(size_t)e * D];
        ((bf16_t*)(ws + OFF_WTM))[(size_t)l * D * D + (size_t)n * D + MX_POOL + c] = f2bf(s);
    }
    {
        float* sl = (float*)(lds + 8 * 64 * 65 * 4);
        __syncthreads();
        for (int i = tid; i < 3 * D; i += NTHREADS) { const int s = i / D, k = i % D; const float v = s < 2 ? p.c[s * D + k] : p.c_ctx[k]; sl[i] = siluf_(v); }
        __syncthreads();
        float* mod = (float*)(ws + OFF_MOD);
        float* red = (float*)lds;
        for (int blk = bid; blk < 2 * 96; blk += nb) {
            const int l = blk / 96, n = (blk % 96) * 64 + (tid & 63), ks = tid >> 6;
            const float* w = p.w_mod + (size_t)l * D * 6 * D + (size_t)(128 * ks) * 6 * D + n; const float* s0 = sl + 128 * ks; float a0 = 0.f, a1 = 0.f, a2 = 0.f;
#pragma unroll 16
            for (int k = 0; k < 128; ++k) { const float wv = w[(size_t)k * 6 * D]; a0 += s0[k] * wv; a1 += s0[D + k] * wv; a2 += s0[2 * D + k] * wv; }
            red[(ks * 3 + 0) * 64 + (tid & 63)] = a0; red[(ks * 3 + 1) * 64 + (tid & 63)] = a1; red[(ks * 3 + 2) * 64 + (tid & 63)] = a2;
            __syncthreads();
            if (tid < 192) { const int sI = tid >> 6, nn = tid & 63; float a = 0.f;
#pragma unroll
                for (int q = 0; q < 8; ++q) a += red[(q * 3 + sI) * 64 + nn];
                const int nc = (blk % 96) * 64 + nn; mod[(size_t)(l * 3 + sI) * 6 * D + nc] = a + p.b_mod[l * 6 * D + nc]; }
            __syncthreads();
        }
    }
    {
        f32x2* tr = (f32x2*)(ws + OFF_TABR);
        const double TWO_PI = 6.283185307179586476925286766559, INV_2PI = 0.15915494309189533576888376337251;
        for (int it = gt; it < L * 32 + 256 * 16 + 64 * 16; it += ngt) {
            double ang; f32x2* dst;
            if (it < L * 32) { ang = (double)(it >> 5) * p.inv_ret[it & 31]; dst = tr + it; }
            else { const int j = it - L * 32; const int pos = j < 256 * 16 ? (j >> 4) : ((j - 256 * 16) >> 4); ang = (double)pos * p.inv_ax[j & 15]; dst = (f32x2*)(ws + OFF_TABA) + j; }
            const double n = rint(ang * INV_2PI); const float r = (float)(ang - n * TWO_PI);
            const float cv = __cosf(r), sv = __sinf(r);
            *dst = (f32x2){cv, sv};
            if (it < L * 32) { float* tt = (float*)(ws + OFF_TABRT); tt[(size_t)(it & 31) * L + (it >> 5)] = cv; tt[(size_t)(32 + (it & 31)) * L + (it >> 5)] = sv; }
        }
        for (int it = gt; it < 2 * 2 * 4 * 128; it += ngt) {
            const int j = it & 127, h = (it >> 7) & 3, dir = (it >> 9) & 1, l = it >> 10; const float lg = log_g(p, l, dir, h);
            ((float*)(ws + OFF_TABW))[it] = __expf(lg * (float)(dir == 0 ? 127 - j : j));
        }
    }
}


DEV void stage_prep_experts(const P& p, int l, int bid, int nb, unsigned char* lds, int wvx) {
    const int tid = TID, lane = tid & 63, wave = tid >> 6;
    float* scr = (float*)lds + wave * (64 * 65);
    unsigned char* ws = p.ws;
    constexpr int I_W1 = 16 * 32, I_W2 = 16 * 16;
    const int gw = bid * NWAVES + wave, ngw = nb * NWAVES;
#if MOE_FP8 >= 2
    auto src = [&](int it, const float*& W, int& N, int& kb, int& nbk) { const int e = it / (I_W1 + I_W2), r = it % (I_W1 + I_W2);
        if (r < I_W1) { W = p.w1 + ((size_t)l * NEXP + e) * D * 2048; N = 2048; kb = r / 32; nbk = r % 32; }
        else { W = p.w2 + ((size_t)l * NEXP + e) * D * D; N = D; kb = (r - I_W1) / 16; nbk = (r - I_W1) % 16; } };
    f32x4 va[16], vb[16];
    int it = gw;
    if (it < NEXP * (I_W1 + I_W2)) { const float* W; int N, kb, nbk; src(it, W, N, kb, nbk); titem_load<true>(W, N, kb, nbk, lane, va); }
    for (; it < NEXP * (I_W1 + I_W2); it += ngw) {
        const int itn = it + ngw;
        if (itn < NEXP * (I_W1 + I_W2)) { const float* W; int N, kb, nbk; src(itn, W, N, kb, nbk); titem_load<true>(W, N, kb, nbk, lane, vb); }
        const int e = it / (I_W1 + I_W2), r = it % (I_W1 + I_W2);
        if (r < I_W1) {
            unsigned char* wq = ws + OFF_WT1 + ((size_t)l * NEXP + e) * 2048 * D;
            titem_finish_q(va, r / 32, r % 32, scr, lane, QW, [&](int n, int which) -> unsigned char* {
                const int j = n & 1023, jq = (j >> 2) & 3, pq = jq == 1 ? 2 : jq == 2 ? 1 : jq;
                const int pr = 32 * (j >> 4) + (n >= 1024 ? 16 : 0) + 4 * pq + (j & 3);
                return which ? (unsigned char*)nullptr : wq + (size_t)pr * D; });
        } else {
            unsigned char* wq = ws + OFF_WT2 + ((size_t)l * NEXP + e) * D * D;
            titem_finish_q(va, (r - I_W1) / 16, (r - I_W1) % 16, scr, lane, QW, [&](int n, int which) -> unsigned char* { return which ? (unsigned char*)nullptr : wq + (size_t)n * D; });
        }
#pragma unroll
        for (int i = 0; i < 16; ++i) va[i] = vb[i];
    }
#else
    for (int it = gw; it < NEXP * (I_W1 + I_W2); it += ngw) {
        int r = it;
        const int e = r / (I_W1 + I_W2); r %= (I_W1 + I_W2);
        if (r < I_W1) {
#if MOE_FP8 >= 1
            unsigned char* wq = ws + OFF_WT1 + ((size_t)l * NEXP + e) * 2048 * D;
            transpose_item_q(p.w1 + ((size_t)l * NEXP + e) * D * 2048, 2048, r / 32, r % 32, scr, lane, QW, [&](int n, int which) -> unsigned char* {
                const int j = n & 1023, jq = (j >> 2) & 3, pq = jq == 1 ? 2 : jq == 2 ? 1 : jq;
                const int pr = 32 * (j >> 4) + (n >= 1024 ? 16 : 0) + 4 * pq + (j & 3);
                return which ? (unsigned char*)nullptr : wq + (size_t)pr * D; });
#else
            bf16_t* wt = (bf16_t*)(ws + OFF_WT1) + ((size_t)l * NEXP + e) * 2048 * D;
            transpose_item(p.w1 + ((size_t)l * NEXP + e) * D * 2048, 2048, r / 32, r % 32, scr, lane, [&](int n, int which) -> bf16_t* {
                const int j = n & 1023, jq = (j >> 2) & 3, pq = jq == 1 ? 2 : jq == 2 ? 1 : jq;
                const int pr = 32 * (j >> 4) + (n >= 1024 ? 16 : 0) + 4 * pq + (j & 3);
                return which ? (bf16_t*)nullptr : wt + (size_t)pr * D; });
#endif
            continue; }
        r -= I_W1;
#if MOE_FP8 >= 2
        { unsigned char* wq = ws + OFF_WT2 + ((size_t)l * NEXP + e) * D * D;
            transpose_item_q(p.w2 + ((size_t)l * NEXP + e) * D * D, D, r / 16, r % 16, scr, lane, QW, [&](int n, int which) -> unsigned char* { return which ? (unsigned char*)nullptr : wq + (size_t)n * D; }); }
#else
        { bf16_t* wt = (bf16_t*)(ws + OFF_WT2) + ((size_t)l * NEXP + e) * D * D;
            transpose_item(p.w2 + ((size_t)l * NEXP + e) * D * D, D, r / 16, r % 16, scr, lane, [&](int n, int which) -> bf16_t* { return which ? (bf16_t*)nullptr : wt + (size_t)n * D; }); }
#endif
    }
#endif
}

DEV void norm_store(const f32x4 (&v)[4], const float* gamma, const float* sc, const float* sh, bf16_t* orow, unsigned char* qrow, int lane) {
    float s = 0.f;
#pragma unroll
    for (int j = 0; j < 4; ++j) s += (v[j].x * v[j].x + v[j].y * v[j].y) + (v[j].z * v[j].z + v[j].w * v[j].w);
    const float rstd = rsqrtf(wave_sum(s) * (1.f / D) + 1e-6f);
    f32x4 g[4], a[4], b[4];
#pragma unroll
    for (int j = 0; j < 4; ++j) { const int k = 4 * lane + 256 * j; g[j] = *(const f32x4*)(gamma + k); a[j] = *(const f32x4*)(sc + k); b[j] = *(const f32x4*)(sh + k); }
#pragma unroll
    for (int j = 0; j < 4; ++j) {
        const int k = 4 * lane + 256 * j;
        f32x4 y = v[j] * rstd * g[j] * (a[j] + 1.f) + b[j];
#if INP_FP8 == 1
        *(unsigned*)((unsigned char*)orow + k) = pk4q(y.x, y.y, y.z, y.w);
#else
        u32x2 o; o.x = pk2(y.x, y.y); o.y = pk2(y.z, y.w);
        *(u32x2*)(orow + k) = o;
#if INP_FP8 == 2
        *(unsigned*)(qrow + k) = pk4q(y.x, y.y, y.z, y.w);
#endif
#endif
    }
}
constexpr size_t OFF_GM2 = OFF_MOD + 512 * 1024;
DEV void stage_norm0(const P& p, int bid, int nb, int wvx) {
    const int tid_ = TID, lane = tid_ & 63, wave = tid_ >> 6;
    if (bid == nb - 1) { float* gm2 = (float*)(p.ws + OFF_GM2);
        for (int i = tid_; i < 2 * 3 * D; i += NTHREADS) { const int l = i / (3 * D), s = (i / D) % 3, k = i % D; gm2[i] = p.norm2[l * D + k] * (modp(p, l, s, 4)[k] + 1.f); } }
    bf16_t* hbf = (bf16_t*)(p.ws + OFF_HBF);
    int r = bid * NWAVES + wave; f32x4 v[4], vn[4];
    if (r < TA) {
#pragma unroll
        for (int j = 0; j < 4; ++j) v[j] = *(const f32x4*)(in_row(p, r) + 4 * lane + 256 * j);
    }
    for (; r < TA; r += nb * NWAVES) {
        const int rn = r + nb * NWAVES;
        if (rn < TA) {
#pragma unroll
            for (int j = 0; j < 4; ++j) vn[j] = *(const f32x4*)(in_row(p, rn) + 4 * lane + 256 * j);
        }
        const int s = row_mod(r);
        norm_store(v, p.norm1, modp(p, 0, s, 1), modp(p, 0, s, 0), hbf + (size_t)r * (INP_FP8 == 1 ? D / 2 : D), p.ws + OFF_HQ + (size_t)r * D, lane);
#pragma unroll
        for (int j = 0; j < 4; ++j) v[j] = vn[j];
    }
}

typedef short s16x4 __attribute__((ext_vector_type(4)));
DEV u32x2 lds_tr16(const LAS unsigned char* a) { const s16x4 v = __builtin_amdgcn_ds_read_tr16_b64_v4i16((LAS s16x4*)a); return __builtin_bit_cast(u32x2, v); }
DEV void mma_tile32(const bf16_t* a0, const bf16_t* a1, const bf16_t* b0, const bf16_t* b1, int K, f32x4 (&acc)[2][2]) {
#pragma unroll 4
    for (int k = 0; k < K; k += 32) {
        const bf16x8 fa0 = *(const bf16x8*)(a0 + k), fa1 = *(const bf16x8*)(a1 + k), fb0 = *(const bf16x8*)(b0 + k), fb1 = *(const bf16x8*)(b1 + k);
        acc[0][0] = __builtin_amdgcn_mfma_f32_16x16x32_bf16(fa0, fb0, acc[0][0], 0, 0, 0);
        acc[0][1] = __builtin_amdgcn_mfma_f32_16x16x32_bf16(fa0, fb1, acc[0][1], 0, 0, 0);
        acc[1][0] = __builtin_amdgcn_mfma_f32_16x16x32_bf16(fa1, fb0, acc[1][0], 0, 0, 0);
        acc[1][1] = __builtin_amdgcn_mfma_f32_16x16x32_bf16(fa1, fb1, acc[1][1], 0, 0, 0);
    }
}
DEV void zero_acc(f32x4 (&acc)[2][2]) {
#pragma unroll
    for (int a = 0; a < 2; ++a)
#pragma unroll
        for (int b = 0; b < 2; ++b) acc[a][b] = (f32x4){0.f, 0.f, 0.f, 0.f};
}

DEV f32x2 ax_cs(const P& p, int row, int sub, int f) {
    if (row >= TL) return (f32x2){1.f, 0.f};
    const int l = row & (L - 1); const f32x2* ta = (const f32x2*)(p.ws + OFF_TABA);
    return sub == 0 ? ta[(l >> 6) * 16 + f] : ta[256 * 16 + (l & 63) * 16 + f];
}
DEV f32x2 ret_cs(const P& p, int row, int f) {
    if (row >= TL) return (f32x2){1.f, 0.f};
    return ((const f32x2*)(p.ws + OFF_TABR))[(row & (L - 1)) * 32 + f];
}

DEV void inproj_pair(const P& p, int row, int c1, float x1, float x2, float& o1, float& o2) {
    const int f16 = c1 & 15;
    if (c1 < C_V) {
        const f32x2 cs = ax_cs(p, row, (c1 >> 5) & 1, f16);
        o1 = x1 * cs.x - x2 * cs.y; o2 = x1 * cs.y + x2 * cs.x;
        if (c1 < C_K) { o1 *= 0.125f; o2 *= 0.125f; }
    } else if (c1 < C_RQ) { o1 = x1; o2 = x2; }
    else if (c1 < C_RV) {
        const f32x2 cs = ret_cs(p, row, ((c1 >> 5) & 1) * 16 + f16);
        o1 = x1 * cs.x - x2 * cs.y; o2 = x1 * cs.y + x2 * cs.x;
        if (c1 >= C_RK) { o1 *= 0.125f; o2 *= 0.125f; }
    } else if (c1 < C_RGF) { o1 = x1; o2 = x2; }
    else if (c1 < C_GA) { o1 = siluf_(x1); o2 = siluf_(x2); }
    else { o1 = sigmoidf_(x1); o2 = sigmoidf_(x2); }
}


DEV void stage_pool_diff(const P& p, int l, int bid, int nb, int wvx) {
    const int NR = l == 0 ? TA : TL;
    const bf16_t* proj = (const bf16_t*)(p.ws + OFF_PROJ); bf16_t* mix = (bf16_t*)(p.ws + OFF_MIX);
    for (int it = bid * NTHREADS + TID; it < 4 * NR * 8; it += nb * NTHREADS) {
        const int g = it / (NR * 8), rem = it % (NR * 8), row = rem >> 3, c = g * 64 + (rem & 7) * 8, w = __builtin_amdgcn_readfirstlane(2 << g);
        int s0, len; if (row < TL) { s0 = row & ~(L - 1); len = L; } else { s0 = TL + (((row - TL) >> 8) << 8); len = LC; }
        const int t = row - s0, lo0 = t - w / 2;
        float acc[8];
#pragma unroll
        for (int j = 0; j < 8; ++j) acc[j] = 0.f;
        bf16x8 own = *(const bf16x8*)(proj + (size_t)row * NIN + C_U + c);
#pragma unroll
        for (int i = 0; i < 16; ++i) {
            {
                const int pos = lo0 + i; const bool ok = i < w && pos >= 0 && pos < len;
                const bf16x8 v = *(const bf16x8*)(proj + (size_t)(s0 + (ok ? pos : t)) * NIN + C_U + c);
                const float mk = ok ? 1.f : 0.f;
#pragma unroll
                for (int j = 0; j < 8; ++j) acc[j] += mk * bf2f((bf16_t)v[j]);
            }
        }
        int lo = lo0 < 0 ? 0 : lo0, hi = lo0 + w > len ? len : lo0 + w;
        const float inv = 1.f / (float)(hi - lo);
        float d[8];
#pragma unroll
        for (int j = 0; j < 8; ++j) d[j] = acc[j] * inv - bf2f((bf16_t)own[j]);
        u32x4 o; o.x = pk2(d[0], d[1]); o.y = pk2(d[2], d[3]); o.z = pk2(d[4], d[5]); o.w = pk2(d[6], d[7]);
        *(u32x4*)(mix + (size_t)row * D + MX_POOL + c) = o;
    }
}


constexpr int MAXENT = 640;
DEV void stage_route(const P& p, int l, int bid, int nb, unsigned char* lds, int wvx) {
    const int tid = TID, lane = tid & 63, wave = tid >> 6;
    float* wl = (float*)lds;
    int* lcnt = (int*)(lds + 131072); int* lbase = lcnt + 32; int* ent = lbase + 32;
    const float* wr = p.w_router + (size_t)l * D * NEXP;
    for (int k = tid; k < D; k += NTHREADS) {
#pragma unroll
        for (int e4 = 0; e4 < 8; ++e4) { const f32x4 w = *(const f32x4*)(wr + (size_t)k * NEXP + 4 * e4);
            wl[(4 * e4 + 0) * D + k] = w.x; wl[(4 * e4 + 1) * D + k] = w.y; wl[(4 * e4 + 2) * D + k] = w.z; wl[(4 * e4 + 3) * D + k] = w.w; }
    }
    for (int i = tid; i < 32; i += NTHREADS) lcnt[i] = 0;
    for (int i = tid; i < MAXENT; i += NTHREADS) ent[i] = -1;
    __syncthreads();
    const float* xr = (const float*)(p.ws + OFF_XR); bf16_t* hbf = (bf16_t*)(p.ws + OFF_HBF);
    int* tk_e = (int*)(p.ws + OFF_TK + (size_t)l * TK_LAYER); float* tk_w = (float*)(tk_e + TA * 4); int* tk_pos = (int*)(tk_w + TA * 4); int* list_tok = tk_pos + TA * 4;
    unsigned* cntg = (unsigned*)(p.ws + OFF_CTL) + CW_CNT + l * 32;
    const int NR = l == 0 ? TA : TL, ngw = nb * NWAVES, gw = bid * NWAVES + wave;
    const int t_begin = (int)(((long long)gw * NR) / ngw), t_end = (int)(((long long)(gw + 1) * NR) / ngw);
    const float* gamma = p.norm2 + l * D;
    f32x4 gam[4];
#pragma unroll
    for (int j = 0; j < 4; ++j) gam[j] = *(const f32x4*)(gamma + 4 * lane + 256 * j);
    for (int t0 = t_begin; t0 < t_end; t0 += 4) {
        f32x4 v[4][4]; int tok[4]; float ss[4];
#pragma unroll
        for (int u = 0; u < 4; ++u) { tok[u] = t0 + u < t_end ? t0 + u : t_end - 1; ss[u] = 0.f;
#pragma unroll
            for (int j = 0; j < 4; ++j) { v[u][j] = *(const f32x4*)(xr + (size_t)tok[u] * D + 4 * lane + 256 * j); ss[u] += (v[u][j].x * v[u][j].x + v[u][j].y * v[u][j].y) + (v[u][j].z * v[u][j].z + v[u][j].w * v[u][j].w); } }
        const int s0 = row_mod(tok[0]);
        f32x4 scv[4], shv[4];
#pragma unroll
        for (int j = 0; j < 4; ++j) { scv[j] = *(const f32x4*)(modp(p, l, s0, 4) + 4 * lane + 256 * j); shv[j] = *(const f32x4*)(modp(p, l, s0, 3) + 4 * lane + 256 * j); }
#pragma unroll
        for (int o = 1; o < 64; o <<= 1) {
#pragma unroll
            for (int u = 0; u < 4; ++u) ss[u] += __shfl_xor(ss[u], o); }
#pragma unroll
        for (int u = 0; u < 4; ++u) {
            const float rstd = rsqrtf(ss[u] * (1.f / D) + 1e-6f); const int sm = row_mod(tok[u]);
            f32x4 av[4], bv[4];
            if (sm != s0) {
                const float* sc = modp(p, l, sm, 4); const float* sh = modp(p, l, sm, 3);
#pragma unroll
                for (int j = 0; j < 4; ++j) { av[j] = *(const f32x4*)(sc + 4 * lane + 256 * j); bv[j] = *(const f32x4*)(sh + 4 * lane + 256 * j); }
            } else {
#pragma unroll
                for (int j = 0; j < 4; ++j) { av[j] = scv[j]; bv[j] = shv[j]; }
            }
#pragma unroll
            for (int j = 0; j < 4; ++j) { const int k = 4 * lane + 256 * j;
                const f32x4 g = gam[j], a = av[j], b = bv[j];
                v[u][j] = v[u][j] * rstd * g * (a + 1.f) + b;
#if MOE_FP8 >= 1
                if (t0 + u < t_end) *(unsigned*)((unsigned char*)hbf + (size_t)tok[u] * D + k) = pk4q(v[u][j].x, v[u][j].y, v[u][j].z, v[u][j].w); }
#else
                u32x2 o; o.x = pk2(v[u][j].x, v[u][j].y); o.y = pk2(v[u][j].z, v[u][j].w);
                if (t0 + u < t_end) *(u32x2*)(hbf + (size_t)tok[u] * D + k) = o; }
#endif
        }
        float lgc[4] = {0.f, 0.f, 0.f, 0.f};
        const int e8 = lane & 7, ut = (lane >> 3) & 3;
#pragma nounroll
        for (int c = 0; c < 4; ++c) {
            float val[32];
#pragma unroll
            for (int x = 0; x < 8; ++x) {
                f32x4 w[4];
#pragma unroll
                for (int j = 0; j < 4; ++j) w[j] = *(const f32x4*)(wl + (8 * c + x) * D + 4 * lane + 256 * j);
#pragma unroll
                for (int u = 0; u < 4; ++u) { float a = 0.f;
#pragma unroll
                    for (int j = 0; j < 4; ++j) a += (v[u][j].x * w[j].x + v[u][j].y * w[j].y) + (v[u][j].z * w[j].z + v[u][j].w * w[j].w);
                    val[u * 8 + x] = a; }
            }
            float v16[16], v8[8], v4[4], v2[2];
#define RT_STAGE(dst, src, n, b) do { const bool hi_ = (lane >> (b)) & 1; _Pragma("unroll") for (int i_ = 0; i_ < (n); ++i_) { const float lo_v = (src)[2 * i_], hi_v = (src)[2 * i_ + 1]; \
                const float keep = hi_ ? hi_v : lo_v, send = hi_ ? lo_v : hi_v; (dst)[i_] = keep + __shfl_xor(send, 1 << (b)); } } while (0)
            RT_STAGE(v16, val, 16, 0); RT_STAGE(v8, v16, 8, 1); RT_STAGE(v4, v8, 4, 2); RT_STAGE(v2, v4, 2, 3);
            float v1; { const bool hi_ = (lane >> 4) & 1; const float keep = hi_ ? v2[1] : v2[0], send = hi_ ? v2[0] : v2[1]; v1 = keep + __shfl_xor(send, 16); }
#undef RT_STAGE
            { const float lv = v1 + __shfl_xor(v1, 32) + p.b_router[l * NEXP + 8 * c + e8];
#pragma unroll
              for (int cc = 0; cc < 4; ++cc) lgc[cc] = (cc == c) ? lv : lgc[cc]; }
        }
        int te[4]; float tv[4];
#pragma unroll
        for (int k = 0; k < 4; ++k) {
            float bv = lgc[0]; int be = e8;
#pragma unroll
            for (int c = 1; c < 4; ++c) { const bool t = lgc[c] > bv; bv = t ? lgc[c] : bv; be = t ? 8 * c + e8 : be; }
#pragma unroll
            for (int d = 1; d < 8; d <<= 1) { const float ov = __shfl_xor(bv, d); const int oe = __shfl_xor(be, d); const bool t = (ov > bv) || (ov == bv && oe < be); bv = t ? ov : bv; be = t ? oe : be; }
            te[k] = be; tv[k] = bv;
#pragma unroll
            for (int c = 0; c < 4; ++c) lgc[c] = (be == 8 * c + e8) ? -INFINITY : lgc[c];
        }
        float ex[4], es = 0.f;
#pragma unroll
        for (int k = 0; k < 4; ++k) { ex[k] = __expf(tv[k] - tv[0]); es += ex[k]; }
        if (lane < 32 && e8 < 4 && t0 + ut < t_end) {
            const int e = e8 == 0 ? te[0] : e8 == 1 ? te[1] : e8 == 2 ? te[2] : te[3];
            const float wgt = (e8 == 0 ? ex[0] : e8 == 1 ? ex[1] : e8 == 2 ? ex[2] : ex[3]) / es;
            const int rank = atomicAdd(&lcnt[e], 1);
            const int tk = t0 + ut, lid = wave * 72 + (tk - t_begin) * 4 + e8;
            ent[lid] = e | (rank << 8);
            tk_e[tk * 4 + e8] = e; tk_w[tk * 4 + e8] = wgt;
        }
    }
    __syncthreads();
    if (tid < 32) lbase[tid] = (int)atomicAdd(&cntg[tid], (unsigned)lcnt[tid]);
    __syncthreads();
    for (int lid = tid; lid < 8 * 72; lid += NTHREADS) {
        const int en = ent[lid]; if (en < 0) continue;
        const int e = en & 255, rank = en >> 8, wv = lid / 72, rem = lid % 72, k = rem & 3;
        const int tb = (int)(((long long)(bid * NWAVES + wv) * NR) / ngw);
        const int tokk = tb + (rem >> 2), pos = lbase[e] + rank;
        tk_pos[tokk * 4 + k] = pos; list_tok[e * CAP + pos] = tokk;
    }
}

DEV void moe_prefix(const P& p, int l, int* pstart, int* cnt, int wvx) {
    const int tid = TID;
    if (tid < 64) {
        unsigned* cntg = (unsigned*)(p.ws + OFF_CTL) + CW_CNT + l * 32;
        const int c = tid < 32 ? (int)__hip_atomic_load(cntg + (tid & 31), __ATOMIC_RELAXED, __HIP_MEMORY_SCOPE_AGENT) : 0;
        const int pad = (c + 255) & ~255; int incl = pad;
#pragma unroll
        for (int o = 1; o < 32; o <<= 1) { const int t = __shfl_up(incl, o); if ((tid & 63) >= o) incl += t; }
        if (tid < 32) { cnt[tid] = c; pstart[tid] = incl - pad; if (tid == 31) pstart[32] = incl; }
    }
    __syncthreads();
}
#ifndef ROUTE_MFMA
#define ROUTE_MFMA 1
#endif
constexpr int RW_STRIDE = 2064, RW_LO = 32 * RW_STRIDE, RT_TAB = 2 * RW_LO, RT_MAXENT = 1024;
DEV void stage_route_mfma(const P& p, int l, int bid, int nb, unsigned char* lds_, int wvx) {
    const int tid = TID, lane = tid & 63, wave = tid >> 6, fr = lane & 15, fq = lane >> 4;
    LAS unsigned char* lds = (LAS unsigned char*)lds_;
    int* lcnt = (int*)(lds_ + RT_TAB); int* lbase = lcnt + 32; int* ent = lbase + 32; int* enttok = ent + RT_MAXENT;
    const float* wr = p.w_router + (size_t)l * D * NEXP;
    for (int k = tid; k < D; k += NTHREADS) {
#pragma unroll
        for (int e4 = 0; e4 < 8; ++e4) { const f32x4 w = *(const f32x4*)(wr + (size_t)k * NEXP + 4 * e4);
#pragma unroll
            for (int j = 0; j < 4; ++j) { const float wv = w[j]; const bf16_t h = f2bf(wv); const bf16_t lo = f2bf(wv - bf2f(h));
                *(LAS bf16_t*)(lds + (4 * e4 + j) * RW_STRIDE + 2 * k) = h; *(LAS bf16_t*)(lds + RW_LO + (4 * e4 + j) * RW_STRIDE + 2 * k) = lo; } }
    }
    for (int i = tid; i < 32; i += NTHREADS) lcnt[i] = 0;
    for (int i = tid; i < RT_MAXENT; i += NTHREADS) ent[i] = -1;
    __syncthreads();
    const float* xr = (const float*)(p.ws + OFF_XR); unsigned char* h2q = p.ws + OFF_HBF;
    int* tk_e = (int*)(p.ws + OFF_TK + (size_t)l * TK_LAYER); float* tk_w = (float*)(tk_e + TA * 4); int* tk_pos = (int*)(tk_w + TA * 4); int* list_tok = tk_pos + TA * 4;
    unsigned* cntg = (unsigned*)(p.ws + OFF_CTL) + CW_CNT + l * 32;
    const int NR = l == 0 ? TA : TL, ntile = NR / 16, ngw = nb * NWAVES, gw = bid * NWAVES + wave;
    auto body = [&](auto ntc) {
        constexpr int NT = decltype(ntc)::value;
        int tk[NT]; const float* xrow[NT]; const float* gmp[NT]; const float* shp[NT]; float rstd[NT]; unsigned char* hq[NT]; f32x4 acc[NT][2];
#pragma unroll
        for (int u = 0; u < NT; ++u) {
            const int tile = gw + u * ngw, sm = row_mod(tile * 16);
            tk[u] = tile * 16 + fr; xrow[u] = (const float*)((const char*)xr + ((size_t)tk[u] * D + 8 * fq) * (XBF16 ? 2 : 4)); hq[u] = h2q + (size_t)tk[u] * D + 8 * fq;
            gmp[u] = (const float*)(p.ws + OFF_GM2) + (size_t)(l * 3 + sm) * D + 8 * fq; shp[u] = modp(p, l, sm, 3) + 8 * fq;
            float ss = 0.f;
            if (tile * 16 < TL) { const f32x4 q = *(const f32x4*)((const float*)(p.ws + OFF_ROWSQ) + (size_t)tk[u] * 16 + 4 * fq); ss = (q.x + q.y) + (q.z + q.w); }
            else {
#pragma unroll 8
                for (int s = 0; s < 32; ++s) { f32x4 a, b;
                    if (XBF16) { const u32x4 w = *(const u32x4*)((const bf16_t*)xrow[u] + 32 * s); a = bf4_to_f32((u32x2){w.x, w.y}); b = bf4_to_f32((u32x2){w.z, w.w}); }
                    else { a = *(const f32x4*)(xrow[u] + 32 * s); b = *(const f32x4*)(xrow[u] + 32 * s + 4); }
                    ss += (a.x * a.x + a.y * a.y) + (a.z * a.z + a.w * a.w) + (b.x * b.x + b.y * b.y) + (b.z * b.z + b.w * b.w); }
            }
            ss += __shfl_xor(ss, 16); ss += __shfl_xor(ss, 32);
            rstd[u] = rsqrtf(ss * (1.f / D) + 1e-6f);
            acc[u][0] = (f32x4){0.f, 0.f, 0.f, 0.f}; acc[u][1] = acc[u][0];
        }
#pragma unroll 4
        for (int s = 0; s < 32; ++s) {
            bf16x8 yh[NT], yl[NT];
#pragma unroll
            for (int u = 0; u < NT; ++u) {
                f32x4 y[2];
                f32x4 xq[2];
                if (XBF16) { const u32x4 w = *(const u32x4*)((const bf16_t*)xrow[u] + 32 * s); xq[0] = bf4_to_f32((u32x2){w.x, w.y}); xq[1] = bf4_to_f32((u32x2){w.z, w.w}); }
                else { xq[0] = *(const f32x4*)(xrow[u] + 32 * s); xq[1] = *(const f32x4*)(xrow[u] + 32 * s + 4); }
#pragma unroll
                for (int c = 0; c < 2; ++c) { const int k = 32 * s + 4 * c; y[c] = xq[c] * rstd[u] * *(const f32x4*)(gmp[u] + k) + *(const f32x4*)(shp[u] + k); }
                u32x2 q8; q8.x = pk4q(y[0].x, y[0].y, y[0].z, y[0].w); q8.y = pk4q(y[1].x, y[1].y, y[1].z, y[1].w);
                *(u32x2*)(hq[u] + 32 * s) = q8;
                u32x4 hw, lw;
                hw.x = pk2(y[0].x, y[0].y); hw.y = pk2(y[0].z, y[0].w); hw.z = pk2(y[1].x, y[1].y); hw.w = pk2(y[1].z, y[1].w);
                lw.x = pk2(y[0].x - bf2f((bf16_t)(hw.x & 0xffff)), y[0].y - bf2f((bf16_t)(hw.x >> 16))); lw.y = pk2(y[0].z - bf2f((bf16_t)(hw.y & 0xffff)), y[0].w - bf2f((bf16_t)(hw.y >> 16)));
                lw.z = pk2(y[1].x - bf2f((bf16_t)(hw.z & 0xffff)), y[1].y - bf2f((bf16_t)(hw.z >> 16))); lw.w = pk2(y[1].z - bf2f((bf16_t)(hw.w & 0xffff)), y[1].w - bf2f((bf16_t)(hw.w >> 16)));
                yh[u] = __builtin_bit_cast(bf16x8, hw); yl[u] = __builtin_bit_cast(bf16x8, lw);
            }
#pragma unroll
            for (int et = 0; et < 2; ++et) {
                const bf16x8 ah = *(const LAS bf16x8*)(lds + (16 * et + fr) * RW_STRIDE + (4 * s + fq) * 16), al = *(const LAS bf16x8*)(lds + RW_LO + (16 * et + fr) * RW_STRIDE + (4 * s + fq) * 16);
#pragma unroll
                for (int u = 0; u < NT; ++u) {
                    acc[u][et] = __builtin_amdgcn_mfma_f32_16x16x32_bf16(ah, yh[u], acc[u][et], 0, 0, 0);
                    acc[u][et] = __builtin_amdgcn_mfma_f32_16x16x32_bf16(ah, yl[u], acc[u][et], 0, 0, 0);
                    acc[u][et] = __builtin_amdgcn_mfma_f32_16x16x32_bf16(al, yh[u], acc[u][et], 0, 0, 0);
                }
            }
        }
#pragma unroll
        for (int u = 0; u < NT; ++u) {
            float lg[8];
#pragma unroll
            for (int et = 0; et < 2; ++et) { const f32x4 bb = *(const f32x4*)(p.b_router + l * NEXP + 16 * et + 4 * fq);
#pragma unroll
                for (int j = 0; j < 4; ++j) lg[4 * et + j] = acc[u][et][j] + bb[j]; }
            int te[4]; float tv[4];
#pragma unroll
            for (int k = 0; k < 4; ++k) {
                float bv = lg[0]; int be = 4 * fq;
#pragma unroll
                for (int i = 1; i < 8; ++i) { const int ei = 16 * (i >> 2) + 4 * fq + (i & 3); const bool t = lg[i] > bv; bv = t ? lg[i] : bv; be = t ? ei : be; }
#pragma unroll
                for (int d = 16; d < 64; d <<= 1) { const float ov = __shfl_xor(bv, d); const int oe = __shfl_xor(be, d); const bool t = (ov > bv) || (ov == bv && oe < be); bv = t ? ov : bv; be = t ? oe : be; }
                te[k] = be; tv[k] = bv;
#pragma unroll
                for (int i = 0; i < 8; ++i) { const int ei = 16 * (i >> 2) + 4 * fq + (i & 3); lg[i] = (be == ei) ? -INFINITY : lg[i]; }
            }
            float ex[4], es = 0.f;
#pragma unroll
            for (int k = 0; k < 4; ++k) { ex[k] = __expf(tv[k] - tv[0]); es += ex[k]; }
            {
                const int e = fq == 0 ? te[0] : fq == 1 ? te[1] : fq == 2 ? te[2] : te[3];
                const float wgt = (fq == 0 ? ex[0] : fq == 1 ? ex[1] : fq == 2 ? ex[2] : ex[3]) / es;
                const int rank = atomicAdd(&lcnt[e], 1);
                const int lid = wave * 128 + u * 64 + fr * 4 + fq;
                ent[lid] = e | (rank << 8); enttok[lid] = tk[u];
                tk_e[tk[u] * 4 + fq] = e; tk_w[tk[u] * 4 + fq] = wgt;
            }
        }
    };
    if (gw + ngw < ntile) body(std::integral_constant<int, 2>{}); else if (gw < ntile) body(std::integral_constant<int, 1>{});
    __syncthreads();
    if (tid < 32) lbase[tid] = (int)atomicAdd(&cntg[tid], (unsigned)lcnt[tid]);
    __syncthreads();
    for (int lid = tid; lid < RT_MAXENT; lid += NTHREADS) {
        const int en = ent[lid]; if (en < 0) continue;
        const int e = en & 255, rank = en >> 8, tokk = enttok[lid], k = lid & 3, pos = lbase[e] + rank;
        tk_pos[tokk * 4 + k] = pos; list_tok[e * CAP + pos] = tokk;
    }
}

DEV void stage_combine(const P& p, int l, int bid, int nb, unsigned char* lds, int wvx) {
    const int tid_ = TID, lane = tid_ & 63, wave = tid_ >> 6;
    int* pstart = (int*)lds; int* cnt = pstart + 40;
    moe_prefix(p, l, pstart, cnt, wvx);
    float* xr = (float*)(p.ws + OFF_XR); const bf16_t* yb = (const bf16_t*)(p.ws + OFF_YB); bf16_t* hbf = (bf16_t*)(p.ws + OFF_HBF);
    const int* tk_e = (const int*)(p.ws + OFF_TK + (size_t)l * TK_LAYER); const float* tk_w = (const float*)(tk_e + TA * 4); const int* tk_pos = (const int*)(tk_w + TA * 4);
    const int NR = l == 0 ? TA : TL;
    int row = bid * NWAVES + wave;
    int ce[4], cp[4]; float cw[4]; f32x4 xv[4];
    if (row < NR) {
#pragma unroll
        for (int k = 0; k < 4; ++k) { ce[k] = tk_e[row * 4 + k]; cw[k] = tk_w[row * 4 + k]; cp[k] = tk_pos[row * 4 + k]; }
#pragma unroll
        for (int j = 0; j < 4; ++j) xv[j] = XBF16 ? bf4_to_f32(*(const u32x2*)((const bf16_t*)xr + (size_t)row * D + 4 * lane + 256 * j)) : *(const f32x4*)(xr + (size_t)row * D + 4 * lane + 256 * j);
    }
    for (; row < NR; row += nb * NWAVES) {
        const int s = row_mod(row); const float* g2 = modp(p, l, s, 5);
        size_t slot[4];
#pragma unroll
        for (int k = 0; k < 4; ++k) slot[k] = (size_t)(pstart[ce[k]] + cp[k]);
#if YB_FP8
        unsigned yv[4][4];
#pragma unroll
        for (int k = 0; k < 4; ++k)
#pragma unroll
            for (int j = 0; j < 4; ++j) yv[k][j] = *(const unsigned*)((const unsigned char*)yb + slot[k] * D + 4 * lane + 256 * j);
#else
        u32x2 yv[4][4];
#pragma unroll
        for (int k = 0; k < 4; ++k)
#pragma unroll
            for (int j = 0; j < 4; ++j) yv[k][j] = *(const u32x2*)(yb + slot[k] * D + 4 * lane + 256 * j);
#endif
        float w4[4]; f32x4 xc[4];
#pragma unroll
        for (int k = 0; k < 4; ++k) w4[k] = cw[k];
#pragma unroll
        for (int j = 0; j < 4; ++j) xc[j] = xv[j];
        const int rown = row + nb * NWAVES;
        if (rown < NR) {
#pragma unroll
            for (int k = 0; k < 4; ++k) { ce[k] = tk_e[rown * 4 + k]; cw[k] = tk_w[rown * 4 + k]; cp[k] = tk_pos[rown * 4 + k]; }
#pragma unroll
            for (int j = 0; j < 4; ++j) xv[j] = XBF16 ? bf4_to_f32(*(const u32x2*)((const bf16_t*)xr + (size_t)rown * D + 4 * lane + 256 * j)) : *(const f32x4*)(xr + (size_t)rown * D + 4 * lane + 256 * j);
        }
        f32x4 a[4];
#pragma unroll
        for (int j = 0; j < 4; ++j) a[j] = (f32x4){0.f, 0.f, 0.f, 0.f};
#pragma unroll
        for (int k = 0; k < 4; ++k) {
#if YB_FP8
            const float w = w4[k] * (1.f / QY);
#pragma unroll
            for (int j = 0; j < 4; ++j) { const int y = (int)yv[k][j]; const f32x2 lo = __builtin_amdgcn_cvt_pk_f32_fp8(y, false), hi = __builtin_amdgcn_cvt_pk_f32_fp8(y, true);
                a[j].x += w * lo.x; a[j].y += w * lo.y; a[j].z += w * hi.x; a[j].w += w * hi.y; }
#else
            const float w = w4[k];
#pragma unroll
            for (int j = 0; j < 4; ++j) { const u32x2 y = yv[k][j];
                a[j].x += w * bf2f((bf16_t)(y.x & 0xffff)); a[j].y += w * bf2f((bf16_t)(y.x >> 16)); a[j].z += w * bf2f((bf16_t)(y.y & 0xffff)); a[j].w += w * bf2f((bf16_t)(y.y >> 16)); }
#endif
        }
        f32x4 v[4];
#pragma unroll
        for (int j = 0; j < 4; ++j) { const int k = 4 * lane + 256 * j; v[j] = xc[j] + *(const f32x4*)(g2 + k) * a[j]; }
        if (l == 0) {
#pragma unroll
            for (int j = 0; j < 4; ++j) { if (XBF16) { u32x2 w_; w_.x = pk2(v[j].x, v[j].y); w_.y = pk2(v[j].z, v[j].w); *(u32x2*)((bf16_t*)xr + (size_t)row * D + 4 * lane + 256 * j) = w_; } else *(f32x4*)(xr + (size_t)row * D + 4 * lane + 256 * j) = v[j]; }
            norm_store(v, p.norm1 + D, modp(p, 1, s, 1), modp(p, 1, s, 0), hbf + (size_t)row * (INP_FP8 == 1 ? D / 2 : D), p.ws + OFF_HQ + (size_t)row * D, lane);
        } else if (row < TL) {
            float ss = 0.f;
#pragma unroll
            for (int j = 0; j < 4; ++j) ss += (v[j].x * v[j].x + v[j].y * v[j].y) + (v[j].z * v[j].z + v[j].w * v[j].w);
            const float rstd = rsqrtf(wave_sum(ss) * (1.f / D) + 1e-6f);
#pragma unroll
            for (int j = 0; j < 4; ++j) { const int k = 4 * lane + 256 * j; *(f32x4*)(p.out + (size_t)row * D + k) = v[j] * rstd * *(const f32x4*)(p.final_norm + k); }
        }
    }
}

namespace pg {
#define LAS __attribute__((address_space(3)))
constexpr int BM = 256, BK = 64, HALF = 128, HTB = HALF * BK * 2, STAGE_BYTES = 8 * HTB, NXCD = 8, WGM = 4;
DEV int lds_byte(int r, int c) { const int st = (r >> 4) * 2 + (c >> 5), rr = r & 15, cc = c & 31, ob = rr * 64 + cc * 2; return st * 1024 + (ob ^ (((ob >> 9) & 1) << 5)); }
DEV int perm32(int rho) { const int n = rho >> 4, i = rho & 15; return 8 * (i >> 2) + 4 * n + (i & 3); }
DEV void stage_rc(int b, int& R, int& C) { const int st = b / 1024, sb = b % 1024, swz = sb ^ (((sb >> 9) & 1) << 5); R = (st >> 1) * 16 + swz / 64; C = (st & 1) * 32 + (swz % 64) / 2; }
typedef int i32x8 __attribute__((ext_vector_type(8)));
typedef int i32x4v __attribute__((ext_vector_type(4)));
DEV i32x8 cat8(const bf16x8 a, const bf16x8 b) { const i32x4v x = __builtin_bit_cast(i32x4v, a), y = __builtin_bit_cast(i32x4v, b); return __builtin_shufflevector(x, y, 0, 1, 2, 3, 4, 5, 6, 7); }
DEV void mfma_q(f32x4& acc, const i32x8 b, const i32x8 a, const int one) {
    asm volatile("v_mfma_scale_f32_16x16x128_f8f6f4 %0, %1, %2, %0, %3, %3 op_sel_hi:[0,0,0]" : "+v"(acc) : "v"(b), "v"(a), "v"(one));
}
template <int N> DEV void wait_v() { asm volatile("s_waitcnt vmcnt(%0)" :: "n"(N) : "memory"); }
struct Unit { const char* aMat; const char* bBase; int pm, pn, kind, nt, perm, bslot; };
DEV void tile_from_L(int Lg, int nM, int nN, int& pm, int& pn) {
    const int nwg = nM * nN; int wgid = Lg; { const int q = nwg / NXCD, r = nwg % NXCD, xcd = wgid % NXCD, off = wgid / NXCD; wgid = (xcd < r ? xcd * (q + 1) : r * (q + 1) + (xcd - r) * q) + off; }
    const int nig = WGM * nN, gid = wgid / nig, fm = gid * WGM, gsz = (nM - fm) < WGM ? (nM - fm) : WGM;
    pm = fm + ((wgid % nig) % gsz); pn = (wgid % nig) / gsz;
}
template <class Epi, class Sched>
DEV void gemm_phase(LAS unsigned char* lds, const Sched& S, const Epi& E, const int ldb, const int wvx) {
    constexpr bool FP8 = Sched::FP8;
    constexpr int PERMC = Sched::PERMC;
    constexpr bool GATHER = Sched::GATHER;
    const int tid = TID, wid = __builtin_amdgcn_readfirstlane(tid >> 6), lane = tid & 63, wr = wid >> 2, wc = wid & 3, fr = lane & 15, fq = lane >> 4;
    unsigned voffB[2], voffBp[2], voffA[2];
#pragma unroll
    for (int i = 0; i < 2; ++i) { int R_, C_; stage_rc(tid * 16 + i * 8192, R_, C_); voffB[i] = (unsigned)(R_ * ldb + C_) * 2u; voffA[i] = (unsigned)(R_ * ldb + C_) * 2u;
        voffBp[i] = (unsigned)(((R_ & ~31) + perm32(R_ & 31)) * ldb + C_) * 2u; }
    const size_t kstep = (size_t)(BK * 2);
    const size_t hstepB = (size_t)HALF * ldb * 2;
    const unsigned ldsw = (unsigned)wid * 1024u;
    const int aoff = lds_byte(wr * 64 + fr, fq * 8), boff = lds_byte(wc * 32 + fr, fq * 8);
#define PG_SA(b, h) (((b) * 2 + (h)) * HTB)
#define PG_SB(b, h) ((4 + (b) * 2 + (h)) * HTB)
#define PG_STAGE(bufoff, gbase, voff) do { const char* gb_ = (const char*)(gbase); asm("" : "+s"(gb_));   _Pragma("unroll") for (int _i = 0; _i < 2; ++_i) { \
        unsigned vo_ = (voff)[_i]; asm volatile("" : "+v"(vo_)); __builtin_amdgcn_global_load_lds((const unsigned*)(gb_ + vo_), (LAS unsigned*)(lds + (bufoff) + ldsw + _i * 8192), 16, 0, 0); } } while (0)
#define PG_STAGE_A(bufoff, gbase, h, og) do { if constexpr (GATHER) PG_STAGE(bufoff, gbase, (og)[h]); else PG_STAGE(bufoff, (gbase) + (h) * hstepB, voffA); } while (0)
#define PG_LDA(dst, b, h) do { _Pragma("unroll") for (int m = 0; m < 4; ++m) _Pragma("unroll") for (int k = 0; k < 2; ++k) dst[m][k] = *(const LAS bf16x8*)(lds + PG_SA(b, h) + aoff + m * 2048 + k * 1024); } while (0)
#define PG_LDB(dst, b, h) do { _Pragma("unroll") for (int n = 0; n < 2; ++n) _Pragma("unroll") for (int k = 0; k < 2; ++k) dst[n][k] = *(const LAS bf16x8*)(lds + PG_SB(b, h) + boff + n * 2048 + k * 1024); } while (0)
#define PG_MMA(ai, bj, At, Bt) do { __builtin_amdgcn_s_setprio(1); if constexpr (FP8) { _Pragma("unroll") for (int m = 0; m < 4; ++m) _Pragma("unroll") for (int n = 0; n < 2; ++n) \
        mfma_q(acc[ai][bj][m][n], cat8(Bt[n][0], Bt[n][1]), cat8(At[m][0], At[m][1]), qone); } \
        else { _Pragma("unroll") for (int m = 0; m < 4; ++m) _Pragma("unroll") for (int n = 0; n < 2; ++n) _Pragma("unroll") for (int k = 0; k < 2; ++k) \
        acc[ai][bj][m][n] = __builtin_amdgcn_mfma_f32_16x16x32_bf16(Bt[n][k], At[m][k], acc[ai][bj][m][n], 0, 0, 0); } __builtin_amdgcn_s_setprio(0); } while (0)
#define PG_WAIT_V(n) asm volatile("s_waitcnt vmcnt(" #n ")" ::: "memory")
#define PG_WAIT_L(n) asm volatile("s_waitcnt lgkmcnt(" #n ")" ::: "memory")
#define PG_BAR __builtin_amdgcn_s_barrier()
#define PG_SCHED __builtin_amdgcn_sched_barrier(0)
    Unit cur, nxt; int ui = 0;
    constexpr bool DYN = Sched::DYN;
    volatile LAS int* dslot = (volatile LAS int*)(lds + 131072 + 1024);
    if constexpr (DYN) {
        if (tid == 0) dslot[0] = S.grab();
        __syncthreads();
        const int L0 = __builtin_amdgcn_readfirstlane(dslot[0]);
        __syncthreads();
        if (!S.decode(L0, cur)) return;
    } else { if (!S.next(0, cur)) return; }
    int qone = 0x7F7F7F7F; if constexpr (FP8) asm volatile("" : "+v"(qone));
    LAS unsigned char* bslots = lds + 131072 + 4096;
    cur.bslot = 0;
    if constexpr (Epi::BIASL) { if (wid == 0) __builtin_amdgcn_global_load_lds((const unsigned*)E.bias_src(cur, lane), (LAS unsigned*)(bslots), 16, 0, 0); }
    f32x4 acc[2][2][4][2];
#pragma unroll
    for (int a = 0; a < 2; ++a)
#pragma unroll
        for (int b = 0; b < 2; ++b)
#pragma unroll
            for (int m = 0; m < 4; ++m)
#pragma unroll
                for (int n = 0; n < 2; ++n) acc[a][b][m][n] = (f32x4){0.f, 0.f, 0.f, 0.f};
    bf16x8 At[4][2], B0[2][2], B1[2][2];
    unsigned offC[2][2], offK[2][2];
    constexpr bool KEEPK = GATHER && !FP8;
    if constexpr (GATHER) { S.aoff(cur, tid, offC);
        if constexpr (KEEPK) {
#pragma unroll
        for (int h = 0; h < 2; ++h)
#pragma unroll
            for (int i = 0; i < 2; ++i) offK[h][i] = offC[h][i]; } }
    const char* cA = cur.aMat; const char* cB = cur.bBase;
    unsigned vbc[2];
#pragma unroll
    for (int i = 0; i < 2; ++i) vbc[i] = PERMC == 0 ? voffB[i] : PERMC == 1 ? voffBp[i] : cur.perm ? voffBp[i] : voffB[i];
    PG_STAGE(PG_SB(0, 0), cB, vbc); PG_STAGE(PG_SB(0, 1), cB + hstepB, vbc); PG_STAGE_A(PG_SA(0, 0), cA, 0, offC); PG_STAGE_A(PG_SA(0, 1), cA, 1, offC);
    if (wr == 1) PG_BAR;
    PG_WAIT_V(2); PG_BAR;
    PG_STAGE(PG_SB(1, 0), cB + kstep, vbc); PG_STAGE_A(PG_SA(1, 0), cA + kstep, 0, offC); PG_STAGE(PG_SB(1, 1), cB + hstepB + kstep, vbc);
    PG_WAIT_V(6); PG_BAR;
    for (;;) {
        bool has_next = false; const char* nA = cA; const char* nB = cB; int tk_ = 0;
        if constexpr (DYN) { if (tid == 0) tk_ = S.grab(); }
        else { has_next = S.next(ui + 1, nxt); nA = has_next ? nxt.aMat : cA; nB = has_next ? nxt.bBase : cB; }
        nxt.bslot = cur.bslot == 2 ? 0 : cur.bslot + 1;
        if constexpr (Epi::BIASL && !DYN) { if (has_next && wid == 0) __builtin_amdgcn_global_load_lds((const unsigned*)E.bias_src(nxt, lane), (LAS unsigned*)(bslots + nxt.bslot * 1024), 16, 0, 0); }
        if constexpr (Sched::IDXL) { if (has_next && wid == 0) __builtin_amdgcn_global_load_lds((const unsigned*)S.idx_src(nxt, lane), (LAS unsigned*)(S.islots + nxt.bslot * 1024), 16, 0, 0); }
        const int nt = cur.nt;
        for (int t = 0; t < nt; t += 2) {
            const bool last = (t == nt - 2);
            if constexpr (DYN) {
                if (t == 2) { if (tid == 0) dslot[(ui + 1) & 1] = tk_; }
                if (t == 4) { const int Ln = __builtin_amdgcn_readfirstlane(dslot[(ui + 1) & 1]); has_next = S.decode(Ln, nxt); nA = has_next ? nxt.aMat : cA; nB = has_next ? nxt.bBase : cB; }
            }
            if constexpr (Epi::HAS_MID) { if (t == 8 || t == 12) E.mid(acc, cur, t, wr, wc, fr, fq); }
            const char* a1 = cA + (size_t)(t + 1) * kstep;
            const char* a2 = last ? nA : cA + (size_t)(t + 2) * kstep; const char* b2 = last ? nB : cB + (size_t)(t + 2) * kstep;
            const char* a3 = a2 + kstep; const char* b3 = b2 + kstep;
            unsigned vb2[2];
            { const int pf_ = (last && has_next) ? nxt.perm : cur.perm;
#pragma unroll
              for (int i = 0; i < 2; ++i) vb2[i] = PERMC == 0 ? voffB[i] : PERMC == 1 ? voffBp[i] : pf_ ? voffBp[i] : voffB[i]; }
            unsigned o2[2][2];
            if constexpr (GATHER) {
                if (last && has_next) { if constexpr (Sched::IDXL) S.aoff_lds(nxt, tid, o2); else S.aoff(nxt, tid, o2);
                    if constexpr (KEEPK) {
#pragma unroll
                    for (int h = 0; h < 2; ++h)
#pragma unroll
                        for (int i = 0; i < 2; ++i) offK[h][i] = o2[h][i]; } }
                else {
#pragma unroll
                    for (int h = 0; h < 2; ++h)
#pragma unroll
                        for (int i = 0; i < 2; ++i) o2[h][i] = offC[h][i];
                }
            }
            const bool rlx_ = Epi::NSTORE > 0 && t == 0 && ui > 0;
            PG_LDB(B0, 0, 0); PG_LDB(B1, 0, 1); PG_SCHED; PG_LDA(At, 0, 0); PG_STAGE_A(PG_SA(1, 1), a1, 1, offC);
            if (rlx_) wait_v<8 + Epi::NSTORE>(); else PG_WAIT_V(8); PG_WAIT_L(0); PG_BAR; PG_MMA(0, 0, At, B0); PG_MMA(0, 1, At, B1); PG_BAR; PG_SCHED;
            PG_LDA(At, 0, 1); PG_STAGE(PG_SB(0, 0), b2, vb2); PG_STAGE(PG_SB(0, 1), b2 + hstepB, vb2); PG_STAGE_A(PG_SA(0, 0), a2, 0, o2);
            if (rlx_) wait_v<8 + Epi::NSTORE>(); else PG_WAIT_V(8); PG_WAIT_L(0); PG_BAR; PG_MMA(1, 0, At, B0); PG_MMA(1, 1, At, B1); PG_BAR; PG_SCHED;
            PG_LDB(B0, 1, 0); PG_LDB(B1, 1, 1); PG_SCHED; PG_LDA(At, 1, 0); PG_STAGE_A(PG_SA(0, 1), a2, 1, o2);
            PG_WAIT_V(8); PG_WAIT_L(0); PG_BAR; PG_MMA(0, 0, At, B0); PG_MMA(0, 1, At, B1); PG_BAR; PG_SCHED;
            PG_LDA(At, 1, 1); PG_STAGE(PG_SB(1, 0), b3, vb2); PG_STAGE(PG_SB(1, 1), b3 + hstepB, vb2); PG_STAGE_A(PG_SA(1, 0), a3, 0, o2);
            PG_WAIT_V(8); PG_WAIT_L(0); PG_BAR; PG_MMA(1, 0, At, B0); PG_MMA(1, 1, At, B1); PG_BAR; PG_SCHED;
        }
        if (wr == 0) PG_BAR;
        if constexpr (FP8) asm volatile("s_nop 15\n\ts_nop 7" ::: "memory");
        if constexpr (Epi::ACCS != 1.f) {
#pragma unroll
            for (int a = 0; a < 2; ++a)
#pragma unroll
                for (int b = 0; b < 2; ++b)
#pragma unroll
                    for (int m = 0; m < 4; ++m)
#pragma unroll
                        for (int n = 0; n < 2; ++n) acc[a][b][m][n] *= Epi::ACCS; }
        E(acc, cur, wr, wc, fr, fq);
        if (!has_next) break;
#pragma unroll
        for (int a = 0; a < 2; ++a)
#pragma unroll
            for (int b = 0; b < 2; ++b)
#pragma unroll
                for (int m = 0; m < 4; ++m)
#pragma unroll
                    for (int n = 0; n < 2; ++n) acc[a][b][m][n] = (f32x4){0.f, 0.f, 0.f, 0.f};
        cur = nxt; cA = nA; cB = nB; ++ui;
        if constexpr (KEEPK) {
#pragma unroll
            for (int h = 0; h < 2; ++h)
#pragma unroll
                for (int i = 0; i < 2; ++i) offC[h][i] = offK[h][i]; }
        else if constexpr (Sched::IDXL) S.aoff_lds(cur, tid, offC);
        else if constexpr (GATHER) S.aoff(cur, tid, offC);
        if (wr == 1) PG_BAR;
    }
    PG_WAIT_V(0);
    PG_BAR;
#undef PG_SA
#undef PG_SB
#undef PG_STAGE
#undef PG_STAGE_A
#undef PG_LDA
#undef PG_LDB
#undef PG_MMA
#undef PG_WAIT_V
#undef PG_WAIT_L
#undef PG_BAR
#undef PG_SCHED
}
}

DEV __amdgpu_buffer_rsrc_t mk_rsrc(const void* ptr, unsigned bytes) { return __builtin_amdgcn_make_buffer_rsrc((void*)ptr, (short)0, (int)bytes, 0x00020000); }
DEV void st_bf16x4(__amdgpu_buffer_rsrc_t rs, int voff, int soff, const f32x4 v) { u32x2 w; w.x = pk2(v[0], v[1]); w.y = pk2(v[2], v[3]); __builtin_amdgcn_raw_buffer_store_b64(w, rs, voff, soff, 0); }
DEV void stg_bf16x8(bf16_t* ptr, const f32x4 a, const f32x4 b) { u32x4 w; w.x = pk2(a[0], a[1]); w.y = pk2(a[2], a[3]); w.z = pk2(b[0], b[1]); w.w = pk2(b[2], b[3]); *(u32x4*)ptr = w; }
DEV f32x4 ld_bf16x4(const bf16_t* ptr) { const u32x2 w = *(const u32x2*)ptr; return (f32x4){bf2f((bf16_t)(w.x & 0xffff)), bf2f((bf16_t)(w.x >> 16)), bf2f((bf16_t)(w.y & 0xffff)), bf2f((bf16_t)(w.y >> 16))}; }

struct SchedA {
    const char* hbf; const char* wtin; const char* wtt; int G, c;
    static constexpr bool GATHER = false, FP8 = INP_FP8 == 1; static constexpr int PERMC = -1; static constexpr bool DYN = false, IDXL = false;
    static constexpr int DR = FP8 ? D / 2 : D;
    static constexpr int NM = TA / 256, NN = NIN / 256 - 1, N1 = NM * NN, N2 = 3 * NM;
    DEV bool next(int i, pg::Unit& u) const {
        const int Lg = i * G + c; if (Lg >= N1 + N2) return false;
        u.nt = FP8 ? 8 : 16;
        if (Lg < N1) { pg::tile_from_L(Lg, NM, NN, u.pm, u.pn); if (u.pn >= 6) ++u.pn; u.kind = 0; u.perm = (u.pn == 3 || u.pn >= 6) ? 1 : 0; u.aMat = hbf + (size_t)u.pm * 256 * DR * 2; u.bBase = wtin + (size_t)u.pn * 256 * DR * 2; }
        else { const int r = Lg - N1; u.pm = r % 3; u.pn = r / 3; u.kind = 1; u.perm = 0; u.aMat = wtt + (size_t)u.pm * 256 * DR * 2; u.bBase = hbf + (size_t)u.pn * 256 * DR * 2; }
        return true;
    }
    DEV void aoff(const pg::Unit& u, const int tid, unsigned (&off)[2][2]) const {
        int R[2], C[2];
#pragma unroll
        for (int i = 0; i < 2; ++i) pg::stage_rc(tid * 16 + i * 8192, R[i], C[i]);
#pragma unroll
        for (int h = 0; h < 2; ++h)
#pragma unroll
            for (int i = 0; i < 2; ++i) off[h][i] = (unsigned)((u.pm * 256 + h * 128 + R[i]) * D + C[i]) * 2u;
    }
};
struct EpiA {
    static constexpr bool HAS_MID = false, BIASL = false; static constexpr int NSTORE = 0; static constexpr float ACCS = INP_FP8 == 1 ? 1.f / QW : 1.f;
    const P& p; int l;
    DEV void operator()(const f32x4 (&acc)[2][2][4][2], const pg::Unit& u, int wr, int wc, int fr, int fq) const {
        if (u.kind == 0) {
            const __amdgpu_buffer_rsrc_t rs = mk_rsrc(p.ws + OFF_PROJ, (unsigned)((size_t)TA * NIN * 2));
            const bool isctx = u.pm * 256 >= TL;
            const f32x2* taba = (const f32x2*)(p.ws + OFF_TABA); const f32x2* tabr = (const f32x2*)(p.ws + OFF_TABR);
            if (G8 && u.perm && u.pn >= C_GA / 256) {
                const int g = (u.pn - C_GA / 256) >> 2, pnl = (u.pn - C_GA / 256) & 3;
#pragma unroll
                for (int ai = 0; ai < 2; ++ai)
#pragma unroll
                    for (int m = 0; m < 4; ++m) {
                        unsigned cw[4] = {0u, 0u, 0u, 0u};
#pragma unroll
                        for (int bj = 0; bj < 2; ++bj)
#pragma unroll
                            for (int n = 0; n < 2; ++n) {
                                f32x4 e = acc[ai][bj][m][n] * (-LOG2E * (INP_FP8 == 2 ? 1.f / QW : 1.f));
#pragma unroll
                                for (int i = 0; i < 4; ++i) e[i] = __builtin_amdgcn_exp2f(e[i]);
                                e = e + 1.f;
#pragma unroll
                                for (int i = 0; i < 4; ++i) e[i] = __builtin_amdgcn_logf(e[i]);
                                e = e * 32.f + 0.5f;
#pragma unroll
                                for (int i = 0; i < 4; ++i) cw[bj * 2 + n] |= (unsigned)fminf(e[i], 255.f) << (8 * i);
                            }
                        u32x4 cq; cq.x = cw[0]; cq.y = cw[1]; cq.z = cw[2]; cq.w = cw[3];
                        *(u32x4*)(p.ws + OFF_G8 + (size_t)(u.pm * 256 + ai * 128 + wr * 64 + m * 16 + fr) * 3072 + g * 1024 + pnl * 256 + wc * 64 + fq * 16) = cq;
                    }
            } else if (u.perm) {
#pragma unroll
                for (int bj = 0; bj < 2; ++bj) {
                    const int cb = u.pn * 256 + bj * 128;
                    const int reg = cb < C_RGF ? 1 : cb < C_GA ? 3 : 4;
#pragma unroll
                    for (int ai = 0; ai < 2; ++ai)
#pragma unroll
                        for (int m = 0; m < 4; ++m) {
                            f32x4 o1 = acc[ai][bj][m][0], o2 = acc[ai][bj][m][1];
                            if (reg == 3) {
#pragma unroll
                                for (int i = 0; i < 4; ++i) { o1[i] = siluf_(o1[i]); o2[i] = siluf_(o2[i]); }
                            } else if (reg == 4) {
#pragma unroll
                                for (int i = 0; i < 4; ++i) { o1[i] = sigmoidf_(o1[i]); o2[i] = sigmoidf_(o2[i]); }
                            }
                            stg_bf16x8((bf16_t*)(p.ws + OFF_PROJ) + (size_t)(u.pm * 256 + ai * 128 + wr * 64 + m * 16 + fr) * NIN + cb + wc * 32 + 8 * fq, o1, o2);
                        }
                }
            } else {
#pragma unroll
            for (int bj = 0; bj < 2; ++bj) {
                const int cb = u.pn * 256 + bj * 128;
                const int reg = cb < C_V ? 0 : cb < C_RQ ? 1 : cb < C_RV ? 2 : cb < C_RGF ? 1 : cb < C_GA ? 3 : 4;
#pragma unroll
                for (int ai = 0; ai < 2; ++ai)
#pragma unroll
                    for (int m = 0; m < 4; ++m) {
                        const int row = u.pm * 256 + ai * 128 + wr * 64 + m * 16 + fr, pos = isctx ? 0 : (row & (L - 1));
                        f32x4 x1 = acc[ai][bj][m][0], x2 = acc[ai][bj][m][1], o1, o2;
                        if (reg == 0 || reg == 2) {
                            const f32x2* tp = reg == 0 ? ((wc & 1) ? taba + 256 * 16 + (pos & 63) * 16 : taba + (pos >> 6) * 16) + 4 * fq : tabr + pos * 32 + (wc & 1) * 16 + 4 * fq;
                            const f32x4 t0 = *(const f32x4*)tp, t1 = *(const f32x4*)(tp + 2);
                            const f32x4 cs = (f32x4){t0[0], t0[2], t1[0], t1[2]}, sn = (f32x4){t0[1], t0[3], t1[1], t1[3]};
                            o1 = x1 * cs - x2 * sn; o2 = x1 * sn + x2 * cs;
                            if (reg == 0 && cb < C_K) { o1 = o1 * (0.125f * LOG2E); o2 = o2 * (0.125f * LOG2E); }
                            else if (reg == 2 && cb >= C_RK) { o1 = o1 * 0.125f; o2 = o2 * 0.125f; }
                        } else if (reg == 1) { o1 = x1; o2 = x2; }
                        else if (reg == 3) {
#pragma unroll
                            for (int i = 0; i < 4; ++i) { o1[i] = siluf_(x1[i]); o2[i] = siluf_(x2[i]); }
                        } else {
#pragma unroll
                            for (int i = 0; i < 4; ++i) { o1[i] = sigmoidf_(x1[i]); o2[i] = sigmoidf_(x2[i]); }
                        }
                        const int so = ((u.pm * 256 + ai * 128 + m * 16) * NIN + cb) * 2;
                        st_bf16x4(rs, ((wr * 64 + fr) * NIN + wc * 32 + 4 * fq) * 2, so, o1);
                        st_bf16x4(rs, ((wr * 64 + fr) * NIN + wc * 32 + 4 * fq) * 2, so + 32, o2);
                    }
            }
            }
        } else {
            bf16_t* projT = (bf16_t*)(p.ws + OFF_PROJT);
            if (u.pm < 2) {
#pragma unroll
                for (int ai = 0; ai < 2; ++ai) {
                    if (u.pm == 0 && ai == 1) continue;
#pragma unroll
                    for (int m = 0; m < 4; ++m) {
                        const int row = u.pm * 256 + ai * 128 + wr * 64 + m * 16 + fr;
#pragma unroll
                        for (int bj = 0; bj < 2; ++bj)
#pragma unroll
                            for (int n = 0; n < 2; ++n) {
                                const int tok = u.pn * 256 + bj * 128 + wc * 32 + 16 * n + 4 * fq; const f32x4 v = acc[ai][bj][m][n];
                                u32x2 w; w.x = pk2(v[0], v[1]); w.y = pk2(v[2], v[3]);
                                *(u32x2*)(projT + (size_t)row * TA + tok) = w;
                            }
                    }
                }
            } else {
                const float* tcos = (const float*)(p.ws + OFF_TABRT); const float* tsin = tcos + (size_t)32 * L;
                const __amdgpu_buffer_rsrc_t rsT = __builtin_amdgcn_make_buffer_rsrc((void*)projT, (short)0, (int)(TROWS * TA * 2), 0x00020000);
                const int voT = ((wr * 64 + fr) * TA + wc * 32 + 4 * fq) * 2, sbase = u.pn * 256;
#pragma unroll
                for (int bj = 0; bj < 2; ++bj)
#pragma unroll
                    for (int n = 0; n < 2; ++n) {
                        const int tok0 = u.pn * 256 + bj * 128 + wc * 32 + 16 * n + 4 * fq, jj = tok0 & 127; const bool isctx = u.pn * 256 >= TL; const int pos = tok0 & (L - 1);
#pragma unroll
                        for (int ai = 0; ai < 2; ++ai) {
                            const int hh = 2 * ai + wr;
                            const f32x4 wf = *(const f32x4*)((const float*)(p.ws + OFF_TABW) + ((l * 2 + 0) * 4 + hh) * 128 + jj) * 0.125f;
                            const f32x4 wb = *(const f32x4*)((const float*)(p.ws + OFF_TABW) + ((l * 2 + 1) * 4 + hh) * 128 + jj) * 0.125f;
#pragma unroll
                            for (int mp = 0; mp < 2; ++mp) {
                                const int prow = ai * 128 + wr * 64 + mp * 32 + fr, f = mp * 16 + fr;
                                f32x4 cs = (f32x4){1.f, 1.f, 1.f, 1.f}, sn = (f32x4){0.f, 0.f, 0.f, 0.f};
                                if (!isctx) { cs = *(const f32x4*)(tcos + (size_t)f * L + pos); sn = *(const f32x4*)(tsin + (size_t)f * L + pos); }
                                const f32x4 x1 = acc[ai][bj][2 * mp][n], x2 = acc[ai][bj][2 * mp + 1][n];
                                const f32x4 o1 = x1 * cs - x2 * sn, o2 = x1 * sn + x2 * cs;
                                const f32x4 a1 = o1 * wf, a2 = o2 * wf, b1 = o1 * wb, b2 = o2 * wb;
                                u32x2 w; const int so = ((ai * 128 + mp * 32) * TA + sbase + bj * 128 + 16 * n) * 2;
                                w.x = pk2(a1[0], a1[1]); w.y = pk2(a1[2], a1[3]); __builtin_amdgcn_raw_buffer_store_b64(w, rsT, voT, so + (T_RKF * TA) * 2, 0);
                                w.x = pk2(a2[0], a2[1]); w.y = pk2(a2[2], a2[3]); __builtin_amdgcn_raw_buffer_store_b64(w, rsT, voT, so + ((T_RKF + 16) * TA) * 2, 0);
                                w.x = pk2(b1[0], b1[1]); w.y = pk2(b1[2], b1[3]); __builtin_amdgcn_raw_buffer_store_b64(w, rsT, voT, so + (T_RKB * TA) * 2, 0);
                                w.x = pk2(b2[0], b2[1]); w.y = pk2(b2[2], b2[3]); __builtin_amdgcn_raw_buffer_store_b64(w, rsT, voT, so + ((T_RKB + 16) * TA) * 2, 0);
                            }
                        }
                    }
            }
        }
    }
};
template <bool Q>
struct SchedAM {
    const char* hb; const char* wt; const char* wtt; unsigned* ctr; int xcd;
    static constexpr bool GATHER = false, FP8 = Q, DYN = true, IDXL = false; static constexpr int PERMC = Q ? 1 : -1;
    static constexpr int DR = Q ? D / 2 : D;
    static constexpr int NM = TA / 256, NN = Q ? 12 : 8, N1 = NM * NN, N2 = Q ? 0 : NM;
    DEV int grab() const { return (int)__hip_atomic_fetch_add(ctr + xcd * 16, 1u, __ATOMIC_RELAXED, __HIP_MEMORY_SCOPE_AGENT); }
    DEV bool decode(int k, pg::Unit& u) const {
        const int Lg = k * 8 + xcd; if (Lg >= N1 + N2) return false;
        u.nt = Q ? 8 : 16;
        if (Lg < N1) { pg::tile_from_L(Lg, NM, NN, u.pm, u.pn); u.kind = 0; u.aMat = hb + (size_t)u.pm * 256 * DR * 2;
            if (Q) { u.bBase = wt + (size_t)u.pn * 256 * DR * 2; u.pn += 9; u.perm = 1; }
            else { if (u.pn >= 6) ++u.pn; u.perm = (u.pn == 3 || u.pn >= 6) ? 1 : 0; u.bBase = wt + (size_t)u.pn * 256 * DR * 2; } }
        else { const int r = Lg - N1; u.pm = 1; u.pn = r; u.kind = 1; u.perm = 0; u.aMat = wtt + (size_t)u.pm * 256 * DR * 2; u.bBase = hb + (size_t)u.pn * 256 * DR * 2; }
        return true;
    }
    DEV bool next(int i, pg::Unit& u) const { return false; }
    DEV void aoff(const pg::Unit& u, const int tid, unsigned (&off)[2][2]) const { off[0][0] = off[0][1] = off[1][0] = off[1][1] = 0u; }
};
struct EpiAQ : EpiA { static constexpr float ACCS = 1.f; static constexpr int NSTORE = G8 ? 8 : 0; };
#ifndef NCONV_
#define NCONV_ 96
#endif
constexpr int NCONV = NCONV_;
DEV void stage_inproj_mixed(const P& p, int l, int bid, int nb, unsigned char* lds, int wvx) {
    unsigned* ctr = (unsigned*)(p.ws + OFF_CTL) + CW_DYN + l * 256;
    if (NCONV > 0 && bid >= nb - NCONV) { stage_prep_experts(p, l, bid - (nb - NCONV), NCONV, lds, wvx); __syncthreads(); }
    { SchedAM<false> S{(const char*)(p.ws + OFF_HBF), (const char*)(p.ws + OFF_WTIN) + (size_t)l * NIN * D * 2, (const char*)(p.ws + OFF_WTT) + (size_t)l * 768 * D * 2, ctr, bid & 7};
      EpiA E{p, l};
      pg::gemm_phase<EpiA, SchedAM<false>>((LAS unsigned char*)lds, S, E, D, wvx); }
    __syncthreads();
    { SchedAM<true> S{(const char*)(p.ws + OFF_HQ), (const char*)(p.ws + OFF_WTINQ) + (size_t)l * (NIN - C_GA) * D, nullptr, ctr + 128, bid & 7};
      EpiAQ E{{p, l}};
      pg::gemm_phase<EpiAQ, SchedAM<true>>((LAS unsigned char*)lds, S, E, D / 2, wvx); }
}
DEV void stage_inproj_fast(const P& p, int l, int bid, int nb, unsigned char* lds, int wvx) {
#if INP_FP8 == 2
    stage_inproj_mixed(p, l, bid, nb, lds, wvx); return;
#endif
    SchedA S{(const char*)(p.ws + OFF_HBF), (const char*)(p.ws + OFF_WTIN) + (size_t)l * NIN * SchedA::DR * 2, (const char*)(p.ws + OFF_WTT) + (size_t)l * 768 * SchedA::DR * 2, nb, bid};
    EpiA E{p, l};
    pg::gemm_phase<EpiA, SchedA>((LAS unsigned char*)lds, S, E, SchedA::DR, wvx);
}

DEV void moe_tiles(const P& p, int l, LAS int* tstart, LAS int* cnt, int wvx, int NN = 0, int G = 0, int c0 = 0) {
    const int tid = TID;
    if (tid < 64) {
        unsigned* cntg = (unsigned*)(p.ws + OFF_CTL) + CW_CNT + l * 32;
        const int c = tid < 32 ? (int)__hip_atomic_load(cntg + (tid & 31), __ATOMIC_RELAXED, __HIP_MEMORY_SCOPE_AGENT) : 0;
        const int nt = (c + 255) >> 8; int incl = nt;
#pragma unroll
        for (int o = 1; o < 32; o <<= 1) { const int t = __shfl_up(incl, o); if ((tid & 63) >= o) incl += t; }
        if (tid < 32) { cnt[tid] = c; tstart[tid] = incl - nt; if (tid == 31) tstart[32] = incl; }
    }
    __syncthreads();
    if (NN > 0 && tid < 64) {
        const int ntile = tstart[32]; const int Lg = tid * G + c0; int v = -1;
        if (Lg < ntile * NN) { int pm, pn; pg::tile_from_L(Lg, ntile, NN, pm, pn); int e = 0;
            for (int j = 1; j < 32; ++j) e = (pm >= tstart[j]) ? j : e;
            v = pm | (pn << 16) | (e << 24); }
        tstart[80 + tid] = v;
    }
    __syncthreads();
}
template <int NN, bool GATHER_, bool FP8_>
struct SchedMoe {
    static constexpr bool GATHER = GATHER_, FP8 = FP8_; static constexpr int PERMC = GATHER_ ? 0 : 1; static constexpr bool DYN = false, IDXL = GATHER_ && FP8_;
    static constexpr int DR = FP8_ ? D / 2 : D;
    const char* amat; const char* wt; const int* list_tok; const LAS int* tstart; const LAS int* cnt; int G, c; LAS unsigned char* islots;
    DEV const int* idx_src(const pg::Unit& u, int lane) const { const int e = u.kind, ts = __builtin_amdgcn_readfirstlane(tstart[e]); return list_tok + (size_t)e * CAP + (u.pm - ts) * 256 + 4 * lane; }
    DEV void aoff_lds(const pg::Unit& u, const int tid, unsigned (&off)[2][2]) const {
        int R[2], C[2];
#pragma unroll
        for (int i = 0; i < 2; ++i) pg::stage_rc(tid * 16 + i * 8192, R[i], C[i]);
        const int e = u.kind, ts = __builtin_amdgcn_readfirstlane(tstart[e]), ce = __builtin_amdgcn_readfirstlane(cnt[e]), lim = ce - 1 - (u.pm - ts) * 256;
        const LAS int* sl = (const LAS int*)(islots + u.bslot * 1024);
#pragma unroll
        for (int h = 0; h < 2; ++h)
#pragma unroll
            for (int i = 0; i < 2; ++i) { const int r = h * 128 + R[i]; const int tok = sl[r < lim ? r : lim]; off[h][i] = (unsigned)(tok * DR + C[i]) * 2u; }
    }
    DEV bool next(int i, pg::Unit& u) const {
        const int v = i < 64 ? __builtin_amdgcn_readfirstlane(tstart[80 + i]) : -1; if (v < 0) return false;
        u.pm = v & 0xffff; u.pn = (v >> 16) & 0xff; const int e = v >> 24;
        u.kind = e; u.nt = FP8_ ? 8 : 16; u.perm = GATHER_ ? 0 : 1; u.aMat = GATHER_ ? amat : amat + (size_t)u.pm * 256 * DR * 2; u.bBase = wt + ((size_t)e * NN * 256 + (size_t)u.pn * 256) * DR * 2;
        return true;
    }
    DEV void aoff(const pg::Unit& u, const int tid, unsigned (&off)[2][2]) const {
        int R[2], C[2];
#pragma unroll
        for (int i = 0; i < 2; ++i) pg::stage_rc(tid * 16 + i * 8192, R[i], C[i]);
#pragma unroll
        for (int h = 0; h < 2; ++h)
#pragma unroll
            for (int i = 0; i < 2; ++i) {
                if (GATHER) { const int e = u.kind, ts = __builtin_amdgcn_readfirstlane(tstart[e]), ce = __builtin_amdgcn_readfirstlane(cnt[e]), pos = (u.pm - ts) * 256 + h * 128 + R[i]; const int tok = list_tok[e * CAP + (pos < ce ? pos : ce - 1)]; off[h][i] = (unsigned)(tok * DR + C[i]) * 2u; }
                else off[h][i] = (unsigned)((u.pm * 256 + h * 128 + R[i]) * DR + C[i]) * 2u;
            }
    }
};
struct EpiM1 {
    static constexpr bool HAS_MID = false, BIASL = true; static constexpr int NSTORE = MOE_FP8 >= 2 ? 8 : 0; static constexpr float ACCS = 1.f;
    const P& p; int l; LAS unsigned char* bl;
    DEV const float* bias_src(const pg::Unit& u, int lane) const { return p.b1 + ((size_t)l * NEXP + u.kind) * 2048 + 128 * u.pn + (lane < 32 ? 4 * lane : 1024 + 4 * (lane - 32)); }
    DEV void operator()(const f32x4 (&acc)[2][2][4][2], const pg::Unit& u, int wr, int wc, int fr, int fq) const {
        bf16_t* act = (bf16_t*)(p.ws + OFF_ACT);
        const float* b1 = p.b1 + ((size_t)l * NEXP + u.kind) * 2048;
        const int q = fq == 1 ? 2 : fq == 2 ? 1 : fq;
        f32x4 bgv[2], blv[2];
#pragma unroll
        for (int bj = 0; bj < 2; ++bj) { const LAS float* sl = (const LAS float*)(bl + u.bslot * 1024) + 16 * (4 * bj + wc) + 4 * q; bgv[bj] = *(const LAS f32x4*)sl; blv[bj] = *(const LAS f32x4*)(sl + 128); }
        const int hi = fq >> 1;
        const int ccol = 16 * (8 * u.pn + 4 * hi + wc) + 8 * (fq & 1);
        constexpr float S1 = MOE_FP8 >= 1 ? 1.f / QW : 1.f;
#pragma unroll
        for (int ai = 0; ai < 2; ++ai)
#pragma unroll
            for (int m = 0; m < 4; ++m) {
#if MOE_FP8 >= 2
                unsigned q0 = 0, q1 = 0;
#pragma unroll
                for (int bj = 0; bj < 2; ++bj) {
                    f32x4 g = acc[ai][bj][m][0] * S1 + bgv[bj], li = acc[ai][bj][m][1] * S1 + blv[bj];
#pragma unroll
                    for (int i = 0; i < 4; ++i) { g[i] = fminf(g[i], 7.f); li[i] = fminf(fmaxf(li[i], -7.f), 7.f); }
                    f32x4 e = g * (-1.702f * LOG2E);
#pragma unroll
                    for (int i = 0; i < 4; ++i) e[i] = __builtin_amdgcn_exp2f(e[i]);
                    e = e + 1.f;
#pragma unroll
                    for (int i = 0; i < 4; ++i) e[i] = __builtin_amdgcn_rcpf(e[i]);
                    const f32x4 o = (g * e) * (li * QA + QA);
                    if (bj == 0) q0 = pk4q(o[0], o[1], o[2], o[3]); else q1 = pk4q(o[0], o[1], o[2], o[3]);
                }
                { const auto r = __builtin_amdgcn_permlane32_swap(q0, q1, false, false); q0 = r[0]; q1 = r[1]; }
                u32x2 wq; wq.x = q0; wq.y = q1;
                *(u32x2*)((unsigned char*)act + (size_t)(u.pm * 256 + ai * 128 + wr * 64 + m * 16 + fr) * D + ccol) = wq;
            }
#else
                unsigned w0[2], w1[2];
#pragma unroll
                for (int bj = 0; bj < 2; ++bj) {
                    f32x4 o;
#pragma unroll
                    for (int i = 0; i < 4; ++i) {
                        float glu = acc[ai][bj][m][0][i] * S1 + bgv[bj][i], lin = acc[ai][bj][m][1][i] * S1 + blv[bj][i];
                        glu = fminf(glu, 7.f); lin = fminf(fmaxf(lin, -7.f), 7.f);
                        o[i] = glu * sigmoidf_(1.702f * glu) * (lin + 1.f);
                    }
                    if (bj == 0) { w0[0] = pk2(o[0], o[1]); w0[1] = pk2(o[2], o[3]); } else { w1[0] = pk2(o[0], o[1]); w1[1] = pk2(o[2], o[3]); }
                }
#pragma unroll
                for (int k = 0; k < 2; ++k) { const auto r = __builtin_amdgcn_permlane32_swap(w0[k], w1[k], false, false); w0[k] = r[0]; w1[k] = r[1]; }
                u32x4 w; w.x = w0[0]; w.y = w0[1]; w.z = w1[0]; w.w = w1[1];
                *(u32x4*)(act + (size_t)(u.pm * 256 + ai * 128 + wr * 64 + m * 16 + fr) * D + ccol) = w;
            }
#endif
    }
};
struct EpiM2 {
    static constexpr bool HAS_MID = false, BIASL = true; static constexpr int NSTORE = 16; static constexpr float ACCS = 1.f;
    const P& p; int l; LAS unsigned char* bl;
    DEV const float* bias_src(const pg::Unit& u, int lane) const { return p.b2 + ((size_t)l * NEXP + u.kind) * D + 256 * u.pn + 4 * lane; }
    DEV void operator()(const f32x4 (&acc)[2][2][4][2], const pg::Unit& u, int wr, int wc, int fr, int fq) const {
        const __amdgpu_buffer_rsrc_t rs = mk_rsrc(p.ws + OFF_YB, (unsigned)((size_t)PMAX * D * 2));
        const float* b2 = p.b2 + ((size_t)l * NEXP + u.kind) * D;
        const int vo = ((wr * 64 + fr) * D + wc * 32 + 8 * fq) * 2;
        f32x4 bv[2][2];
#pragma unroll
        for (int bj = 0; bj < 2; ++bj)
#pragma unroll
            for (int n = 0; n < 2; ++n) bv[bj][n] = *(const LAS f32x4*)((const LAS float*)(bl + u.bslot * 1024) + bj * 128 + wc * 32 + 8 * fq + 4 * n);
#pragma unroll
        for (int bj = 0; bj < 2; ++bj)
#pragma unroll
            for (int ai = 0; ai < 2; ++ai)
#pragma unroll
                for (int m = 0; m < 4; ++m)
                    { constexpr float S2 = MOE_FP8 >= 2 ? 1.f / (QW * QA) : 1.f; const f32x4 a_ = acc[ai][bj][m][0] * S2 + bv[bj][0], b_ = acc[ai][bj][m][1] * S2 + bv[bj][1];
#if YB_FP8
                      u32x2 q_; q_.x = pk4q(a_[0] * QY, a_[1] * QY, a_[2] * QY, a_[3] * QY); q_.y = pk4q(b_[0] * QY, b_[1] * QY, b_[2] * QY, b_[3] * QY);
                      *(u32x2*)(p.ws + OFF_YB + (size_t)(u.pm * 256 + ai * 128 + wr * 64 + m * 16 + fr) * D + u.pn * 256 + bj * 128 + wc * 32 + 8 * fq) = q_; }
#else
                      u32x4 w_; w_.x = pk2(a_[0], a_[1]); w_.y = pk2(a_[2], a_[3]); w_.z = pk2(b_[0], b_[1]); w_.w = pk2(b_[2], b_[3]);
                      *(u32x4*)((bf16_t*)(p.ws + OFF_YB) + (size_t)(u.pm * 256 + ai * 128 + wr * 64 + m * 16 + fr) * D + u.pn * 256 + bj * 128 + wc * 32 + 8 * fq) = w_; }
#endif
    }
};
DEV void stage_moe1_fast(const P& p, int l, int bid, int nb, unsigned char* lds, int wvx) {
    LAS int* tstart = (LAS int*)((LAS unsigned char*)lds + 131072); LAS int* cnt = tstart + 40;
    moe_tiles(p, l, tstart, cnt, wvx, 8, nb, bid);
    constexpr bool Q = MOE_FP8 >= 1;
    SchedMoe<8, true, Q> S{(const char*)(p.ws + OFF_HBF), (const char*)(p.ws + OFF_WT1) + (size_t)l * NEXP * 2048 * D * (Q ? 1 : 2), (const int*)(p.ws + OFF_TK + (size_t)l * TK_LAYER) + 3 * TA * 4, tstart, cnt, nb, bid, (LAS unsigned char*)lds + 131072 + 8192};
    EpiM1 E{p, l, (LAS unsigned char*)lds + 131072 + 4096};
    pg::gemm_phase<EpiM1, SchedMoe<8, true, Q>>((LAS unsigned char*)lds, S, E, Q ? D / 2 : D, wvx);
}
DEV void stage_moe2_fast(const P& p, int l, int bid, int nb, unsigned char* lds, int wvx) {
    LAS int* tstart = (LAS int*)((LAS unsigned char*)lds + 131072); LAS int* cnt = tstart + 40;
    moe_tiles(p, l, tstart, cnt, wvx, 4, nb, bid);
    constexpr bool Q = MOE_FP8 >= 2;
    SchedMoe<4, false, Q> S{(const char*)(p.ws + OFF_ACT), (const char*)(p.ws + OFF_WT2) + (size_t)l * NEXP * D * D * (Q ? 1 : 2), nullptr, tstart, cnt, nb, bid, nullptr};
    EpiM2 E{p, l, (LAS unsigned char*)lds + 131072 + 4096};
    pg::gemm_phase<EpiM2, SchedMoe<4, false, Q>>((LAS unsigned char*)lds, S, E, Q ? D / 2 : D, wvx);
}

struct SchedMerge {
    const char* mix; const char* wtm; int G, c, NM;
    static constexpr bool GATHER = false, FP8 = false; static constexpr int PERMC = -1; static constexpr bool DYN = false, IDXL = false;
    static constexpr int NN = D / 256;
    DEV bool next(int i, pg::Unit& u) const {
        const int Lt = i * G + c; if (Lt >= NM * NN) return false;
        pg::tile_from_L(Lt, NM, NN, u.pm, u.pn);
        u.kind = 0; u.nt = 16; u.perm = 1; u.aMat = mix + (size_t)u.pm * 256 * D * 2; u.bBase = wtm + (size_t)u.pn * 256 * D * 2;
        return true;
    }
    DEV void aoff(const pg::Unit& u, const int tid, unsigned (&off)[2][2]) const {}
};
struct EpiMerge {
    static constexpr bool HAS_MID = true, BIASL = false; static constexpr int NSTORE = 16; static constexpr float ACCS = 1.f;
    const P& p;
    DEV void mid(f32x4 (&acc)[2][2][4][2], const pg::Unit& u, int t, int wr, int wc, int fr, int fq) const {
        const bf16_t* proj = (const bf16_t*)(p.ws + OFF_PROJ);
        const int cnum = C_GA + (t == 8 ? 0 : 1024), cden = cnum + 1024;
#pragma unroll
        for (int ai = 0; ai < 2; ++ai)
#pragma unroll
            for (int m = 0; m < 4; ++m) {
#if G8
                { const unsigned char* grow = p.ws + OFF_G8 + (size_t)(u.pm * 256 + ai * 128 + wr * 64 + m * 16 + fr) * 3072 + u.pn * 256 + wc * 64 + fq * 16;
                  const u32x4 gn8 = *(const u32x4*)(grow + (cnum - C_GA)), gd8 = *(const u32x4*)(grow + (cden - C_GA));
                  const unsigned wn_[4] = {gn8.x, gn8.y, gn8.z, gn8.w}, wd_[4] = {gd8.x, gd8.y, gd8.z, gd8.w};
#pragma unroll
                  for (int bj = 0; bj < 2; ++bj)
#pragma unroll
                    for (int n = 0; n < 2; ++n) {
                        const unsigned wd = wd_[bj * 2 + n], wn = wn_[bj * 2 + n];
                        f32x4 r = ((f32x4){(float)(wd & 255u), (float)((wd >> 8) & 255u), (float)((wd >> 16) & 255u), (float)(wd >> 24)}
                                 - (f32x4){(float)(wn & 255u), (float)((wn >> 8) & 255u), (float)((wn >> 16) & 255u), (float)(wn >> 24)}) * (1.f / 32.f);
#pragma unroll
                        for (int i = 0; i < 4; ++i) r[i] = __builtin_amdgcn_exp2f(r[i]);
                        acc[ai][bj][m][n] = acc[ai][bj][m][n] * r;
                    }
                }
                continue;
#endif
                const bf16_t* rowp = proj + (size_t)(u.pm * 256 + ai * 128 + wr * 64 + m * 16 + fr) * NIN + u.pn * 256 + wc * 32 + 8 * fq;
#pragma unroll
                for (int bj = 0; bj < 2; ++bj) {
                    const u32x4 gnw = *(const u32x4*)(rowp + cnum + bj * 128), gdw = *(const u32x4*)(rowp + cden + bj * 128);
                    const unsigned gn_[4] = {gnw.x, gnw.y, gnw.z, gnw.w}, gd_[4] = {gdw.x, gdw.y, gdw.z, gdw.w};
#pragma unroll
                    for (int n = 0; n < 2; ++n)
#pragma unroll
                        for (int i = 0; i < 4; ++i) {
                            const unsigned wn = gn_[2 * n + (i >> 1)], wd = gd_[2 * n + (i >> 1)];
                            const float gnf = bf2f((bf16_t)((i & 1) ? (wn >> 16) : (wn & 0xffff))), gdf = bf2f((bf16_t)((i & 1) ? (wd >> 16) : (wd & 0xffff)));
                            acc[ai][bj][m][n][i] *= gnf * __builtin_amdgcn_rcpf(fmaxf(gdf, 1e-30f));
                        }
                }
            }
    }
    DEV void operator()(const f32x4 (&acc)[2][2][4][2], const pg::Unit& u, int wr, int wc, int fr, int fq) const {
        const bf16_t* proj = (const bf16_t*)(p.ws + OFF_PROJ);
        bf16_t* mo = (bf16_t*)(p.ws + OFF_M);
#if G8
        u32x2 gw[2][4][2];
#pragma unroll
        for (int ai = 0; ai < 2; ++ai)
#pragma unroll
            for (int m = 0; m < 4; ++m) {
                const u32x4 g4 = *(const u32x4*)(p.ws + OFF_G8 + (size_t)(u.pm * 256 + ai * 128 + wr * 64 + m * 16 + fr) * 3072 + 2048 + u.pn * 256 + wc * 64 + fq * 16);
                gw[ai][m][0] = (u32x2){g4.x, g4.y}; gw[ai][m][1] = (u32x2){g4.z, g4.w};
            }
#else
        u32x4 gw[2][4][2];
#pragma unroll
        for (int ai = 0; ai < 2; ++ai)
#pragma unroll
            for (int m = 0; m < 4; ++m) {
                const bf16_t* rowp = proj + (size_t)(u.pm * 256 + ai * 128 + wr * 64 + m * 16 + fr) * NIN + C_GA + 2048 + u.pn * 256 + wc * 32 + 8 * fq;
#pragma unroll
                for (int bj = 0; bj < 2; ++bj) gw[ai][m][bj] = *(const u32x4*)(rowp + bj * 128);
            }
#endif
#pragma unroll
        for (int ai = 0; ai < 2; ++ai)
#pragma unroll
            for (int m = 0; m < 4; ++m)
#pragma unroll
                for (int bj = 0; bj < 2; ++bj) {
#if G8
                    const u32x2 w = gw[ai][m][bj]; f32x4 g0, g1;
#pragma unroll
                    for (int i = 0; i < 4; ++i) { g0[i] = __builtin_amdgcn_exp2f((float)((w.x >> (8 * i)) & 255u) * (-1.f / 32.f)); g1[i] = __builtin_amdgcn_exp2f((float)((w.y >> (8 * i)) & 255u) * (-1.f / 32.f)); }
#else
                    const u32x4 w = gw[ai][m][bj];
                    const f32x4 g0 = (f32x4){bf2f((bf16_t)(w.x & 0xffff)), bf2f((bf16_t)(w.x >> 16)), bf2f((bf16_t)(w.y & 0xffff)), bf2f((bf16_t)(w.y >> 16))};
                    const f32x4 g1 = (f32x4){bf2f((bf16_t)(w.z & 0xffff)), bf2f((bf16_t)(w.z >> 16)), bf2f((bf16_t)(w.w & 0xffff)), bf2f((bf16_t)(w.w >> 16))};
#endif
#if OUT_FP8
                    { const f32x4 a_ = g0 * acc[ai][bj][m][0] * QM, b_ = g1 * acc[ai][bj][m][1] * QM; u32x2 wq; wq.x = pk4q(a_[0], a_[1], a_[2], a_[3]); wq.y = pk4q(b_[0], b_[1], b_[2], b_[3]);
                      *(u32x2*)((unsigned char*)mo + (size_t)(u.pm * 256 + ai * 128 + wr * 64 + m * 16 + fr) * D + u.pn * 256 + bj * 128 + wc * 32 + 8 * fq) = wq; }
#else
                    stg_bf16x8(mo + (size_t)(u.pm * 256 + ai * 128 + wr * 64 + m * 16 + fr) * D + u.pn * 256 + bj * 128 + wc * 32 + 8 * fq, g0 * acc[ai][bj][m][0], g1 * acc[ai][bj][m][1]);
#endif
                }
    }
};
DEV void stage_merge_fast(const P& p, int l, int bid, int nb, unsigned char* lds, int wvx) {
    SchedMerge S{(const char*)(p.ws + OFF_MIX), (const char*)(p.ws + OFF_WTM) + (size_t)l * D * D * 2, nb, bid, TL / 256};
    EpiMerge E{p};
    pg::gemm_phase<EpiMerge, SchedMerge>((LAS unsigned char*)lds, S, E, D, wvx);
}
struct SchedOut {
    const char* a; const char* wt; int G, c, NM;
    static constexpr bool GATHER = false, FP8 = OUT_FP8 != 0; static constexpr int PERMC = XBF16 ? 1 : 0; static constexpr bool DYN = false, IDXL = false;
    static constexpr int NN = D / 256, DR = FP8 ? D / 2 : D;
    DEV bool next(int i, pg::Unit& u) const {
        const int Lt = i * G + c; if (Lt >= NM * NN) return false;
        pg::tile_from_L(Lt, NM, NN, u.pm, u.pn);
        u.kind = 0; u.nt = FP8 ? 8 : 16; u.perm = XBF16 ? 1 : 0; u.aMat = a + (size_t)u.pm * 256 * DR * 2; u.bBase = wt + (size_t)u.pn * 256 * DR * 2;
        return true;
    }
    DEV void aoff(const pg::Unit& u, const int tid, unsigned (&off)[2][2]) const {
        int R[2], C[2];
#pragma unroll
        for (int i = 0; i < 2; ++i) pg::stage_rc(tid * 16 + i * 8192, R[i], C[i]);
#pragma unroll
        for (int h = 0; h < 2; ++h)
#pragma unroll
            for (int i = 0; i < 2; ++i) off[h][i] = (unsigned)((u.pm * 256 + h * 128 + R[i]) * D + C[i]) * 2u;
    }
};
struct EpiOut {
    static constexpr bool HAS_MID = false, BIASL = false; static constexpr int NSTORE = 4; static constexpr float ACCS = OUT_FP8 ? 1.f / (QW * QM) : 1.f;
    const P& p; int l;
#if XBF16
    DEV void operator()(const f32x4 (&acc)[2][2][4][2], const pg::Unit& u, int wr, int wc, int fr, int fq) const {
        bf16_t* xr = (bf16_t*)(p.ws + OFF_XR);
        const int row00 = u.pm * 256; const int s = row_mod(row00);
        const float* g1 = modp(p, l, s, 2);
        const float* xin0 = row00 < TL ? p.x : p.ctx - (size_t)TL * D;
        float sq[8] = {0.f, 0.f, 0.f, 0.f, 0.f, 0.f, 0.f, 0.f};
#pragma unroll
        for (int bj = 0; bj < 2; ++bj) {
            const int c = u.pn * 256 + bj * 128 + wc * 32 + 8 * fq;
            const f32x4 gv0 = *(const f32x4*)(g1 + c), gv1 = *(const f32x4*)(g1 + c + 4);
#pragma unroll
            for (int ai = 0; ai < 2; ++ai) {
                f32x4 x0[4], x1[4];
#pragma unroll
                for (int m = 0; m < 4; ++m) { const size_t ro = (size_t)(row00 + ai * 128 + wr * 64 + m * 16 + fr) * D + c;
                    if (l == 0) { x0[m] = *(const f32x4*)(xin0 + ro); x1[m] = *(const f32x4*)(xin0 + ro + 4); }
                    else { const u32x4 w = *(const u32x4*)(xr + ro); x0[m] = bf4_to_f32((u32x2){w.x, w.y}); x1[m] = bf4_to_f32((u32x2){w.z, w.w}); } }
#pragma unroll
                for (int m = 0; m < 4; ++m) { const f32x4 a_ = x0[m] + gv0 * acc[ai][bj][m][0], b_ = x1[m] + gv1 * acc[ai][bj][m][1];
                    stg_bf16x8(xr + (size_t)(row00 + ai * 128 + wr * 64 + m * 16 + fr) * D + c, a_, b_);
                    sq[ai * 4 + m] += ((a_.x * a_.x + a_.y * a_.y) + (a_.z * a_.z + a_.w * a_.w)) + ((b_.x * b_.x + b_.y * b_.y) + (b_.z * b_.z + b_.w * b_.w)); }
            }
        }
        float* rowsq = (float*)(p.ws + OFF_ROWSQ);
#pragma unroll
        for (int i = 0; i < 8; ++i) { float v = sq[i]; v += __shfl_xor(v, 16); v += __shfl_xor(v, 32);
            if (fq == 0) rowsq[(size_t)(row00 + (i >> 2) * 128 + wr * 64 + (i & 3) * 16 + fr) * 16 + u.pn * 4 + wc] = v; }
    }
#else
    DEV void operator()(const f32x4 (&acc)[2][2][4][2], const pg::Unit& u, int wr, int wc, int fr, int fq) const {
        float* xr = (float*)(p.ws + OFF_XR);
        const int row00 = u.pm * 256; const int s = row_mod(row00);
        const float* g1 = modp(p, l, s, 2);
        const float* xbase = l == 0 ? (row00 < TL ? p.x : p.ctx - (size_t)TL * D) : xr;
        float sq[8] = {0.f, 0.f, 0.f, 0.f, 0.f, 0.f, 0.f, 0.f};
#pragma unroll
        for (int bj = 0; bj < 2; ++bj)
#pragma unroll
            for (int n = 0; n < 2; ++n) {
                const int c = u.pn * 256 + bj * 128 + wc * 32 + 16 * n + 4 * fq;
                const f32x4 gvn = *(const f32x4*)(g1 + c);
                f32x4 xin[8];
#pragma unroll
                for (int ai = 0; ai < 2; ++ai)
#pragma unroll
                    for (int m = 0; m < 4; ++m) xin[ai * 4 + m] = *(const f32x4*)(xbase + (size_t)(row00 + ai * 128 + wr * 64 + m * 16 + fr) * D + c);
#pragma unroll
                for (int ai = 0; ai < 2; ++ai)
#pragma unroll
                    for (int m = 0; m < 4; ++m) { const f32x4 xn = xin[ai * 4 + m] + gvn * acc[ai][bj][m][n];
                        *(f32x4*)(xr + (size_t)(row00 + ai * 128 + wr * 64 + m * 16 + fr) * D + c) = xn;
                        sq[ai * 4 + m] += (xn.x * xn.x + xn.y * xn.y) + (xn.z * xn.z + xn.w * xn.w); }
            }
        float* rowsq = (float*)(p.ws + OFF_ROWSQ);
#pragma unroll
        for (int i = 0; i < 8; ++i) { float v = sq[i]; v += __shfl_xor(v, 16); v += __shfl_xor(v, 32);
            if (fq == 0) rowsq[(size_t)(row00 + (i >> 2) * 128 + wr * 64 + (i & 3) * 16 + fr) * 16 + u.pn * 4 + wc] = v; }
    }
#endif
};
DEV void stage_out_fast(const P& p, int l, int bid, int nb, unsigned char* lds, int wvx) {
    SchedOut S{(const char*)(p.ws + OFF_M), OUT_FP8 ? (const char*)(p.ws + OFF_WTOQ) + (size_t)l * D * D : (const char*)(p.ws + OFF_WTO) + (size_t)l * D * D * 2, nb, bid, TL / 256};
    EpiOut E{p, l};
    pg::gemm_phase<EpiOut, SchedOut>((LAS unsigned char*)lds, S, E, SchedOut::DR, wvx);
}


DEV void stage_merge_ctx(const P& p, int l, int bid, int nb, unsigned char* lds_, int wvx) {
    const int tid_ = TID, lane = tid_ & 63, wave = tid_ >> 6, r16 = lane & 15, q4 = lane >> 4, grp = wave >> 2, part = wave & 3;
    const bf16_t* mix = (const bf16_t*)(p.ws + OFF_MIX); const bf16_t* wt = (const bf16_t*)(p.ws + OFF_WTM) + (size_t)l * D * D;
    const bf16_t* proj = (const bf16_t*)(p.ws + OFF_PROJ); bf16_t* mo = (bf16_t*)(p.ws + OFF_M);
    LAS float* red = (LAS float*)((LAS unsigned char*)lds_ + grp * 16384);
    constexpr int TN = D / 32, TM = TC / 32;
    for (int t0 = bid * 2; t0 < TM * TN; t0 += nb * 2) {
        const int t = t0 + grp; const bool on = t < TM * TN;
        const int tm = t / TN, tn = t % TN, row0 = TL + tm * 32, col0 = tn * 32;
        const int k0 = 256 * part, br = part < 2 ? 0 : part - 1;
        if (on) {
            f32x4 acc[2][2]; zero_acc(acc);
            mma_tile32(mix + (size_t)(row0 + r16) * D + k0 + 8 * q4, mix + (size_t)(row0 + 16 + r16) * D + k0 + 8 * q4,
                       wt + (size_t)(col0 + r16) * D + k0 + 8 * q4, wt + (size_t)(col0 + 16 + r16) * D + k0 + 8 * q4, 256, acc);
#pragma unroll
            for (int mt = 0; mt < 2; ++mt)
#pragma unroll
                for (int nt = 0; nt < 2; ++nt)
#pragma unroll
                    for (int j = 0; j < 4; ++j) {
                        const int row = row0 + 16 * mt + 4 * q4 + j, col = col0 + 16 * nt + r16;
                        red[part * 1024 + ((mt * 2 + nt) * 4 + j) * 64 + lane] = (G8 ? __builtin_amdgcn_exp2f((float)(p.ws + OFF_G8)[(size_t)row * 3072 + br * 1024 + (col & ~255) + ((col >> 5) & 3) * 64 + ((col >> 3) & 3) * 16 + ((col >> 7) & 1) * 8 + (col & 7)] * (-1.f / 32.f)) : bf2f(proj[(size_t)row * NIN + C_GA + br * 1024 + col])) * acc[mt][nt][j];
                    }
        }
        __syncthreads();
        if (on && part == 0) {
#pragma unroll
            for (int mt = 0; mt < 2; ++mt)
#pragma unroll
                for (int nt = 0; nt < 2; ++nt)
#pragma unroll
                    for (int j = 0; j < 4; ++j) { const int o = ((mt * 2 + nt) * 4 + j) * 64 + lane;
                        mo[(size_t)(row0 + 16 * mt + 4 * q4 + j) * D + col0 + 16 * nt + r16] = f2bf((red[o] + red[1024 + o]) + (red[2048 + o] + red[3072 + o])); }
        }
        __syncthreads();
    }
}
DEV void stage_out_ctx(const P& p, int l, int bid, int nb, unsigned char* lds_, int wvx) {
    const int tid_ = TID, lane = tid_ & 63, wave = tid_ >> 6, r16 = lane & 15, q4 = lane >> 4, grp = wave >> 2, part = wave & 3;
    const bf16_t* mo = (const bf16_t*)(p.ws + OFF_M); const bf16_t* wt = (const bf16_t*)(p.ws + OFF_WTO) + (size_t)l * D * D;
    float* xr = (float*)(p.ws + OFF_XR);
    LAS float* red = (LAS float*)((LAS unsigned char*)lds_ + grp * 16384);
    constexpr int TN = D / 32, TM = TC / 32;
    for (int t0 = bid * 2; t0 < TM * TN; t0 += nb * 2) {
        const int t = t0 + grp; const bool on = t < TM * TN;
        const int tm = t / TN, tn = t % TN, row0 = TL + tm * 32, col0 = tn * 32, k0 = 256 * part;
        if (on) {
            f32x4 acc[2][2]; zero_acc(acc);
            mma_tile32(mo + (size_t)(row0 + r16) * D + k0 + 8 * q4, mo + (size_t)(row0 + 16 + r16) * D + k0 + 8 * q4,
                       wt + (size_t)(col0 + r16) * D + k0 + 8 * q4, wt + (size_t)(col0 + 16 + r16) * D + k0 + 8 * q4, 256, acc);
#pragma unroll
            for (int mt = 0; mt < 2; ++mt)
#pragma unroll
                for (int nt = 0; nt < 2; ++nt)
#pragma unroll
                    for (int j = 0; j < 4; ++j) red[part * 1024 + ((mt * 2 + nt) * 4 + j) * 64 + lane] = acc[mt][nt][j];
        }
        __syncthreads();
        if (on && part == 0) {
#pragma unroll
            for (int mt = 0; mt < 2; ++mt)
#pragma unroll
                for (int nt = 0; nt < 2; ++nt)
#pragma unroll
                    for (int j = 0; j < 4; ++j) {
                        const int row = row0 + 16 * mt + 4 * q4 + j, col = col0 + 16 * nt + r16, o = ((mt * 2 + nt) * 4 + j) * 64 + lane;
                        { const float xv_ = p.ctx[(size_t)(row - TL) * D + col] + modp(p, l, 2, 2)[col] * ((red[o] + red[1024 + o]) + (red[2048 + o] + red[3072 + o]));
                          if (XBF16) ((bf16_t*)xr)[(size_t)row * D + col] = f2bf(xv_); else xr[(size_t)row * D + col] = xv_; }
                    }
        }
        __syncthreads();
    }
}

constexpr size_t OFF_SPREV = OFF_ACT;
DEV void chunk_chain(int cidx, int& b, int& nf, int& nbk) {
    if (cidx < 256) { b = cidx >> 7; const int nl = cidx & 127; nf = 2 + nl; nbk = 2 + (127 - nl); }
    else { const int cc = cidx - 256; b = cc >> 1; const int nc = cc & 1; nf = nc; nbk = 1 - nc; }
}
constexpr int RKV_S = 160, RKV_F = 0, RKV_B = 128 * RKV_S;
DEV void stage_ret_kv(const P& p, int l, int bid, int nb, unsigned char* lds_, int wvx) {
    const int tid_ = TID, lane = tid_ & 63, wave = tid_ >> 6, r16 = lane & 15, q4 = lane >> 4;
    LAS unsigned char* lds = (LAS unsigned char*)lds_;
    const bf16_t* proj = (const bf16_t*)(p.ws + OFF_PROJ); const bf16_t* projT = (const bf16_t*)(p.ws + OFF_PROJT); float* kvbuf = (float*)(p.ws + OFF_KV);
    const float* wtab = (const float*)(p.ws + OFF_TABW) + (size_t)(l * 2) * 4 * 128;
    const int nunits = 260 * 4;
    u32x4 pre[2];
#define RKV_LOAD(unit_) do { const int row0_ = ((unit_) >> 2) * 128, h_ = (unit_) & 3; _Pragma("unroll") for (int i_ = 0; i_ < 2; ++i_) { const int pc = tid_ + 512 * i_; \
        pre[i_] = *(const u32x4*)(proj + (size_t)(row0_ + (pc >> 3)) * NIN + C_RK + h_ * 64 + (pc & 7) * 8); } } while (0)
    if (bid < nunits) RKV_LOAD(bid);
    for (int unit = bid; unit < nunits; unit += nb) {
        const int cidx = unit >> 2, h = unit & 3, row0 = cidx * 128;
        __syncthreads();
#pragma unroll
        for (int i = 0; i < 2; ++i) {
            const int pc = tid_ + 512 * i, j = pc >> 3;
            const float wf = wtab[(0 * 4 + h) * 128 + j], wb = wtab[(1 * 4 + h) * 128 + j];
            const unsigned w4[4] = {pre[i].x, pre[i].y, pre[i].z, pre[i].w};
            u32x4 of, ob; unsigned rf[4], rb[4];
#pragma unroll
            for (int k = 0; k < 4; ++k) { const float lo = bf2f((bf16_t)(w4[k] & 0xffff)), hi = bf2f((bf16_t)(w4[k] >> 16)); rf[k] = pk2(lo * wf, hi * wf); rb[k] = pk2(lo * wb, hi * wb); }
            of.x = rf[0]; of.y = rf[1]; of.z = rf[2]; of.w = rf[3]; ob.x = rb[0]; ob.y = rb[1]; ob.z = rb[2]; ob.w = rb[3];
            *(LAS u32x4*)(lds + RKV_F + j * RKV_S + (pc & 7) * 16) = of;
            *(LAS u32x4*)(lds + RKV_B + j * RKV_S + (pc & 7) * 16) = ob;
        }
        __syncthreads();
        if (unit + nb < nunits) RKV_LOAD(unit + nb);
        const int dir = wave >> 2, quad = wave & 3, e0 = (quad >> 1) * 32, d0 = (quad & 1) * 32;
        int b, nf, nbk; chunk_chain(cidx, b, nf, nbk);
        const bf16_t* va = projT + (size_t)(T_RV + h * 64 + e0 + r16) * TA + row0 + 8 * q4;
        const LAS unsigned char* kimg = lds + (dir ? RKV_B : RKV_F) + (8 * q4 + (r16 >> 2)) * RKV_S + (d0 + 4 * (r16 & 3)) * 2;
        f32x4 acc[2][2]; zero_acc(acc);
#pragma unroll
        for (int ks = 0; ks < 4; ++ks) {
            const bf16x8 fa0 = *(const bf16x8*)(va + 32 * ks), fa1 = *(const bf16x8*)(va + (size_t)16 * TA + 32 * ks);
            bf16x8 fb[2];
#pragma unroll
            for (int nt = 0; nt < 2; ++nt) {
                const u32x2 lo = lds_tr16(kimg + 32 * ks * RKV_S + 32 * nt), hi = lds_tr16(kimg + (32 * ks + 4) * RKV_S + 32 * nt);
                u32x4 w; w.x = lo.x; w.y = lo.y; w.z = hi.x; w.w = hi.y; fb[nt] = __builtin_bit_cast(bf16x8, w);
            }
            acc[0][0] = __builtin_amdgcn_mfma_f32_16x16x32_bf16(fa0, fb[0], acc[0][0], 0, 0, 0);
            acc[0][1] = __builtin_amdgcn_mfma_f32_16x16x32_bf16(fa0, fb[1], acc[0][1], 0, 0, 0);
            acc[1][0] = __builtin_amdgcn_mfma_f32_16x16x32_bf16(fa1, fb[0], acc[1][0], 0, 0, 0);
            acc[1][1] = __builtin_amdgcn_mfma_f32_16x16x32_bf16(fa1, fb[1], acc[1][1], 0, 0, 0);
        }
        float* dst = kvbuf + ((size_t)(((b * 4 + h) * 2 + dir) * 130 + (dir ? nbk : nf))) * 4096;
#pragma unroll
        for (int mt = 0; mt < 2; ++mt)
#pragma unroll
            for (int nt = 0; nt < 2; ++nt)
#pragma unroll
                for (int j = 0; j < 4; ++j) dst[(e0 + 16 * mt + 4 * q4 + j) * 64 + d0 + 16 * nt + r16] = acc[mt][nt][j];
    }
    __syncthreads();
#undef RKV_LOAD
}
DEV void stage_ret_scan(const P& p, int l, int bid, int nb, int wvx) {
    const float* kvbuf = (const float*)(p.ws + OFF_KV); unsigned* sprev = (unsigned*)(p.ws + OFF_SPREV);
    for (int gt = bid * NTHREADS + TID; gt < 16 * 2048; gt += nb * NTHREADS) {
        const int chain = gt >> 11, i2 = gt & 2047, h = (chain >> 1) & 3, dir = chain & 1;
        const float gC = __expf(128.f * log_g(p, l, dir, h));
        const f32x2* src = (const f32x2*)(kvbuf + (size_t)chain * 130 * 4096) + i2; unsigned* dst = sprev + (size_t)chain * 130 * 2048 + i2;
        f32x2 s = (f32x2){0.f, 0.f};
        for (int n0 = 0; n0 < 130; n0 += 10) {
            f32x2 kv[10];
#pragma unroll
            for (int u = 0; u < 10; ++u) kv[u] = src[(size_t)(n0 + u) * 2048];
#pragma unroll
            for (int u = 0; u < 10; ++u) { dst[(size_t)(n0 + u) * 2048] = pk2(s.x, s.y); s = s * gC + kv[u]; }
        }
    }
}
DEV bf16x8 pack_b(const f32x4 a, const f32x4 b) {
    u32x4 w; w.x = pk2(a[0], a[1]); w.y = pk2(a[2], a[3]); w.z = pk2(b[0], b[1]); w.w = pk2(b[2], b[3]);
    return __builtin_bit_cast(bf16x8, w);
}
DEV bf16x8 ldv_frag(const bf16_t* rowp  , int q4) {
    const u32x2 a = *(const u32x2*)(rowp + 4 * q4), b = *(const u32x2*)(rowp + 16 + 4 * q4);
    u32x4 w; w.x = a.x; w.y = a.y; w.z = b.x; w.w = b.y; return __builtin_bit_cast(bf16x8, w);
}
constexpr int RO_K = 0, RO_V = 128 * 144, RO_S = RO_V + 64 * 272, RO_END = RO_S + 2 * 64 * 144;
DEV void stage_ret_out(const P& p, int l, int bid, int nb, unsigned char* lds_, int wvx) {
    const int tid_ = TID, lane = tid_ & 63, wave = tid_ >> 6, r16 = lane & 15, q4 = lane >> 4;
    LAS unsigned char* lds = (LAS unsigned char*)lds_;
    const bf16_t* proj = (const bf16_t*)(p.ws + OFF_PROJ); const bf16_t* projT = (const bf16_t*)(p.ws + OFF_PROJT);
    const bf16_t* sprev = (const bf16_t*)(p.ws + OFF_SPREV); bf16_t* mix = (bf16_t*)(p.ws + OFF_MIX);
    const int nunits = (l == 0 ? 260 : 256) * 4;
    u32x4 pre[6];
#define RO_LOAD(unit_) do { const int cidx_ = (unit_) >> 2, h_ = (unit_) & 3, row0_ = cidx_ * 128; int b_, nf_, nbk_; chunk_chain(cidx_, b_, nf_, nbk_); \
        _Pragma("unroll") for (int i_ = 0; i_ < 2; ++i_) { const int pc = tid_ + 512 * i_; \
            pre[i_] = *(const u32x4*)(proj + (size_t)(row0_ + (pc >> 3)) * NIN + C_RK + h_ * 64 + (pc & 7) * 8); \
            pre[2 + i_] = *(const u32x4*)(projT + (size_t)(T_RV + h_ * 64 + (pc >> 4)) * TA + row0_ + (pc & 15) * 8); \
            const int dir_ = pc >> 9, pp = pc & 511; \
            pre[4 + i_] = *(const u32x4*)(sprev + ((size_t)(((b_ * 4 + h_) * 2 + dir_) * 130 + (dir_ ? nbk_ : nf_))) * 4096 + (pp >> 3) * 64 + (pp & 7) * 8); } } while (0)
#define RO_WRITE() do { _Pragma("unroll") for (int i_ = 0; i_ < 2; ++i_) { const int pc = tid_ + 512 * i_; \
            *(LAS u32x4*)(lds + RO_K + (pc >> 3) * 144 + (pc & 7) * 16) = pre[i_]; \
            *(LAS u32x4*)(lds + RO_V + (pc >> 4) * 272 + (pc & 15) * 16) = pre[2 + i_]; \
            const int dir_ = pc >> 9, pp = pc & 511; \
            *(LAS u32x4*)(lds + RO_S + dir_ * 64 * 144 + (pp >> 3) * 144 + (pp & 7) * 16) = pre[4 + i_]; } } while (0)
    for (int unit = bid; unit < nunits; unit += nb) {
        RO_LOAD(unit);
        __syncthreads();
        RO_WRITE();
        __syncthreads();
        const int cidx = unit >> 2, h = unit & 3, row0 = cidx * 128;
        const int irow = row0 + 16 * wave + r16, ii = 16 * wave + r16;
        const float lgf = log_g(p, l, 0, h), lgb = log_g(p, l, 1, h);
        bf16x8 qf[2];
#pragma unroll
        for (int ks = 0; ks < 2; ++ks) qf[ks] = *(const bf16x8*)(proj + (size_t)irow * NIN + C_RQ + h * 64 + 32 * ks + 8 * q4);
        f32x4 st[8];
#pragma unroll
        for (int mt = 0; mt < 8; ++mt) {
            st[mt] = (f32x4){0.f, 0.f, 0.f, 0.f};
#pragma unroll
            for (int ks = 0; ks < 2; ++ks) {
                const bf16x8 kf = *(const LAS bf16x8*)(lds + RO_K + (16 * mt + r16) * 144 + ks * 64 + q4 * 16);
                st[mt] = __builtin_amdgcn_mfma_f32_16x16x32_bf16(kf, qf[ks], st[mt], 0, 0, 0);
            }
        }
        float outv[4][4];
#pragma unroll
        for (int mt = 0; mt < 4; ++mt)
#pragma unroll
            for (int jj = 0; jj < 4; ++jj) outv[mt][jj] = 0.f;
#pragma nounroll
        for (int dir = 0; dir < 2; ++dir) {
            const float lg = dir ? lgb : lgf;
            f32x4 y[4];
#pragma unroll
            for (int mt = 0; mt < 4; ++mt) {
                y[mt] = (f32x4){0.f, 0.f, 0.f, 0.f};
#pragma unroll
                for (int ks = 0; ks < 2; ++ks) {
                    const bf16x8 sf = *(const LAS bf16x8*)(lds + RO_S + dir * 64 * 144 + (16 * mt + r16) * 144 + ks * 64 + q4 * 16);
                    y[mt] = __builtin_amdgcn_mfma_f32_16x16x32_bf16(sf, qf[ks], y[mt], 0, 0, 0);
                }
            }
            const float cs = __expf(lg * (float)(dir ? 128 - ii : ii + 1));
#pragma unroll
            for (int mt = 0; mt < 4; ++mt) y[mt] = y[mt] * cs;
#pragma unroll
            for (int s = 0; s < 4; ++s) {
                f32x4 pa, pb;
#pragma unroll
                for (int jj = 0; jj < 4; ++jj) {
                    const int ja = 32 * s + 4 * q4 + jj, jb = ja + 16;
                    const int da = dir ? ja - ii : ii - ja, db = dir ? jb - ii : ii - jb;
                    pa[jj] = da >= 0 ? st[2 * s][jj] * __expf(lg * (float)da) : 0.f;
                    pb[jj] = db >= 0 ? st[2 * s + 1][jj] * __expf(lg * (float)db) : 0.f;
                }
                const bf16x8 pf = pack_b(pa, pb);
#pragma unroll
                for (int mt = 0; mt < 4; ++mt) {
                    const LAS unsigned char* vp = lds + RO_V + (16 * mt + r16) * 272 + (32 * s + 4 * q4) * 2;
                    const u32x2 va = *(const LAS u32x2*)vp, vb = *(const LAS u32x2*)(vp + 32);
                    u32x4 vw; vw.x = va.x; vw.y = va.y; vw.z = vb.x; vw.w = vb.y;
                    y[mt] = __builtin_amdgcn_mfma_f32_16x16x32_bf16(__builtin_bit_cast(bf16x8, vw), pf, y[mt], 0, 0, 0);
                }
            }
            float sm = 0.f;
#pragma unroll
            for (int mt = 0; mt < 4; ++mt) sm += (y[mt][0] + y[mt][1]) + (y[mt][2] + y[mt][3]);
            sm += __shfl_xor(sm, 16); sm += __shfl_xor(sm, 32);
            const float mu = sm * (1.f / 64.f); float qv = 0.f;
#pragma unroll
            for (int mt = 0; mt < 4; ++mt) { const f32x4 dd = y[mt] - mu; qv += (dd[0] * dd[0] + dd[1] * dd[1]) + (dd[2] * dd[2] + dd[3] * dd[3]); }
            qv += __shfl_xor(qv, 16); qv += __shfl_xor(qv, 32);
            const float rs = rsqrtf(qv * (1.f / 64.f) + 1e-5f);
#pragma unroll
            for (int mt = 0; mt < 4; ++mt) {
                const f32x4 g = ld_bf16x4(proj + (size_t)irow * NIN + (dir ? C_RGB : C_RGF) + h * 64 + 16 * mt + 4 * q4);
#pragma unroll
                for (int jj = 0; jj < 4; ++jj) outv[mt][jj] += (y[mt][jj] - mu) * rs * g[jj];
            }
        }
#pragma unroll
        for (int mt = 0; mt < 4; ++mt) { u32x2 w; w.x = pk2(outv[mt][0], outv[mt][1]); w.y = pk2(outv[mt][2], outv[mt][3]);
            *(u32x2*)(mix + (size_t)irow * D + MX_RET + h * 64 + 16 * mt + 4 * q4) = w; }
    }
    __syncthreads();
#undef RO_LOAD
#undef RO_WRITE
}

#ifndef ATT_THR
#define ATT_THR 11.5f
#endif
constexpr int AT_K = 0, AT_V = 128 * 144, AT_VS = 160, AT_END = AT_V + 128 * AT_VS;
DEV void stage_attn_fast(const P& p, int l, int bid, int nb, unsigned char* lds_, int wvx) {
    const int tid_ = TID, lane = tid_ & 63, wave = tid_ >> 6, r16 = lane & 15, q4 = lane >> 4;
    LAS unsigned char* lds = (LAS unsigned char*)lds_;
    const bf16_t* proj = (const bf16_t*)(p.ws + OFF_PROJ); const bf16_t* projT = (const bf16_t*)(p.ws + OFF_PROJT); bf16_t* mix = (bf16_t*)(p.ws + OFF_MIX);
    constexpr int BIG = 1 << 20;
    constexpr int NQT = 4;
    for (int it = bid; it < (l == 0 ? 520 : 512); it += nb) {
        const int grp = it, g = wave >> 1, hq = wave & 1;
        int hk, qrow0, cbase, nblk = -1, lbase = 0;
        if (grp < 512) { const int b = grp >> 8; nblk = (grp >> 1) & 127; hk = grp & 1; lbase = b * L; qrow0 = lbase + nblk * 128 + 64 * hq; cbase = TL + b * LC; }
        else { const int gg = grp - 512, cb = gg >> 2, qb = (gg >> 1) & 1; hk = gg & 1; qrow0 = TL + cb * LC + qb * 128 + 64 * hq; cbase = TL + cb * LC; }
        const int h = hk * 4 + g;
        bf16x8 qf[NQT][2];
#pragma unroll
        for (int nt = 0; nt < NQT; ++nt)
#pragma unroll
            for (int ks = 0; ks < 2; ++ks) qf[nt][ks] = *(const bf16x8*)(proj + (size_t)(qrow0 + 16 * nt + r16) * NIN + C_Q + h * 64 + 32 * ks + 8 * q4);
        const float sink = p.sinks[l * 8 + h] * LOG2E;
        float mrun[NQT], lrun[NQT];
#pragma unroll
        for (int nt = 0; nt < NQT; ++nt) { mrun[nt] = sink; lrun[nt] = (q4 == 0) ? 1.f : 0.f; }
        f32x4 o[4][NQT];
#pragma unroll
        for (int mt = 0; mt < 4; ++mt)
#pragma unroll
            for (int nt = 0; nt < NQT; ++nt) o[mt][nt] = (f32x4){0.f, 0.f, 0.f, 0.f};
        u32x4 pre[4];
#define AT_CHUNK_OK(c) ((c) == 0 ? nblk >= 1 : (c) == 1 ? nblk >= 0 : (c) == 2 ? (nblk >= 0 && nblk < 127) : true)
#define AT_CHUNK_ROW(c) ((c) < 3 ? lbase + (nblk - 1 + (c)) * 128 : cbase + ((c) - 3) * 128)
#define AT_LOAD(c) do { const int kr_ = AT_CHUNK_ROW(c); _Pragma("unroll") for (int i_ = 0; i_ < 2; ++i_) { const int pc = tid_ + 512 * i_; \
            pre[i_] = *(const u32x4*)(proj + (size_t)(kr_ + (pc >> 3)) * NIN + C_K + hk * 64 + (pc & 7) * 8); \
            pre[2 + i_] = *(const u32x4*)(proj + (size_t)(kr_ + (pc >> 3)) * NIN + C_V + hk * 64 + (pc & 7) * 8); } } while (0)
#define AT_WRITE() do { _Pragma("unroll") for (int i_ = 0; i_ < 2; ++i_) { const int pc = tid_ + 512 * i_; \
            *(LAS u32x4*)(lds + AT_K + (pc >> 3) * 144 + (pc & 7) * 16) = pre[i_]; \
            *(LAS u32x4*)(lds + AT_V + (pc >> 3) * AT_VS + (pc & 7) * 16) = pre[2 + i_]; } } while (0)
        int c = 0; while (c < 5 && !AT_CHUNK_OK(c)) ++c;
        if (c < 5) AT_LOAD(c);
        while (c < 5) {
            int cn = c + 1; while (cn < 5 && !AT_CHUNK_OK(cn)) ++cn;
            __syncthreads();
            AT_WRITE();
            __syncthreads();
            if (cn < 5) AT_LOAD(cn);
            const int clo = c == 0 ? 0 : -BIG, chi = c == 2 ? 0 : BIG;
            const int sb0 = c == 0 ? 2 * hq : 0, sb1 = c == 2 ? 2 * hq + 1 : 3;
            for (int sb = sb0; sb <= sb1; ++sb) {
                const int dl0 = 32 * sb - 64 * hq;
                f32x4 sa[2][NQT];
#pragma unroll
                for (int mt = 0; mt < 2; ++mt) {
                    bf16x8 kf[2];
#pragma unroll
                    for (int ks = 0; ks < 2; ++ks) kf[ks] = *(const LAS bf16x8*)(lds + AT_K + (32 * sb + 16 * mt + r16) * 144 + ks * 64 + q4 * 16);
#pragma unroll
                    for (int nt = 0; nt < NQT; ++nt) {
                        sa[mt][nt] = (f32x4){0.f, 0.f, 0.f, 0.f};
#pragma unroll
                        for (int ks = 0; ks < 2; ++ks) sa[mt][nt] = __builtin_amdgcn_mfma_f32_16x16x32_bf16(kf[ks], qf[nt][ks], sa[mt][nt], 0, 0, 0);
                    }
                }
                bf16x8 pf[NQT];
                float lmax[NQT];
                if (c == 0 || c == 2) {
#pragma unroll
                    for (int nt = 0; nt < NQT; ++nt) {
                        float bm = -1e30f;
#pragma unroll
                        for (int mt = 0; mt < 2; ++mt)
#pragma unroll
                            for (int jj = 0; jj < 4; ++jj) {
                                const int dl = dl0 + 16 * mt + 4 * q4 + jj - (16 * nt + r16);
                                const float sv = (dl >= clo && dl <= chi) ? sa[mt][nt][jj] : -1e30f;
                                sa[mt][nt][jj] = sv; bm = fmaxf(bm, sv);
                            }
                        lmax[nt] = bm;
                    }
                } else {
#pragma unroll
                    for (int nt = 0; nt < NQT; ++nt)
                        lmax[nt] = fmaxf(fmaxf(fmaxf(sa[0][nt][0], sa[0][nt][1]), fmaxf(sa[0][nt][2], sa[0][nt][3])), fmaxf(fmaxf(sa[1][nt][0], sa[1][nt][1]), fmaxf(sa[1][nt][2], sa[1][nt][3])));
                }
                bool need = false;
#pragma unroll
                for (int nt = 0; nt < NQT; ++nt) need = need || (lmax[nt] > mrun[nt] + ATT_THR);
                if (__any(need)) {
#pragma unroll
                    for (int nt = 0; nt < NQT; ++nt) {
                        float bm = lmax[nt];
                        bm = fmaxf(bm, __shfl_xor(bm, 16)); bm = fmaxf(bm, __shfl_xor(bm, 32));
                        const float mn = fmaxf(mrun[nt], bm), sc = __builtin_amdgcn_exp2f(mrun[nt] - mn);
                        mrun[nt] = mn; lrun[nt] *= sc;
#pragma unroll
                        for (int mt = 0; mt < 4; ++mt) o[mt][nt] = o[mt][nt] * sc;
                    }
                }
#pragma unroll
                for (int nt = 0; nt < NQT; ++nt) {
                    float ps = 0.f;
#pragma unroll
                    for (int mt = 0; mt < 2; ++mt)
#pragma unroll
                        for (int jj = 0; jj < 4; ++jj) { const float pe = __builtin_amdgcn_exp2f(sa[mt][nt][jj] - mrun[nt]); sa[mt][nt][jj] = pe; ps += pe; }
                    lrun[nt] += ps;
                    pf[nt] = pack_b(sa[0][nt], sa[1][nt]);
                }
#pragma unroll
                for (int mt = 0; mt < 4; ++mt) {
                    const LAS unsigned char* vp = lds + AT_V + (32 * sb + 4 * q4 + (r16 >> 2)) * AT_VS + (16 * mt + 4 * (r16 & 3)) * 2;
                    const u32x2 va = lds_tr16(vp), vb = lds_tr16(vp + 16 * AT_VS);
                    u32x4 vw; vw.x = va.x; vw.y = va.y; vw.z = vb.x; vw.w = vb.y;
                    const bf16x8 vf = __builtin_bit_cast(bf16x8, vw);
#pragma unroll
                    for (int nt = 0; nt < NQT; ++nt) o[mt][nt] = __builtin_amdgcn_mfma_f32_16x16x32_bf16(vf, pf[nt], o[mt][nt], 0, 0, 0);
                }
            }
            c = cn;
        }
#undef AT_CHUNK_OK
#undef AT_CHUNK_ROW
#undef AT_LOAD
#undef AT_WRITE
#pragma unroll
        for (int nt = 0; nt < NQT; ++nt) {
            float lt = lrun[nt]; lt += __shfl_xor(lt, 16); lt += __shfl_xor(lt, 32);
            const float inv = 1.f / lt;
#pragma unroll
            for (int mt = 0; mt < 4; ++mt) { const f32x4 v = o[mt][nt] * inv; u32x2 w; w.x = pk2(v[0], v[1]); w.y = pk2(v[2], v[3]);
                *(u32x2*)(mix + (size_t)(qrow0 + 16 * nt + r16) * D + MX_ATTN + h * 64 + 16 * mt + 4 * q4) = w; }
        }
    }
    __syncthreads();
}

#define XB_TMO      128
#define XB_XCNT(j)  (256  + 64 * (j))
#define XB_XSUB(j)  (1280 + 64 * (j))
#define XB_XGEN(j)  (2304 + 64 * (j))
#define XB_TOP      3328
#define XB_TOPGEN   3392
#define XCD_BAR_WORDS 3456
#define XB_SPIN_CAP (1u << 18)
__device__ __forceinline__ unsigned xb_ld(unsigned* p)              { return __hip_atomic_load(p, __ATOMIC_RELAXED, __HIP_MEMORY_SCOPE_AGENT); }
__device__ __forceinline__ unsigned xb_add(unsigned* p, unsigned v) { return __hip_atomic_fetch_add(p, v, __ATOMIC_RELAXED, __HIP_MEMORY_SCOPE_AGENT); }
__device__ __forceinline__ unsigned xb_xcc_id() { return (unsigned)__builtin_amdgcn_s_getreg((3 << 11) | 20) & 0xFu; }
#define XB_SPIN(cond, bar) do { unsigned _sp = 0; while (cond) { __builtin_amdgcn_s_sleep(1); \
    if ((++_sp & 255u) == 0u) { if (xb_ld(&(bar)[XB_TMO])) break; if (_sp > XB_SPIN_CAP) { atomicAdd(&(bar)[XB_TMO], 1u); break; } } } } while (0)
struct XcdBarrier { unsigned* bar; unsigned x; volatile LAS unsigned* st; };
__device__ __forceinline__ XcdBarrier xcd_barrier_post(unsigned* bar, volatile LAS unsigned* st, const int wvx) {
    XcdBarrier b; b.bar = bar; b.x = xb_xcc_id(); b.st = st;
    if (TID == 0) (void)xb_add(&bar[XB_XCNT(b.x)], 1u);
    return b;
}
__device__ __forceinline__ void xcd_barrier_complete(unsigned* bar, unsigned x, unsigned& nloc, unsigned& nx) {
    const unsigned G = gridDim.x * gridDim.y * gridDim.z;
    unsigned sum, cnt, mine, sp = 0u;
    for (;;) {
        sum = 0u; cnt = 0u; mine = 0u;
#pragma unroll
        for (unsigned j = 0; j < 16; ++j) { const unsigned c = xb_ld(&bar[XB_XCNT(j)]); sum += c; cnt += (c > 0u) ? 1u : 0u; mine = (j == x) ? c : mine; }
        if (sum == G) break;
        __builtin_amdgcn_s_sleep(1);
        if ((++sp & 255u) == 0u) { if (xb_ld(&bar[XB_TMO])) break; if (sp > XB_SPIN_CAP) { atomicAdd(&bar[XB_TMO], 1u); break; } }
    }
    nloc = mine > 0u ? mine : 1u; nx = cnt > 0u ? cnt : 1u;
}
__device__ __forceinline__ void xcd_barrier(const XcdBarrier& b, const int wvx) {
    asm volatile("s_waitcnt vmcnt(0)" ::: "memory");
    __syncthreads();
    if (TID == 0) {
        unsigned* bar = b.bar;
        __builtin_amdgcn_s_waitcnt(0);
        unsigned nloc = b.st[0], nx = b.st[1];
        if (nloc == 0u) { xcd_barrier_complete(bar, b.x, nloc, nx); b.st[0] = nloc; b.st[1] = nx; }
        const unsigned old = xb_add(&bar[XB_XSUB(b.x)], 1u);
        const unsigned gen = old / nloc;
        if (old + 1u == (gen + 1u) * nloc) {
            __builtin_amdgcn_fence(__ATOMIC_RELEASE, "agent");
            asm volatile("s_waitcnt vmcnt(0)" ::: "memory");
            const unsigned og = xb_add(&bar[XB_TOP], 1u);
            const unsigned tg = og / nx;
            if (og + 1u == (tg + 1u) * nx) xb_add(&bar[XB_TOPGEN], 1u);
            else XB_SPIN(xb_ld(&bar[XB_TOPGEN]) == tg, bar);
            __builtin_amdgcn_fence(__ATOMIC_ACQUIRE, "agent");
            xb_add(&bar[XB_XGEN(b.x)], 1u);
            asm volatile("s_waitcnt vmcnt(0)" ::: "memory");
        } else {
            XB_SPIN(xb_ld(&bar[XB_XGEN(b.x)]) == gen, bar);
            __builtin_amdgcn_fence(__ATOMIC_ACQUIRE, "agent");
            asm volatile("s_waitcnt vmcnt(0)" ::: "memory");
        }
    }
    __syncthreads();
}

constexpr int NPL = 10;
constexpr int NPHASES = 2 + 2 * NPL;
constexpr int CW_BAR = 4096;
constexpr int LDS_BARW = LDS_BYTES - 16;
__global__ void __launch_bounds__(NTHREADS, 2) mk_fwd(P p) {
    extern __shared__ __attribute__((aligned(16))) unsigned char lds[];
    const int bid = blockIdx.x, nb = gridDim.x;
    const int wvx = __builtin_amdgcn_readfirstlane((int)(threadIdx.x >> 6));
    if (TID == 0) { ((volatile LAS unsigned*)(lds + LDS_BARW))[0] = 0u; ((volatile LAS unsigned*)(lds + LDS_BARW))[1] = 0u; }
    __syncthreads();
    const bool multi = (p.ph_hi - p.ph_lo) > 1;
    XcdBarrier bar; bar.bar = (unsigned*)(p.ws + OFF_CTL) + CW_BAR; bar.x = 0; bar.st = (volatile LAS unsigned*)(lds + LDS_BARW);
    if (multi) bar = xcd_barrier_post((unsigned*)(p.ws + OFF_CTL) + CW_BAR, (volatile LAS unsigned*)(lds + LDS_BARW), wvx);
#define IN(k) (p.ph_lo <= (k) && (k) < p.ph_hi)
#define STAGE(call) do { const P& q = p; const int ll = l; call; } while (0)
#define SEAM(k) do { if (IN(k) && IN((k) + 1)) xcd_barrier(bar, wvx); } while (0)
#ifndef PHMASK
#define PHMASK 0xFFFF
#endif
#define PHON(b) ((PHMASK >> (b)) & 1)
#ifndef DUPMASK
#define DUPMASK 0
#endif
#define DUPN(b) (1 + ((DUPMASK >> (b)) & 1))
    if (PHON(0) && IN(0)) { const int l = 0; for (int r_ = 0; r_ < DUPN(0); ++r_) { STAGE(stage_prep(q, bid, nb, lds, wvx)); __syncthreads(); } } SEAM(0);
    if (PHON(1) && IN(1)) { const int l = 0; STAGE(stage_norm0(q, bid, nb, wvx)); } SEAM(1);
    { constexpr int l = 0; const int pb = 2 + l * NPL;
        if (PHON(2) && IN(pb + 0)) { for (int r_ = 0; r_ < DUPN(2); ++r_) { STAGE(stage_inproj_fast(q, ll, bid, nb, lds, wvx)); __syncthreads(); } } SEAM(pb + 0);
        if (PHON(3) && IN(pb + 1)) { for (int r_ = 0; r_ < DUPN(3); ++r_) { if (l == 0) { if (bid >= 8) STAGE(stage_ret_kv(q, ll, bid - 8, nb - 8, lds, wvx)); } else STAGE(stage_ret_kv(q, ll, bid, nb, lds, wvx));     STAGE(stage_attn_fast(q, ll, bid, nb, lds, wvx)); __syncthreads(); } } SEAM(pb + 1);
        if (PHON(4) && IN(pb + 2)) { for (int r_ = 0; r_ < DUPN(4); ++r_) { if (bid < 64) STAGE(stage_ret_scan(q, ll, bid, 64, wvx)); else STAGE(stage_pool_diff(q, ll, bid - 64, nb - 64, wvx));     __syncthreads(); } } SEAM(pb + 2);
        if (PHON(5) && IN(pb + 3)) { for (int r_ = 0; r_ < DUPN(5); ++r_) { STAGE(stage_ret_out(q, ll, bid, nb, lds, wvx)); __syncthreads(); } } SEAM(pb + 3);
        if (PHON(6) && IN(pb + 4)) { for (int r_ = 0; r_ < DUPN(6); ++r_) { STAGE(stage_merge_fast(q, ll, bid, nb, lds, wvx)); if (l == 0) STAGE(stage_merge_ctx(q, ll, bid, nb, lds, wvx)); __syncthreads(); } } SEAM(pb + 4);
        if (PHON(7) && IN(pb + 5)) { STAGE(stage_out_fast(q, ll, bid, nb, lds, wvx)); if (l == 0) STAGE(stage_out_ctx(q, ll, bid, nb, lds, wvx)); } SEAM(pb + 5);
        if (PHON(8) && IN(pb + 6)) { if (INP_FP8 != 2 || NCONV_ == 0) { STAGE(stage_prep_experts(q, ll, bid, nb, lds, wvx)); __syncthreads(); } if (ROUTE_MFMA) STAGE(stage_route_mfma(q, ll, bid, nb, lds, wvx)); else STAGE(stage_route(q, ll, bid, nb, lds, wvx)); } SEAM(pb + 6);
        if (PHON(9) && IN(pb + 7)) { for (int r_ = 0; r_ < DUPN(9); ++r_) { STAGE(stage_moe1_fast(q, ll, bid, nb, lds, wvx)); __syncthreads(); } } SEAM(pb + 7);
        if (PHON(10) && IN(pb + 8)) { for (int r_ = 0; r_ < DUPN(10); ++r_) { STAGE(stage_moe2_fast(q, ll, bid, nb, lds, wvx)); __syncthreads(); } } SEAM(pb + 8);
        if (PHON(11) && IN(pb + 9)) { STAGE(stage_combine(q, ll, bid, nb, lds, wvx)); } SEAM(pb + 9);
     }
    { constexpr int l = 1; const int pb = 2 + l * NPL;
        if (PHON(2) && IN(pb + 0)) { for (int r_ = 0; r_ < DUPN(2); ++r_) { STAGE(stage_inproj_fast(q, ll, bid, nb, lds, wvx)); __syncthreads(); } } SEAM(pb + 0);
        if (PHON(3) && IN(pb + 1)) { for (int r_ = 0; r_ < DUPN(3); ++r_) { if (l == 0) { if (bid >= 8) STAGE(stage_ret_kv(q, ll, bid - 8, nb - 8, lds, wvx)); } else STAGE(stage_ret_kv(q, ll, bid, nb, lds, wvx));     STAGE(stage_attn_fast(q, ll, bid, nb, lds, wvx)); __syncthreads(); } } SEAM(pb + 1);
        if (PHON(4) && IN(pb + 2)) { for (int r_ = 0; r_ < DUPN(4); ++r_) { if (bid < 64) STAGE(stage_ret_scan(q, ll, bid, 64, wvx)); else STAGE(stage_pool_diff(q, ll, bid - 64, nb - 64, wvx));     __syncthreads(); } } SEAM(pb + 2);
        if (PHON(5) && IN(pb + 3)) { for (int r_ = 0; r_ < DUPN(5); ++r_) { STAGE(stage_ret_out(q, ll, bid, nb, lds, wvx)); __syncthreads(); } } SEAM(pb + 3);
        if (PHON(6) && IN(pb + 4)) { for (int r_ = 0; r_ < DUPN(6); ++r_) { STAGE(stage_merge_fast(q, ll, bid, nb, lds, wvx)); if (l == 0) STAGE(stage_merge_ctx(q, ll, bid, nb, lds, wvx)); __syncthreads(); } } SEAM(pb + 4);
        if (PHON(7) && IN(pb + 5)) { STAGE(stage_out_fast(q, ll, bid, nb, lds, wvx)); if (l == 0) STAGE(stage_out_ctx(q, ll, bid, nb, lds, wvx)); } SEAM(pb + 5);
        if (PHON(8) && IN(pb + 6)) { if (INP_FP8 != 2 || NCONV_ == 0) { STAGE(stage_prep_experts(q, ll, bid, nb, lds, wvx)); __syncthreads(); } if (ROUTE_MFMA) STAGE(stage_route_mfma(q, ll, bid, nb, lds, wvx)); else STAGE(stage_route(q, ll, bid, nb, lds, wvx)); } SEAM(pb + 6);
        if (PHON(9) && IN(pb + 7)) { for (int r_ = 0; r_ < DUPN(9); ++r_) { STAGE(stage_moe1_fast(q, ll, bid, nb, lds, wvx)); __syncthreads(); } } SEAM(pb + 7);
        if (PHON(10) && IN(pb + 8)) { for (int r_ = 0; r_ < DUPN(10); ++r_) { STAGE(stage_moe2_fast(q, ll, bid, nb, lds, wvx)); __syncthreads(); } } SEAM(pb + 8);
        if (PHON(11) && IN(pb + 9)) { STAGE(stage_combine(q, ll, bid, nb, lds, wvx)); } SEAM(pb + 9);
     }
#undef IN
#undef SEAM
}

#ifndef MK_CUTS
#define MK_CUTS 1
#endif
extern "C" void kernel_launch(void* const* d_in, const int* in_sizes, int n_in, void* d_out, int out_size, void* d_ws, size_t ws_size, hipStream_t stream) {
    static int grid = 0;
    if (grid == 0) {
        if (n_in != 24 || out_size != TL * D || ws_size < WS_END) { fprintf(stderr, "kernel_launch: unexpected shapes: n_in %d out %d ws %zu (need %zu)\n", n_in, out_size, ws_size, (size_t)WS_END); grid = -1; return; }
        int dev = 0, cus = 0, per_cu = 0;
        if (hipGetDevice(&dev) != hipSuccess || hipDeviceGetAttribute(&cus, hipDeviceAttributeMultiprocessorCount, dev) != hipSuccess) { grid = -1; return; }
        if (hipFuncSetAttribute((const void*)mk_fwd, hipFuncAttributeMaxDynamicSharedMemorySize, LDS_BYTES) != hipSuccess) { fprintf(stderr, "kernel_launch: hipFuncSetAttribute failed\n"); grid = -1; return; }
        if (hipOccupancyMaxActiveBlocksPerMultiprocessor(&per_cu, (const void*)mk_fwd, NTHREADS, LDS_BYTES) != hipSuccess || per_cu < 1) { fprintf(stderr, "kernel_launch: occupancy query says %d blocks per CU\n", per_cu); (void)hipGetLastError(); }
        grid = cus > 0 ? cus : 256;
    }
    if (grid < 0) return;
    (void)hipMemsetAsync((char*)d_ws + OFF_CTL, 0, CTL_BYTES, stream);
    P p; memset(&p, 0, sizeof(p));
    const float** f = (const float**)&p;
    for (int i = 0; i < 24; ++i) f[i] = (const float*)d_in[i];
    p.out = (float*)d_out; p.ws = (unsigned char*)d_ws;
    for (int i = 0; i < 32; ++i) p.inv_ret[i] = 1.0 / pow(10000.0, (double)((float)i / 31.0f));
    for (int i = 0; i < 16; ++i) p.inv_ax[i] = pow(10000.0, -(double)(2 * i) / 32.0);
#if MK_CUTS
    p.ph_lo = 0; p.ph_hi = NPHASES;
    hipLaunchKernelGGL(mk_fwd, dim3(grid), dim3(NTHREADS), LDS_BYTES, stream, p);
#else
    for (int ph = 0; ph < NPHASES; ++ph) { p.ph_lo = ph; p.ph_hi = ph + 1; hipLaunchKernelGGL(mk_fwd, dim3(grid), dim3(NTHREADS), LDS_BYTES, stream, p); }
#endif
}
```
